# Optimizing an MI355X kernel written in HIP

```python
import jax, jax.numpy as jnp
from jax import lax
import numpy as np

D_MODEL = 2048
BATCH = 4
SEQ = 8192
DEPTH = 1

D_CONV = 1024
CONV_K = 3
N_HEADS = 16
N_KV_HEADS = 4
HEAD_DIM = 64
D_ATTN = N_HEADS * HEAD_DIM
D_KV = N_KV_HEADS * HEAD_DIM
D_MIX = D_CONV + D_ATTN
D_IN = 3 * D_CONV + D_ATTN + 2 * D_KV
WINDOW = 128
ATTN_BLOCK = 128
N_GROUPS = 4
EXPERTS_PER_GROUP = 8
N_EXPERTS = N_GROUPS * EXPERTS_PER_GROUP
TOP_K = 2
D_EXPERT = 512
MOE_BLOCK = 256
PLE_DIM = 256
EPS = 1e-6
NEG_INF = -1e30

kernel_name = "hymba_conv_swa_hiermoe_ple"


def rms_norm(x, g):
    xf = x.astype(jnp.float32)
    y = xf * lax.rsqrt(jnp.mean(xf * xf, axis=-1, keepdims=True) + EPS)
    return (y * g.astype(jnp.float32)).astype(x.dtype)


def short_conv_mixer(b_gate, c_gate, hc, conv_w):
    u = c_gate * hc
    z = lax.conv_general_dilated(
        u, conv_w[:, None, :].astype(u.dtype), window_strides=(1,),
        padding=[(CONV_K - 1, 0)], dimension_numbers=('NWC', 'WIO', 'NWC'),
        feature_group_count=D_CONV)
    return b_gate * z


def sliding_window_attention(q, k, v, sinks, slopes):
    bsz, seq = q.shape[0], q.shape[1]
    nb = seq // ATTN_BLOCK
    grp = N_HEADS // N_KV_HEADS
    qb = q.reshape(bsz, nb, ATTN_BLOCK, N_KV_HEADS, grp, HEAD_DIM)

    def band(t):
        tb = t.reshape(bsz, nb, ATTN_BLOCK, N_KV_HEADS, HEAD_DIM)
        prev = jnp.pad(tb[:, :-1], ((0, 0), (1, 0), (0, 0), (0, 0), (0, 0)))
        return jnp.concatenate([prev, tb], axis=2)

    kb, vb = band(k), band(v)
    s = jnp.einsum('bnqkgd,bnskd->bnkgqs', qb, kb,
                   preferred_element_type=jnp.float32) * (HEAD_DIM ** -0.5)
    qi = jnp.arange(ATTN_BLOCK)[:, None]
    sj = jnp.arange(2 * ATTN_BLOCK)[None, :]
    dist = ATTN_BLOCK + qi - sj
    in_window = (dist >= 0) & (dist < WINDOW)
    key_exists = (jnp.arange(nb)[:, None] > 0) | (sj >= ATTN_BLOCK)
    mask = in_window[None, :, :] & key_exists[:, None, :]
    m_h = slopes.astype(jnp.float32).reshape(N_KV_HEADS, grp, 1, 1)
    alibi = -m_h * dist.astype(jnp.float32)
    s = jnp.where(mask[None, :, None, None], s + alibi, NEG_INF)
    sink = sinks.astype(jnp.float32).reshape(N_KV_HEADS, grp, 1, 1)
    m = jnp.maximum(jnp.max(s, axis=-1, keepdims=True), sink)
    pr = jnp.exp(s - m)
    denom = jnp.sum(pr, axis=-1, keepdims=True) + jnp.exp(sink - m)
    pr = pr / denom
    o = jnp.einsum('bnkgqs,bnskd->bnqkgd', pr, vb.astype(jnp.float32))
    return o.reshape(bsz, seq, D_ATTN).astype(q.dtype)


def hierarchical_moe(x, w_group, b_group, w_router, b_router, w_gate, w_up, w_down):
    bsz, seq, d = x.shape
    n = bsz * seq
    xt = x.reshape(n, d)
    group_probs = jax.nn.softmax((xt @ w_group).astype(jnp.float32) + b_group.astype(jnp.float32), axis=-1)
    g_w, g_idx = lax.top_k(group_probs, 1)
    g_w, g_idx = g_w[:, 0], g_idx[:, 0]
    expert_logits = ((xt @ w_router).astype(jnp.float32) + b_router.astype(jnp.float32))
    expert_logits = expert_logits.reshape(n, N_GROUPS, EXPERTS_PER_GROUP)
    within = expert_logits[jnp.arange(n), g_idx]
    within_probs = jax.nn.softmax(within, axis=-1)
    top_w, top_local = lax.top_k(within_probs, TOP_K)
    top_w = top_w / jnp.sum(top_w, axis=-1, keepdims=True)
    weights = g_w[:, None] * top_w
    expert_id = g_idx[:, None] * EXPERTS_PER_GROUP + top_local

    a = n * TOP_K
    e_flat = expert_id.reshape(a).astype(jnp.int32)
    tok_flat = jnp.repeat(jnp.arange(n, dtype=jnp.int32), TOP_K)
    w_flat = weights.reshape(a)
    order = jnp.argsort(e_flat)
    e_sorted, tok_sorted, w_sorted = e_flat[order], tok_flat[order], w_flat[order]
    counts = jax.ops.segment_sum(jnp.ones((a,), jnp.int32), e_flat, num_segments=N_EXPERTS)
    starts = jnp.cumsum(counts) - counts
    padded = (counts + MOE_BLOCK - 1) // MOE_BLOCK * MOE_BLOCK
    pad_ends = jnp.cumsum(padded)
    pad_starts = pad_ends - padded
    dest = pad_starts[e_sorted] + (jnp.arange(a, dtype=jnp.int32) - starts[e_sorted])
    n_rows = a + N_EXPERTS * MOE_BLOCK
    n_blocks = n_rows // MOE_BLOCK
    row_tok = jnp.zeros((n_rows,), jnp.int32).at[dest].set(tok_sorted)
    row_w = jnp.zeros((n_rows,), jnp.float32).at[dest].set(w_sorted)
    block_e = jnp.searchsorted(pad_ends, jnp.arange(n_blocks, dtype=jnp.int32) * MOE_BLOCK, side='right')
    block_e = jnp.minimum(block_e, N_EXPERTS - 1)

    def expert_block(args):
        e, toks, ws = args
        xb = xt[toks]
        hidden = jax.nn.silu(xb @ w_gate[e]) * (xb @ w_up[e])
        y = hidden @ w_down[e]
        return y * ws[:, None].astype(y.dtype)

    y = lax.map(expert_block, (block_e, row_tok.reshape(n_blocks, MOE_BLOCK),
                               row_w.reshape(n_blocks, MOE_BLOCK)))
    out = jax.ops.segment_sum(y.reshape(n_rows, d), row_tok, num_segments=n)
    return out.reshape(bsz, seq, d)


def setup_inputs(seed: int = 0) -> dict:
    key = jax.random.key(seed)
    ks = jax.random.split(key, 24)
    f32 = jnp.float32

    def nrm(k, shape, scale):
        return jax.random.normal(k, shape, f32) * scale

    def gain(k, shape):
        return 1.0 + 0.02 * jax.random.normal(k, shape, f32)

    L = DEPTH
    return {
        "x": nrm(ks[0], (BATCH, SEQ, D_MODEL), 1.0),
        "p": nrm(ks[1], (DEPTH, BATCH, SEQ, PLE_DIM), 1.0),
        "norm_mix": gain(ks[2], (L, D_MODEL)),
        "w_in": nrm(ks[3], (L, D_MODEL, D_IN), D_MODEL ** -0.5),
        "conv_w": nrm(ks[4], (L, CONV_K, D_CONV), CONV_K ** -0.5),
        "q_norm": gain(ks[5], (L, HEAD_DIM)),
        "k_norm": gain(ks[6], (L, HEAD_DIM)),
        "sinks": nrm(ks[7], (L, N_HEADS), 0.5),
        "out_norm_conv": gain(ks[8], (L, D_CONV)),
        "out_norm_attn": gain(ks[9], (L, D_ATTN)),
        "w_out": nrm(ks[10], (L, D_MIX, D_MODEL), D_MIX ** -0.5),
        "norm_ffn": gain(ks[11], (L, D_MODEL)),
        "w_group": nrm(ks[12], (L, D_MODEL, N_GROUPS), D_MODEL ** -0.5),
        "b_group": nrm(ks[13], (L, N_GROUPS), 0.01),
        "w_router": nrm(ks[14], (L, D_MODEL, N_EXPERTS), D_MODEL ** -0.5),
        "b_router": nrm(ks[15], (L, N_EXPERTS), 0.01),
        "w_gate": nrm(ks[16], (L, N_EXPERTS, D_MODEL, D_EXPERT), D_MODEL ** -0.5),
        "w_up": nrm(ks[17], (L, N_EXPERTS, D_MODEL, D_EXPERT), D_MODEL ** -0.5),
        "w_down": nrm(ks[18], (L, N_EXPERTS, D_EXPERT, D_MODEL), D_EXPERT ** -0.5),
        "norm_ple": gain(ks[19], (L, D_MODEL)),
        "w_ple_gate": nrm(ks[20], (L, D_MODEL, D_MODEL), D_MODEL ** -0.5),
        "w_ple": nrm(ks[21], (L, PLE_DIM, D_MODEL), PLE_DIM ** -0.5),
    }


def reference(x, p, norm_mix, w_in, conv_w, q_norm, k_norm, sinks, out_norm_conv,
              out_norm_attn, w_out, norm_ffn, w_group, b_group, w_router, b_router,
              w_gate, w_up, w_down, norm_ple, w_ple_gate, w_ple):
    bsz, seq, _ = x.shape
    slopes = 2.0 ** (-8.0 * jnp.arange(1, N_HEADS + 1, dtype=jnp.float32) / N_HEADS)
    split_at = [D_CONV, 2 * D_CONV, 3 * D_CONV, 3 * D_CONV + D_ATTN, 3 * D_CONV + D_ATTN + D_KV]
    h = x
    for i in range(DEPTH):
        xn = rms_norm(h, norm_mix[i])
        proj = xn @ w_in[i]
        b_g, c_g, hc, q, k, v = jnp.split(proj, split_at, axis=-1)
        y_conv = short_conv_mixer(b_g, c_g, hc, conv_w[i])
        q = rms_norm(q.reshape(bsz, seq, N_HEADS, HEAD_DIM), q_norm[i])
        k = rms_norm(k.reshape(bsz, seq, N_KV_HEADS, HEAD_DIM), k_norm[i])
        v = v.reshape(bsz, seq, N_KV_HEADS, HEAD_DIM)
        y_attn = sliding_window_attention(q, k, v, sinks[i], slopes)
        mixed = jnp.concatenate([rms_norm(y_conv, out_norm_conv[i]),
                                 rms_norm(y_attn, out_norm_attn[i])], axis=-1)
        h = h + mixed @ w_out[i]
        h = h + hierarchical_moe(rms_norm(h, norm_ffn[i]), w_group[i], b_group[i],
                                 w_router[i], b_router[i], w_gate[i], w_up[i], w_down[i])
        gate = jax.nn.sigmoid(rms_norm(h, norm_ple[i]) @ w_ple_gate[i])
        h = h + gate * (p[i] @ w_ple[i])
    return h
```

```cpp
#include <hip/hip_runtime.h>
#include <cstdio>
#include <cstdint>

typedef unsigned short bf16;
typedef unsigned v4u __attribute__((ext_vector_type(4)));
typedef float f32x4 __attribute__((ext_vector_type(4)));

constexpr int BATCH = 4, SEQ = 8192, D = 2048, M = BATCH * SEQ;
constexpr int DCONV = 1024, NH = 16, NKV = 4, HD = 64, DATTN = 1024, DKV = 256, DIN = 4608;
constexpr int C_B = 0, C_C = 1024, C_HC = 2048, C_Q = 3072, C_K = 4096, C_V = 4352;
constexpr int NGRP = 4, EPG = 8, NE = 32, DEXP = 512, PLE = 256, NRT = 36;
constexpr float EPS = 1e-6f;

constexpr size_t MiB = 1u << 20;
constexpr size_t WS_CTL = 0;
constexpr size_t WS_WIN = 2 * MiB;
constexpr size_t WS_WOUT = 20 * MiB;
constexpr size_t WS_WPLG = 28 * MiB;
constexpr size_t WS_WPLE = 36 * MiB;
constexpr size_t WS_WR = 37 * MiB;
constexpr size_t WS_RSX = 38 * MiB;
constexpr size_t WS_RS1 = 38 * MiB + 256 * 1024;
constexpr size_t WS_RS2 = 38 * MiB + 512 * 1024;
constexpr size_t WS_EID = 39 * MiB;
constexpr size_t WS_EW = 39 * MiB + 512 * 1024;
constexpr size_t WS_LOG = 42 * MiB;
constexpr size_t WS_WGU = 64 * MiB;
constexpr size_t WS_WD = 192 * MiB;
constexpr size_t WS_XB = 256 * MiB;
constexpr size_t WS_MIX = WS_XB;
constexpr size_t WS_PB = 384 * MiB;
constexpr size_t WS_PROJ = 400 * MiB;
constexpr size_t WS_HID = 400 * MiB;
constexpr size_t WS_PW = 480 * MiB;
constexpr size_t WS_H1 = 688 * MiB;
constexpr size_t WS_H2 = 816 * MiB;
constexpr size_t WS_YA = 816 * MiB;
constexpr size_t WS_YC = 944 * MiB;
constexpr size_t WS_END = 944 * MiB;

__device__ __forceinline__ float bf2f(bf16 v) { return __uint_as_float(((unsigned)v) << 16); }
__device__ __forceinline__ bf16 f2bf(float f) { unsigned u = __float_as_uint(f); return (bf16)((u + 0x7fffu + ((u >> 16) & 1u)) >> 16); }
__device__ __forceinline__ float wsum(float v) {
#pragma unroll
    for (int o = 32; o > 0; o >>= 1) v += __shfl_xor(v, o);
    return v;
}
__device__ __forceinline__ void unpack8(v4u w, float* f) {
    f[0] = __uint_as_float(w.x << 16); f[1] = __uint_as_float(w.x & 0xffff0000u);
    f[2] = __uint_as_float(w.y << 16); f[3] = __uint_as_float(w.y & 0xffff0000u);
    f[4] = __uint_as_float(w.z << 16); f[5] = __uint_as_float(w.z & 0xffff0000u);
    f[6] = __uint_as_float(w.w << 16); f[7] = __uint_as_float(w.w & 0xffff0000u);
}

struct Ptrs {
    const float *x, *p, *norm_mix, *w_in, *conv_w, *q_norm, *k_norm, *sinks, *onc, *ona, *w_out, *norm_ffn, *w_group, *b_group, *w_router, *b_router,
        *w_gate, *w_up, *w_down, *norm_ple, *w_ple_gate, *w_ple;
    float* out; unsigned char* ws;
};

namespace nv {
struct RmId { __device__ int operator()(int n) const { return n; } };
struct RmOff { int off; __device__ int operator()(int n) const { return n + off; } };
struct RmGate { __device__ int operator()(int n) const { return (n >> 7) * 256 + (n & 127); } };
struct RmUp { __device__ int operator()(int n) const { return (n >> 7) * 256 + 128 + (n & 127); } };
template <class RM> __global__ void __launch_bounds__(256) wt(const float* W, int K, int N, const float* g0, const float* g1, int gsplit, bf16* WT, RM rm, size_t wstride, size_t tstride) {
    const size_t i = blockIdx.x * (size_t)blockDim.x + threadIdx.x; if (i >= (size_t)K * N) return;
    const int n = (int)(i / K), k = (int)(i % K);
    const float* Wz = W + blockIdx.y * wstride; bf16* Tz = WT + blockIdx.y * tstride;
    const float g = g0 ? (k < gsplit ? g0[k] : g1[k - gsplit]) : 1.f;
    Tz[(size_t)rm(n) * K + k] = f2bf(g * Wz[(size_t)k * N + n]);
}
__global__ void __launch_bounds__(256) zero_rows(bf16* p, size_t n) { const size_t i = blockIdx.x * (size_t)blockDim.x + threadIdx.x; if (i < n) p[i] = 0; }
__global__ void __launch_bounds__(256) rowcvt(const float* x, bf16* xb, float* rs) {
    const int lane = threadIdx.x & 63; const int row = blockIdx.x * 4 + (threadIdx.x >> 6); if (row >= M) return;
    float s = 0.f;
    for (int c = lane; c < D; c += 64) { const float v = x[(size_t)row * D + c]; s += v * v; xb[(size_t)row * D + c] = f2bf(v); }
    s = wsum(s); if (lane == 0) rs[row] = 1.0f / sqrtf(s / D + EPS);
}
__global__ void __launch_bounds__(256) cvt(const float* p, bf16* pb, size_t n) { const size_t i = blockIdx.x * (size_t)blockDim.x + threadIdx.x; if (i < n) pb[i] = f2bf(p[i]); }
__global__ void __launch_bounds__(256) rowrs(const bf16* h, float* rs) {
    const int lane = threadIdx.x & 63; const int row = blockIdx.x * 4 + (threadIdx.x >> 6); if (row >= M) return;
    float s = 0.f;
    for (int c = lane; c < D; c += 64) { const float v = bf2f(h[(size_t)row * D + c]); s += v * v; }
    s = wsum(s); if (lane == 0) rs[row] = 1.0f / sqrtf(s / D + EPS);
}
template <int K, int NC, class AP, class BP, class EP>
__global__ void __launch_bounds__(256) gemm(long nrows, long ncols_, AP ap, BP bp, EP ep) {
    const int ncols = (int)ncols_;
    const int lane = threadIdx.x & 63; const long wave = blockIdx.x * 4L + (threadIdx.x >> 6);
    const int ngrp = ncols / NC; if (wave >= nrows * ngrp) return;
    const long r = wave / ngrp; const int c0 = (int)(wave % ngrp) * NC;
    constexpr int NCH = (K + 511) / 512;
    float a[NCH][8];
    const bf16* A = ap(r);
#pragma unroll
    for (int ch = 0; ch < NCH; ++ch) { const int k = ch * 512 + lane * 8;
        if (k < K) unpack8(*(const v4u*)(A + k), a[ch]); else { for (int j = 0; j < 8; ++j) a[ch][j] = 0.f; } }
    float res[NC];
#pragma unroll
    for (int c = 0; c < NC; ++c) {
        const bf16* B = bp(r, c0 + c); float s = 0.f;
#pragma unroll
        for (int ch = 0; ch < NCH; ++ch) { const int k = ch * 512 + lane * 8;
            if (k < K) { float b[8]; unpack8(*(const v4u*)(B + k), b);
#pragma unroll
                for (int j = 0; j < 8; ++j) s += a[ch][j] * b[j]; } }
        res[c] = wsum(s);
    }
    if (lane == 0) {
#pragma unroll
        for (int c = 0; c < NC; ++c) ep(r, c0 + c, res[c], res[c ^ 1]);
    }
}
__global__ void __launch_bounds__(256) conv(const bf16* proj, const float* cw, bf16* mixed) {
    const int lane = threadIdx.x & 63; const int row = blockIdx.x * 4 + (threadIdx.x >> 6); if (row >= M) return;
    const int t = row % SEQ; float y[16]; float ss = 0.f;
#pragma unroll
    for (int j = 0; j < 16; ++j) {
        const int ch = lane * 16 + j; const bf16* pr = proj + (size_t)row * DIN;
        const float b = bf2f(pr[C_B + ch]);
        const float u0 = bf2f(pr[C_C + ch]) * bf2f(pr[C_HC + ch]);
        const float u1 = t >= 1 ? bf2f(pr[C_C + ch - DIN]) * bf2f(pr[C_HC + ch - DIN]) : 0.f;
        const float u2 = t >= 2 ? bf2f(pr[C_C + ch - 2 * DIN]) * bf2f(pr[C_HC + ch - 2 * DIN]) : 0.f;
        y[j] = b * (cw[ch] * u2 + cw[DCONV + ch] * u1 + cw[2 * DCONV + ch] * u0); ss += y[j] * y[j];
    }
    ss = wsum(ss); const float rstd = 1.0f / sqrtf(ss / DCONV + EPS);
#pragma unroll
    for (int j = 0; j < 16; ++j) mixed[(size_t)row * D + lane * 16 + j] = f2bf(y[j] * rstd);
}
__global__ void __launch_bounds__(256) attn(const bf16* proj, const float* qn, const float* kn, const float* sinks, float* ya) {
    const int lane = threadIdx.x & 63; const long wave = blockIdx.x * 4L + (threadIdx.x >> 6); if (wave >= (long)M * NH) return;
    const int row = (int)(wave / NH), h = (int)(wave % NH), kvh = h / (NH / NKV), t = row % SEQ;
    float q = bf2f(proj[(size_t)row * DIN + C_Q + h * HD + lane]);
    const float rq = 1.0f / sqrtf(wsum(q * q) / HD + EPS); q = q * rq * qn[lane];
    const float gk = kn[lane]; const float slope = exp2f(-0.5f * (float)(h + 1)); const float sink = sinks[h];
    float m = sink, l = 1.f, o = 0.f;
    const int s0 = t >= 127 ? t - 127 : 0;
    for (int s = s0; s <= t; ++s) {
        const size_t kr = (size_t)(row - (t - s)) * DIN;
        const float k = bf2f(proj[kr + C_K + kvh * HD + lane]); const float v = bf2f(proj[kr + C_V + kvh * HD + lane]);
        const float kk = wsum(k * k); const float rk = 1.0f / sqrtf(kk / HD + EPS);
        const float dot = wsum(q * k * gk) * rk;
        const float sc = dot * 0.125f - slope * (float)(t - s);
        const float mn = fmaxf(m, sc); const float f = __expf(m - mn), pe = __expf(sc - mn);
        l = l * f + pe; o = o * f + pe * v; m = mn;
    }
    ya[(size_t)row * DATTN + h * HD + lane] = o / l;
}
__global__ void __launch_bounds__(256) attnnorm(const float* ya, bf16* mixed) {
    const int lane = threadIdx.x & 63; const int row = blockIdx.x * 4 + (threadIdx.x >> 6); if (row >= M) return;
    float y[16]; float ss = 0.f;
#pragma unroll
    for (int j = 0; j < 16; ++j) { y[j] = ya[(size_t)row * DATTN + lane * 16 + j]; ss += y[j] * y[j]; }
    ss = wsum(ss); const float rstd = 1.0f / sqrtf(ss / DATTN + EPS);
#pragma unroll
    for (int j = 0; j < 16; ++j) mixed[(size_t)row * D + DCONV + lane * 16 + j] = f2bf(y[j] * rstd);
}
__global__ void __launch_bounds__(256) topk(const float* logits, int* eid, float* ew) {
    const int row = blockIdx.x * blockDim.x + threadIdx.x; if (row >= M) return;
    const float* L = logits + (size_t)row * 64;
    int g = 0; float gm = L[0];
    for (int j = 1; j < NGRP; ++j) if (L[j] > gm) { gm = L[j]; g = j; }
    float gs = 0.f; for (int j = 0; j < NGRP; ++j) gs += __expf(L[j] - gm);
    const float gw = 1.0f / gs;
    const float* E = L + NGRP + g * EPG;
    int i1 = 0; float v1 = E[0];
    for (int j = 1; j < EPG; ++j) if (E[j] > v1) { v1 = E[j]; i1 = j; }
    int i2 = -1; float v2 = -3.0e38f;
    for (int j = 0; j < EPG; ++j) if (j != i1 && E[j] > v2) { v2 = E[j]; i2 = j; }
    const float e2 = __expf(v2 - v1); const float w1 = 1.0f / (1.0f + e2), w2 = e2 / (1.0f + e2);
    eid[row * 2] = g * EPG + i1; eid[row * 2 + 1] = g * EPG + i2; ew[row * 2] = gw * w1; ew[row * 2 + 1] = gw * w2;
}
}

template <class K, class... Args> static void launch1d(K kern, size_t nthreads, int bs, hipStream_t s, Args... args) {
    hipLaunchKernelGGL(kern, dim3((unsigned)((nthreads + bs - 1) / bs)), dim3(bs), 0, s, args...);
}

extern "C" void kernel_launch(void* const* d_in, const int* in_sizes, int n_in, void* d_out, int out_size, void* d_ws, size_t ws_size, hipStream_t stream) {
    if (n_in != 22 || ws_size < WS_END) { fprintf(stderr, "kernel_launch: unexpected n_in %d / ws %zu\n", n_in, ws_size); return; }
    Ptrs P{};
    const float** pp = (const float**)&P;
    for (int i = 0; i < 22; ++i) pp[i] = (const float*)d_in[i];
    P.out = (float*)d_out; P.ws = (unsigned char*)d_ws;
    unsigned char* ws = P.ws;
    bf16* Win = (bf16*)(ws + WS_WIN); bf16* Wout = (bf16*)(ws + WS_WOUT); bf16* Wplg = (bf16*)(ws + WS_WPLG); bf16* Wple = (bf16*)(ws + WS_WPLE);
    bf16* Wr = (bf16*)(ws + WS_WR); bf16* Wgu = (bf16*)(ws + WS_WGU); bf16* Wd = (bf16*)(ws + WS_WD);
    bf16* xb = (bf16*)(ws + WS_XB); bf16* mixed = (bf16*)(ws + WS_MIX); bf16* pb = (bf16*)(ws + WS_PB); bf16* proj = (bf16*)(ws + WS_PROJ);
    bf16* hid = (bf16*)(ws + WS_HID); bf16* pw = (bf16*)(ws + WS_PW); bf16* h1 = (bf16*)(ws + WS_H1); bf16* h2 = (bf16*)(ws + WS_H2);
    float* rsx = (float*)(ws + WS_RSX); float* rs1 = (float*)(ws + WS_RS1); float* rs2 = (float*)(ws + WS_RS2);
    int* eid = (int*)(ws + WS_EID); float* ew = (float*)(ws + WS_EW); float* logits = (float*)(ws + WS_LOG); float* ya = (float*)(ws + WS_YA);
    const float* nul = nullptr;
    hipLaunchKernelGGL(nv::wt<nv::RmId>, dim3((unsigned)(((size_t)D * DIN + 255) / 256), 1), dim3(256), 0, stream, P.w_in, D, DIN, P.norm_mix, nul, D, Win, nv::RmId{}, (size_t)0, (size_t)0);
    hipLaunchKernelGGL(nv::wt<nv::RmId>, dim3((unsigned)(((size_t)D * D + 255) / 256), 1), dim3(256), 0, stream, P.w_out, D, D, P.onc, P.ona, DCONV, Wout, nv::RmId{}, (size_t)0, (size_t)0);
    hipLaunchKernelGGL(nv::wt<nv::RmId>, dim3((unsigned)(((size_t)D * D + 255) / 256), 1), dim3(256), 0, stream, P.w_ple_gate, D, D, P.norm_ple, nul, D, Wplg, nv::RmId{}, (size_t)0, (size_t)0);
    hipLaunchKernelGGL(nv::wt<nv::RmId>, dim3((unsigned)(((size_t)PLE * D + 255) / 256), 1), dim3(256), 0, stream, P.w_ple, PLE, D, nul, nul, 0, Wple, nv::RmId{}, (size_t)0, (size_t)0);
    hipLaunchKernelGGL(nv::wt<nv::RmId>, dim3((unsigned)(((size_t)D * NGRP + 255) / 256), 1), dim3(256), 0, stream, P.w_group, D, NGRP, P.norm_ffn, nul, D, Wr, nv::RmId{}, (size_t)0, (size_t)0);
    hipLaunchKernelGGL(nv::wt<nv::RmOff>, dim3((unsigned)(((size_t)D * NE + 255) / 256), 1), dim3(256), 0, stream, P.w_router, D, NE, P.norm_ffn, nul, D, Wr, nv::RmOff{NGRP}, (size_t)0, (size_t)0);
    launch1d(nv::zero_rows, (size_t)(256 - NRT) * D, 256, stream, Wr + (size_t)NRT * D, (size_t)(256 - NRT) * D);
    hipLaunchKernelGGL(nv::wt<nv::RmGate>, dim3((unsigned)(((size_t)D * DEXP + 255) / 256), NE), dim3(256), 0, stream, P.w_gate, D, DEXP, P.norm_ffn, nul, D, Wgu, nv::RmGate{}, (size_t)D * DEXP, (size_t)1024 * D);
    hipLaunchKernelGGL(nv::wt<nv::RmUp>, dim3((unsigned)(((size_t)D * DEXP + 255) / 256), NE), dim3(256), 0, stream, P.w_up, D, DEXP, P.norm_ffn, nul, D, Wgu, nv::RmUp{}, (size_t)D * DEXP, (size_t)1024 * D);
    hipLaunchKernelGGL(nv::wt<nv::RmId>, dim3((unsigned)(((size_t)DEXP * D + 255) / 256), NE), dim3(256), 0, stream, P.w_down, DEXP, D, nul, nul, 0, Wd, nv::RmId{}, (size_t)DEXP * D, (size_t)D * DEXP);
    hipLaunchKernelGGL(nv::rowcvt, dim3(M / 4), dim3(256), 0, stream, P.x, xb, rsx);
    launch1d(nv::cvt, (size_t)M * PLE, 256, stream, P.p, pb, (size_t)M * PLE);
    { auto ap = [=] __device__(long r) { return xb + (size_t)r * D; };
      auto bp = [=] __device__(long r, int c) { return Win + (size_t)c * D; };
      auto ep = [=] __device__(long r, int c, float v, float vo) { proj[(size_t)r * DIN + c] = f2bf(v * rsx[r]); };
      hipLaunchKernelGGL((nv::gemm<D, 8, decltype(ap), decltype(bp), decltype(ep)>), dim3((unsigned)((size_t)M * (DIN / 8) / 4)), dim3(256), 0, stream, (long)M, (long)DIN, ap, bp, ep); }
    hipLaunchKernelGGL(nv::conv, dim3(M / 4), dim3(256), 0, stream, proj, P.conv_w, mixed);
    hipLaunchKernelGGL(nv::attn, dim3((unsigned)((size_t)M * NH / 4)), dim3(256), 0, stream, proj, P.q_norm, P.k_norm, P.sinks, ya);
    hipLaunchKernelGGL(nv::attnnorm, dim3(M / 4), dim3(256), 0, stream, ya, mixed);
    { const float* x = P.x;
      auto ap = [=] __device__(long r) { return mixed + (size_t)r * D; };
      auto bp = [=] __device__(long r, int c) { return Wout + (size_t)c * D; };
      auto ep = [=] __device__(long r, int c, float v, float vo) { h1[(size_t)r * D + c] = f2bf(x[(size_t)r * D + c] + v); };
      hipLaunchKernelGGL((nv::gemm<D, 8, decltype(ap), decltype(bp), decltype(ep)>), dim3((unsigned)((size_t)M * (D / 8) / 4)), dim3(256), 0, stream, (long)M, (long)D, ap, bp, ep); }
    hipLaunchKernelGGL(nv::rowrs, dim3(M / 4), dim3(256), 0, stream, h1, rs1);
    { const float* bg = P.b_group; const float* br = P.b_router;
      auto ap = [=] __device__(long r) { return h1 + (size_t)r * D; };
      auto bp = [=] __device__(long r, int c) { return Wr + (size_t)c * D; };
      auto ep = [=] __device__(long r, int c, float v, float vo) { logits[(size_t)r * 64 + c] = v * rs1[r] + (c < NGRP ? bg[c] : br[c - NGRP]); };
      hipLaunchKernelGGL((nv::gemm<D, 4, decltype(ap), decltype(bp), decltype(ep)>), dim3((unsigned)((size_t)M * (NRT / 4) / 4)), dim3(256), 0, stream, (long)M, (long)NRT, ap, bp, ep); }
    launch1d(nv::topk, (size_t)M, 256, stream, logits, eid, ew);
    { auto ap = [=] __device__(long r) { return h1 + (size_t)(r >> 1) * D; };
      auto bp = [=] __device__(long r, int c) { const int e = eid[r]; const int f = c >> 1; const int rowi = (f >> 7) * 256 + (c & 1) * 128 + (f & 127); return Wgu + ((size_t)e * 1024 + rowi) * D; };
      auto ep = [=] __device__(long r, int c, float v, float vo) {
          if (c & 1) { const float rs = rs1[r >> 1]; const int f = c >> 1; const float g = vo * rs, u = v * rs; hid[(size_t)r * DEXP + f] = f2bf(ew[r] * (g / (1.0f + __expf(-g))) * u); } };
      hipLaunchKernelGGL((nv::gemm<D, 8, decltype(ap), decltype(bp), decltype(ep)>), dim3((unsigned)((size_t)M * 2 * (1024 / 8) / 4)), dim3(256), 0, stream, (long)M * 2, (long)1024, ap, bp, ep); }
    for (long k = 0; k < 2; ++k) {
      const bf16* base = k == 0 ? h1 : h2;
      auto ap = [=] __device__(long r) { return hid + (size_t)(r * 2 + k) * DEXP; };
      auto bp = [=] __device__(long r, int c) { const int e = eid[r * 2 + k]; return Wd + ((size_t)e * D + c) * DEXP; };
      auto ep = [=] __device__(long r, int c, float v, float vo) { h2[(size_t)r * D + c] = f2bf(bf2f(base[(size_t)r * D + c]) + v); };
      hipLaunchKernelGGL((nv::gemm<DEXP, 8, decltype(ap), decltype(bp), decltype(ep)>), dim3((unsigned)((size_t)M * (D / 8) / 4)), dim3(256), 0, stream, (long)M, (long)D, ap, bp, ep); }
    hipLaunchKernelGGL(nv::rowrs, dim3(M / 4), dim3(256), 0, stream, h2, rs2);
    { auto ap = [=] __device__(long r) { return pb + (size_t)r * PLE; };
      auto bp = [=] __device__(long r, int c) { return Wple + (size_t)c * PLE; };
      auto ep = [=] __device__(long r, int c, float v, float vo) { pw[(size_t)r * D + c] = f2bf(v); };
      hipLaunchKernelGGL((nv::gemm<PLE, 8, decltype(ap), decltype(bp), decltype(ep)>), dim3((unsigned)((size_t)M * (D / 8) / 4)), dim3(256), 0, stream, (long)M, (long)D, ap, bp, ep); }
    { float* out = P.out;
      auto ap = [=] __device__(long r) { return h2 + (size_t)r * D; };
      auto bp = [=] __device__(long r, int c) { return Wplg + (size_t)c * D; };
      auto ep = [=] __device__(long r, int c, float v, float vo) { const float z = v * rs2[r]; out[(size_t)r * D + c] = bf2f(h2[(size_t)r * D + c]) + (1.0f / (1.0f + __expf(-z))) * bf2f(pw[(size_t)r * D + c]); };
      hipLaunchKernelGGL((nv::gemm<D, 8, decltype(ap), decltype(bp), decltype(ep)>), dim3((unsigned)((size_t)M * (D / 8) / 4)), dim3(256), 0, stream, (long)M, (long)D, ap, bp, ep); }
}
```

```cpp
#include <hip/hip_runtime.h>
#include <cstdio>
#include <cstdint>

typedef unsigned short bf16;
typedef unsigned v4u __attribute__((ext_vector_type(4)));
typedef unsigned v2u __attribute__((ext_vector_type(2)));
typedef float f32x4 __attribute__((ext_vector_type(4)));
typedef float f32x16 __attribute__((ext_vector_type(16)));
typedef short bf16x8 __attribute__((ext_vector_type(8)));
#define GAS __attribute__((address_space(1)))
#define LAS __attribute__((address_space(3)))
typedef GAS unsigned gu32;

constexpr int BATCH = 4, SEQ = 8192, D = 2048, M = BATCH * SEQ;
constexpr int DCONV = 1024, NH = 16, NKV = 4, HD = 64, DATTN = 1024, DKV = 256, DIN = 4608;
constexpr int C_B = 0, C_C = 1024, C_HC = 2048, C_Q = 3072, C_K = 4096, C_V = 4352;
constexpr int NGRP = 4, EPG = 8, NE = 32, DEXP = 512, PLE = 256, NRT = 36;
constexpr int NLIST = 64, LCAP = 32768;
constexpr float EPS = 1e-6f;
constexpr float LOG2E = 1.4426950408889634f;

constexpr size_t MiB = 1u << 20;
constexpr size_t WS_CTL = 0, CTL_ZERO_BYTES = 1 * MiB;
constexpr size_t WS_WIN = 2 * MiB;
constexpr size_t WS_WOUT = 20 * MiB;
constexpr size_t WS_WPLG = 28 * MiB;
constexpr size_t WS_WPLE = 36 * MiB;
constexpr size_t WS_WR = 37 * MiB;
constexpr size_t WS_RSX = 38 * MiB;
constexpr size_t WS_RS1 = 38 * MiB + 256 * 1024;
constexpr size_t WS_RS2 = 38 * MiB + 512 * 1024;
constexpr size_t WS_EID = 39 * MiB;
constexpr size_t WS_EW = 39 * MiB + 512 * 1024;
constexpr size_t WS_LOG = 42 * MiB;
constexpr size_t WS_SS1P = 50 * MiB;
constexpr size_t WS_SS2P = 54 * MiB;
constexpr size_t WS_WGU = 64 * MiB;
constexpr size_t WS_WD = 192 * MiB;
constexpr size_t WS_XB = 256 * MiB;
constexpr size_t WS_MIX = WS_XB;
constexpr size_t WS_PB = 384 * MiB;
constexpr size_t WS_PROJ = 400 * MiB;
constexpr size_t WS_HID = 400 * MiB;
constexpr size_t WS_PW = 480 * MiB;
constexpr size_t WS_H1 = 688 * MiB;
constexpr size_t WS_H2 = 816 * MiB;
constexpr size_t WS_YA = 816 * MiB;
constexpr size_t WS_ENT = 944 * MiB;
constexpr size_t WS_END = 976 * MiB;
constexpr int CW_TMO = 0, CW_BAR = 4096, CW_CNT = 8192;

__device__ __forceinline__ float bf2f(bf16 v) { return __uint_as_float(((unsigned)v) << 16); }
__device__ __forceinline__ unsigned f2bfu(float f) { unsigned u = __float_as_uint(f); return (u + 0x7fffu + ((u >> 16) & 1u)) >> 16; }
__device__ __forceinline__ bf16 f2bf(float f) { return (bf16)f2bfu(f); }
__device__ __forceinline__ unsigned pk2(float lo, float hi) { return f2bfu(lo) | (f2bfu(hi) << 16); }
__device__ __forceinline__ float wsum(float v) {
#pragma unroll
    for (int o = 32; o > 0; o >>= 1) v += __shfl_xor(v, o);
    return v;
}
__device__ __forceinline__ void unpack8(v4u w, float* f) {
    f[0] = __uint_as_float(w.x << 16); f[1] = __uint_as_float(w.x & 0xffff0000u);
    f[2] = __uint_as_float(w.y << 16); f[3] = __uint_as_float(w.y & 0xffff0000u);
    f[4] = __uint_as_float(w.z << 16); f[5] = __uint_as_float(w.z & 0xffff0000u);
    f[6] = __uint_as_float(w.w << 16); f[7] = __uint_as_float(w.w & 0xffff0000u);
}
__device__ __forceinline__ v4u pack8(const float* f) { v4u o; o.x = pk2(f[0], f[1]); o.y = pk2(f[2], f[3]); o.z = pk2(f[4], f[5]); o.w = pk2(f[6], f[7]); return o; }

struct Ptrs {
    const float *x, *p, *norm_mix, *w_in, *conv_w, *q_norm, *k_norm, *sinks, *onc, *ona, *w_out, *norm_ffn, *w_group, *b_group, *w_router, *b_router,
        *w_gate, *w_up, *w_down, *norm_ple, *w_ple_gate, *w_ple;
    float* out; unsigned char* ws;
};
struct Ent { int tok; float w; float rs; int pad; };
namespace pg8 {
constexpr int BM = 256, BK = 64, HALF = 128, HTB = HALF * BK * 2  , STAGE_BYTES = 8 * HTB, NXCD = 8, WGM = 8;
constexpr int RING_BYTES = 131072;
constexpr int LDSX_OFF = RING_BYTES;
constexpr int MISC_OFF = LDSX_OFF + 320;
constexpr int TAB_OFF = LDSX_OFF + 1024;
constexpr int LST_OFF = TAB_OFF + 8192;
constexpr int LDS_BYTES = 147456;

__host__ __device__ __forceinline__ int lds_byte(int r, int c) { const int st = (r >> 4) * 2 + (c >> 5), rr = r & 15, cc = c & 31, ob = rr * 64 + cc * 2; return st * 1024 + (ob ^ (((ob >> 9) & 1) << 5)); }
__host__ __device__ __forceinline__ void stage_rc(int b, int& R, int& C) { const int st = b / 1024, sb = b % 1024, swz = sb ^ (((sb >> 9) & 1) << 5); R = (st >> 1) * 16 + swz / 64; C = (st & 1) * 32 + (swz % 64) / 2; }
__host__ __device__ __forceinline__ int perm32(int rho) { const int n = rho >> 4, i = rho & 15; return 8 * (i >> 2) + 4 * n + (i & 3); }

struct Unit { int pm, pn, bt, par, lst, rk0, nl; };
struct Gemm { const bf16* A; const bf16* Bt; int M, N, K; };

struct StaticOrder {
    static constexpr bool GATHER = false;
    int nM, nN, nwg, G, c;
    __host__ __device__ void init(int M_, int N_, int G_, int c_) { nM = M_ / BM; nN = N_ / BM; nwg = nM * nN; G = G_; c = c_; }
    __host__ __device__ bool next(int i, Unit& u) const {
        const long L = (long)i * G + c; if (L >= nwg) return false;
        int wgid = (int)L; { const int q = nwg / NXCD, r = nwg % NXCD, xcd = wgid % NXCD, off = wgid / NXCD; wgid = (xcd < r ? xcd * (q + 1) : r * (q + 1) + (xcd - r) * q) + off; }
        const int nig = WGM * nN, gid = wgid / nig, fm = gid * WGM, gsz = (nM - fm) < WGM ? (nM - fm) : WGM;
        u.pm = fm + ((wgid % nig) % gsz); u.pn = (wgid % nig) / gsz; u.bt = u.pn; u.par = i & 1; u.lst = 0; u.rk0 = 0; u.nl = 0; return true;
    }
    __device__ __forceinline__ void a_ready(const Unit&) const {}
    __device__ __forceinline__ void done(const Unit&) const {}
};

__device__ __forceinline__ unsigned cvt_pk_bf16(float lo, float hi) { unsigned r; asm volatile("v_cvt_pk_bf16_f32 %0, %1, %2" : "=v"(r) : "v"(lo), "v"(hi)); return r; }

template <class Epi, class Sched, bool ALIGN_EPI>
__device__ __forceinline__ void gemm_phase(LAS unsigned char* lds, const Gemm g, const Sched& S, const Epi& E) {
    const int tid = threadIdx.x, wid = __builtin_amdgcn_readfirstlane(tid >> 6), lane = tid & 63, wr = wid >> 2, wc = wid & 3, fr = lane & 15, fq = lane >> 4;
    const int K = g.K, nt = K / BK;
    unsigned voffA[2], voffB[2]; int R0 = 0, C0 = 0;
#pragma unroll
    for (int i = 0; i < 2; ++i) { int R, C; stage_rc(tid * 16 + i * 8192, R, C); const int Rb = Epi::PERM ? ((R & ~31) + perm32(R & 31)) : R;
        voffA[i] = (unsigned)(R * K + C) * 2u; voffB[i] = (unsigned)(Rb * K + C) * 2u; if (i == 0) { R0 = R; C0 = C; } }
    const size_t kstep = (size_t)(BK * 2);
    const size_t hstep = (size_t)HALF * K * 2;
    const size_t tstep = 2 * hstep;
    const unsigned ldsw = (unsigned)wid * 1024u;
    const int aoff = lds_byte(wr * 64 + fr, fq * 8), boff = lds_byte(wc * 32 + fr, fq * 8);
    unsigned gc[2][2] = {{0u, 0u}, {0u, 0u}}, gn[2][2] = {{0u, 0u}, {0u, 0u}}, gs[2][2] = {{0u, 0u}, {0u, 0u}};
#define PG8_TOK(par, r) (*(const LAS int*)(lds + TAB_OFF + (par) * 4096 + (r) * 16))
#define PG8_GLOAD(dst, par) do { _Pragma("unroll") for (int _h = 0; _h < 2; ++_h) _Pragma("unroll") for (int _i = 0; _i < 2; ++_i) \
        dst[_h][_i] = (unsigned)PG8_TOK(par, _h * 128 + _i * 64 + R0) * (unsigned)(K * 2) + (unsigned)(C0 * 2); } while (0)
#define PG8_SA(b, h) (((b) * 2 + (h)) * HTB)
#define PG8_SB(b, h) ((4 + (b) * 2 + (h)) * HTB)
#define PG8_STAGE(bufoff, gbase, voff) do { _Pragma("unroll") for (int _i = 0; _i < 2; ++_i) \
        __builtin_amdgcn_global_load_lds((const unsigned*)((const char*)(gbase) + (voff)[_i]), (LAS unsigned*)(lds + (bufoff) + ldsw + _i * 8192), 16, 0, 0); } while (0)
#define PG8_STAGE_A(bufoff, ub, go, h, kb) do { if constexpr (Sched::GATHER) { PG8_STAGE(bufoff, (const char*)g.A + (kb), go[h]); } else { PG8_STAGE(bufoff, (ub) + (kb) + (h) * hstep, voffA); } } while (0)
#define PG8_LDA(dst, b, h) do { _Pragma("unroll") for (int m = 0; m < 4; ++m) _Pragma("unroll") for (int k = 0; k < 2; ++k) dst[m][k] = *(const LAS bf16x8*)(lds + PG8_SA(b, h) + aoff + m * 2048 + k * 1024); } while (0)
#define PG8_LDB(dst, b, h) do { _Pragma("unroll") for (int n = 0; n < 2; ++n) _Pragma("unroll") for (int k = 0; k < 2; ++k) dst[n][k] = *(const LAS bf16x8*)(lds + PG8_SB(b, h) + boff + n * 2048 + k * 1024); } while (0)
#define PG8_MMA(ai, bj, At, Bt) do { __builtin_amdgcn_s_setprio(1); _Pragma("unroll") for (int m = 0; m < 4; ++m) _Pragma("unroll") for (int n = 0; n < 2; ++n) _Pragma("unroll") for (int k = 0; k < 2; ++k) \
        acc[ai][bj][m][n] = __builtin_amdgcn_mfma_f32_16x16x32_bf16(Bt[n][k], At[m][k], acc[ai][bj][m][n], 0, 0, 0); __builtin_amdgcn_s_setprio(0); } while (0)
#define PG8_WAIT_V(n) asm volatile("s_waitcnt vmcnt(" #n ")" ::: "memory")
#define PG8_WAIT_L(n) asm volatile("s_waitcnt lgkmcnt(" #n ")" ::: "memory")
#define PG8_BAR __builtin_amdgcn_s_barrier()
#define PG8_SCHED __builtin_amdgcn_sched_barrier(0)
    Unit cur, nxt; int ui = 0;
    if (!S.next(0, cur)) return;
    f32x4 acc[2][2][4][2];
#pragma unroll
    for (int a = 0; a < 2; ++a)
#pragma unroll
        for (int b = 0; b < 2; ++b)
#pragma unroll
            for (int m = 0; m < 4; ++m)
#pragma unroll
                for (int n = 0; n < 2; ++n) acc[a][b][m][n] = (f32x4){0.f, 0.f, 0.f, 0.f};
    bf16x8 At[4][2], B0[2][2], B1[2][2];
    const char* cA = (const char*)g.A + (size_t)cur.pm * tstep; const char* cB = (const char*)g.Bt + (size_t)cur.bt * tstep;
    S.a_ready(cur);
    if constexpr (Sched::GATHER) { PG8_GLOAD(gc, cur.par); }
    PG8_STAGE(PG8_SB(0, 0), cB, voffB); PG8_STAGE(PG8_SB(0, 1), cB + hstep, voffB); PG8_STAGE_A(PG8_SA(0, 0), cA, gc, 0, (size_t)0); PG8_STAGE_A(PG8_SA(0, 1), cA, gc, 1, (size_t)0);
    if (wr == 1) PG8_BAR;
    PG8_WAIT_V(2); PG8_BAR;
    PG8_STAGE(PG8_SB(1, 0), cB + kstep, voffB); PG8_STAGE_A(PG8_SA(1, 0), cA, gc, 0, kstep); PG8_STAGE(PG8_SB(1, 1), cB + hstep + kstep, voffB);
    PG8_WAIT_V(6); PG8_BAR;
    for (;;) {
        const bool has_next = S.next(ui + 1, nxt);
        const char* nA = has_next ? (const char*)g.A + (size_t)nxt.pm * tstep : cA; const char* nB = has_next ? (const char*)g.Bt + (size_t)nxt.bt * tstep : cB;
        for (int t = 0; t < nt; t += 2) {
            const bool last = (t == nt - 2);
            const size_t k1 = (size_t)(t + 1) * kstep;
            const char* sA = last ? nA : cA; const size_t k2 = last ? (size_t)0 : (size_t)(t + 2) * kstep, k3 = k2 + kstep;
            const char* b2 = last ? nB : cB + (size_t)(t + 2) * kstep; const char* b3 = b2 + kstep;
            if (last && has_next) { S.a_ready(nxt); if constexpr (Sched::GATHER) { PG8_GLOAD(gn, nxt.par); } }
            if constexpr (Sched::GATHER) {
#pragma unroll
                for (int h = 0; h < 2; ++h)
#pragma unroll
                    for (int i = 0; i < 2; ++i) gs[h][i] = (last && has_next) ? gn[h][i] : gc[h][i];
            }
            PG8_LDB(B0, 0, 0); PG8_LDB(B1, 0, 1); PG8_SCHED; PG8_LDA(At, 0, 0); PG8_STAGE_A(PG8_SA(1, 1), cA, gc, 1, k1);
            PG8_WAIT_V(8); PG8_WAIT_L(0); PG8_BAR; PG8_MMA(0, 0, At, B0); PG8_MMA(0, 1, At, B1); PG8_BAR; PG8_SCHED;
            PG8_LDA(At, 0, 1); PG8_STAGE(PG8_SB(0, 0), b2, voffB); PG8_STAGE(PG8_SB(0, 1), b2 + hstep, voffB); PG8_STAGE_A(PG8_SA(0, 0), sA, gs, 0, k2);
            PG8_WAIT_V(8); PG8_WAIT_L(0); PG8_BAR; PG8_MMA(1, 0, At, B0); PG8_MMA(1, 1, At, B1); PG8_BAR; PG8_SCHED;
            PG8_LDB(B0, 1, 0); PG8_LDB(B1, 1, 1); PG8_SCHED; PG8_LDA(At, 1, 0); PG8_STAGE_A(PG8_SA(0, 1), sA, gs, 1, k2);
            PG8_WAIT_V(8); PG8_WAIT_L(0); PG8_BAR; PG8_MMA(0, 0, At, B0); PG8_MMA(0, 1, At, B1); PG8_BAR; PG8_SCHED;
            PG8_LDA(At, 1, 1); PG8_STAGE(PG8_SB(1, 0), b3, voffB); PG8_STAGE(PG8_SB(1, 1), b3 + hstep, voffB); PG8_STAGE_A(PG8_SA(1, 0), sA, gs, 0, k3);
            PG8_WAIT_V(8); PG8_WAIT_L(0); PG8_BAR; PG8_MMA(1, 0, At, B0); PG8_MMA(1, 1, At, B1); PG8_BAR; PG8_SCHED;
        }
        if constexpr (ALIGN_EPI) { if (wr == 0) PG8_BAR; }
        if constexpr (!Epi::AFTER_DRAIN) { E(acc, cur, wr, wc, fr, fq); S.done(cur); }
        if (!has_next) break;
#pragma unroll
        for (int a = 0; a < 2; ++a)
#pragma unroll
            for (int b = 0; b < 2; ++b)
#pragma unroll
                for (int m = 0; m < 4; ++m)
#pragma unroll
                    for (int n = 0; n < 2; ++n) acc[a][b][m][n] = (f32x4){0.f, 0.f, 0.f, 0.f};
        cur = nxt; cA = nA; cB = nB; ++ui;
        if constexpr (Sched::GATHER) {
#pragma unroll
            for (int h = 0; h < 2; ++h)
#pragma unroll
                for (int i = 0; i < 2; ++i) gc[h][i] = gn[h][i];
        }
        if constexpr (ALIGN_EPI) { if (wr == 1) PG8_BAR; }
    }
    PG8_WAIT_V(0);
    if constexpr (!ALIGN_EPI) { if (wr == 0) PG8_BAR; }
    PG8_BAR;
    if constexpr (Epi::AFTER_DRAIN) { E.fused(acc, cur, wr, wc, fr, fq, lds, wid, lane); S.done(cur); }
#undef PG8_TOK
#undef PG8_GLOAD
#undef PG8_SA
#undef PG8_SB
#undef PG8_STAGE
#undef PG8_STAGE_A
#undef PG8_LDA
#undef PG8_LDB
#undef PG8_MMA
#undef PG8_WAIT_V
#undef PG8_WAIT_L
#undef PG8_BAR
#undef PG8_SCHED
}

typedef f32x4 Acc[2][2][4][2];
#define TAB_ENT(ldsx, par, r) ((const LAS Ent*)((ldsx) + TAB_OFF + (par) * 4096 + (r) * 16))

struct EpiBf16 {
    static constexpr bool PERM = true, AFTER_DRAIN = false;
    bf16* O; int ldc; const float* rs;
    __device__ __forceinline__ void operator()(const Acc& acc, const Unit& u, int wr, int wc, int fr, int fq) const {
        const int row0 = u.pm * BM + wr * 64 + fr, col0 = u.pn * BM + wc * 32 + 8 * fq;
#pragma unroll
        for (int ai = 0; ai < 2; ++ai)
#pragma unroll
            for (int m = 0; m < 4; ++m) { const int row = row0 + ai * HALF + m * 16; const float s = rs ? rs[row] : 1.f; bf16* rowp = O + (size_t)row * ldc + col0;
#pragma unroll
                for (int bj = 0; bj < 2; ++bj) { const f32x4 v0 = acc[ai][bj][m][0] * s, v1 = acc[ai][bj][m][1] * s; v4u w;
                    w.x = cvt_pk_bf16(v0[0], v0[1]); w.y = cvt_pk_bf16(v0[2], v0[3]); w.z = cvt_pk_bf16(v1[0], v1[1]); w.w = cvt_pk_bf16(v1[2], v1[3]);
                    *(v4u*)(rowp + bj * HALF) = w; } }
    }
};
struct EpiH1 {
    static constexpr bool PERM = true, AFTER_DRAIN = false;
    const float* x; bf16* h1; float* ssp;
    __device__ __forceinline__ void operator()(const Acc& acc, const Unit& u, int wr, int wc, int fr, int fq) const {
        const int row0 = u.pm * BM + wr * 64 + fr, col0 = u.pn * BM + wc * 32 + 8 * fq;
#pragma unroll
        for (int ai = 0; ai < 2; ++ai)
#pragma unroll
            for (int m = 0; m < 4; ++m) { const int row = row0 + ai * HALF + m * 16; const size_t off = (size_t)row * D + col0; float ss = 0.f;
#pragma unroll
                for (int bj = 0; bj < 2; ++bj) { const f32x4 x0 = *(const f32x4*)(x + off + bj * HALF), x1 = *(const f32x4*)(x + off + bj * HALF + 4);
                    const f32x4 v0 = acc[ai][bj][m][0] + x0, v1 = acc[ai][bj][m][1] + x1; v4u w;
                    ss += (v0[0] * v0[0] + v0[1] * v0[1]) + (v0[2] * v0[2] + v0[3] * v0[3]) + (v1[0] * v1[0] + v1[1] * v1[1]) + (v1[2] * v1[2] + v1[3] * v1[3]);
                    w.x = cvt_pk_bf16(v0[0], v0[1]); w.y = cvt_pk_bf16(v0[2], v0[3]); w.z = cvt_pk_bf16(v1[0], v1[1]); w.w = cvt_pk_bf16(v1[2], v1[3]);
                    *(v4u*)(h1 + off + bj * HALF) = w; }
                ss += __shfl_xor(ss, 16); ss += __shfl_xor(ss, 32);
                if (fq == 0) ssp[(size_t)row * 32 + u.pn * 4 + wc] = ss; }
    }
};
struct EpiRouter {
    static constexpr bool PERM = false, AFTER_DRAIN = true;
    const float* ssp; const float* bg; const float* br; float* rs1; int* eid; float* ew; Ent* ent; unsigned* cnt;
    __device__ __forceinline__ void fused(const Acc& acc, const Unit& u, int wr, int wc, int fr, int fq, LAS unsigned char* lds, int wid, int lane) const {
        LAS float* LG = (LAS float*)lds;
        LAS unsigned* HIST = (LAS unsigned*)(lds + 65536);
        LAS unsigned* BASE = (LAS unsigned*)(lds + 65536 + 256);
        const int tid = threadIdx.x;
        if (tid < 64) HIST[tid] = 0u;
        if (wc < 2) {
#pragma unroll
            for (int ai = 0; ai < 2; ++ai)
#pragma unroll
                for (int m = 0; m < 4; ++m) { const int r = ai * HALF + wr * 64 + m * 16 + fr;
#pragma unroll
                    for (int n = 0; n < 2; ++n) { const int c = wc * 32 + 16 * n + 4 * fq; if (c < 40) *(LAS f32x4*)(LG + r * 40 + c) = acc[ai][0][m][n]; } }
        }
        __syncthreads();
        int l0 = 0, l1 = 0; unsigned k0 = 0, k1 = 0; float w0 = 0.f, w1 = 0.f, rs = 0.f; const int row = u.pm * BM + tid;
        if (tid < 256) {
            float ss = 0.f;
#pragma unroll
            for (int j = 0; j < 8; ++j) { const f32x4 p = *(const f32x4*)(ssp + (size_t)row * 32 + 4 * j); ss += (p[0] + p[1]) + (p[2] + p[3]); }
            rs = 1.0f / sqrtf(ss * (1.0f / D) + EPS);
            const LAS float* L = LG + tid * 40;
            float gl[NGRP]; int g = 0;
#pragma unroll
            for (int j = 0; j < NGRP; ++j) gl[j] = L[j] * rs + bg[j];
            float gm = gl[0];
#pragma unroll
            for (int j = 1; j < NGRP; ++j) if (gl[j] > gm) { gm = gl[j]; g = j; }
            float gsum = 0.f;
#pragma unroll
            for (int j = 0; j < NGRP; ++j) gsum += __expf(gl[j] - gm);
            const float gw = 1.0f / gsum;
            const LAS float* E = L + NGRP + g * EPG; const float* be = br + g * EPG;
            int i1 = 0; float v1 = E[0] * rs + be[0];
            for (int j = 1; j < EPG; ++j) { const float v = E[j] * rs + be[j]; if (v > v1) { v1 = v; i1 = j; } }
            int i2 = 0; float v2 = -3.0e38f;
            for (int j = 0; j < EPG; ++j) { const float v = E[j] * rs + be[j]; if (j != i1 && v > v2) { v2 = v; i2 = j; } }
            const float e2 = __expf(v2 - v1); w0 = gw / (1.0f + e2); w1 = gw * e2 / (1.0f + e2);
            l0 = g * EPG + i1; l1 = NE + g * EPG + i2;
            eid[row * 2] = l0; eid[row * 2 + 1] = l1 - NE; ew[row * 2] = w0; ew[row * 2 + 1] = w1; rs1[row] = rs;
            k0 = __hip_atomic_fetch_add(HIST + l0, 1u, __ATOMIC_RELAXED, __HIP_MEMORY_SCOPE_WORKGROUP); k1 = __hip_atomic_fetch_add(HIST + l1, 1u, __ATOMIC_RELAXED, __HIP_MEMORY_SCOPE_WORKGROUP);
        }
        __syncthreads();
        if (tid < 64) { const unsigned n = HIST[tid]; BASE[tid] = n ? __hip_atomic_fetch_add(cnt + 64 * tid, n, __ATOMIC_RELAXED, __HIP_MEMORY_SCOPE_AGENT) : 0u; }
        __syncthreads();
        if (tid < 256) {
            *(v4u*)(ent + (size_t)l0 * LCAP + BASE[l0] + k0) = (v4u){(unsigned)row, __float_as_uint(w0), __float_as_uint(rs), 0u};
            *(v4u*)(ent + (size_t)l1 * LCAP + BASE[l1] + k1) = (v4u){(unsigned)row, __float_as_uint(w1), __float_as_uint(rs), 0u};
        }
    }
};
struct EpiGU {
    static constexpr bool PERM = true, AFTER_DRAIN = false;
    bf16* hid; LAS unsigned char* ldsx;
    __device__ __forceinline__ void operator()(const Acc& acc, const Unit& u, int wr, int wc, int fr, int fq) const {
        const int col0 = u.pn * HALF + wc * 32 + 8 * fq;
#pragma unroll
        for (int ai = 0; ai < 2; ++ai)
#pragma unroll
            for (int m = 0; m < 4; ++m) { const int r = ai * HALF + wr * 64 + m * 16 + fr; const LAS Ent* e = TAB_ENT(ldsx, u.par, r); const float w = e->w, rs = e->rs;
                float o[8];
#pragma unroll
                for (int n = 0; n < 2; ++n)
#pragma unroll
                    for (int i = 0; i < 4; ++i) { const float gg = acc[ai][0][m][n][i] * rs, uu = acc[ai][1][m][n][i] * rs; o[n * 4 + i] = w * (gg / (1.0f + __expf(-gg))) * uu; }
                v4u q; q.x = cvt_pk_bf16(o[0], o[1]); q.y = cvt_pk_bf16(o[2], o[3]); q.z = cvt_pk_bf16(o[4], o[5]); q.w = cvt_pk_bf16(o[6], o[7]);
                *(v4u*)(hid + (size_t)(u.pm * BM + r) * DEXP + col0) = q; }
    }
};
template <int KK> struct EpiDown {
    static constexpr bool PERM = true, AFTER_DRAIN = false;
    const bf16* base; bf16* h2; float* ssp; LAS unsigned char* ldsx;
    __device__ __forceinline__ void operator()(const Acc& acc, const Unit& u, int wr, int wc, int fr, int fq) const {
        const int col0 = u.pn * BM + wc * 32 + 8 * fq;
#pragma unroll
        for (int ai = 0; ai < 2; ++ai)
#pragma unroll
            for (int m = 0; m < 4; ++m) { const int r = ai * HALF + wr * 64 + m * 16 + fr; const bool valid = (u.rk0 + r) < u.nl; const int tok = TAB_ENT(ldsx, u.par, r)->tok;
                const size_t off = (size_t)tok * D + col0; float ss = 0.f;
#pragma unroll
                for (int bj = 0; bj < 2; ++bj) { float b[8]; unpack8(*(const v4u*)(base + off + bj * HALF), b);
                    float o[8];
#pragma unroll
                    for (int n = 0; n < 2; ++n)
#pragma unroll
                        for (int i = 0; i < 4; ++i) { o[n * 4 + i] = b[n * 4 + i] + acc[ai][bj][m][n][i]; ss += o[n * 4 + i] * o[n * 4 + i]; }
                    v4u q; q.x = cvt_pk_bf16(o[0], o[1]); q.y = cvt_pk_bf16(o[2], o[3]); q.z = cvt_pk_bf16(o[4], o[5]); q.w = cvt_pk_bf16(o[6], o[7]);
                    if (valid) *(v4u*)(h2 + off + bj * HALF) = q; }
                if (KK == 1) { ss += __shfl_xor(ss, 16); ss += __shfl_xor(ss, 32); if (fq == 0 && valid) ssp[(size_t)tok * 32 + u.pn * 4 + wc] = ss; } }
    }
};
struct EpiFinal {
    static constexpr bool PERM = false, AFTER_DRAIN = false;
    const bf16* h2; const bf16* pw; float* out; LAS unsigned char* ldsx;
    __device__ __forceinline__ void operator()(const Acc& acc, const Unit& u, int wr, int wc, int fr, int fq) const {
        const int col0 = u.pn * BM + wc * 32 + 4 * fq;
#pragma unroll
        for (int ai = 0; ai < 2; ++ai)
#pragma unroll
            for (int m = 0; m < 4; ++m) { const int r = ai * HALF + wr * 64 + m * 16 + fr; const float rs = TAB_ENT(ldsx, u.par, r)->rs; const size_t off = (size_t)(u.pm * BM + r) * D + col0;
#pragma unroll
                for (int bj = 0; bj < 2; ++bj)
#pragma unroll
                    for (int n = 0; n < 2; ++n) { const size_t o2 = off + bj * HALF + n * 16; const v2u hv = *(const v2u*)(h2 + o2), pv = *(const v2u*)(pw + o2);
                        const f32x4 z = acc[ai][bj][m][n] * rs; f32x4 o;
                        o[0] = __uint_as_float(hv.x << 16) + __uint_as_float(pv.x << 16) / (1.0f + __expf(-z[0]));
                        o[1] = __uint_as_float(hv.x & 0xffff0000u) + __uint_as_float(pv.x & 0xffff0000u) / (1.0f + __expf(-z[1]));
                        o[2] = __uint_as_float(hv.y << 16) + __uint_as_float(pv.y << 16) / (1.0f + __expf(-z[2]));
                        o[3] = __uint_as_float(hv.y & 0xffff0000u) + __uint_as_float(pv.y & 0xffff0000u) / (1.0f + __expf(-z[3]));
                        *(f32x4*)(out + o2) = o; } }
    }
};

template <bool GATHER_, int NPN> struct MoeOrder {
    static constexpr bool GATHER = GATHER_;
    LAS unsigned char* ldsx; const Ent* ent; int tlo, thi, G, c;
    __device__ __forceinline__ bool next(int i, Unit& u) const {
        const long L = (long)i * G + c; const int nun = (thi - tlo) * NPN; if (L >= nun) return false;
        const int tile = tlo + (int)(L / NPN); const LAS int* T0 = (const LAS int*)(ldsx + LST_OFF + 256);
        int l = 0;
        for (int j = 1; j < NLIST; ++j) l += (T0[j] <= tile) ? 1 : 0;
        u.pm = tile; u.pn = (int)(L % NPN); u.bt = (l & (NE - 1)) * NPN + u.pn; u.par = i & 1; u.lst = l; u.rk0 = (tile - T0[l]) * BM; u.nl = ((const LAS int*)(ldsx + LST_OFF))[l];
        return true;
    }
    __device__ __forceinline__ void a_ready(const Unit& u) const {
        const int tid = threadIdx.x;
        if (tid < 256) { const int rk = u.rk0 + tid; v4u e = (v4u){0u, 0u, 0u, 0u}; if (rk < u.nl) e = *(const v4u*)(ent + (size_t)u.lst * LCAP + rk);
            *(LAS v4u*)(ldsx + TAB_OFF + u.par * 4096 + tid * 16) = e; }
        if (GATHER) { asm volatile("s_waitcnt vmcnt(0) lgkmcnt(0)" ::: "memory"); __builtin_amdgcn_s_barrier(); asm volatile("" ::: "memory"); }
    }
    __device__ __forceinline__ void done(const Unit&) const {}
};
struct FinalOrder : StaticOrder {
    LAS unsigned char* ldsx; const float* ssp;
    __device__ __forceinline__ void a_ready(const Unit& u) const {
        const int tid = threadIdx.x;
        if (tid < 256) { const int row = u.pm * BM + tid; float ss = 0.f;
#pragma unroll
            for (int j = 0; j < 8; ++j) { const f32x4 p = *(const f32x4*)(ssp + (size_t)row * 32 + 4 * j); ss += (p[0] + p[1]) + (p[2] + p[3]); }
            *(LAS v4u*)(ldsx + TAB_OFF + u.par * 4096 + tid * 16) = (v4u){(unsigned)row, 0u, __float_as_uint(1.0f / sqrtf(ss * (1.0f / D) + EPS)), 0u}; }
    }
};
}
#define RLX_AGENT __ATOMIC_RELAXED, __HIP_MEMORY_SCOPE_AGENT
#define XB_TMO      128
#define XB_XCNT(j)  (256  + 64 * (j))
#define XB_XSUB(j)  (1280 + 64 * (j))
#define XB_XGEN(j)  (2304 + 64 * (j))
#define XB_TOP      3328
#define XB_TOPGEN   3392
#define XCD_BAR_WORDS 3456
#define XB_SPIN_CAP (1u << 18)

__device__ __forceinline__ unsigned xb_ld(unsigned* p)              { return __hip_atomic_load(p, __ATOMIC_RELAXED, __HIP_MEMORY_SCOPE_AGENT); }
__device__ __forceinline__ unsigned xb_add(unsigned* p, unsigned v) { return __hip_atomic_fetch_add(p, v, __ATOMIC_RELAXED, __HIP_MEMORY_SCOPE_AGENT); }
__device__ __forceinline__ unsigned xb_xcc_id() { return (unsigned)__builtin_amdgcn_s_getreg((3 << 11) | 20) & 0xFu; }
#define XB_SPIN(cond, bar) do { unsigned _sp = 0; while (cond) { __builtin_amdgcn_s_sleep(1); \
    if ((++_sp & 255u) == 0u) { if (xb_ld(&(bar)[XB_TMO])) break; if (_sp > XB_SPIN_CAP) { atomicAdd(&(bar)[XB_TMO], 1u); break; } } } } while (0)

struct XcdBarrier {
    unsigned* bar; unsigned x;
    volatile LAS unsigned* st;
};
__device__ __forceinline__ XcdBarrier xcd_barrier_post(unsigned* bar, volatile LAS unsigned* st) {
    XcdBarrier b; b.bar = bar; b.x = xb_xcc_id(); b.st = st;
    if (threadIdx.x == 0) (void)xb_add(&bar[XB_XCNT(b.x)], 1u);
    return b;
}
__device__ __forceinline__ void xcd_barrier_complete(unsigned* bar, unsigned x, unsigned& nloc, unsigned& nx) {
    const unsigned G = gridDim.x * gridDim.y * gridDim.z;
    unsigned sum, cnt, mine, sp = 0u;
    for (;;) {
        sum = 0u; cnt = 0u; mine = 0u;
#pragma unroll
        for (unsigned j = 0; j < 16; ++j) { const unsigned c = xb_ld(&bar[XB_XCNT(j)]); sum += c; cnt += (c > 0u) ? 1u : 0u; mine = (j == x) ? c : mine; }
        if (sum == G) break;
        __builtin_amdgcn_s_sleep(1);
        if ((++sp & 255u) == 0u) { if (xb_ld(&bar[XB_TMO])) break; if (sp > XB_SPIN_CAP) { atomicAdd(&bar[XB_TMO], 1u); break; } }
    }
    nloc = mine > 0u ? mine : 1u; nx = cnt > 0u ? cnt : 1u;
}
__device__ __forceinline__ void xcd_barrier(const XcdBarrier& b) {
    asm volatile("s_waitcnt vmcnt(0)" ::: "memory");
    __syncthreads();
    if (threadIdx.x == 0) {
        unsigned* bar = b.bar;
        __builtin_amdgcn_s_waitcnt(0);
        unsigned nloc = b.st[0], nx = b.st[1];
        if (nloc == 0u) { xcd_barrier_complete(bar, b.x, nloc, nx); b.st[0] = nloc; b.st[1] = nx; }
        const unsigned old = xb_add(&bar[XB_XSUB(b.x)], 1u);
        const unsigned gen = old / nloc;
        if (old + 1u == (gen + 1u) * nloc) {
            __builtin_amdgcn_fence(__ATOMIC_RELEASE, "agent");
            asm volatile("s_waitcnt vmcnt(0)" ::: "memory");
            const unsigned og = xb_add(&bar[XB_TOP], 1u);
            const unsigned tg = og / nx;
            if (og + 1u == (tg + 1u) * nx) xb_add(&bar[XB_TOPGEN], 1u);
            else XB_SPIN(xb_ld(&bar[XB_TOPGEN]) == tg, bar);
            __builtin_amdgcn_fence(__ATOMIC_ACQUIRE, "agent");
            xb_add(&bar[XB_XGEN(b.x)], 1u);
            asm volatile("s_waitcnt vmcnt(0)" ::: "memory");
        } else {
            XB_SPIN(xb_ld(&bar[XB_XGEN(b.x)]) == gen, bar);
            __builtin_amdgcn_fence(__ATOMIC_ACQUIRE, "agent");
            asm volatile("s_waitcnt vmcnt(0)" ::: "memory");
        }
    }
    __syncthreads();
}

constexpr int NWAVES = 8;
__device__ __forceinline__ void p0_transpose_item(const float* W, int K, int N, const float* g0, const float* g1, int gsplit, bf16* WT, int rowbase, int k0, int n0, LAS float* scr, int lane) {
#pragma unroll 8
    for (int i = 0; i < 32; ++i) { const int kk = 2 * i + (lane >> 5); const int k = k0 + kk; const float gg = g0 ? (k < gsplit ? g0[k] : g1[k - gsplit]) : 1.f;
        scr[kk * 33 + (lane & 31)] = gg * W[(size_t)k * N + n0 + (lane & 31)]; }
    asm volatile("s_waitcnt lgkmcnt(0)" ::: "memory");
    const int c = lane & 7;
#pragma unroll
    for (int j = 0; j < 4; ++j) { const int n = (lane >> 3) + 8 * j; const LAS float* s = scr + (8 * c) * 33 + n;
        v4u o; o.x = pk2(s[0 * 33], s[1 * 33]); o.y = pk2(s[2 * 33], s[3 * 33]); o.z = pk2(s[4 * 33], s[5 * 33]); o.w = pk2(s[6 * 33], s[7 * 33]);
        *(v4u*)(WT + (size_t)(rowbase + n) * K + k0 + 8 * c) = o; }
    asm volatile("s_waitcnt lgkmcnt(0)" ::: "memory");
}
__device__ __forceinline__ void p0_prologue(const Ptrs& P, LAS unsigned char* lds, int vcu, int G) {
    const int tid = threadIdx.x, lane = tid & 63, wave = __builtin_amdgcn_readfirstlane(tid >> 6);
    unsigned char* ws = P.ws;
    LAS float* scr = (LAS float*)(lds + wave * 16384);
    const int gw = vcu * NWAVES + wave, NGW = G * NWAVES;
    constexpr int I_IN = (D / 64) * (DIN / 32), I_OUT = (D / 64) * (D / 32), I_PLG = I_OUT, I_PLE = (PLE / 64) * (D / 32), I_RT = (D / 64) * (NE / 32);
    constexpr int I_G1 = (D / 64) * (DEXP / 32), I_D1 = (DEXP / 64) * (D / 32);
    constexpr int NITEMS = I_IN + I_OUT + I_PLG + I_PLE + I_RT + NE * (2 * I_G1 + I_D1);
    for (int it = gw; it < NITEMS; it += NGW) {
        int r = it;
        if (r < I_IN) { const int nb = DIN / 32; p0_transpose_item(P.w_in, D, DIN, P.norm_mix, nullptr, D, (bf16*)(ws + WS_WIN), (r % nb) * 32, (r / nb) * 64, (r % nb) * 32, scr, lane); continue; } r -= I_IN;
        if (r < I_OUT) { const int nb = D / 32; p0_transpose_item(P.w_out, D, D, P.onc, P.ona, DCONV, (bf16*)(ws + WS_WOUT), (r % nb) * 32, (r / nb) * 64, (r % nb) * 32, scr, lane); continue; } r -= I_OUT;
        if (r < I_PLG) { const int nb = D / 32; p0_transpose_item(P.w_ple_gate, D, D, P.norm_ple, nullptr, D, (bf16*)(ws + WS_WPLG), (r % nb) * 32, (r / nb) * 64, (r % nb) * 32, scr, lane); continue; } r -= I_PLG;
        if (r < I_PLE) { const int nb = D / 32; p0_transpose_item(P.w_ple, PLE, D, nullptr, nullptr, 0, (bf16*)(ws + WS_WPLE), (r % nb) * 32, (r / nb) * 64, (r % nb) * 32, scr, lane); continue; } r -= I_PLE;
        if (r < I_RT) { p0_transpose_item(P.w_router, D, NE, P.norm_ffn, nullptr, D, (bf16*)(ws + WS_WR), NGRP, r * 64, 0, scr, lane); continue; } r -= I_RT;
        const int e = r / (2 * I_G1 + I_D1); r -= e * (2 * I_G1 + I_D1);
        if (r < 2 * I_G1) { const int up = r >= I_G1; r -= up * I_G1; const int nb = DEXP / 32, n0 = (r % nb) * 32, k0 = (r / nb) * 64;
            p0_transpose_item((up ? P.w_up : P.w_gate) + (size_t)e * D * DEXP, D, DEXP, P.norm_ffn, nullptr, D, (bf16*)(ws + WS_WGU) + (size_t)e * 1024 * D, (n0 >> 7) * 256 + up * 128 + (n0 & 127), k0, n0, scr, lane); continue; }
        r -= 2 * I_G1; { const int nb = D / 32; p0_transpose_item(P.w_down + (size_t)e * DEXP * D, DEXP, D, nullptr, nullptr, 0, (bf16*)(ws + WS_WD) + (size_t)e * D * DEXP, (r % nb) * 32, (r / nb) * 64, (r % nb) * 32, scr, lane); }
    }
    { bf16* Wr = (bf16*)(ws + WS_WR); const int gt = vcu * (NWAVES * 64) + tid, NT = G * NWAVES * 64;
      for (int i = gt; i < NGRP * D; i += NT) { const int n = i / D, k = i % D; Wr[(size_t)n * D + k] = f2bf(P.norm_ffn[k] * P.w_group[(size_t)k * NGRP + n]); }
      for (int i = gt; i < (256 - NRT) * D / 8; i += NT) *(v4u*)(Wr + (size_t)NRT * D + (size_t)i * 8) = (v4u){0u, 0u, 0u, 0u}; }
    for (int m = gw; m < M; m += NGW) {
        const f32x4* xr = (const f32x4*)(P.x + (size_t)m * D) + lane; f32x4 v[8]; float s = 0.f;
#pragma unroll
        for (int j = 0; j < 8; ++j) { v[j] = xr[64 * j]; s += (v[j][0] * v[j][0] + v[j][1] * v[j][1]) + (v[j][2] * v[j][2] + v[j][3] * v[j][3]); }
        s = wsum(s);
        v2u* o8 = (v2u*)((bf16*)(ws + WS_XB) + (size_t)m * D) + lane;
#pragma unroll
        for (int j = 0; j < 8; ++j) { v2u o; o.x = pk2(v[j][0], v[j][1]); o.y = pk2(v[j][2], v[j][3]); o8[64 * j] = o; }
        if (lane == 0) ((float*)(ws + WS_RSX))[m] = 1.0f / sqrtf(s * (1.0f / D) + EPS);
    }
    { const int gt = vcu * (NWAVES * 64) + tid, NT = G * NWAVES * 64; const f32x4* src = (const f32x4*)P.p; v4u* dst = (v4u*)(ws + WS_PB);
      for (int i = gt; i < M * PLE / 8; i += NT) { const f32x4 a = src[2 * i], b = src[2 * i + 1]; v4u o; o.x = pk2(a[0], a[1]); o.y = pk2(a[2], a[3]); o.z = pk2(b[0], b[1]); o.w = pk2(b[2], b[3]); dst[i] = o; } }
}

constexpr int P2_KS = 0, P2_KROW = 144, P2_VT = 36864, P2_VROW = 528, P2_OST = 70656, P2_OROW = 144, P2_SS = 107520, P2_RSTD = 108032;
__device__ __forceinline__ int crow(int r, int hi) { return (r & 3) + 8 * (r >> 2) + 4 * hi; }
__device__ __forceinline__ void p2_unit(const Ptrs& P, LAS unsigned char* lds, int unit) {
    const int tid = threadIdx.x, lane = tid & 63, wid = __builtin_amdgcn_readfirstlane(tid >> 6), l32 = lane & 31, hi = lane >> 5;
    const bf16* proj = (const bf16*)(P.ws + WS_PROJ); bf16* mixed = (bf16*)(P.ws + WS_MIX);
    const int b = unit / (SEQ / 128), qb = unit % (SEQ / 128), q0 = qb * 128; const size_t rowbase = (size_t)b * SEQ;
    LAS float* rowss = (LAS float*)(lds + P2_SS);
    __syncthreads();
    if (tid < 128) rowss[tid] = 0.f;
    const int h4 = wid & 3, half = wid >> 2;
    const int part = tid & 7;
    float kg[8];
#pragma unroll
    for (int j = 0; j < 8; ++j) kg[j] = P.k_norm[part * 8 + j];
#pragma unroll 1
    for (int g = 0; g < NKV; ++g) {
        __syncthreads();
#pragma unroll
        for (int i = 0; i < 4; ++i) {
            const int key = (tid >> 3) + 64 * i; const int kpos = q0 - 128 + key;
            v4u kraw = (v4u){0u, 0u, 0u, 0u}, vraw = (v4u){0u, 0u, 0u, 0u};
            if (kpos >= 0) { const bf16* pr = proj + (rowbase + kpos) * DIN; kraw = *(const v4u*)(pr + C_K + g * HD + part * 8); vraw = *(const v4u*)(pr + C_V + g * HD + part * 8); }
            float kf[8]; unpack8(kraw, kf); float ss = 0.f;
#pragma unroll
            for (int j = 0; j < 8; ++j) ss += kf[j] * kf[j];
            ss += __shfl_xor(ss, 1); ss += __shfl_xor(ss, 2); ss += __shfl_xor(ss, 4);
            const float rk = 1.0f / sqrtf(ss * (1.0f / HD) + EPS);
#pragma unroll
            for (int j = 0; j < 8; ++j) kf[j] = kf[j] * rk * kg[j];
            *(LAS v4u*)(lds + P2_KS + key * P2_KROW + part * 16) = pack8(kf);
            const int x = key & 15; const int pos = (key & ~15) + (x & 3) + ((x >> 3) & 1) * 4 + ((x >> 2) & 1) * 8;
            LAS bf16* vt = (LAS bf16*)(lds + P2_VT) + pos;
            const unsigned vw[4] = {vraw.x, vraw.y, vraw.z, vraw.w};
#pragma unroll
            for (int j = 0; j < 4; ++j) { vt[(part * 8 + 2 * j) * (P2_VROW / 2)] = (bf16)(vw[j] & 0xffffu); vt[(part * 8 + 2 * j + 1) * (P2_VROW / 2)] = (bf16)(vw[j] >> 16); }
        }
        __syncthreads();
        const int h = g * 4 + h4;
        const float slope2 = exp2f(-0.5f * (float)(h + 1)) * LOG2E, sink2 = P.sinks[h] * LOG2E;
#pragma unroll 1
        for (int sub = 0; sub < 2; ++sub) {
            const int qs = 64 * half + 32 * sub;
            const int kt0 = 2 * half + sub;
            const size_t qrow = rowbase + q0 + qs + l32;
            bf16x8 qf[4];
            { float qv[4][8]; float ss = 0.f;
#pragma unroll
              for (int d0 = 0; d0 < 4; ++d0) { unpack8(*(const v4u*)(proj + qrow * DIN + C_Q + h * HD + 16 * d0 + 8 * hi), qv[d0]);
#pragma unroll
                  for (int j = 0; j < 8; ++j) ss += qv[d0][j] * qv[d0][j]; }
              ss += __shfl_xor(ss, 32);
              const float rq = (1.0f / sqrtf(ss * (1.0f / HD) + EPS)) * (0.125f * LOG2E);
#pragma unroll
              for (int d0 = 0; d0 < 4; ++d0) {
#pragma unroll
                  for (int j = 0; j < 8; ++j) qv[d0][j] = qv[d0][j] * rq * P.q_norm[16 * d0 + 8 * hi + j];
                  const v4u w = pack8(qv[d0]); qf[d0] = __builtin_bit_cast(bf16x8, w); } }
            f32x16 sc[5];
#pragma unroll
            for (int jt = 0; jt < 5; ++jt) { sc[jt] = (f32x16){0.f, 0.f, 0.f, 0.f, 0.f, 0.f, 0.f, 0.f, 0.f, 0.f, 0.f, 0.f, 0.f, 0.f, 0.f, 0.f};
#pragma unroll
                for (int d0 = 0; d0 < 4; ++d0) { const bf16x8 kfr = *(const LAS bf16x8*)(lds + P2_KS + ((kt0 + jt) * 32 + l32) * P2_KROW + (16 * d0 + 8 * hi) * 2);
                    sc[jt] = __builtin_amdgcn_mfma_f32_32x32x16_bf16(kfr, qf[d0], sc[jt], 0, 0, 0); } }
            int bl = l32 - 4 * hi; asm volatile("" : "+v"(bl));
            const float ab = -slope2 * (float)bl;
            float mx = sink2;
#pragma unroll
            for (int jt = 0; jt < 5; ++jt)
#pragma unroll
                for (int r = 0; r < 16; ++r) { const int cc = 128 - 32 * jt - (r & 3) - 8 * (r >> 2);
                    float v = sc[jt][r] + (ab - slope2 * (float)cc);
                    if (jt == 0) v = (bl + cc < 128) ? v : -1.0e30f;
                    if (jt == 4) v = (bl + cc >= 0) ? v : -1.0e30f;
                    sc[jt][r] = v; }
            if (q0 == 0) {
                const int lim = 128 - qs;
#pragma unroll
                for (int jt = 0; jt < 4; ++jt)
#pragma unroll
                    for (int r = 0; r < 16; ++r) { const int kr = crow(r, hi); sc[jt][r] = (32 * jt + kr >= lim) ? sc[jt][r] : -1.0e30f; }
            }
#pragma unroll
            for (int jt = 0; jt < 5; ++jt)
#pragma unroll
                for (int r = 0; r < 16; ++r) mx = fmaxf(mx, sc[jt][r]);
            mx = fmaxf(mx, __shfl_xor(mx, 32));
            float l = 0.f;
#pragma unroll
            for (int jt = 0; jt < 5; ++jt)
#pragma unroll
                for (int r = 0; r < 16; ++r) { const float p = exp2f(sc[jt][r] - mx); sc[jt][r] = p; l += p; }
            l += __shfl_xor(l, 32); l += exp2f(sink2 - mx);
            const float rl = 1.0f / l;
            f32x16 o[2];
#pragma unroll
            for (int dh = 0; dh < 2; ++dh) { o[dh] = (f32x16){0.f, 0.f, 0.f, 0.f, 0.f, 0.f, 0.f, 0.f, 0.f, 0.f, 0.f, 0.f, 0.f, 0.f, 0.f, 0.f}; }
#pragma unroll
            for (int jt = 0; jt < 5; ++jt)
#pragma unroll
                for (int j = 0; j < 2; ++j) { v4u pw; pw.x = pk2(sc[jt][8 * j + 0], sc[jt][8 * j + 1]); pw.y = pk2(sc[jt][8 * j + 2], sc[jt][8 * j + 3]); pw.z = pk2(sc[jt][8 * j + 4], sc[jt][8 * j + 5]); pw.w = pk2(sc[jt][8 * j + 6], sc[jt][8 * j + 7]);
                    const bf16x8 pf = __builtin_bit_cast(bf16x8, pw);
#pragma unroll
                    for (int dh = 0; dh < 2; ++dh) { const bf16x8 vf = *(const LAS bf16x8*)(lds + P2_VT + (32 * dh + l32) * P2_VROW + ((kt0 + jt) * 32 + 16 * j + 8 * hi) * 2);
                        o[dh] = __builtin_amdgcn_mfma_f32_32x32x16_bf16(vf, pf, o[dh], 0, 0, 0); } }
            float ss = 0.f;
            LAS unsigned char* ost = lds + P2_OST + wid * (32 * P2_OROW);
#pragma unroll
            for (int dh = 0; dh < 2; ++dh)
#pragma unroll
                for (int r4 = 0; r4 < 4; ++r4) { float a0 = o[dh][4 * r4] * rl, a1 = o[dh][4 * r4 + 1] * rl, a2 = o[dh][4 * r4 + 2] * rl, a3 = o[dh][4 * r4 + 3] * rl;
                    ss += (a0 * a0 + a1 * a1) + (a2 * a2 + a3 * a3);
                    v2u w; w.x = pk2(a0, a1); w.y = pk2(a2, a3);
                    *(LAS v2u*)(ost + l32 * P2_OROW + (32 * dh + 8 * r4 + 4 * hi) * 2) = w; }
            ss += __shfl_xor(ss, 32);
            if (hi == 0) __hip_atomic_fetch_add(rowss + qs + l32, ss, __ATOMIC_RELAXED, __HIP_MEMORY_SCOPE_WORKGROUP);
            asm volatile("s_waitcnt lgkmcnt(0)" ::: "memory");
#pragma unroll
            for (int i = 0; i < 4; ++i) { const int rr = i * 8 + (lane >> 3), ch = lane & 7; const v4u v = *(const LAS v4u*)(ost + rr * P2_OROW + ch * 16);
                *(v4u*)(mixed + (rowbase + q0 + qs + rr) * D + DCONV + h * HD + ch * 8) = v; }
            asm volatile("s_waitcnt lgkmcnt(0)" ::: "memory");
        }
    }
    asm volatile("s_waitcnt vmcnt(0)" ::: "memory");
    __syncthreads();
    LAS float* rstd = (LAS float*)(lds + P2_RSTD);
    if (tid < 128) rstd[tid] = 1.0f / sqrtf(rowss[tid] * (1.0f / DATTN) + EPS);
    __syncthreads();
#pragma unroll 4
    for (int i = 0; i < 32; ++i) { const int rr = (tid >> 7) + 4 * i, ch = tid & 127; bf16* p = mixed + (rowbase + q0 + rr) * D + DCONV + ch * 8;
        float f[8]; unpack8(*(const v4u*)p, f); const float s = rstd[rr];
#pragma unroll
        for (int j = 0; j < 8; ++j) f[j] *= s;
        *(v4u*)p = pack8(f); }
    {
        const float* cw = P.conv_w; float w0[16], w1[16], w2[16];
#pragma unroll
        for (int j = 0; j < 16; ++j) { const int ch = (j >> 3) * 512 + lane * 8 + (j & 7); w0[j] = cw[ch]; w1[j] = cw[DCONV + ch]; w2[j] = cw[2 * DCONV + ch]; }
        float u1[16], u2[16];
        const int t0 = q0 + 16 * wid;
#pragma unroll
        for (int j = 0; j < 16; ++j) { u1[j] = 0.f; u2[j] = 0.f; }
        if (t0 >= 2) {
#pragma unroll
            for (int hf = 0; hf < 2; ++hf) { const int ch = hf * 512 + lane * 8; float c[8], hc[8];
                const bf16* pr = proj + (rowbase + t0 - 1) * DIN; unpack8(*(const v4u*)(pr + C_C + ch), c); unpack8(*(const v4u*)(pr + C_HC + ch), hc);
#pragma unroll
                for (int j = 0; j < 8; ++j) u1[hf * 8 + j] = c[j] * hc[j];
                pr -= DIN; unpack8(*(const v4u*)(pr + C_C + ch), c); unpack8(*(const v4u*)(pr + C_HC + ch), hc);
#pragma unroll
                for (int j = 0; j < 8; ++j) u2[hf * 8 + j] = c[j] * hc[j]; }
        }
#pragma unroll 2
        for (int rr = 0; rr < 16; ++rr) {
            const bf16* pr = proj + (rowbase + t0 + rr) * DIN; float y[16]; float ss = 0.f;
#pragma unroll
            for (int hf = 0; hf < 2; ++hf) { const int ch = hf * 512 + lane * 8; float bb[8], c[8], hc[8];
                unpack8(*(const v4u*)(pr + C_B + ch), bb); unpack8(*(const v4u*)(pr + C_C + ch), c); unpack8(*(const v4u*)(pr + C_HC + ch), hc);
#pragma unroll
                for (int j = 0; j < 8; ++j) { const int jj = hf * 8 + j; const float u0 = c[j] * hc[j];
                    y[jj] = bb[j] * (w0[jj] * u2[jj] + w1[jj] * u1[jj] + w2[jj] * u0); ss += y[jj] * y[jj]; u2[jj] = u1[jj]; u1[jj] = u0; } }
            ss = wsum(ss); const float rs = 1.0f / sqrtf(ss * (1.0f / DCONV) + EPS);
#pragma unroll
            for (int hf = 0; hf < 2; ++hf) { float f[8];
#pragma unroll
                for (int j = 0; j < 8; ++j) f[j] = y[hf * 8 + j] * rs;
                *(v4u*)(mixed + (rowbase + t0 + rr) * D + hf * 512 + lane * 8) = pack8(f); }
        }
    }
}
constexpr int NPHASE = 10;
struct Args { Ptrs P; int ph_lo, ph_hi; };
__device__ __forceinline__ void moe_tables(LAS unsigned char* ldsx, gu32* ctl) {
    const int tid = threadIdx.x;
    __syncthreads();
    if (tid < 64) {
        const int n = (int)__hip_atomic_load(ctl + CW_CNT + 64 * tid, RLX_AGENT);
        int x = (n + 255) >> 8;
#pragma unroll
        for (int o = 1; o < 64; o <<= 1) { const int v = __shfl_up(x, o); if (tid >= o) x += v; }
        ((LAS int*)(ldsx + pg8::LST_OFF))[tid] = n;
        ((LAS int*)(ldsx + pg8::LST_OFF + 256))[tid + 1] = x;
        if (tid == 0) ((LAS int*)(ldsx + pg8::LST_OFF + 256))[0] = 0;
    }
    __syncthreads();
}
__global__ void __launch_bounds__(NWAVES * 64, 2) mk_fwd(Args args) {
    extern __shared__ __attribute__((aligned(16))) unsigned char lds_raw[];
    LAS unsigned char* lds = (LAS unsigned char*)lds_raw;
    const Ptrs& P = args.P;
    const int tid = threadIdx.x;
    const int G = gridDim.x, bx = blockIdx.x, vcu = (G % 8 == 0) ? (bx % 8) * (G / 8) + bx / 8 : bx;
    unsigned char* ws = P.ws; gu32* ctl = (gu32*)(ws + WS_CTL);
    for (int u = tid; u < (pg8::LDS_BYTES - pg8::LDSX_OFF) / 4; u += NWAVES * 64) ((LAS unsigned*)(lds + pg8::LDSX_OFF))[u] = 0u;
    __syncthreads();
    const int lo = args.ph_lo, hi = args.ph_hi;
    XcdBarrier bar; bar.bar = (unsigned*)(ctl + CW_BAR); bar.x = 0; bar.st = nullptr;
    if (hi - lo > 1) bar = xcd_barrier_post((unsigned*)(ctl + CW_BAR), (volatile LAS unsigned*)(lds + pg8::MISC_OFF) + 8);
#ifdef ONLY_PHASE
#define IN(k) ((k) == ONLY_PHASE && lo <= (k) && (k) < hi)
#else
#define IN(k) (lo <= (k) && (k) < hi)
#endif
#define SEAM(k) do { if (IN(k) && IN((k) + 1)) xcd_barrier(bar); } while (0)
    bf16* Win = (bf16*)(ws + WS_WIN); bf16* Wout = (bf16*)(ws + WS_WOUT); bf16* Wplg = (bf16*)(ws + WS_WPLG); bf16* Wple = (bf16*)(ws + WS_WPLE);
    bf16* Wr = (bf16*)(ws + WS_WR); bf16* Wgu = (bf16*)(ws + WS_WGU); bf16* Wd = (bf16*)(ws + WS_WD);
    bf16* xb = (bf16*)(ws + WS_XB); bf16* mixed = (bf16*)(ws + WS_MIX); bf16* pb = (bf16*)(ws + WS_PB); bf16* proj = (bf16*)(ws + WS_PROJ);
    bf16* hid = (bf16*)(ws + WS_HID); bf16* pw = (bf16*)(ws + WS_PW); bf16* h1 = (bf16*)(ws + WS_H1); bf16* h2 = (bf16*)(ws + WS_H2);
    float* rsx = (float*)(ws + WS_RSX); float* rs1 = (float*)(ws + WS_RS1); float* ss1p = (float*)(ws + WS_SS1P); float* ss2p = (float*)(ws + WS_SS2P);
    int* eid = (int*)(ws + WS_EID); float* ew = (float*)(ws + WS_EW); Ent* ent = (Ent*)(ws + WS_ENT);

    if (IN(0)) { p0_prologue(P, lds, vcu, G); } SEAM(0);
    if (IN(1)) { pg8::Gemm g{xb, Win, M, DIN, D}; pg8::StaticOrder S; S.init(M, DIN, G, bx); pg8::EpiBf16 E{proj, DIN, rsx};
        pg8::gemm_phase<pg8::EpiBf16, pg8::StaticOrder, true>(lds, g, S, E); } SEAM(1);
    if (IN(2)) { for (int unit = vcu; unit < BATCH * (SEQ / 128); unit += G) p2_unit(P, lds, unit); __syncthreads(); } SEAM(2);
    if (IN(3)) { pg8::Gemm g{mixed, Wout, M, D, D}; pg8::StaticOrder S; S.init(M, D, G, bx); pg8::EpiH1 E{P.x, h1, ss1p};
        pg8::gemm_phase<pg8::EpiH1, pg8::StaticOrder, true>(lds, g, S, E); } SEAM(3);
    if (IN(4)) { pg8::Gemm g{h1, Wr, M, 256, D}; pg8::StaticOrder S; S.init(M, 256, G, bx); pg8::EpiRouter E{ss1p, P.b_group, P.b_router, rs1, eid, ew, ent, (unsigned*)(ctl + CW_CNT)};
        pg8::gemm_phase<pg8::EpiRouter, pg8::StaticOrder, false>(lds, g, S, E); } SEAM(4);
    if (IN(5) || IN(6) || IN(7)) moe_tables(lds, ctl);
    const LAS int* T0 = (const LAS int*)(lds + pg8::LST_OFF + 256);
    if (IN(5)) { pg8::Gemm g{h1, Wgu, M, NE * 1024, D}; pg8::MoeOrder<true, 4> S{lds, ent, 0, T0[NLIST], G, vcu}; pg8::EpiGU E{hid, lds};
        pg8::gemm_phase<pg8::EpiGU, pg8::MoeOrder<true, 4>, true>(lds, g, S, E); } SEAM(5);
    if (IN(6)) { pg8::Gemm g{hid, Wd, 0, NE * D, DEXP}; pg8::MoeOrder<false, 8> S{lds, ent, 0, T0[NE], G, vcu}; pg8::EpiDown<0> E{h1, h2, nullptr, lds};
        pg8::gemm_phase<pg8::EpiDown<0>, pg8::MoeOrder<false, 8>, true>(lds, g, S, E); } SEAM(6);
    if (IN(7)) { pg8::Gemm g{hid, Wd, 0, NE * D, DEXP}; pg8::MoeOrder<false, 8> S{lds, ent, T0[NE], T0[NLIST], G, vcu}; pg8::EpiDown<1> E{h2, h2, ss2p, lds};
        pg8::gemm_phase<pg8::EpiDown<1>, pg8::MoeOrder<false, 8>, true>(lds, g, S, E); } SEAM(7);
    if (IN(8)) { pg8::Gemm g{pb, Wple, M, D, PLE}; pg8::StaticOrder S; S.init(M, D, G, bx); pg8::EpiBf16 E{pw, D, nullptr};
        pg8::gemm_phase<pg8::EpiBf16, pg8::StaticOrder, true>(lds, g, S, E); } SEAM(8);
    if (IN(9)) { pg8::Gemm g{h2, Wplg, M, D, D}; pg8::FinalOrder S; S.init(M, D, G, bx); S.ldsx = lds; S.ssp = ss2p; pg8::EpiFinal E{h2, pw, P.out, lds};
        pg8::gemm_phase<pg8::EpiFinal, pg8::FinalOrder, true>(lds, g, S, E); }
#undef IN
#undef SEAM
}
namespace nv {
struct RmId { __device__ int operator()(int n) const { return n; } };
struct RmOff { int off; __device__ int operator()(int n) const { return n + off; } };
struct RmGate { __device__ int operator()(int n) const { return (n >> 7) * 256 + (n & 127); } };
struct RmUp { __device__ int operator()(int n) const { return (n >> 7) * 256 + 128 + (n & 127); } };
template <class RM> __global__ void __launch_bounds__(256) wt(const float* W, int K, int N, const float* g0, const float* g1, int gsplit, bf16* WT, RM rm, size_t wstride, size_t tstride) {
    const size_t i = blockIdx.x * (size_t)blockDim.x + threadIdx.x; if (i >= (size_t)K * N) return;
    const int n = (int)(i / K), k = (int)(i % K);
    const float* Wz = W + blockIdx.y * wstride; bf16* Tz = WT + blockIdx.y * tstride;
    const float g = g0 ? (k < gsplit ? g0[k] : g1[k - gsplit]) : 1.f;
    Tz[(size_t)rm(n) * K + k] = f2bf(g * Wz[(size_t)k * N + n]);
}
__global__ void __launch_bounds__(256) zero_rows(bf16* p, size_t n) { const size_t i = blockIdx.x * (size_t)blockDim.x + threadIdx.x; if (i < n) p[i] = 0; }
__global__ void __launch_bounds__(256) rowcvt(const float* x, bf16* xb, float* rs) {
    const int lane = threadIdx.x & 63; const int row = blockIdx.x * 4 + (threadIdx.x >> 6); if (row >= M) return;
    float s = 0.f;
    for (int c = lane; c < D; c += 64) { const float v = x[(size_t)row * D + c]; s += v * v; xb[(size_t)row * D + c] = f2bf(v); }
    s = wsum(s); if (lane == 0) rs[row] = 1.0f / sqrtf(s / D + EPS);
}
__global__ void __launch_bounds__(256) cvt(const float* p, bf16* pb, size_t n) { const size_t i = blockIdx.x * (size_t)blockDim.x + threadIdx.x; if (i < n) pb[i] = f2bf(p[i]); }
__global__ void __launch_bounds__(256) rowrs(const bf16* h, float* rs) {
    const int lane = threadIdx.x & 63; const int row = blockIdx.x * 4 + (threadIdx.x >> 6); if (row >= M) return;
    float s = 0.f;
    for (int c = lane; c < D; c += 64) { const float v = bf2f(h[(size_t)row * D + c]); s += v * v; }
    s = wsum(s); if (lane == 0) rs[row] = 1.0f / sqrtf(s / D + EPS);
}
template <int K, int NC, class AP, class BP, class EP>
__global__ void __launch_bounds__(256) gemm(long nrows, long ncols_, AP ap, BP bp, EP ep) {
    const int ncols = (int)ncols_;
    const int lane = threadIdx.x & 63; const long wave = blockIdx.x * 4L + (threadIdx.x >> 6);
    const int ngrp = ncols / NC; if (wave >= nrows * ngrp) return;
    const long r = wave / ngrp; const int c0 = (int)(wave % ngrp) * NC;
    constexpr int NCH = (K + 511) / 512;
    float a[NCH][8];
    const bf16* A = ap(r);
#pragma unroll
    for (int ch = 0; ch < NCH; ++ch) { const int k = ch * 512 + lane * 8;
        if (k < K) unpack8(*(const v4u*)(A + k), a[ch]); else { for (int j = 0; j < 8; ++j) a[ch][j] = 0.f; } }
    float res[NC];
#pragma unroll
    for (int c = 0; c < NC; ++c) {
        const bf16* B = bp(r, c0 + c); float s = 0.f;
#pragma unroll
        for (int ch = 0; ch < NCH; ++ch) { const int k = ch * 512 + lane * 8;
            if (k < K) { float b[8]; unpack8(*(const v4u*)(B + k), b);
#pragma unroll
                for (int j = 0; j < 8; ++j) s += a[ch][j] * b[j]; } }
        res[c] = wsum(s);
    }
    if (lane == 0) {
#pragma unroll
        for (int c = 0; c < NC; ++c) ep(r, c0 + c, res[c], res[c ^ 1]);
    }
}
__global__ void __launch_bounds__(256) conv(const bf16* proj, const float* cw, bf16* mixed) {
    const int lane = threadIdx.x & 63; const int row = blockIdx.x * 4 + (threadIdx.x >> 6); if (row >= M) return;
    const int t = row % SEQ; float y[16]; float ss = 0.f;
#pragma unroll
    for (int j = 0; j < 16; ++j) {
        const int ch = lane * 16 + j; const bf16* pr = proj + (size_t)row * DIN;
        const float b = bf2f(pr[C_B + ch]);
        const float u0 = bf2f(pr[C_C + ch]) * bf2f(pr[C_HC + ch]);
        const float u1 = t >= 1 ? bf2f(pr[C_C + ch - DIN]) * bf2f(pr[C_HC + ch - DIN]) : 0.f;
        const float u2 = t >= 2 ? bf2f(pr[C_C + ch - 2 * DIN]) * bf2f(pr[C_HC + ch - 2 * DIN]) : 0.f;
        y[j] = b * (cw[ch] * u2 + cw[DCONV + ch] * u1 + cw[2 * DCONV + ch] * u0); ss += y[j] * y[j];
    }
    ss = wsum(ss); const float rstd = 1.0f / sqrtf(ss / DCONV + EPS);
#pragma unroll
    for (int j = 0; j < 16; ++j) mixed[(size_t)row * D + lane * 16 + j] = f2bf(y[j] * rstd);
}
__global__ void __launch_bounds__(256) attn(const bf16* proj, const float* qn, const float* kn, const float* sinks, float* ya) {
    const int lane = threadIdx.x & 63; const long wave = blockIdx.x * 4L + (threadIdx.x >> 6); if (wave >= (long)M * NH) return;
    const int row = (int)(wave / NH), h = (int)(wave % NH), kvh = h / (NH / NKV), t = row % SEQ;
    float q = bf2f(proj[(size_t)row * DIN + C_Q + h * HD + lane]);
    const float rq = 1.0f / sqrtf(wsum(q * q) / HD + EPS); q = q * rq * qn[lane];
    const float gk = kn[lane]; const float slope = exp2f(-0.5f * (float)(h + 1)); const float sink = sinks[h];
    float m = sink, l = 1.f, o = 0.f;
    const int s0 = t >= 127 ? t - 127 : 0;
    for (int s = s0; s <= t; ++s) {
        const size_t kr = (size_t)(row - (t - s)) * DIN;
        const float k = bf2f(proj[kr + C_K + kvh * HD + lane]); const float v = bf2f(proj[kr + C_V + kvh * HD + lane]);
        const float kk = wsum(k * k); const float rk = 1.0f / sqrtf(kk / HD + EPS);
        const float dot = wsum(q * k * gk) * rk;
        const float sc = dot * 0.125f - slope * (float)(t - s);
        const float mn = fmaxf(m, sc); const float f = __expf(m - mn), pe = __expf(sc - mn);
        l = l * f + pe; o = o * f + pe * v; m = mn;
    }
    ya[(size_t)row * DATTN + h * HD + lane] = o / l;
}
__global__ void __launch_bounds__(256) attnnorm(const float* ya, bf16* mixed) {
    const int lane = threadIdx.x & 63; const int row = blockIdx.x * 4 + (threadIdx.x >> 6); if (row >= M) return;
    float y[16]; float ss = 0.f;
#pragma unroll
    for (int j = 0; j < 16; ++j) { y[j] = ya[(size_t)row * DATTN + lane * 16 + j]; ss += y[j] * y[j]; }
    ss = wsum(ss); const float rstd = 1.0f / sqrtf(ss / DATTN + EPS);
#pragma unroll
    for (int j = 0; j < 16; ++j) mixed[(size_t)row * D + DCONV + lane * 16 + j] = f2bf(y[j] * rstd);
}
__global__ void __launch_bounds__(256) topk(const float* logits, int* eid, float* ew) {
    const int row = blockIdx.x * blockDim.x + threadIdx.x; if (row >= M) return;
    const float* L = logits + (size_t)row * 64;
    int g = 0; float gm = L[0];
    for (int j = 1; j < NGRP; ++j) if (L[j] > gm) { gm = L[j]; g = j; }
    float gs = 0.f; for (int j = 0; j < NGRP; ++j) gs += __expf(L[j] - gm);
    const float gw = 1.0f / gs;
    const float* E = L + NGRP + g * EPG;
    int i1 = 0; float v1 = E[0];
    for (int j = 1; j < EPG; ++j) if (E[j] > v1) { v1 = E[j]; i1 = j; }
    int i2 = -1; float v2 = -3.0e38f;
    for (int j = 0; j < EPG; ++j) if (j != i1 && E[j] > v2) { v2 = E[j]; i2 = j; }
    const float e2 = __expf(v2 - v1); const float w1 = 1.0f / (1.0f + e2), w2 = e2 / (1.0f + e2);
    eid[row * 2] = g * EPG + i1; eid[row * 2 + 1] = g * EPG + i2; ew[row * 2] = gw * w1; ew[row * 2 + 1] = gw * w2;
}

__global__ void __launch_bounds__(256) rs_to_part(const float* rs, float* part) {
    const int i = blockIdx.x * blockDim.x + threadIdx.x; if (i >= M * 32) return; const int row = i >> 5, j = i & 31;
    const float r = rs[row]; part[i] = j == 0 ? (1.0f / (r * r) - EPS) * (float)D : 0.f;
}
__global__ void __launch_bounds__(256) part_to_rs(const float* part, float* rs) {
    const int row = blockIdx.x * blockDim.x + threadIdx.x; if (row >= M) return; float s = 0.f;
    for (int j = 0; j < 32; ++j) s += part[(size_t)row * 32 + j];
    rs[row] = 1.0f / sqrtf(s / D + EPS);
}
__global__ void __launch_bounds__(256) build_lists(const int* eid, const float* ew, const float* rs1, Ent* ent, unsigned* cnt) {
    const int i = blockIdx.x * blockDim.x + threadIdx.x; if (i >= M * 2) return; const int tok = i >> 1, k = i & 1;
    const int l = k * NE + eid[i]; const unsigned slot = atomicAdd(cnt + 64 * l, 1u);
    Ent e; e.tok = tok; e.w = ew[i]; e.rs = rs1[tok]; e.pad = 0; ent[(size_t)l * LCAP + slot] = e;
}
}

#ifndef MK_MASK
#define MK_MASK 0x3ff
#endif
#ifndef MK_SPLIT
#define MK_SPLIT 0
#endif
template <class K, class... A> static void launch1d(K kern, size_t nthreads, int bs, hipStream_t s, A... args) {
    hipLaunchKernelGGL(kern, dim3((unsigned)((nthreads + bs - 1) / bs)), dim3(bs), 0, s, args...);
}
static void nv_stage(int st, const Ptrs& P, hipStream_t stream) {
    unsigned char* ws = P.ws;
    bf16* Win = (bf16*)(ws + WS_WIN); bf16* Wout = (bf16*)(ws + WS_WOUT); bf16* Wplg = (bf16*)(ws + WS_WPLG); bf16* Wple = (bf16*)(ws + WS_WPLE);
    bf16* Wr = (bf16*)(ws + WS_WR); bf16* Wgu = (bf16*)(ws + WS_WGU); bf16* Wd = (bf16*)(ws + WS_WD);
    bf16* xb = (bf16*)(ws + WS_XB); bf16* mixed = (bf16*)(ws + WS_MIX); bf16* pb = (bf16*)(ws + WS_PB); bf16* proj = (bf16*)(ws + WS_PROJ);
    bf16* hid = (bf16*)(ws + WS_HID); bf16* pw = (bf16*)(ws + WS_PW); bf16* h1 = (bf16*)(ws + WS_H1); bf16* h2 = (bf16*)(ws + WS_H2);
    float* rsx = (float*)(ws + WS_RSX); float* rs1 = (float*)(ws + WS_RS1); float* rs2 = (float*)(ws + WS_RS2);
    int* eid = (int*)(ws + WS_EID); float* ew = (float*)(ws + WS_EW); float* logits = (float*)(ws + WS_LOG); float* ya = (float*)(ws + WS_YA);
    const float* nul = nullptr;
    if (st == 0) {
        hipLaunchKernelGGL(nv::wt<nv::RmId>, dim3((unsigned)(((size_t)D * DIN + 255) / 256), 1), dim3(256), 0, stream, P.w_in, D, DIN, P.norm_mix, nul, D, Win, nv::RmId{}, (size_t)0, (size_t)0);
        hipLaunchKernelGGL(nv::wt<nv::RmId>, dim3((unsigned)(((size_t)D * D + 255) / 256), 1), dim3(256), 0, stream, P.w_out, D, D, P.onc, P.ona, DCONV, Wout, nv::RmId{}, (size_t)0, (size_t)0);
        hipLaunchKernelGGL(nv::wt<nv::RmId>, dim3((unsigned)(((size_t)D * D + 255) / 256), 1), dim3(256), 0, stream, P.w_ple_gate, D, D, P.norm_ple, nul, D, Wplg, nv::RmId{}, (size_t)0, (size_t)0);
        hipLaunchKernelGGL(nv::wt<nv::RmId>, dim3((unsigned)(((size_t)PLE * D + 255) / 256), 1), dim3(256), 0, stream, P.w_ple, PLE, D, nul, nul, 0, Wple, nv::RmId{}, (size_t)0, (size_t)0);
        hipLaunchKernelGGL(nv::wt<nv::RmId>, dim3((unsigned)(((size_t)D * NGRP + 255) / 256), 1), dim3(256), 0, stream, P.w_group, D, NGRP, P.norm_ffn, nul, D, Wr, nv::RmId{}, (size_t)0, (size_t)0);
        hipLaunchKernelGGL(nv::wt<nv::RmOff>, dim3((unsigned)(((size_t)D * NE + 255) / 256), 1), dim3(256), 0, stream, P.w_router, D, NE, P.norm_ffn, nul, D, Wr, nv::RmOff{NGRP}, (size_t)0, (size_t)0);
        launch1d(nv::zero_rows, (size_t)(256 - NRT) * D, 256, stream, Wr + (size_t)NRT * D, (size_t)(256 - NRT) * D);
        hipLaunchKernelGGL(nv::wt<nv::RmGate>, dim3((unsigned)(((size_t)D * DEXP + 255) / 256), NE), dim3(256), 0, stream, P.w_gate, D, DEXP, P.norm_ffn, nul, D, Wgu, nv::RmGate{}, (size_t)D * DEXP, (size_t)1024 * D);
        hipLaunchKernelGGL(nv::wt<nv::RmUp>, dim3((unsigned)(((size_t)D * DEXP + 255) / 256), NE), dim3(256), 0, stream, P.w_up, D, DEXP, P.norm_ffn, nul, D, Wgu, nv::RmUp{}, (size_t)D * DEXP, (size_t)1024 * D);
        hipLaunchKernelGGL(nv::wt<nv::RmId>, dim3((unsigned)(((size_t)DEXP * D + 255) / 256), NE), dim3(256), 0, stream, P.w_down, DEXP, D, nul, nul, 0, Wd, nv::RmId{}, (size_t)DEXP * D, (size_t)D * DEXP);
        hipLaunchKernelGGL(nv::rowcvt, dim3(M / 4), dim3(256), 0, stream, P.x, xb, rsx);
        launch1d(nv::cvt, (size_t)M * PLE, 256, stream, P.p, pb, (size_t)M * PLE);
    } else if (st == 1) {
        auto ap = [=] __device__(long r) { return xb + (size_t)r * D; };
        auto bp = [=] __device__(long r, int c) { return Win + (size_t)c * D; };
        auto ep = [=] __device__(long r, int c, float v, float vo) { proj[(size_t)r * DIN + c] = f2bf(v * rsx[r]); };
        hipLaunchKernelGGL((nv::gemm<D, 8, decltype(ap), decltype(bp), decltype(ep)>), dim3((unsigned)((size_t)M * (DIN / 8) / 4)), dim3(256), 0, stream, (long)M, (long)DIN, ap, bp, ep);
    } else if (st == 2) {
        hipLaunchKernelGGL(nv::conv, dim3(M / 4), dim3(256), 0, stream, proj, P.conv_w, mixed);
        hipLaunchKernelGGL(nv::attn, dim3((unsigned)((size_t)M * NH / 4)), dim3(256), 0, stream, proj, P.q_norm, P.k_norm, P.sinks, ya);
        hipLaunchKernelGGL(nv::attnnorm, dim3(M / 4), dim3(256), 0, stream, ya, mixed);
    } else if (st == 3) {
        const float* x = P.x;
        auto ap = [=] __device__(long r) { return mixed + (size_t)r * D; };
        auto bp = [=] __device__(long r, int c) { return Wout + (size_t)c * D; };
        auto ep = [=] __device__(long r, int c, float v, float vo) { h1[(size_t)r * D + c] = f2bf(x[(size_t)r * D + c] + v); };
        hipLaunchKernelGGL((nv::gemm<D, 8, decltype(ap), decltype(bp), decltype(ep)>), dim3((unsigned)((size_t)M * (D / 8) / 4)), dim3(256), 0, stream, (long)M, (long)D, ap, bp, ep);
        hipLaunchKernelGGL(nv::rowrs, dim3(M / 4), dim3(256), 0, stream, h1, rs1);
    } else if (st == 4) {
        const float* bg = P.b_group; const float* br = P.b_router;
        auto ap = [=] __device__(long r) { return h1 + (size_t)r * D; };
        auto bp = [=] __device__(long r, int c) { return Wr + (size_t)c * D; };
        auto ep = [=] __device__(long r, int c, float v, float vo) { logits[(size_t)r * 64 + c] = v * rs1[r] + (c < NGRP ? bg[c] : br[c - NGRP]); };
        hipLaunchKernelGGL((nv::gemm<D, 4, decltype(ap), decltype(bp), decltype(ep)>), dim3((unsigned)((size_t)M * (NRT / 4) / 4)), dim3(256), 0, stream, (long)M, (long)NRT, ap, bp, ep);
        launch1d(nv::topk, (size_t)M, 256, stream, logits, eid, ew);
    } else if (st == 5) {
        auto ap = [=] __device__(long r) { return h1 + (size_t)(r >> 1) * D; };
        auto bp = [=] __device__(long r, int c) { const int e = eid[r]; const int f = c >> 1; const int rowi = (f >> 7) * 256 + (c & 1) * 128 + (f & 127); return Wgu + ((size_t)e * 1024 + rowi) * D; };
        auto ep = [=] __device__(long r, int c, float v, float vo) {
            if (c & 1) { const float rs = rs1[r >> 1]; const int f = c >> 1; const float g = vo * rs, u = v * rs; hid[(size_t)r * DEXP + f] = f2bf(ew[r] * (g / (1.0f + __expf(-g))) * u); } };
        hipLaunchKernelGGL((nv::gemm<D, 8, decltype(ap), decltype(bp), decltype(ep)>), dim3((unsigned)((size_t)M * 2 * (1024 / 8) / 4)), dim3(256), 0, stream, (long)M * 2, (long)1024, ap, bp, ep);
    } else if (st == 6 || st == 7) {
        const long k = st - 6; const bf16* base = k == 0 ? h1 : h2;
        auto ap = [=] __device__(long r) { return hid + (size_t)(r * 2 + k) * DEXP; };
        auto bp = [=] __device__(long r, int c) { const int e = eid[r * 2 + k]; return Wd + ((size_t)e * D + c) * DEXP; };
        auto ep = [=] __device__(long r, int c, float v, float vo) { h2[(size_t)r * D + c] = f2bf(bf2f(base[(size_t)r * D + c]) + v); };
        hipLaunchKernelGGL((nv::gemm<DEXP, 8, decltype(ap), decltype(bp), decltype(ep)>), dim3((unsigned)((size_t)M * (D / 8) / 4)), dim3(256), 0, stream, (long)M, (long)D, ap, bp, ep);
        if (st == 7) hipLaunchKernelGGL(nv::rowrs, dim3(M / 4), dim3(256), 0, stream, h2, rs2);
    } else if (st == 8) {
        auto ap = [=] __device__(long r) { return pb + (size_t)r * PLE; };
        auto bp = [=] __device__(long r, int c) { return Wple + (size_t)c * PLE; };
        auto ep = [=] __device__(long r, int c, float v, float vo) { pw[(size_t)r * D + c] = f2bf(v); };
        hipLaunchKernelGGL((nv::gemm<PLE, 8, decltype(ap), decltype(bp), decltype(ep)>), dim3((unsigned)((size_t)M * (D / 8) / 4)), dim3(256), 0, stream, (long)M, (long)D, ap, bp, ep);
    } else if (st == 9) {
        float* out = P.out;
        auto ap = [=] __device__(long r) { return h2 + (size_t)r * D; };
        auto bp = [=] __device__(long r, int c) { return Wplg + (size_t)c * D; };
        auto ep = [=] __device__(long r, int c, float v, float vo) { const float z = v * rs2[r]; out[(size_t)r * D + c] = bf2f(h2[(size_t)r * D + c]) + (1.0f / (1.0f + __expf(-z))) * bf2f(pw[(size_t)r * D + c]); };
        hipLaunchKernelGGL((nv::gemm<D, 8, decltype(ap), decltype(bp), decltype(ep)>), dim3((unsigned)((size_t)M * (D / 8) / 4)), dim3(256), 0, stream, (long)M, (long)D, ap, bp, ep);
    }
}

extern "C" void kernel_launch(void* const* d_in, const int* in_sizes, int n_in, void* d_out, int out_size, void* d_ws, size_t ws_size, hipStream_t stream) {
    static int grid = 0;
    if (grid == 0) {
        if (n_in != 22 || in_sizes[0] != M * D || out_size != M * D || ws_size < WS_END) { fprintf(stderr, "kernel_launch: unexpected problem (n_in %d, in0 %d, out %d, ws %zu); nothing launched\n", n_in, n_in > 0 ? in_sizes[0] : -1, out_size, ws_size); grid = -1; return; }
        int dev = 0, cus = 0, per_cu = 0;
        if (hipGetDevice(&dev) != hipSuccess || hipDeviceGetAttribute(&cus, hipDeviceAttributeMultiprocessorCount, dev) != hipSuccess) { grid = -1; return; }
        if (hipFuncSetAttribute((const void*)mk_fwd, hipFuncAttributeMaxDynamicSharedMemorySize, pg8::LDS_BYTES) != hipSuccess) { fprintf(stderr, "kernel_launch: hipFuncSetAttribute failed\n"); grid = -1; return; }
        if (hipOccupancyMaxActiveBlocksPerMultiprocessor(&per_cu, (const void*)mk_fwd, NWAVES * 64, pg8::LDS_BYTES) != hipSuccess || per_cu < 1) { fprintf(stderr, "kernel_launch: occupancy query says %d blocks per CU\n", per_cu); (void)hipGetLastError(); grid = -1; return; }
        grid = cus;
    }
    if (grid < 0) return;
    if (hipMemsetAsync((char*)d_ws + WS_CTL, 0, CTL_ZERO_BYTES, stream) != hipSuccess) return;
    Args a{};
    { const float** pp = (const float**)&a.P; for (int i = 0; i < 22; ++i) pp[i] = (const float*)d_in[i]; }
    a.P.out = (float*)d_out; a.P.ws = (unsigned char*)d_ws;
    unsigned char* ws = a.P.ws;
    const unsigned mask = MK_MASK;
    auto is_mk = [&](int s) { return ((mask >> s) & 1u) != 0u; };
    int s = 0;
    while (s < NPHASE) {
        if (is_mk(s)) {
            int e = s + 1; if (!MK_SPLIT) while (e < NPHASE && is_mk(e)) ++e;
            if (s == 4 && !is_mk(3)) launch1d(nv::rs_to_part, (size_t)M * 32, 256, stream, (const float*)(ws + WS_RS1), (float*)(ws + WS_SS1P));
            if (s >= 5 && s <= 7 && !is_mk(4) && s == 5) launch1d(nv::build_lists, (size_t)M * 2, 256, stream, (const int*)(ws + WS_EID), (const float*)(ws + WS_EW), (const float*)(ws + WS_RS1), (Ent*)(ws + WS_ENT), (unsigned*)(ws + WS_CTL) + CW_CNT);
            if (s == 9 && !is_mk(7)) launch1d(nv::rs_to_part, (size_t)M * 32, 256, stream, (const float*)(ws + WS_RS2), (float*)(ws + WS_SS2P));
            a.ph_lo = s; a.ph_hi = e;
            hipLaunchKernelGGL(mk_fwd, dim3(grid), dim3(NWAVES * 64), pg8::LDS_BYTES, stream, a);
            s = e;
        } else {
            if (s == 4 && is_mk(3)) launch1d(nv::part_to_rs, (size_t)M, 256, stream, (const float*)(ws + WS_SS1P), (float*)(ws + WS_RS1));
            if (s == 9 && is_mk(7)) launch1d(nv::part_to_rs, (size_t)M, 256, stream, (const float*)(ws + WS_SS2P), (float*)(ws + WS_RS2));
            nv_stage(s, a.P, stream);
            ++s;
        }
    }
}
```

```cpp
#include <hip/hip_runtime.h>
#include <cstdio>
#include <cstdint>

typedef unsigned short bf16;
typedef unsigned v4u __attribute__((ext_vector_type(4)));
typedef unsigned v2u __attribute__((ext_vector_type(2)));
typedef float f32x4 __attribute__((ext_vector_type(4)));
typedef float f32x16 __attribute__((ext_vector_type(16)));
typedef short bf16x8 __attribute__((ext_vector_type(8)));
#define GAS __attribute__((address_space(1)))
#define LAS __attribute__((address_space(3)))
typedef GAS unsigned gu32;

constexpr int BATCH = 4, SEQ = 8192, D = 2048, M = BATCH * SEQ;
constexpr int DCONV = 1024, NH = 16, NKV = 4, HD = 64, DATTN = 1024, DKV = 256, DIN = 4608;
constexpr int C_B = 0, C_C = 1024, C_HC = 2048, C_Q = 3072, C_K = 4096, C_V = 4352;
constexpr int NGRP = 4, EPG = 8, NE = 32, DEXP = 512, PLE = 256, NRT = 36;
constexpr int NLIST = 64, LCAP = 32768;
constexpr float EPS = 1e-6f;
constexpr float LOG2E = 1.4426950408889634f;

constexpr size_t MiB = 1u << 20;
constexpr size_t WS_CTL = 0, CTL_ZERO_BYTES = 1 * MiB;
constexpr size_t WS_WIN = 2 * MiB;
constexpr size_t WS_WOUT = 20 * MiB;
constexpr size_t WS_WPLG = 28 * MiB;
constexpr size_t WS_WPLE = 36 * MiB;
constexpr size_t WS_WR = 37 * MiB;
constexpr size_t WS_RSX = 38 * MiB;
constexpr size_t WS_RS1 = 38 * MiB + 256 * 1024;
constexpr size_t WS_RS2 = 38 * MiB + 512 * 1024;
constexpr size_t WS_EID = 39 * MiB;
constexpr size_t WS_EW = 39 * MiB + 512 * 1024;
constexpr size_t WS_LOG = 42 * MiB;
constexpr size_t WS_SS1P = 50 * MiB;
constexpr size_t WS_SS2P = 54 * MiB;
constexpr size_t WS_WGU = 64 * MiB;
constexpr size_t WS_WD = 192 * MiB;
constexpr size_t WS_XB = 256 * MiB;
constexpr size_t WS_MIX = WS_XB;
constexpr size_t WS_PB = 384 * MiB;
constexpr size_t WS_PROJ = 400 * MiB;
constexpr size_t WS_HID = 400 * MiB;
constexpr size_t WS_PW = 480 * MiB;
constexpr size_t WS_H1 = 688 * MiB;
constexpr size_t WS_H2 = 816 * MiB;
constexpr size_t WS_YA = 816 * MiB;
constexpr size_t WS_ENT = 944 * MiB;
constexpr size_t WS_END = 976 * MiB;
constexpr int CW_TMO = 0, CW_BAR = 4096, CW_CNT = 8192;

__device__ __forceinline__ float bf2f(bf16 v) { return __uint_as_float(((unsigned)v) << 16); }
__device__ __forceinline__ unsigned f2bfu(float f) { unsigned u = __float_as_uint(f); return (u + 0x7fffu + ((u >> 16) & 1u)) >> 16; }
__device__ __forceinline__ bf16 f2bf(float f) { return (bf16)f2bfu(f); }
__device__ __forceinline__ unsigned pk2(float lo, float hi) { return f2bfu(lo) | (f2bfu(hi) << 16); }
__device__ __forceinline__ float wsum(float v) {
#pragma unroll
    for (int o = 32; o > 0; o >>= 1) v += __shfl_xor(v, o);
    return v;
}
__device__ __forceinline__ void unpack8(v4u w, float* f) {
    f[0] = __uint_as_float(w.x << 16); f[1] = __uint_as_float(w.x & 0xffff0000u);
    f[2] = __uint_as_float(w.y << 16); f[3] = __uint_as_float(w.y & 0xffff0000u);
    f[4] = __uint_as_float(w.z << 16); f[5] = __uint_as_float(w.z & 0xffff0000u);
    f[6] = __uint_as_float(w.w << 16); f[7] = __uint_as_float(w.w & 0xffff0000u);
}
__device__ __forceinline__ v4u pack8(const float* f) { v4u o; o.x = pk2(f[0], f[1]); o.y = pk2(f[2], f[3]); o.z = pk2(f[4], f[5]); o.w = pk2(f[6], f[7]); return o; }

struct Ptrs {
    const float *x, *p, *norm_mix, *w_in, *conv_w, *q_norm, *k_norm, *sinks, *onc, *ona, *w_out, *norm_ffn, *w_group, *b_group, *w_router, *b_router,
        *w_gate, *w_up, *w_down, *norm_ple, *w_ple_gate, *w_ple;
    float* out; unsigned char* ws;
};
struct Ent { int tok; float w; float rs; int pad; };
namespace pg8 {
constexpr int BM = 256, BK = 64, HALF = 128, HTB = HALF * BK * 2  , STAGE_BYTES = 8 * HTB, NXCD = 8, WGM = 8;
constexpr int RING_BYTES = 131072;
constexpr int LDSX_OFF = RING_BYTES;
constexpr int MISC_OFF = LDSX_OFF + 320;
constexpr int TAB_OFF = LDSX_OFF + 1024;
constexpr int LST_OFF = TAB_OFF + 8192;
constexpr int LDS_BYTES = 147456;

__host__ __device__ __forceinline__ int lds_byte(int r, int c) { const int st = (r >> 4) * 2 + (c >> 5), rr = r & 15, cc = c & 31, ob = rr * 64 + cc * 2; return st * 1024 + (ob ^ (((ob >> 9) & 1) << 5)); }
__host__ __device__ __forceinline__ void stage_rc(int b, int& R, int& C) { const int st = b / 1024, sb = b % 1024, swz = sb ^ (((sb >> 9) & 1) << 5); R = (st >> 1) * 16 + swz / 64; C = (st & 1) * 32 + (swz % 64) / 2; }
__host__ __device__ __forceinline__ int perm32(int rho) { const int n = rho >> 4, i = rho & 15; return 8 * (i >> 2) + 4 * n + (i & 3); }

struct Unit { int pm, pn, bt, par, lst, rk0, nl; };
struct Gemm { const bf16* A; const bf16* Bt; int M, N, K; };

struct StaticOrder {
    static constexpr bool GATHER = false;
    int nM, nN, nwg, G, c;
    __host__ __device__ void init(int M_, int N_, int G_, int c_) { nM = M_ / BM; nN = N_ / BM; nwg = nM * nN; G = G_; c = c_; }
    __host__ __device__ bool next(int i, Unit& u) const {
        const long L = (long)i * G + c; if (L >= nwg) return false;
        int wgid = (int)L; { const int q = nwg / NXCD, r = nwg % NXCD, xcd = wgid % NXCD, off = wgid / NXCD; wgid = (xcd < r ? xcd * (q + 1) : r * (q + 1) + (xcd - r) * q) + off; }
        const int nig = WGM * nN, gid = wgid / nig, fm = gid * WGM, gsz = (nM - fm) < WGM ? (nM - fm) : WGM;
        u.pm = fm + ((wgid % nig) % gsz); u.pn = (wgid % nig) / gsz; u.bt = u.pn; u.par = i & 1; u.lst = 0; u.rk0 = 0; u.nl = 0; return true;
    }
    __device__ __forceinline__ void a_ready(const Unit&) const {}
    __device__ __forceinline__ void done(const Unit&) const {}
};

__device__ __forceinline__ unsigned cvt_pk_bf16(float lo, float hi) { unsigned r; asm volatile("v_cvt_pk_bf16_f32 %0, %1, %2" : "=v"(r) : "v"(lo), "v"(hi)); return r; }

template <class Epi, class Sched, bool ALIGN_EPI>
__device__ __forceinline__ void gemm_phase(LAS unsigned char* lds, const Gemm g, const Sched& S, const Epi& E) {
    const int tid = threadIdx.x, wid = __builtin_amdgcn_readfirstlane(tid >> 6), lane = tid & 63, wr = wid >> 2, wc = wid & 3, fr = lane & 15, fq = lane >> 4;
    const int K = g.K, nt = K / BK;
    unsigned voffA[2], voffB[2]; int R0 = 0, C0 = 0;
#pragma unroll
    for (int i = 0; i < 2; ++i) { int R, C; stage_rc(tid * 16 + i * 8192, R, C); const int Rb = Epi::PERM ? ((R & ~31) + perm32(R & 31)) : R;
        voffA[i] = (unsigned)(R * K + C) * 2u; voffB[i] = (unsigned)(Rb * K + C) * 2u; if (i == 0) { R0 = R; C0 = C; } }
    const size_t kstep = (size_t)(BK * 2);
    const size_t hstep = (size_t)HALF * K * 2;
    const size_t tstep = 2 * hstep;
    const unsigned ldsw = (unsigned)wid * 1024u;
    const int aoff = lds_byte(wr * 64 + fr, fq * 8), boff = lds_byte(wc * 32 + fr, fq * 8);
    unsigned gc[2][2] = {{0u, 0u}, {0u, 0u}}, gn[2][2] = {{0u, 0u}, {0u, 0u}}, gs[2][2] = {{0u, 0u}, {0u, 0u}};
#define PG8_TOK(par, r) (*(const LAS int*)(lds + TAB_OFF + (par) * 4096 + (r) * 16))
#define PG8_GLOAD(dst, par) do { _Pragma("unroll") for (int _h = 0; _h < 2; ++_h) _Pragma("unroll") for (int _i = 0; _i < 2; ++_i) \
        dst[_h][_i] = (unsigned)PG8_TOK(par, _h * 128 + _i * 64 + R0) * (unsigned)(K * 2) + (unsigned)(C0 * 2); } while (0)
#define PG8_SA(b, h) (((b) * 2 + (h)) * HTB)
#define PG8_SB(b, h) ((4 + (b) * 2 + (h)) * HTB)
#define PG8_STAGE(bufoff, gbase, voff) do { _Pragma("unroll") for (int _i = 0; _i < 2; ++_i) \
        __builtin_amdgcn_global_load_lds((const unsigned*)((const char*)(gbase) + (voff)[_i]), (LAS unsigned*)(lds + (bufoff) + ldsw + _i * 8192), 16, 0, 0); } while (0)
#define PG8_STAGE_A(bufoff, ub, go, h, kb) do { if constexpr (Sched::GATHER) { PG8_STAGE(bufoff, (const char*)g.A + (kb), go[h]); } else { PG8_STAGE(bufoff, (ub) + (kb) + (h) * hstep, voffA); } } while (0)
#define PG8_LDA(dst, b, h) do { _Pragma("unroll") for (int m = 0; m < 4; ++m) _Pragma("unroll") for (int k = 0; k < 2; ++k) dst[m][k] = *(const LAS bf16x8*)(lds + PG8_SA(b, h) + aoff + m * 2048 + k * 1024); } while (0)
#define PG8_LDB(dst, b, h) do { _Pragma("unroll") for (int n = 0; n < 2; ++n) _Pragma("unroll") for (int k = 0; k < 2; ++k) dst[n][k] = *(const LAS bf16x8*)(lds + PG8_SB(b, h) + boff + n * 2048 + k * 1024); } while (0)
#define PG8_MMA(ai, bj, At, Bt) do { __builtin_amdgcn_s_setprio(1); _Pragma("unroll") for (int m = 0; m < 4; ++m) _Pragma("unroll") for (int n = 0; n < 2; ++n) _Pragma("unroll") for (int k = 0; k < 2; ++k) \
        acc[ai][bj][m][n] = __builtin_amdgcn_mfma_f32_16x16x32_bf16(Bt[n][k], At[m][k], acc[ai][bj][m][n], 0, 0, 0); __builtin_amdgcn_s_setprio(0); } while (0)
#define PG8_WAIT_V(n) asm volatile("s_waitcnt vmcnt(" #n ")" ::: "memory")
#define PG8_WAIT_L(n) asm volatile("s_waitcnt lgkmcnt(" #n ")" ::: "memory")
#define PG8_BAR __builtin_amdgcn_s_barrier()
#define PG8_SCHED __builtin_amdgcn_sched_barrier(0)
    Unit cur, nxt; int ui = 0;
    if (!S.next(0, cur)) return;
    f32x4 acc[2][2][4][2];
#pragma unroll
    for (int a = 0; a < 2; ++a)
#pragma unroll
        for (int b = 0; b < 2; ++b)
#pragma unroll
            for (int m = 0; m < 4; ++m)
#pragma unroll
                for (int n = 0; n < 2; ++n) acc[a][b][m][n] = (f32x4){0.f, 0.f, 0.f, 0.f};
    bf16x8 At[4][2], B0[2][2], B1[2][2];
    const char* cA = (const char*)g.A + (size_t)cur.pm * tstep; const char* cB = (const char*)g.Bt + (size_t)cur.bt * tstep;
    S.a_ready(cur);
    if constexpr (Sched::GATHER) { PG8_GLOAD(gc, cur.par); }
    PG8_STAGE(PG8_SB(0, 0), cB, voffB); PG8_STAGE(PG8_SB(0, 1), cB + hstep, voffB); PG8_STAGE_A(PG8_SA(0, 0), cA, gc, 0, (size_t)0); PG8_STAGE_A(PG8_SA(0, 1), cA, gc, 1, (size_t)0);
    if (wr == 1) PG8_BAR;
    PG8_WAIT_V(2); PG8_BAR;
    PG8_STAGE(PG8_SB(1, 0), cB + kstep, voffB); PG8_STAGE_A(PG8_SA(1, 0), cA, gc, 0, kstep); PG8_STAGE(PG8_SB(1, 1), cB + hstep + kstep, voffB);
    PG8_WAIT_V(6); PG8_BAR;
    for (;;) {
        const bool has_next = S.next(ui + 1, nxt);
        const char* nA = has_next ? (const char*)g.A + (size_t)nxt.pm * tstep : cA; const char* nB = has_next ? (const char*)g.Bt + (size_t)nxt.bt * tstep : cB;
        for (int t = 0; t < nt; t += 2) {
            const bool last = (t == nt - 2);
            const size_t k1 = (size_t)(t + 1) * kstep;
            const char* sA = last ? nA : cA; const size_t k2 = last ? (size_t)0 : (size_t)(t + 2) * kstep, k3 = k2 + kstep;
            const char* b2 = last ? nB : cB + (size_t)(t + 2) * kstep; const char* b3 = b2 + kstep;
            if (last && has_next) { S.a_ready(nxt); if constexpr (Sched::GATHER) { PG8_GLOAD(gn, nxt.par); } }
            if constexpr (Sched::GATHER) {
#pragma unroll
                for (int h = 0; h < 2; ++h)
#pragma unroll
                    for (int i = 0; i < 2; ++i) gs[h][i] = (last && has_next) ? gn[h][i] : gc[h][i];
            }
            PG8_LDB(B0, 0, 0); PG8_LDB(B1, 0, 1); PG8_SCHED; PG8_LDA(At, 0, 0); PG8_STAGE_A(PG8_SA(1, 1), cA, gc, 1, k1);
            PG8_WAIT_V(8); PG8_WAIT_L(0); PG8_BAR; PG8_MMA(0, 0, At, B0); PG8_MMA(0, 1, At, B1); PG8_BAR; PG8_SCHED;
            PG8_LDA(At, 0, 1); PG8_STAGE(PG8_SB(0, 0), b2, voffB); PG8_STAGE(PG8_SB(0, 1), b2 + hstep, voffB); PG8_STAGE_A(PG8_SA(0, 0), sA, gs, 0, k2);
            PG8_WAIT_V(8); PG8_WAIT_L(0); PG8_BAR; PG8_MMA(1, 0, At, B0); PG8_MMA(1, 1, At, B1); PG8_BAR; PG8_SCHED;
            PG8_LDB(B0, 1, 0); PG8_LDB(B1, 1, 1); PG8_SCHED; PG8_LDA(At, 1, 0); PG8_STAGE_A(PG8_SA(0, 1), sA, gs, 1, k2);
            PG8_WAIT_V(8); PG8_WAIT_L(0); PG8_BAR; PG8_MMA(0, 0, At, B0); PG8_MMA(0, 1, At, B1); PG8_BAR; PG8_SCHED;
            PG8_LDA(At, 1, 1); PG8_STAGE(PG8_SB(1, 0), b3, voffB); PG8_STAGE(PG8_SB(1, 1), b3 + hstep, voffB); PG8_STAGE_A(PG8_SA(1, 0), sA, gs, 0, k3);
            PG8_WAIT_V(8); PG8_WAIT_L(0); PG8_BAR; PG8_MMA(1, 0, At, B0); PG8_MMA(1, 1, At, B1); PG8_BAR; PG8_SCHED;
        }
        if constexpr (ALIGN_EPI) { if (wr == 0) PG8_BAR; }
        if constexpr (!Epi::AFTER_DRAIN) { E(acc, cur, wr, wc, fr, fq); S.done(cur); }
        if (!has_next) break;
#pragma unroll
        for (int a = 0; a < 2; ++a)
#pragma unroll
            for (int b = 0; b < 2; ++b)
#pragma unroll
                for (int m = 0; m < 4; ++m)
#pragma unroll
                    for (int n = 0; n < 2; ++n) acc[a][b][m][n] = (f32x4){0.f, 0.f, 0.f, 0.f};
        cur = nxt; cA = nA; cB = nB; ++ui;
        if constexpr (Sched::GATHER) {
#pragma unroll
            for (int h = 0; h < 2; ++h)
#pragma unroll
                for (int i = 0; i < 2; ++i) gc[h][i] = gn[h][i];
        }
        if constexpr (ALIGN_EPI) { if (wr == 1) PG8_BAR; }
    }
    PG8_WAIT_V(0);
    if constexpr (!ALIGN_EPI) { if (wr == 0) PG8_BAR; }
    PG8_BAR;
    if constexpr (Epi::AFTER_DRAIN) { E.fused(acc, cur, wr, wc, fr, fq, lds, wid, lane); S.done(cur); }
#undef PG8_TOK
#undef PG8_GLOAD
#undef PG8_SA
#undef PG8_SB
#undef PG8_STAGE
#undef PG8_STAGE_A
#undef PG8_LDA
#undef PG8_LDB
#undef PG8_MMA
#undef PG8_WAIT_V
#undef PG8_WAIT_L
#undef PG8_BAR
#undef PG8_SCHED
}

typedef f32x4 Acc[2][2][4][2];
#define TAB_ENT(ldsx, par, r) ((const LAS Ent*)((ldsx) + TAB_OFF + (par) * 4096 + (r) * 16))

struct EpiBf16 {
    static constexpr bool PERM = true, AFTER_DRAIN = false;
    bf16* O; int ldc; const float* rs;
    __device__ __forceinline__ void operator()(const Acc& acc, const Unit& u, int wr, int wc, int fr, int fq) const {
        const int row0 = u.pm * BM + wr * 64 + fr, col0 = u.pn * BM + wc * 32 + 8 * fq;
#pragma unroll
        for (int ai = 0; ai < 2; ++ai)
#pragma unroll
            for (int m = 0; m < 4; ++m) { const int row = row0 + ai * HALF + m * 16; const float s = rs ? rs[row] : 1.f; bf16* rowp = O + (size_t)row * ldc + col0;
#pragma unroll
                for (int bj = 0; bj < 2; ++bj) { const f32x4 v0 = acc[ai][bj][m][0] * s, v1 = acc[ai][bj][m][1] * s; v4u w;
                    w.x = cvt_pk_bf16(v0[0], v0[1]); w.y = cvt_pk_bf16(v0[2], v0[3]); w.z = cvt_pk_bf16(v1[0], v1[1]); w.w = cvt_pk_bf16(v1[2], v1[3]);
                    *(v4u*)(rowp + bj * HALF) = w; } }
    }
};
struct EpiH1 {
    static constexpr bool PERM = true, AFTER_DRAIN = false;
    const float* x; bf16* h1; float* ssp;
    __device__ __forceinline__ void operator()(const Acc& acc, const Unit& u, int wr, int wc, int fr, int fq) const {
        const int row0 = u.pm * BM + wr * 64 + fr, col0 = u.pn * BM + wc * 32 + 8 * fq;
        f32x4 xv[2][4];
#define H1_LOAD(g_, buf) do { const size_t off_ = (size_t)(row0 + ((g_) >> 2) * HALF + ((g_) & 3) * 16) * D + col0; \
            xv[buf][0] = *(const f32x4*)(x + off_); xv[buf][1] = *(const f32x4*)(x + off_ + 4); xv[buf][2] = *(const f32x4*)(x + off_ + HALF); xv[buf][3] = *(const f32x4*)(x + off_ + HALF + 4); } while (0)
        H1_LOAD(0, 0);
#pragma unroll
        for (int gi = 0; gi < 8; ++gi) { const int ai = gi >> 2, m = gi & 3;
            if (gi + 1 < 8) H1_LOAD(gi + 1, (gi + 1) & 1);
            asm volatile("" ::: "memory");
            const int row = row0 + ai * HALF + m * 16; const size_t off = (size_t)row * D + col0; float ss = 0.f;
#pragma unroll
            for (int bj = 0; bj < 2; ++bj) { const f32x4 v0 = acc[ai][bj][m][0] + xv[gi & 1][2 * bj], v1 = acc[ai][bj][m][1] + xv[gi & 1][2 * bj + 1]; v4u w;
                ss += (v0[0] * v0[0] + v0[1] * v0[1]) + (v0[2] * v0[2] + v0[3] * v0[3]) + (v1[0] * v1[0] + v1[1] * v1[1]) + (v1[2] * v1[2] + v1[3] * v1[3]);
                w.x = cvt_pk_bf16(v0[0], v0[1]); w.y = cvt_pk_bf16(v0[2], v0[3]); w.z = cvt_pk_bf16(v1[0], v1[1]); w.w = cvt_pk_bf16(v1[2], v1[3]);
                *(v4u*)(h1 + off + bj * HALF) = w; }
            ss += __shfl_xor(ss, 16); ss += __shfl_xor(ss, 32);
            if (fq == 0) ssp[(size_t)row * 32 + u.pn * 4 + wc] = ss;
            asm volatile("" ::: "memory"); }
#undef H1_LOAD
    }
};
struct EpiRouter {
    static constexpr bool PERM = false, AFTER_DRAIN = true;
    const float* ssp; const float* bg; const float* br; float* rs1; int* eid; float* ew; Ent* ent; unsigned* cnt;
    __device__ __forceinline__ void fused(const Acc& acc, const Unit& u, int wr, int wc, int fr, int fq, LAS unsigned char* lds, int wid, int lane) const {
        LAS float* LG = (LAS float*)lds;
        LAS unsigned* HIST = (LAS unsigned*)(lds + 65536);
        LAS unsigned* BASE = (LAS unsigned*)(lds + 65536 + 256);
        const int tid = threadIdx.x;
        if (tid < 64) HIST[tid] = 0u;
        if (wc < 2) {
#pragma unroll
            for (int ai = 0; ai < 2; ++ai)
#pragma unroll
                for (int m = 0; m < 4; ++m) { const int r = ai * HALF + wr * 64 + m * 16 + fr;
#pragma unroll
                    for (int n = 0; n < 2; ++n) { const int c = wc * 32 + 16 * n + 4 * fq; if (c < 40) *(LAS f32x4*)(LG + r * 40 + c) = acc[ai][0][m][n]; } }
        }
        __syncthreads();
        int l0 = 0, l1 = 0; unsigned k0 = 0, k1 = 0; float w0 = 0.f, w1 = 0.f, rs = 0.f; const int row = u.pm * BM + tid;
        if (tid < 256) {
            float ss = 0.f;
#pragma unroll
            for (int j = 0; j < 8; ++j) { const f32x4 p = *(const f32x4*)(ssp + (size_t)row * 32 + 4 * j); ss += (p[0] + p[1]) + (p[2] + p[3]); }
            rs = 1.0f / sqrtf(ss * (1.0f / D) + EPS);
            const LAS float* L = LG + tid * 40;
            float gl[NGRP]; int g = 0;
#pragma unroll
            for (int j = 0; j < NGRP; ++j) gl[j] = L[j] * rs + bg[j];
            float gm = gl[0];
#pragma unroll
            for (int j = 1; j < NGRP; ++j) if (gl[j] > gm) { gm = gl[j]; g = j; }
            float gsum = 0.f;
#pragma unroll
            for (int j = 0; j < NGRP; ++j) gsum += __expf(gl[j] - gm);
            const float gw = 1.0f / gsum;
            const LAS float* E = L + NGRP + g * EPG; const float* be = br + g * EPG;
            int i1 = 0; float v1 = E[0] * rs + be[0];
            for (int j = 1; j < EPG; ++j) { const float v = E[j] * rs + be[j]; if (v > v1) { v1 = v; i1 = j; } }
            int i2 = 0; float v2 = -3.0e38f;
            for (int j = 0; j < EPG; ++j) { const float v = E[j] * rs + be[j]; if (j != i1 && v > v2) { v2 = v; i2 = j; } }
            const float e2 = __expf(v2 - v1); w0 = gw / (1.0f + e2); w1 = gw * e2 / (1.0f + e2);
            l0 = g * EPG + i1; l1 = NE + g * EPG + i2;
            eid[row * 2] = l0; eid[row * 2 + 1] = l1 - NE; ew[row * 2] = w0; ew[row * 2 + 1] = w1; rs1[row] = rs;
            k0 = __hip_atomic_fetch_add(HIST + l0, 1u, __ATOMIC_RELAXED, __HIP_MEMORY_SCOPE_WORKGROUP); k1 = __hip_atomic_fetch_add(HIST + l1, 1u, __ATOMIC_RELAXED, __HIP_MEMORY_SCOPE_WORKGROUP);
        }
        __syncthreads();
        if (tid < 64) { const unsigned n = HIST[tid]; BASE[tid] = n ? __hip_atomic_fetch_add(cnt + 64 * tid, n, __ATOMIC_RELAXED, __HIP_MEMORY_SCOPE_AGENT) : 0u; }
        __syncthreads();
        if (tid < 256) {
            *(v4u*)(ent + (size_t)l0 * LCAP + BASE[l0] + k0) = (v4u){(unsigned)row, __float_as_uint(w0), __float_as_uint(rs), 0u};
            *(v4u*)(ent + (size_t)l1 * LCAP + BASE[l1] + k1) = (v4u){(unsigned)row, __float_as_uint(w1), __float_as_uint(rs), 0u};
        }
    }
};
struct EpiGU {
    static constexpr bool PERM = true, AFTER_DRAIN = false;
    bf16* hid; LAS unsigned char* ldsx;
    __device__ __forceinline__ void operator()(const Acc& acc, const Unit& u, int wr, int wc, int fr, int fq) const {
        const int col0 = u.pn * HALF + wc * 32 + 8 * fq;
#pragma unroll
        for (int ai = 0; ai < 2; ++ai)
#pragma unroll
            for (int m = 0; m < 4; ++m) { const int r = ai * HALF + wr * 64 + m * 16 + fr; const LAS Ent* e = TAB_ENT(ldsx, u.par, r); const float w = e->w, rs = e->rs;
                float o[8];
#pragma unroll
                for (int n = 0; n < 2; ++n)
#pragma unroll
                    for (int i = 0; i < 4; ++i) { const float gg = acc[ai][0][m][n][i] * rs, uu = acc[ai][1][m][n][i] * rs; o[n * 4 + i] = w * (gg / (1.0f + __expf(-gg))) * uu; }
                v4u q; q.x = cvt_pk_bf16(o[0], o[1]); q.y = cvt_pk_bf16(o[2], o[3]); q.z = cvt_pk_bf16(o[4], o[5]); q.w = cvt_pk_bf16(o[6], o[7]);
                *(v4u*)(hid + (size_t)(u.pm * BM + r) * DEXP + col0) = q; }
    }
};
template <int KK> struct EpiDown {
    static constexpr bool PERM = true, AFTER_DRAIN = false;
    const bf16* base; bf16* h2; float* ssp; LAS unsigned char* ldsx;
    __device__ __forceinline__ void operator()(const Acc& acc, const Unit& u, int wr, int wc, int fr, int fq) const {
        const int col0 = u.pn * BM + wc * 32 + 8 * fq;
        int tk[8];
#pragma unroll
        for (int gi = 0; gi < 8; ++gi) tk[gi] = TAB_ENT(ldsx, u.par, (gi >> 2) * HALF + wr * 64 + (gi & 3) * 16 + fr)->tok;
        v4u bv[2][2];
#define DN_LOAD(g_, buf) do { const size_t off_ = (size_t)tk[g_] * D + col0; bv[buf][0] = *(const v4u*)(base + off_); bv[buf][1] = *(const v4u*)(base + off_ + HALF); } while (0)
        DN_LOAD(0, 0);
#pragma unroll
        for (int gi = 0; gi < 8; ++gi) { const int ai = gi >> 2, m = gi & 3;
            if (gi + 1 < 8) DN_LOAD(gi + 1, (gi + 1) & 1);
            asm volatile("" ::: "memory");
            const int r = ai * HALF + wr * 64 + m * 16 + fr; const bool valid = (u.rk0 + r) < u.nl; const size_t off = (size_t)tk[gi] * D + col0; float ss = 0.f;
#pragma unroll
            for (int bj = 0; bj < 2; ++bj) { float b[8]; unpack8(bv[gi & 1][bj], b);
                float o[8];
#pragma unroll
                for (int n = 0; n < 2; ++n)
#pragma unroll
                    for (int i = 0; i < 4; ++i) { o[n * 4 + i] = b[n * 4 + i] + acc[ai][bj][m][n][i]; ss += o[n * 4 + i] * o[n * 4 + i]; }
                v4u q; q.x = cvt_pk_bf16(o[0], o[1]); q.y = cvt_pk_bf16(o[2], o[3]); q.z = cvt_pk_bf16(o[4], o[5]); q.w = cvt_pk_bf16(o[6], o[7]);
                if (valid) *(v4u*)(h2 + off + bj * HALF) = q; }
            if (KK == 1) { ss += __shfl_xor(ss, 16); ss += __shfl_xor(ss, 32); if (fq == 0 && valid) ssp[(size_t)tk[gi] * 32 + u.pn * 4 + wc] = ss; }
            asm volatile("" ::: "memory"); }
#undef DN_LOAD
    }
};
struct EpiFinal {
    static constexpr bool PERM = true, AFTER_DRAIN = false;
    const bf16* h2; const bf16* pw; float* out; LAS unsigned char* ldsx;
    __device__ __forceinline__ void operator()(const Acc& acc, const Unit& u, int wr, int wc, int fr, int fq) const {
        const int col0 = u.pn * BM + wc * 32 + 8 * fq;
        v4u hv[2][2], pv[2][2];
#define FN_LOAD(g_, buf) do { const size_t off_ = (size_t)(u.pm * BM + ((g_) >> 2) * HALF + wr * 64 + ((g_) & 3) * 16 + fr) * D + col0; \
            hv[buf][0] = *(const v4u*)(h2 + off_); hv[buf][1] = *(const v4u*)(h2 + off_ + HALF); pv[buf][0] = *(const v4u*)(pw + off_); pv[buf][1] = *(const v4u*)(pw + off_ + HALF); } while (0)
        FN_LOAD(0, 0);
#pragma unroll
        for (int gi = 0; gi < 8; ++gi) { const int ai = gi >> 2, m = gi & 3;
            if (gi + 1 < 8) FN_LOAD(gi + 1, (gi + 1) & 1);
            asm volatile("" ::: "memory");
            const int r = ai * HALF + wr * 64 + m * 16 + fr; const float rs = TAB_ENT(ldsx, u.par, r)->rs; const size_t off = (size_t)(u.pm * BM + r) * D + col0;
#pragma unroll
            for (int bj = 0; bj < 2; ++bj) { float hf[8], pf[8]; unpack8(hv[gi & 1][bj], hf); unpack8(pv[gi & 1][bj], pf);
#pragma unroll
                for (int n = 0; n < 2; ++n) { const f32x4 z = acc[ai][bj][m][n] * rs; f32x4 o;
#pragma unroll
                    for (int i = 0; i < 4; ++i) o[i] = hf[n * 4 + i] + pf[n * 4 + i] * __builtin_amdgcn_rcpf(1.0f + __expf(-z[i]));
                    *(f32x4*)(out + off + bj * HALF + n * 4) = o; } }
            asm volatile("" ::: "memory"); }
#undef FN_LOAD
    }
};

template <bool GATHER_, int NPN> struct MoeOrder {
    static constexpr bool GATHER = GATHER_;
    LAS unsigned char* ldsx; const Ent* ent; int tlo, thi, G, c;
    __device__ __forceinline__ bool next(int i, Unit& u) const {
        const long L = (long)i * G + c; const int nun = (thi - tlo) * NPN; if (L >= nun) return false;
        const int tile = tlo + (int)(L / NPN); const LAS int* T0 = (const LAS int*)(ldsx + LST_OFF + 256);
        int l = 0;
        for (int j = 1; j < NLIST; ++j) l += (T0[j] <= tile) ? 1 : 0;
        u.pm = tile; u.pn = (int)(L % NPN); u.bt = (l & (NE - 1)) * NPN + u.pn; u.par = i & 1; u.lst = l; u.rk0 = (tile - T0[l]) * BM; u.nl = ((const LAS int*)(ldsx + LST_OFF))[l];
        return true;
    }
    __device__ __forceinline__ void a_ready(const Unit& u) const {
        const int tid = threadIdx.x;
        if (tid < 256) { const int rk = u.rk0 + tid; v4u e = (v4u){0u, 0u, 0u, 0u}; if (rk < u.nl) e = *(const v4u*)(ent + (size_t)u.lst * LCAP + rk);
            *(LAS v4u*)(ldsx + TAB_OFF + u.par * 4096 + tid * 16) = e; }
        if (GATHER) { asm volatile("s_waitcnt vmcnt(0) lgkmcnt(0)" ::: "memory"); __builtin_amdgcn_s_barrier(); asm volatile("" ::: "memory"); }
    }
    __device__ __forceinline__ void done(const Unit&) const {}
};
struct FinalOrder : StaticOrder {
    LAS unsigned char* ldsx; const float* ssp;
    __device__ __forceinline__ void a_ready(const Unit& u) const {
        const int tid = threadIdx.x;
        if (tid < 256) { const int row = u.pm * BM + tid; float ss = 0.f;
#pragma unroll
            for (int j = 0; j < 8; ++j) { const f32x4 p = *(const f32x4*)(ssp + (size_t)row * 32 + 4 * j); ss += (p[0] + p[1]) + (p[2] + p[3]); }
            *(LAS v4u*)(ldsx + TAB_OFF + u.par * 4096 + tid * 16) = (v4u){(unsigned)row, 0u, __float_as_uint(1.0f / sqrtf(ss * (1.0f / D) + EPS)), 0u}; }
    }
};
}
#define RLX_AGENT __ATOMIC_RELAXED, __HIP_MEMORY_SCOPE_AGENT
#define XB_TMO      128
#define XB_XCNT(j)  (256  + 64 * (j))
#define XB_XSUB(j)  (1280 + 64 * (j))
#define XB_XGEN(j)  (2304 + 64 * (j))
#define XB_TOP      3328
#define XB_TOPGEN   3392
#define XCD_BAR_WORDS 3456
#define XB_SPIN_CAP (1u << 18)

__device__ __forceinline__ unsigned xb_ld(unsigned* p)              { return __hip_atomic_load(p, __ATOMIC_RELAXED, __HIP_MEMORY_SCOPE_AGENT); }
__device__ __forceinline__ unsigned xb_add(unsigned* p, unsigned v) { return __hip_atomic_fetch_add(p, v, __ATOMIC_RELAXED, __HIP_MEMORY_SCOPE_AGENT); }
__device__ __forceinline__ unsigned xb_xcc_id() { return (unsigned)__builtin_amdgcn_s_getreg((3 << 11) | 20) & 0xFu; }
#define XB_SPIN(cond, bar) do { unsigned _sp = 0; while (cond) { __builtin_amdgcn_s_sleep(1); \
    if ((++_sp & 255u) == 0u) { if (xb_ld(&(bar)[XB_TMO])) break; if (_sp > XB_SPIN_CAP) { atomicAdd(&(bar)[XB_TMO], 1u); break; } } } } while (0)

struct XcdBarrier {
    unsigned* bar; unsigned x;
    volatile LAS unsigned* st;
};
__device__ __forceinline__ XcdBarrier xcd_barrier_post(unsigned* bar, volatile LAS unsigned* st) {
    XcdBarrier b; b.bar = bar; b.x = xb_xcc_id(); b.st = st;
    if (threadIdx.x == 0) (void)xb_add(&bar[XB_XCNT(b.x)], 1u);
    return b;
}
__device__ __forceinline__ void xcd_barrier_complete(unsigned* bar, unsigned x, unsigned& nloc, unsigned& nx) {
    const unsigned G = gridDim.x * gridDim.y * gridDim.z;
    unsigned sum, cnt, mine, sp = 0u;
    for (;;) {
        sum = 0u; cnt = 0u; mine = 0u;
#pragma unroll
        for (unsigned j = 0; j < 16; ++j) { const unsigned c = xb_ld(&bar[XB_XCNT(j)]); sum += c; cnt += (c > 0u) ? 1u : 0u; mine = (j == x) ? c : mine; }
        if (sum == G) break;
        __builtin_amdgcn_s_sleep(1);
        if ((++sp & 255u) == 0u) { if (xb_ld(&bar[XB_TMO])) break; if (sp > XB_SPIN_CAP) { atomicAdd(&bar[XB_TMO], 1u); break; } }
    }
    nloc = mine > 0u ? mine : 1u; nx = cnt > 0u ? cnt : 1u;
}
__device__ __forceinline__ void xcd_barrier(const XcdBarrier& b) {
    asm volatile("s_waitcnt vmcnt(0)" ::: "memory");
    __syncthreads();
    if (threadIdx.x == 0) {
        unsigned* bar = b.bar;
        __builtin_amdgcn_s_waitcnt(0);
        unsigned nloc = b.st[0], nx = b.st[1];
        if (nloc == 0u) { xcd_barrier_complete(bar, b.x, nloc, nx); b.st[0] = nloc; b.st[1] = nx; }
        const unsigned old = xb_add(&bar[XB_XSUB(b.x)], 1u);
        const unsigned gen = old / nloc;
        if (old + 1u == (gen + 1u) * nloc) {
            __builtin_amdgcn_fence(__ATOMIC_RELEASE, "agent");
            asm volatile("s_waitcnt vmcnt(0)" ::: "memory");
            const unsigned og = xb_add(&bar[XB_TOP], 1u);
            const unsigned tg = og / nx;
            if (og + 1u == (tg + 1u) * nx) xb_add(&bar[XB_TOPGEN], 1u);
            else XB_SPIN(xb_ld(&bar[XB_TOPGEN]) == tg, bar);
            __builtin_amdgcn_fence(__ATOMIC_ACQUIRE, "agent");
            xb_add(&bar[XB_XGEN(b.x)], 1u);
            asm volatile("s_waitcnt vmcnt(0)" ::: "memory");
        } else {
            XB_SPIN(xb_ld(&bar[XB_XGEN(b.x)]) == gen, bar);
            __builtin_amdgcn_fence(__ATOMIC_ACQUIRE, "agent");
            asm volatile("s_waitcnt vmcnt(0)" ::: "memory");
        }
    }
    __syncthreads();
}

constexpr int NWAVES = 8;
__device__ __forceinline__ void p0_transpose_item(const float* W, int K, int N, const float* g0, const float* g1, int gsplit, bf16* WT, int rowbase, int k0, int n0, LAS float* scr, int lane) {
    float v[32];
    const float* src = W + (size_t)(k0 + (lane >> 5)) * N + n0 + (lane & 31);
#pragma unroll
    for (int i = 0; i < 32; ++i) v[i] = src[(size_t)(2 * i) * N];
    const int c = lane & 7;
    float gg[8];
#pragma unroll
    for (int j = 0; j < 8; ++j) { const int k = k0 + 8 * c + j; gg[j] = g0 ? (k < gsplit ? g0[k] : g1[k - gsplit]) : 1.f; }
#pragma unroll
    for (int i = 0; i < 32; ++i) scr[(2 * i + (lane >> 5)) * 33 + (lane & 31)] = v[i];
    asm volatile("s_waitcnt lgkmcnt(0)" ::: "memory");
#pragma unroll
    for (int j = 0; j < 4; ++j) { const int n = (lane >> 3) + 8 * j; const LAS float* s = scr + (8 * c) * 33 + n;
        v4u o; o.x = pk2(s[0 * 33] * gg[0], s[1 * 33] * gg[1]); o.y = pk2(s[2 * 33] * gg[2], s[3 * 33] * gg[3]); o.z = pk2(s[4 * 33] * gg[4], s[5 * 33] * gg[5]); o.w = pk2(s[6 * 33] * gg[6], s[7 * 33] * gg[7]);
        *(v4u*)(WT + (size_t)(rowbase + n) * K + k0 + 8 * c) = o; }
    asm volatile("s_waitcnt lgkmcnt(0)" ::: "memory");
}
__device__ __forceinline__ void p0_prologue(const Ptrs& P, LAS unsigned char* lds, int vcu, int G) {
    const int tid = threadIdx.x, lane = tid & 63, wave = __builtin_amdgcn_readfirstlane(tid >> 6);
    unsigned char* ws = P.ws;
    LAS float* scr = (LAS float*)(lds + wave * 16384);
    const int gw = vcu * NWAVES + wave, NGW = G * NWAVES;
    constexpr int I_IN = (D / 64) * (DIN / 32), I_OUT = (D / 64) * (D / 32), I_PLG = I_OUT, I_PLE = (PLE / 64) * (D / 32), I_RT = (D / 64) * (NE / 32);
    constexpr int I_G1 = (D / 64) * (DEXP / 32), I_D1 = (DEXP / 64) * (D / 32);
    constexpr int NITEMS = I_IN + I_OUT + I_PLG + I_PLE + I_RT + NE * (2 * I_G1 + I_D1);
    for (int it = gw; it < NITEMS; it += NGW) {
        int r = it;
        if (r < I_IN) { const int nb = DIN / 32; p0_transpose_item(P.w_in, D, DIN, P.norm_mix, nullptr, D, (bf16*)(ws + WS_WIN), (r % nb) * 32, (r / nb) * 64, (r % nb) * 32, scr, lane); continue; } r -= I_IN;
        if (r < I_OUT) { const int nb = D / 32; p0_transpose_item(P.w_out, D, D, P.onc, P.ona, DCONV, (bf16*)(ws + WS_WOUT), (r % nb) * 32, (r / nb) * 64, (r % nb) * 32, scr, lane); continue; } r -= I_OUT;
        if (r < I_PLG) { const int nb = D / 32; p0_transpose_item(P.w_ple_gate, D, D, P.norm_ple, nullptr, D, (bf16*)(ws + WS_WPLG), (r % nb) * 32, (r / nb) * 64, (r % nb) * 32, scr, lane); continue; } r -= I_PLG;
        if (r < I_PLE) { const int nb = D / 32; p0_transpose_item(P.w_ple, PLE, D, nullptr, nullptr, 0, (bf16*)(ws + WS_WPLE), (r % nb) * 32, (r / nb) * 64, (r % nb) * 32, scr, lane); continue; } r -= I_PLE;
        if (r < I_RT) { p0_transpose_item(P.w_router, D, NE, P.norm_ffn, nullptr, D, (bf16*)(ws + WS_WR), NGRP, r * 64, 0, scr, lane); continue; } r -= I_RT;
        const int e = r / (2 * I_G1 + I_D1); r -= e * (2 * I_G1 + I_D1);
        if (r < 2 * I_G1) { const int up = r >= I_G1; r -= up * I_G1; const int nb = DEXP / 32, n0 = (r % nb) * 32, k0 = (r / nb) * 64;
            p0_transpose_item((up ? P.w_up : P.w_gate) + (size_t)e * D * DEXP, D, DEXP, P.norm_ffn, nullptr, D, (bf16*)(ws + WS_WGU) + (size_t)e * 1024 * D, (n0 >> 7) * 256 + up * 128 + (n0 & 127), k0, n0, scr, lane); continue; }
        r -= 2 * I_G1; { const int nb = D / 32; p0_transpose_item(P.w_down + (size_t)e * DEXP * D, DEXP, D, nullptr, nullptr, 0, (bf16*)(ws + WS_WD) + (size_t)e * D * DEXP, (r % nb) * 32, (r / nb) * 64, (r % nb) * 32, scr, lane); }
    }
    { bf16* Wr = (bf16*)(ws + WS_WR); const int gt = vcu * (NWAVES * 64) + tid, NT = G * NWAVES * 64;
      for (int i = gt; i < NGRP * D; i += NT) { const int n = i / D, k = i % D; Wr[(size_t)n * D + k] = f2bf(P.norm_ffn[k] * P.w_group[(size_t)k * NGRP + n]); }
      for (int i = gt; i < (256 - NRT) * D / 8; i += NT) *(v4u*)(Wr + (size_t)NRT * D + (size_t)i * 8) = (v4u){0u, 0u, 0u, 0u}; }
    for (int m = gw; m < M; m += NGW) {
        const f32x4* xr = (const f32x4*)(P.x + (size_t)m * D) + lane; f32x4 v[8]; float s = 0.f;
#pragma unroll
        for (int j = 0; j < 8; ++j) { v[j] = xr[64 * j]; s += (v[j][0] * v[j][0] + v[j][1] * v[j][1]) + (v[j][2] * v[j][2] + v[j][3] * v[j][3]); }
        s = wsum(s);
        v2u* o8 = (v2u*)((bf16*)(ws + WS_XB) + (size_t)m * D) + lane;
        const float rstd = 1.0f / sqrtf(s * (1.0f / D) + EPS);
#pragma unroll
        for (int j = 0; j < 8; ++j) { v2u o; o.x = pk2(v[j][0] * rstd, v[j][1] * rstd); o.y = pk2(v[j][2] * rstd, v[j][3] * rstd); o8[64 * j] = o; }
        if (lane == 0) ((float*)(ws + WS_RSX))[m] = 1.0f;
    }
    { const int gt = vcu * (NWAVES * 64) + tid, NT = G * NWAVES * 64; const f32x4* src = (const f32x4*)P.p; v4u* dst = (v4u*)(ws + WS_PB);
      for (int i = gt; i < M * PLE / 8; i += NT) { const f32x4 a = src[2 * i], b = src[2 * i + 1]; v4u o; o.x = pk2(a[0], a[1]); o.y = pk2(a[2], a[3]); o.z = pk2(b[0], b[1]); o.w = pk2(b[2], b[3]); dst[i] = o; } }
}

constexpr int P2_KS = 0, P2_KROW = 144, P2_VT = 36864, P2_VROW = 528, P2_OST = 70656, P2_OROW = 144, P2_SS = 107520, P2_RSTD = 108032;
__device__ __forceinline__ int crow(int r, int hi) { return (r & 3) + 8 * (r >> 2) + 4 * hi; }
__device__ __forceinline__ void p2_unit(const Ptrs& P, LAS unsigned char* lds, int unit) {
    const int tid = threadIdx.x, lane = tid & 63, wid = __builtin_amdgcn_readfirstlane(tid >> 6), l32 = lane & 31, hi = lane >> 5;
    const bf16* proj = (const bf16*)(P.ws + WS_PROJ); bf16* mixed = (bf16*)(P.ws + WS_MIX);
    const int b = unit / (SEQ / 128), qb = unit % (SEQ / 128), q0 = qb * 128; const size_t rowbase = (size_t)b * SEQ;
    LAS float* rowss = (LAS float*)(lds + P2_SS);
    __syncthreads();
    if (tid < 128) rowss[tid] = 0.f;
    const int h4 = wid & 3, half = wid >> 2;
    const int part = tid & 7;
    float kg[8];
#pragma unroll
    for (int j = 0; j < 8; ++j) kg[j] = P.k_norm[part * 8 + j];
#pragma unroll 1
    for (int g = 0; g < NKV; ++g) {
        __syncthreads();
#pragma unroll
        for (int i = 0; i < 4; ++i) {
            const int key = (tid >> 3) + 64 * i; const int kpos = q0 - 128 + key;
            v4u kraw = (v4u){0u, 0u, 0u, 0u}, vraw = (v4u){0u, 0u, 0u, 0u};
            if (kpos >= 0) { const bf16* pr = proj + (rowbase + kpos) * DIN; kraw = *(const v4u*)(pr + C_K + g * HD + part * 8); vraw = *(const v4u*)(pr + C_V + g * HD + part * 8); }
            float kf[8]; unpack8(kraw, kf); float ss = 0.f;
#pragma unroll
            for (int j = 0; j < 8; ++j) ss += kf[j] * kf[j];
            ss += __shfl_xor(ss, 1); ss += __shfl_xor(ss, 2); ss += __shfl_xor(ss, 4);
            const float rk = 1.0f / sqrtf(ss * (1.0f / HD) + EPS);
#pragma unroll
            for (int j = 0; j < 8; ++j) kf[j] = kf[j] * rk * kg[j];
            *(LAS v4u*)(lds + P2_KS + key * P2_KROW + part * 16) = pack8(kf);
            const int x = key & 15; const int pos = (key & ~15) + (x & 3) + ((x >> 3) & 1) * 4 + ((x >> 2) & 1) * 8;
            LAS bf16* vt = (LAS bf16*)(lds + P2_VT) + pos;
            const unsigned vw[4] = {vraw.x, vraw.y, vraw.z, vraw.w};
#pragma unroll
            for (int j = 0; j < 4; ++j) { vt[(part * 8 + 2 * j) * (P2_VROW / 2)] = (bf16)(vw[j] & 0xffffu); vt[(part * 8 + 2 * j + 1) * (P2_VROW / 2)] = (bf16)(vw[j] >> 16); }
        }
        __syncthreads();
        const int h = g * 4 + h4;
        const float slope2 = exp2f(-0.5f * (float)(h + 1)) * LOG2E, sink2 = P.sinks[h] * LOG2E;
#pragma unroll 1
        for (int sub = 0; sub < 2; ++sub) {
            const int qs = 64 * half + 32 * sub;
            const int kt0 = 2 * half + sub;
            const size_t qrow = rowbase + q0 + qs + l32;
            bf16x8 qf[4];
            { float qv[4][8]; float ss = 0.f;
#pragma unroll
              for (int d0 = 0; d0 < 4; ++d0) { unpack8(*(const v4u*)(proj + qrow * DIN + C_Q + h * HD + 16 * d0 + 8 * hi), qv[d0]);
#pragma unroll
                  for (int j = 0; j < 8; ++j) ss += qv[d0][j] * qv[d0][j]; }
              ss += __shfl_xor(ss, 32);
              const float rq = (1.0f / sqrtf(ss * (1.0f / HD) + EPS)) * (0.125f * LOG2E);
#pragma unroll
              for (int d0 = 0; d0 < 4; ++d0) {
#pragma unroll
                  for (int j = 0; j < 8; ++j) qv[d0][j] = qv[d0][j] * rq * P.q_norm[16 * d0 + 8 * hi + j];
                  const v4u w = pack8(qv[d0]); qf[d0] = __builtin_bit_cast(bf16x8, w); } }
            f32x16 sc[5];
#pragma unroll
            for (int jt = 0; jt < 5; ++jt) { sc[jt] = (f32x16){0.f, 0.f, 0.f, 0.f, 0.f, 0.f, 0.f, 0.f, 0.f, 0.f, 0.f, 0.f, 0.f, 0.f, 0.f, 0.f};
#pragma unroll
                for (int d0 = 0; d0 < 4; ++d0) { const bf16x8 kfr = *(const LAS bf16x8*)(lds + P2_KS + ((kt0 + jt) * 32 + l32) * P2_KROW + (16 * d0 + 8 * hi) * 2);
                    sc[jt] = __builtin_amdgcn_mfma_f32_32x32x16_bf16(kfr, qf[d0], sc[jt], 0, 0, 0); } }
            int bl = l32 - 4 * hi; asm volatile("" : "+v"(bl));
            const float ab = -slope2 * (float)bl;
            float mx = sink2;
#pragma unroll
            for (int jt = 0; jt < 5; ++jt)
#pragma unroll
                for (int r = 0; r < 16; ++r) { const int cc = 128 - 32 * jt - (r & 3) - 8 * (r >> 2);
                    float v = sc[jt][r] + (ab - slope2 * (float)cc);
                    if (jt == 0) v = (bl + cc < 128) ? v : -1.0e30f;
                    if (jt == 4) v = (bl + cc >= 0) ? v : -1.0e30f;
                    sc[jt][r] = v; }
            if (q0 == 0) {
                const int lim = 128 - qs;
#pragma unroll
                for (int jt = 0; jt < 4; ++jt)
#pragma unroll
                    for (int r = 0; r < 16; ++r) { const int kr = crow(r, hi); sc[jt][r] = (32 * jt + kr >= lim) ? sc[jt][r] : -1.0e30f; }
            }
#pragma unroll
            for (int jt = 0; jt < 5; ++jt)
#pragma unroll
                for (int r = 0; r < 16; ++r) mx = fmaxf(mx, sc[jt][r]);
            mx = fmaxf(mx, __shfl_xor(mx, 32));
            float l = 0.f;
#pragma unroll
            for (int jt = 0; jt < 5; ++jt)
#pragma unroll
                for (int r = 0; r < 16; ++r) { const float p = exp2f(sc[jt][r] - mx); sc[jt][r] = p; l += p; }
            l += __shfl_xor(l, 32); l += exp2f(sink2 - mx);
            const float rl = 1.0f / l;
            f32x16 o[2];
#pragma unroll
            for (int dh = 0; dh < 2; ++dh) { o[dh] = (f32x16){0.f, 0.f, 0.f, 0.f, 0.f, 0.f, 0.f, 0.f, 0.f, 0.f, 0.f, 0.f, 0.f, 0.f, 0.f, 0.f}; }
#pragma unroll
            for (int jt = 0; jt < 5; ++jt)
#pragma unroll
                for (int j = 0; j < 2; ++j) { v4u pw; pw.x = pk2(sc[jt][8 * j + 0], sc[jt][8 * j + 1]); pw.y = pk2(sc[jt][8 * j + 2], sc[jt][8 * j + 3]); pw.z = pk2(sc[jt][8 * j + 4], sc[jt][8 * j + 5]); pw.w = pk2(sc[jt][8 * j + 6], sc[jt][8 * j + 7]);
                    const bf16x8 pf = __builtin_bit_cast(bf16x8, pw);
#pragma unroll
                    for (int dh = 0; dh < 2; ++dh) { const bf16x8 vf = *(const LAS bf16x8*)(lds + P2_VT + (32 * dh + l32) * P2_VROW + ((kt0 + jt) * 32 + 16 * j + 8 * hi) * 2);
                        o[dh] = __builtin_amdgcn_mfma_f32_32x32x16_bf16(vf, pf, o[dh], 0, 0, 0); } }
            float ss = 0.f;
            LAS unsigned char* ost = lds + P2_OST + wid * (32 * P2_OROW);
#pragma unroll
            for (int dh = 0; dh < 2; ++dh)
#pragma unroll
                for (int r4 = 0; r4 < 4; ++r4) { float a0 = o[dh][4 * r4] * rl, a1 = o[dh][4 * r4 + 1] * rl, a2 = o[dh][4 * r4 + 2] * rl, a3 = o[dh][4 * r4 + 3] * rl;
                    ss += (a0 * a0 + a1 * a1) + (a2 * a2 + a3 * a3);
                    v2u w; w.x = pk2(a0, a1); w.y = pk2(a2, a3);
                    *(LAS v2u*)(ost + l32 * P2_OROW + (32 * dh + 8 * r4 + 4 * hi) * 2) = w; }
            ss += __shfl_xor(ss, 32);
            if (hi == 0) __hip_atomic_fetch_add(rowss + qs + l32, ss, __ATOMIC_RELAXED, __HIP_MEMORY_SCOPE_WORKGROUP);
            asm volatile("s_waitcnt lgkmcnt(0)" ::: "memory");
#pragma unroll
            for (int i = 0; i < 4; ++i) { const int rr = i * 8 + (lane >> 3), ch = lane & 7; const v4u v = *(const LAS v4u*)(ost + rr * P2_OROW + ch * 16);
                *(v4u*)(mixed + (rowbase + q0 + qs + rr) * D + DCONV + h * HD + ch * 8) = v; }
            asm volatile("s_waitcnt lgkmcnt(0)" ::: "memory");
        }
    }
    asm volatile("s_waitcnt vmcnt(0)" ::: "memory");
    __syncthreads();
    LAS float* rstd = (LAS float*)(lds + P2_RSTD);
    if (tid < 128) rstd[tid] = 1.0f / sqrtf(rowss[tid] * (1.0f / DATTN) + EPS);
    __syncthreads();
#pragma unroll 4
    for (int i = 0; i < 32; ++i) { const int rr = (tid >> 7) + 4 * i, ch = tid & 127; bf16* p = mixed + (rowbase + q0 + rr) * D + DCONV + ch * 8;
        float f[8]; unpack8(*(const v4u*)p, f); const float s = rstd[rr];
#pragma unroll
        for (int j = 0; j < 8; ++j) f[j] *= s;
        *(v4u*)p = pack8(f); }
    {
        const float* cw = P.conv_w; float w0[16], w1[16], w2[16];
#pragma unroll
        for (int j = 0; j < 16; ++j) { const int ch = (j >> 3) * 512 + lane * 8 + (j & 7); w0[j] = cw[ch]; w1[j] = cw[DCONV + ch]; w2[j] = cw[2 * DCONV + ch]; }
        float u1[16], u2[16];
        const int t0 = q0 + 16 * wid;
#pragma unroll
        for (int j = 0; j < 16; ++j) { u1[j] = 0.f; u2[j] = 0.f; }
        if (t0 >= 2) {
#pragma unroll
            for (int hf = 0; hf < 2; ++hf) { const int ch = hf * 512 + lane * 8; float c[8], hc[8];
                const bf16* pr = proj + (rowbase + t0 - 1) * DIN; unpack8(*(const v4u*)(pr + C_C + ch), c); unpack8(*(const v4u*)(pr + C_HC + ch), hc);
#pragma unroll
                for (int j = 0; j < 8; ++j) u1[hf * 8 + j] = c[j] * hc[j];
                pr -= DIN; unpack8(*(const v4u*)(pr + C_C + ch), c); unpack8(*(const v4u*)(pr + C_HC + ch), hc);
#pragma unroll
                for (int j = 0; j < 8; ++j) u2[hf * 8 + j] = c[j] * hc[j]; }
        }
#pragma unroll 2
        for (int rr = 0; rr < 16; ++rr) {
            const bf16* pr = proj + (rowbase + t0 + rr) * DIN; float y[16]; float ss = 0.f;
#pragma unroll
            for (int hf = 0; hf < 2; ++hf) { const int ch = hf * 512 + lane * 8; float bb[8], c[8], hc[8];
                unpack8(*(const v4u*)(pr + C_B + ch), bb); unpack8(*(const v4u*)(pr + C_C + ch), c); unpack8(*(const v4u*)(pr + C_HC + ch), hc);
#pragma unroll
                for (int j = 0; j < 8; ++j) { const int jj = hf * 8 + j; const float u0 = c[j] * hc[j];
                    y[jj] = bb[j] * (w0[jj] * u2[jj] + w1[jj] * u1[jj] + w2[jj] * u0); ss += y[jj] * y[jj]; u2[jj] = u1[jj]; u1[jj] = u0; } }
            ss = wsum(ss); const float rs = 1.0f / sqrtf(ss * (1.0f / DCONV) + EPS);
#pragma unroll
            for (int hf = 0; hf < 2; ++hf) { float f[8];
#pragma unroll
                for (int j = 0; j < 8; ++j) f[j] = y[hf * 8 + j] * rs;
                *(v4u*)(mixed + (rowbase + t0 + rr) * D + hf * 512 + lane * 8) = pack8(f); }
        }
    }
}
constexpr int NPHASE = 10;
struct Args { Ptrs P; int ph_lo, ph_hi; };
__device__ __forceinline__ void moe_tables(LAS unsigned char* ldsx, gu32* ctl) {
    const int tid = threadIdx.x;
    __syncthreads();
    if (tid < 64) {
        const int n = (int)__hip_atomic_load(ctl + CW_CNT + 64 * tid, RLX_AGENT);
        int x = (n + 255) >> 8;
#pragma unroll
        for (int o = 1; o < 64; o <<= 1) { const int v = __shfl_up(x, o); if (tid >= o) x += v; }
        ((LAS int*)(ldsx + pg8::LST_OFF))[tid] = n;
        ((LAS int*)(ldsx + pg8::LST_OFF + 256))[tid + 1] = x;
        if (tid == 0) ((LAS int*)(ldsx + pg8::LST_OFF + 256))[0] = 0;
    }
    __syncthreads();
}
__global__ void __launch_bounds__(NWAVES * 64, 2) mk_fwd(Args args) {
    extern __shared__ __attribute__((aligned(16))) unsigned char lds_raw[];
    LAS unsigned char* lds = (LAS unsigned char*)lds_raw;
    const Ptrs& P = args.P;
    const int tid = threadIdx.x;
    const int G = gridDim.x, bx = blockIdx.x, vcu = (G % 8 == 0) ? (bx % 8) * (G / 8) + bx / 8 : bx;
    unsigned char* ws = P.ws; gu32* ctl = (gu32*)(ws + WS_CTL);
    for (int u = tid; u < (pg8::LDS_BYTES - pg8::LDSX_OFF) / 4; u += NWAVES * 64) ((LAS unsigned*)(lds + pg8::LDSX_OFF))[u] = 0u;
    __syncthreads();
    const int lo = args.ph_lo, hi = args.ph_hi;
    XcdBarrier bar; bar.bar = (unsigned*)(ctl + CW_BAR); bar.x = 0; bar.st = nullptr;
    if (hi - lo > 1) bar = xcd_barrier_post((unsigned*)(ctl + CW_BAR), (volatile LAS unsigned*)(lds + pg8::MISC_OFF) + 8);
#ifdef ONLY_PHASE
#define IN(k) ((k) == ONLY_PHASE && lo <= (k) && (k) < hi)
#else
#define IN(k) (lo <= (k) && (k) < hi)
#endif
#define SEAM(k) do { if (IN(k) && IN((k) + 1)) xcd_barrier(bar); } while (0)
    bf16* Win = (bf16*)(ws + WS_WIN); bf16* Wout = (bf16*)(ws + WS_WOUT); bf16* Wplg = (bf16*)(ws + WS_WPLG); bf16* Wple = (bf16*)(ws + WS_WPLE);
    bf16* Wr = (bf16*)(ws + WS_WR); bf16* Wgu = (bf16*)(ws + WS_WGU); bf16* Wd = (bf16*)(ws + WS_WD);
    bf16* xb = (bf16*)(ws + WS_XB); bf16* mixed = (bf16*)(ws + WS_MIX); bf16* pb = (bf16*)(ws + WS_PB); bf16* proj = (bf16*)(ws + WS_PROJ);
    bf16* hid = (bf16*)(ws + WS_HID); bf16* pw = (bf16*)(ws + WS_PW); bf16* h1 = (bf16*)(ws + WS_H1); bf16* h2 = (bf16*)(ws + WS_H2);
    float* rsx = (float*)(ws + WS_RSX); float* rs1 = (float*)(ws + WS_RS1); float* ss1p = (float*)(ws + WS_SS1P); float* ss2p = (float*)(ws + WS_SS2P);
    int* eid = (int*)(ws + WS_EID); float* ew = (float*)(ws + WS_EW); Ent* ent = (Ent*)(ws + WS_ENT);

    if (IN(0)) { p0_prologue(P, lds, vcu, G); } SEAM(0);
    if (IN(1)) { pg8::Gemm g{xb, Win, M, DIN, D}; pg8::StaticOrder S; S.init(M, DIN, G, bx); pg8::EpiBf16 E{proj, DIN, nullptr};
        pg8::gemm_phase<pg8::EpiBf16, pg8::StaticOrder, true>(lds, g, S, E); } SEAM(1);
    if (IN(2)) { for (int unit = vcu; unit < BATCH * (SEQ / 128); unit += G) p2_unit(P, lds, unit); __syncthreads(); } SEAM(2);
    if (IN(3)) { pg8::Gemm g{mixed, Wout, M, D, D}; pg8::StaticOrder S; S.init(M, D, G, bx); pg8::EpiH1 E{P.x, h1, ss1p};
        pg8::gemm_phase<pg8::EpiH1, pg8::StaticOrder, true>(lds, g, S, E); } SEAM(3);
    if (IN(4)) { pg8::Gemm g{h1, Wr, M, 256, D}; pg8::StaticOrder S; S.init(M, 256, G, bx); pg8::EpiRouter E{ss1p, P.b_group, P.b_router, rs1, eid, ew, ent, (unsigned*)(ctl + CW_CNT)};
        pg8::gemm_phase<pg8::EpiRouter, pg8::StaticOrder, false>(lds, g, S, E); } SEAM(4);
    if (IN(5) || IN(6) || IN(7)) moe_tables(lds, ctl);
    const LAS int* T0 = (const LAS int*)(lds + pg8::LST_OFF + 256);
    if (IN(5)) { pg8::Gemm g{h1, Wgu, M, NE * 1024, D}; pg8::MoeOrder<true, 4> S{lds, ent, 0, T0[NLIST], G, vcu}; pg8::EpiGU E{hid, lds};
        pg8::gemm_phase<pg8::EpiGU, pg8::MoeOrder<true, 4>, true>(lds, g, S, E); } SEAM(5);
    if (IN(6)) { pg8::Gemm g{hid, Wd, 0, NE * D, DEXP}; pg8::MoeOrder<false, 8> S{lds, ent, 0, T0[NE], G, vcu}; pg8::EpiDown<0> E{h1, h2, nullptr, lds};
        pg8::gemm_phase<pg8::EpiDown<0>, pg8::MoeOrder<false, 8>, true>(lds, g, S, E); } SEAM(6);
    if (IN(7)) { pg8::Gemm g{hid, Wd, 0, NE * D, DEXP}; pg8::MoeOrder<false, 8> S{lds, ent, T0[NE], T0[NLIST], G, vcu}; pg8::EpiDown<1> E{h2, h2, ss2p, lds};
        pg8::gemm_phase<pg8::EpiDown<1>, pg8::MoeOrder<false, 8>, true>(lds, g, S, E); } SEAM(7);
    if (IN(8)) { pg8::Gemm g{pb, Wple, M, D, PLE}; pg8::StaticOrder S; S.init(M, D, G, bx); pg8::EpiBf16 E{pw, D, nullptr};
        pg8::gemm_phase<pg8::EpiBf16, pg8::StaticOrder, true>(lds, g, S, E); } SEAM(8);
    if (IN(9)) { pg8::Gemm g{h2, Wplg, M, D, D}; pg8::FinalOrder S; S.init(M, D, G, bx); S.ldsx = lds; S.ssp = ss2p; pg8::EpiFinal E{h2, pw, P.out, lds};
        pg8::gemm_phase<pg8::EpiFinal, pg8::FinalOrder, true>(lds, g, S, E); }
#undef IN
#undef SEAM
}
namespace nv {
struct RmId { __device__ int operator()(int n) const { return n; } };
struct RmOff { int off; __device__ int operator()(int n) const { return n + off; } };
struct RmGate { __device__ int operator()(int n) const { return (n >> 7) * 256 + (n & 127); } };
struct RmUp { __device__ int operator()(int n) const { return (n >> 7) * 256 + 128 + (n & 127); } };
template <class RM> __global__ void __launch_bounds__(256) wt(const float* W, int K, int N, const float* g0, const float* g1, int gsplit, bf16* WT, RM rm, size_t wstride, size_t tstride) {
    const size_t i = blockIdx.x * (size_t)blockDim.x + threadIdx.x; if (i >= (size_t)K * N) return;
    const int n = (int)(i / K), k = (int)(i % K);
    const float* Wz = W + blockIdx.y * wstride; bf16* Tz = WT + blockIdx.y * tstride;
    const float g = g0 ? (k < gsplit ? g0[k] : g1[k - gsplit]) : 1.f;
    Tz[(size_t)rm(n) * K + k] = f2bf(g * Wz[(size_t)k * N + n]);
}
__global__ void __launch_bounds__(256) zero_rows(bf16* p, size_t n) { const size_t i = blockIdx.x * (size_t)blockDim.x + threadIdx.x; if (i < n) p[i] = 0; }
__global__ void __launch_bounds__(256) rowcvt(const float* x, bf16* xb, float* rs) {
    const int lane = threadIdx.x & 63; const int row = blockIdx.x * 4 + (threadIdx.x >> 6); if (row >= M) return;
    float s = 0.f;
    for (int c = lane; c < D; c += 64) { const float v = x[(size_t)row * D + c]; s += v * v; xb[(size_t)row * D + c] = f2bf(v); }
    s = wsum(s); if (lane == 0) rs[row] = 1.0f / sqrtf(s / D + EPS);
}
__global__ void __launch_bounds__(256) cvt(const float* p, bf16* pb, size_t n) { const size_t i = blockIdx.x * (size_t)blockDim.x + threadIdx.x; if (i < n) pb[i] = f2bf(p[i]); }
__global__ void __launch_bounds__(256) rowrs(const bf16* h, float* rs) {
    const int lane = threadIdx.x & 63; const int row = blockIdx.x * 4 + (threadIdx.x >> 6); if (row >= M) return;
    float s = 0.f;
    for (int c = lane; c < D; c += 64) { const float v = bf2f(h[(size_t)row * D + c]); s += v * v; }
    s = wsum(s); if (lane == 0) rs[row] = 1.0f / sqrtf(s / D + EPS);
}
template <int K, int NC, class AP, class BP, class EP>
__global__ void __launch_bounds__(256) gemm(long nrows, long ncols_, AP ap, BP bp, EP ep) {
    const int ncols = (int)ncols_;
    const int lane = threadIdx.x & 63; const long wave = blockIdx.x * 4L + (threadIdx.x >> 6);
    const int ngrp = ncols / NC; if (wave >= nrows * ngrp) return;
    const long r = wave / ngrp; const int c0 = (int)(wave % ngrp) * NC;
    constexpr int NCH = (K + 511) / 512;
    float a[NCH][8];
    const bf16* A = ap(r);
#pragma unroll
    for (int ch = 0; ch < NCH; ++ch) { const int k = ch * 512 + lane * 8;
        if (k < K) unpack8(*(const v4u*)(A + k), a[ch]); else { for (int j = 0; j < 8; ++j) a[ch][j] = 0.f; } }
    float res[NC];
#pragma unroll
    for (int c = 0; c < NC; ++c) {
        const bf16* B = bp(r, c0 + c); float s = 0.f;
#pragma unroll
        for (int ch = 0; ch < NCH; ++ch) { const int k = ch * 512 + lane * 8;
            if (k < K) { float b[8]; unpack8(*(const v4u*)(B + k), b);
#pragma unroll
                for (int j = 0; j < 8; ++j) s += a[ch][j] * b[j]; } }
        res[c] = wsum(s);
    }
    if (lane == 0) {
#pragma unroll
        for (int c = 0; c < NC; ++c) ep(r, c0 + c, res[c], res[c ^ 1]);
    }
}
__global__ void __launch_bounds__(256) conv(const bf16* proj, const float* cw, bf16* mixed) {
    const int lane = threadIdx.x & 63; const int row = blockIdx.x * 4 + (threadIdx.x >> 6); if (row >= M) return;
    const int t = row % SEQ; float y[16]; float ss = 0.f;
#pragma unroll
    for (int j = 0; j < 16; ++j) {
        const int ch = lane * 16 + j; const bf16* pr = proj + (size_t)row * DIN;
        const float b = bf2f(pr[C_B + ch]);
        const float u0 = bf2f(pr[C_C + ch]) * bf2f(pr[C_HC + ch]);
        const float u1 = t >= 1 ? bf2f(pr[C_C + ch - DIN]) * bf2f(pr[C_HC + ch - DIN]) : 0.f;
        const float u2 = t >= 2 ? bf2f(pr[C_C + ch - 2 * DIN]) * bf2f(pr[C_HC + ch - 2 * DIN]) : 0.f;
        y[j] = b * (cw[ch] * u2 + cw[DCONV + ch] * u1 + cw[2 * DCONV + ch] * u0); ss += y[j] * y[j];
    }
    ss = wsum(ss); const float rstd = 1.0f / sqrtf(ss / DCONV + EPS);
#pragma unroll
    for (int j = 0; j < 16; ++j) mixed[(size_t)row * D + lane * 16 + j] = f2bf(y[j] * rstd);
}
__global__ void __launch_bounds__(256) attn(const bf16* proj, const float* qn, const float* kn, const float* sinks, float* ya) {
    const int lane = threadIdx.x & 63; const long wave = blockIdx.x * 4L + (threadIdx.x >> 6); if (wave >= (long)M * NH) return;
    const int row = (int)(wave / NH), h = (int)(wave % NH), kvh = h / (NH / NKV), t = row % SEQ;
    float q = bf2f(proj[(size_t)row * DIN + C_Q + h * HD + lane]);
    const float rq = 1.0f / sqrtf(wsum(q * q) / HD + EPS); q = q * rq * qn[lane];
    const float gk = kn[lane]; const float slope = exp2f(-0.5f * (float)(h + 1)); const float sink = sinks[h];
    float m = sink, l = 1.f, o = 0.f;
    const int s0 = t >= 127 ? t - 127 : 0;
    for (int s = s0; s <= t; ++s) {
        const size_t kr = (size_t)(row - (t - s)) * DIN;
        const float k = bf2f(proj[kr + C_K + kvh * HD + lane]); const float v = bf2f(proj[kr + C_V + kvh * HD + lane]);
        const float kk = wsum(k * k); const float rk = 1.0f / sqrtf(kk / HD + EPS);
        const float dot = wsum(q * k * gk) * rk;
        const float sc = dot * 0.125f - slope * (float)(t - s);
        const float mn = fmaxf(m, sc); const float f = __expf(m - mn), pe = __expf(sc - mn);
        l = l * f + pe; o = o * f + pe * v; m = mn;
    }
    ya[(size_t)row * DATTN + h * HD + lane] = o / l;
}
__global__ void __launch_bounds__(256) attnnorm(const float* ya, bf16* mixed) {
    const int lane = threadIdx.x & 63; const int row = blockIdx.x * 4 + (threadIdx.x >> 6); if (row >= M) return;
    float y[16]; float ss = 0.f;
#pragma unroll
    for (int j = 0; j < 16; ++j) { y[j] = ya[(size_t)row * DATTN + lane * 16 + j]; ss += y[j] * y[j]; }
    ss = wsum(ss); const float rstd = 1.0f / sqrtf(ss / DATTN + EPS);
#pragma unroll
    for (int j = 0; j < 16; ++j) mixed[(size_t)row * D + DCONV + lane * 16 + j] = f2bf(y[j] * rstd);
}
__global__ void __launch_bounds__(256) topk(const float* logits, int* eid, float* ew) {
    const int row = blockIdx.x * blockDim.x + threadIdx.x; if (row >= M) return;
    const float* L = logits + (size_t)row * 64;
    int g = 0; float gm = L[0];
    for (int j = 1; j < NGRP; ++j) if (L[j] > gm) { gm = L[j]; g = j; }
    float gs = 0.f; for (int j = 0; j < NGRP; ++j) gs += __expf(L[j] - gm);
    const float gw = 1.0f / gs;
    const float* E = L + NGRP + g * EPG;
    int i1 = 0; float v1 = E[0];
    for (int j = 1; j < EPG; ++j) if (E[j] > v1) { v1 = E[j]; i1 = j; }
    int i2 = -1; float v2 = -3.0e38f;
    for (int j = 0; j < EPG; ++j) if (j != i1 && E[j] > v2) { v2 = E[j]; i2 = j; }
    const float e2 = __expf(v2 - v1); const float w1 = 1.0f / (1.0f + e2), w2 = e2 / (1.0f + e2);
    eid[row * 2] = g * EPG + i1; eid[row * 2 + 1] = g * EPG + i2; ew[row * 2] = gw * w1; ew[row * 2 + 1] = gw * w2;
}

__global__ void __launch_bounds__(256) rs_to_part(const float* rs, float* part) {
    const int i = blockIdx.x * blockDim.x + threadIdx.x; if (i >= M * 32) return; const int row = i >> 5, j = i & 31;
    const float r = rs[row]; part[i] = j == 0 ? (1.0f / (r * r) - EPS) * (float)D : 0.f;
}
__global__ void __launch_bounds__(256) part_to_rs(const float* part, float* rs) {
    const int row = blockIdx.x * blockDim.x + threadIdx.x; if (row >= M) return; float s = 0.f;
    for (int j = 0; j < 32; ++j) s += part[(size_t)row * 32 + j];
    rs[row] = 1.0f / sqrtf(s / D + EPS);
}
__global__ void __launch_bounds__(256) build_lists(const int* eid, const float* ew, const float* rs1, Ent* ent, unsigned* cnt) {
    const int i = blockIdx.x * blockDim.x + threadIdx.x; if (i >= M * 2) return; const int tok = i >> 1, k = i & 1;
    const int l = k * NE + eid[i]; const unsigned slot = atomicAdd(cnt + 64 * l, 1u);
    Ent e; e.tok = tok; e.w = ew[i]; e.rs = rs1[tok]; e.pad = 0; ent[(size_t)l * LCAP + slot] = e;
}
}

#ifndef MK_MASK
#define MK_MASK 0x3ff
#endif
#ifndef MK_SPLIT
#define MK_SPLIT 0
#endif
template <class K, class... A> static void launch1d(K kern, size_t nthreads, int bs, hipStream_t s, A... args) {
    hipLaunchKernelGGL(kern, dim3((unsigned)((nthreads + bs - 1) / bs)), dim3(bs), 0, s, args...);
}
static void nv_stage(int st, const Ptrs& P, hipStream_t stream) {
    unsigned char* ws = P.ws;
    bf16* Win = (bf16*)(ws + WS_WIN); bf16* Wout = (bf16*)(ws + WS_WOUT); bf16* Wplg = (bf16*)(ws + WS_WPLG); bf16* Wple = (bf16*)(ws + WS_WPLE);
    bf16* Wr = (bf16*)(ws + WS_WR); bf16* Wgu = (bf16*)(ws + WS_WGU); bf16* Wd = (bf16*)(ws + WS_WD);
    bf16* xb = (bf16*)(ws + WS_XB); bf16* mixed = (bf16*)(ws + WS_MIX); bf16* pb = (bf16*)(ws + WS_PB); bf16* proj = (bf16*)(ws + WS_PROJ);
    bf16* hid = (bf16*)(ws + WS_HID); bf16* pw = (bf16*)(ws + WS_PW); bf16* h1 = (bf16*)(ws + WS_H1); bf16* h2 = (bf16*)(ws + WS_H2);
    float* rsx = (float*)(ws + WS_RSX); float* rs1 = (float*)(ws + WS_RS1); float* rs2 = (float*)(ws + WS_RS2);
    int* eid = (int*)(ws + WS_EID); float* ew = (float*)(ws + WS_EW); float* logits = (float*)(ws + WS_LOG); float* ya = (float*)(ws + WS_YA);
    const float* nul = nullptr;
    if (st == 0) {
        hipLaunchKernelGGL(nv::wt<nv::RmId>, dim3((unsigned)(((size_t)D * DIN + 255) / 256), 1), dim3(256), 0, stream, P.w_in, D, DIN, P.norm_mix, nul, D, Win, nv::RmId{}, (size_t)0, (size_t)0);
        hipLaunchKernelGGL(nv::wt<nv::RmId>, dim3((unsigned)(((size_t)D * D + 255) / 256), 1), dim3(256), 0, stream, P.w_out, D, D, P.onc, P.ona, DCONV, Wout, nv::RmId{}, (size_t)0, (size_t)0);
        hipLaunchKernelGGL(nv::wt<nv::RmId>, dim3((unsigned)(((size_t)D * D + 255) / 256), 1), dim3(256), 0, stream, P.w_ple_gate, D, D, P.norm_ple, nul, D, Wplg, nv::RmId{}, (size_t)0, (size_t)0);
        hipLaunchKernelGGL(nv::wt<nv::RmId>, dim3((unsigned)(((size_t)PLE * D + 255) / 256), 1), dim3(256), 0, stream, P.w_ple, PLE, D, nul, nul, 0, Wple, nv::RmId{}, (size_t)0, (size_t)0);
        hipLaunchKernelGGL(nv::wt<nv::RmId>, dim3((unsigned)(((size_t)D * NGRP + 255) / 256), 1), dim3(256), 0, stream, P.w_group, D, NGRP, P.norm_ffn, nul, D, Wr, nv::RmId{}, (size_t)0, (size_t)0);
        hipLaunchKernelGGL(nv::wt<nv::RmOff>, dim3((unsigned)(((size_t)D * NE + 255) / 256), 1), dim3(256), 0, stream, P.w_router, D, NE, P.norm_ffn, nul, D, Wr, nv::RmOff{NGRP}, (size_t)0, (size_t)0);
        launch1d(nv::zero_rows, (size_t)(256 - NRT) * D, 256, stream, Wr + (size_t)NRT * D, (size_t)(256 - NRT) * D);
        hipLaunchKernelGGL(nv::wt<nv::RmGate>, dim3((unsigned)(((size_t)D * DEXP + 255) / 256), NE), dim3(256), 0, stream, P.w_gate, D, DEXP, P.norm_ffn, nul, D, Wgu, nv::RmGate{}, (size_t)D * DEXP, (size_t)1024 * D);
        hipLaunchKernelGGL(nv::wt<nv::RmUp>, dim3((unsigned)(((size_t)D * DEXP + 255) / 256), NE), dim3(256), 0, stream, P.w_up, D, DEXP, P.norm_ffn, nul, D, Wgu, nv::RmUp{}, (size_t)D * DEXP, (size_t)1024 * D);
        hipLaunchKernelGGL(nv::wt<nv::RmId>, dim3((unsigned)(((size_t)DEXP * D + 255) / 256), NE), dim3(256), 0, stream, P.w_down, DEXP, D, nul, nul, 0, Wd, nv::RmId{}, (size_t)DEXP * D, (size_t)D * DEXP);
        hipLaunchKernelGGL(nv::rowcvt, dim3(M / 4), dim3(256), 0, stream, P.x, xb, rsx);
        launch1d(nv::cvt, (size_t)M * PLE, 256, stream, P.p, pb, (size_t)M * PLE);
    } else if (st == 1) {
        auto ap = [=] __device__(long r) { return xb + (size_t)r * D; };
        auto bp = [=] __device__(long r, int c) { return Win + (size_t)c * D; };
        auto ep = [=] __device__(long r, int c, float v, float vo) { proj[(size_t)r * DIN + c] = f2bf(v * rsx[r]); };
        hipLaunchKernelGGL((nv::gemm<D, 8, decltype(ap), decltype(bp), decltype(ep)>), dim3((unsigned)((size_t)M * (DIN / 8) / 4)), dim3(256), 0, stream, (long)M, (long)DIN, ap, bp, ep);
    } else if (st == 2) {
        hipLaunchKernelGGL(nv::conv, dim3(M / 4), dim3(256), 0, stream, proj, P.conv_w, mixed);
        hipLaunchKernelGGL(nv::attn, dim3((unsigned)((size_t)M * NH / 4)), dim3(256), 0, stream, proj, P.q_norm, P.k_norm, P.sinks, ya);
        hipLaunchKernelGGL(nv::attnnorm, dim3(M / 4), dim3(256), 0, stream, ya, mixed);
    } else if (st == 3) {
        const float* x = P.x;
        auto ap = [=] __device__(long r) { return mixed + (size_t)r * D; };
        auto bp = [=] __device__(long r, int c) { return Wout + (size_t)c * D; };
        auto ep = [=] __device__(long r, int c, float v, float vo) { h1[(size_t)r * D + c] = f2bf(x[(size_t)r * D + c] + v); };
        hipLaunchKernelGGL((nv::gemm<D, 8, decltype(ap), decltype(bp), decltype(ep)>), dim3((unsigned)((size_t)M * (D / 8) / 4)), dim3(256), 0, stream, (long)M, (long)D, ap, bp, ep);
        hipLaunchKernelGGL(nv::rowrs, dim3(M / 4), dim3(256), 0, stream, h1, rs1);
    } else if (st == 4) {
        const float* bg = P.b_group; const float* br = P.b_router;
        auto ap = [=] __device__(long r) { return h1 + (size_t)r * D; };
        auto bp = [=] __device__(long r, int c) { return Wr + (size_t)c * D; };
        auto ep = [=] __device__(long r, int c, float v, float vo) { logits[(size_t)r * 64 + c] = v * rs1[r] + (c < NGRP ? bg[c] : br[c - NGRP]); };
        hipLaunchKernelGGL((nv::gemm<D, 4, decltype(ap), decltype(bp), decltype(ep)>), dim3((unsigned)((size_t)M * (NRT / 4) / 4)), dim3(256), 0, stream, (long)M, (long)NRT, ap, bp, ep);
        launch1d(nv::topk, (size_t)M, 256, stream, logits, eid, ew);
    } else if (st == 5) {
        auto ap = [=] __device__(long r) { return h1 + (size_t)(r >> 1) * D; };
        auto bp = [=] __device__(long r, int c) { const int e = eid[r]; const int f = c >> 1; const int rowi = (f >> 7) * 256 + (c & 1) * 128 + (f & 127); return Wgu + ((size_t)e * 1024 + rowi) * D; };
        auto ep = [=] __device__(long r, int c, float v, float vo) {
            if (c & 1) { const float rs = rs1[r >> 1]; const int f = c >> 1; const float g = vo * rs, u = v * rs; hid[(size_t)r * DEXP + f] = f2bf(ew[r] * (g / (1.0f + __expf(-g))) * u); } };
        hipLaunchKernelGGL((nv::gemm<D, 8, decltype(ap), decltype(bp), decltype(ep)>), dim3((unsigned)((size_t)M * 2 * (1024 / 8) / 4)), dim3(256), 0, stream, (long)M * 2, (long)1024, ap, bp, ep);
    } else if (st == 6 || st == 7) {
        const long k = st - 6; const bf16* base = k == 0 ? h1 : h2;
        auto ap = [=] __device__(long r) { return hid + (size_t)(r * 2 + k) * DEXP; };
        auto bp = [=] __device__(long r, int c) { const int e = eid[r * 2 + k]; return Wd + ((size_t)e * D + c) * DEXP; };
        auto ep = [=] __device__(long r, int c, float v, float vo) { h2[(size_t)r * D + c] = f2bf(bf2f(base[(size_t)r * D + c]) + v); };
        hipLaunchKernelGGL((nv::gemm<DEXP, 8, decltype(ap), decltype(bp), decltype(ep)>), dim3((unsigned)((size_t)M * (D / 8) / 4)), dim3(256), 0, stream, (long)M, (long)D, ap, bp, ep);
        if (st == 7) hipLaunchKernelGGL(nv::rowrs, dim3(M / 4), dim3(256), 0, stream, h2, rs2);
    } else if (st == 8) {
        auto ap = [=] __device__(long r) { return pb + (size_t)r * PLE; };
        auto bp = [=] __device__(long r, int c) { return Wple + (size_t)c * PLE; };
        auto ep = [=] __device__(long r, int c, float v, float vo) { pw[(size_t)r * D + c] = f2bf(v); };
        hipLaunchKernelGGL((nv::gemm<PLE, 8, decltype(ap), decltype(bp), decltype(ep)>), dim3((unsigned)((size_t)M * (D / 8) / 4)), dim3(256), 0, stream, (long)M, (long)D, ap, bp, ep);
    } else if (st == 9) {
        float* out = P.out;
        auto ap = [=] __device__(long r) { return h2 + (size_t)r * D; };
        auto bp = [=] __device__(long r, int c) { return Wplg + (size_t)c * D; };
        auto ep = [=] __device__(long r, int c, float v, float vo) { const float z = v * rs2[r]; out[(size_t)r * D + c] = bf2f(h2[(size_t)r * D + c]) + (1.0f / (1.0f + __expf(-z))) * bf2f(pw[(size_t)r * D + c]); };
        hipLaunchKernelGGL((nv::gemm<D, 8, decltype(ap), decltype(bp), decltype(ep)>), dim3((unsigned)((size_t)M * (D / 8) / 4)), dim3(256), 0, stream, (long)M, (long)D, ap, bp, ep);
    }
}

extern "C" void kernel_launch(void* const* d_in, const int* in_sizes, int n_in, void* d_out, int out_size, void* d_ws, size_t ws_size, hipStream_t stream) {
    static int grid = 0;
    if (grid == 0) {
        if (n_in != 22 || in_sizes[0] != M * D || out_size != M * D || ws_size < WS_END) { fprintf(stderr, "kernel_launch: unexpected problem (n_in %d, in0 %d, out %d, ws %zu); nothing launched\n", n_in, n_in > 0 ? in_sizes[0] : -1, out_size, ws_size); grid = -1; return; }
        int dev = 0, cus = 0, per_cu = 0;
        if (hipGetDevice(&dev) != hipSuccess || hipDeviceGetAttribute(&cus, hipDeviceAttributeMultiprocessorCount, dev) != hipSuccess) { grid = -1; return; }
        if (hipFuncSetAttribute((const void*)mk_fwd, hipFuncAttributeMaxDynamicSharedMemorySize, pg8::LDS_BYTES) != hipSuccess) { fprintf(stderr, "kernel_launch: hipFuncSetAttribute failed\n"); grid = -1; return; }
        if (hipOccupancyMaxActiveBlocksPerMultiprocessor(&per_cu, (const void*)mk_fwd, NWAVES * 64, pg8::LDS_BYTES) != hipSuccess || per_cu < 1) { fprintf(stderr, "kernel_launch: occupancy query says %d blocks per CU\n", per_cu); (void)hipGetLastError(); grid = -1; return; }
        grid = cus;
    }
    if (grid < 0) return;
    if (hipMemsetAsync((char*)d_ws + WS_CTL, 0, CTL_ZERO_BYTES, stream) != hipSuccess) return;
    Args a{};
    { const float** pp = (const float**)&a.P; for (int i = 0; i < 22; ++i) pp[i] = (const float*)d_in[i]; }
    a.P.out = (float*)d_out; a.P.ws = (unsigned char*)d_ws;
    unsigned char* ws = a.P.ws;
    const unsigned mask = MK_MASK;
    auto is_mk = [&](int s) { return ((mask >> s) & 1u) != 0u; };
    int s = 0;
    while (s < NPHASE) {
        if (is_mk(s)) {
            int e = s + 1; if (!MK_SPLIT) while (e < NPHASE && is_mk(e)) ++e;
            if (s == 4 && !is_mk(3)) launch1d(nv::rs_to_part, (size_t)M * 32, 256, stream, (const float*)(ws + WS_RS1), (float*)(ws + WS_SS1P));
            if (s >= 5 && s <= 7 && !is_mk(4) && s == 5) launch1d(nv::build_lists, (size_t)M * 2, 256, stream, (const int*)(ws + WS_EID), (const float*)(ws + WS_EW), (const float*)(ws + WS_RS1), (Ent*)(ws + WS_ENT), (unsigned*)(ws + WS_CTL) + CW_CNT);
            if (s == 9 && !is_mk(7)) launch1d(nv::rs_to_part, (size_t)M * 32, 256, stream, (const float*)(ws + WS_RS2), (float*)(ws + WS_SS2P));
            a.ph_lo = s; a.ph_hi = e;
            hipLaunchKernelGGL(mk_fwd, dim3(grid), dim3(NWAVES * 64), pg8::LDS_BYTES, stream, a);
            s = e;
        } else {
            if (s == 4 && is_mk(3)) launch1d(nv::part_to_rs, (size_t)M, 256, stream, (const float*)(ws + WS_SS1P), (float*)(ws + WS_RS1));
            if (s == 9 && is_mk(7)) launch1d(nv::part_to_rs, (size_t)M, 256, stream, (const float*)(ws + WS_SS2P), (float*)(ws + WS_RS2));
            nv_stage(s, a.P, stream);
            ++s;
        }
    }
}
```

```cpp
#include <hip/hip_runtime.h>
#include <cstdio>
#include <cstdint>

typedef unsigned short bf16;
typedef unsigned v4u __attribute__((ext_vector_type(4)));
typedef unsigned v2u __attribute__((ext_vector_type(2)));
typedef float f32x4 __attribute__((ext_vector_type(4)));
typedef float f32x16 __attribute__((ext_vector_type(16)));
typedef short bf16x8 __attribute__((ext_vector_type(8)));
#define GAS __attribute__((address_space(1)))
#define LAS __attribute__((address_space(3)))
typedef GAS unsigned gu32;

constexpr int BATCH = 4, SEQ = 8192, D = 2048, M = BATCH * SEQ;
constexpr int DCONV = 1024, NH = 16, NKV = 4, HD = 64, DATTN = 1024, DKV = 256, DIN = 4608;
constexpr int C_B = 0, C_C = 1024, C_HC = 2048, C_Q = 3072, C_K = 4096, C_V = 4352;
constexpr int NGRP = 4, EPG = 8, NE = 32, DEXP = 512, PLE = 256, NRT = 36;
constexpr int NLIST = 64, LCAP = 32768;
constexpr float EPS = 1e-6f;
constexpr float LOG2E = 1.4426950408889634f;

constexpr size_t MiB = 1u << 20;
constexpr size_t WS_CTL = 0, CTL_ZERO_BYTES = 1 * MiB;
constexpr size_t WS_WIN = 2 * MiB;
constexpr size_t WS_WOUT = 20 * MiB;
constexpr size_t WS_WPLG = 28 * MiB;
constexpr size_t WS_WPLE = 36 * MiB;
constexpr size_t WS_WR = 37 * MiB;
constexpr size_t WS_RSX = 38 * MiB;
constexpr size_t WS_RS1 = 38 * MiB + 256 * 1024;
constexpr size_t WS_RS2 = 38 * MiB + 512 * 1024;
constexpr size_t WS_RMSX = 38 * MiB + 768 * 1024;
constexpr size_t WS_EID = 39 * MiB;
constexpr size_t WS_EW = 39 * MiB + 512 * 1024;
constexpr size_t WS_LOG = 42 * MiB;
constexpr size_t WS_SS1P = 50 * MiB;
constexpr size_t WS_SS2P = 54 * MiB;
#ifndef FP8
#define FP8 1
#endif
constexpr float F8_ASCALE = 16.f, F8_WSCALE = 32.f, F8_INV = 1.0f / (16.f * 32.f);
constexpr size_t WS_WGU = 64 * MiB;
constexpr size_t WS_H18 = 128 * MiB;
constexpr size_t WS_H28 = 608 * MiB;
constexpr size_t WS_WD = 192 * MiB;
constexpr size_t WS_XB = 256 * MiB;
constexpr size_t WS_MIX = 816 * MiB;
constexpr size_t WS_PB = 384 * MiB;
constexpr size_t WS_PROJ = 400 * MiB;
constexpr size_t WS_HID = 400 * MiB;
constexpr size_t WS_PW = 480 * MiB;
constexpr size_t WS_H1 = 688 * MiB;
constexpr size_t WS_H2 = 816 * MiB;
constexpr size_t WS_YA = 688 * MiB;
constexpr size_t WS_ENT = 944 * MiB;
constexpr size_t WS_END = 976 * MiB;
constexpr int CW_TMO = 0, CW_BAR = 4096, CW_CNT = 8192;

__device__ __forceinline__ float bf2f(bf16 v) { return __uint_as_float(((unsigned)v) << 16); }
__device__ __forceinline__ unsigned f2bfu(float f) { unsigned u = __float_as_uint(f); return (u + 0x7fffu + ((u >> 16) & 1u)) >> 16; }
__device__ __forceinline__ bf16 f2bf(float f) { return (bf16)f2bfu(f); }
__device__ __forceinline__ unsigned pk2(float lo, float hi) { return f2bfu(lo) | (f2bfu(hi) << 16); }
__device__ __forceinline__ float wsum(float v) {
#pragma unroll
    for (int o = 32; o > 0; o >>= 1) v += __shfl_xor(v, o);
    return v;
}
__device__ __forceinline__ void unpack8(v4u w, float* f) {
    f[0] = __uint_as_float(w.x << 16); f[1] = __uint_as_float(w.x & 0xffff0000u);
    f[2] = __uint_as_float(w.y << 16); f[3] = __uint_as_float(w.y & 0xffff0000u);
    f[4] = __uint_as_float(w.z << 16); f[5] = __uint_as_float(w.z & 0xffff0000u);
    f[6] = __uint_as_float(w.w << 16); f[7] = __uint_as_float(w.w & 0xffff0000u);
}
__device__ __forceinline__ v2u pack8_f8(const float* f, float sc) {
    int lo = 0, hi = 0;
    lo = __builtin_amdgcn_cvt_pk_fp8_f32(f[0] * sc, f[1] * sc, lo, false); lo = __builtin_amdgcn_cvt_pk_fp8_f32(f[2] * sc, f[3] * sc, lo, true);
    hi = __builtin_amdgcn_cvt_pk_fp8_f32(f[4] * sc, f[5] * sc, hi, false); hi = __builtin_amdgcn_cvt_pk_fp8_f32(f[6] * sc, f[7] * sc, hi, true);
    v2u o; o.x = (unsigned)lo; o.y = (unsigned)hi; return o;
}
__device__ __forceinline__ v4u pack8(const float* f) { v4u o; o.x = pk2(f[0], f[1]); o.y = pk2(f[2], f[3]); o.z = pk2(f[4], f[5]); o.w = pk2(f[6], f[7]); return o; }

__device__ __forceinline__ int lane_id() { return (int)(threadIdx.x & 63u); }
#define TIDX(wave_) ((int)threadIdx.x)

struct Ptrs {
    const float *x, *p, *norm_mix, *w_in, *conv_w, *q_norm, *k_norm, *sinks, *onc, *ona, *w_out, *norm_ffn, *w_group, *b_group, *w_router, *b_router,
        *w_gate, *w_up, *w_down, *norm_ple, *w_ple_gate, *w_ple;
    float* out; unsigned char* ws;
};
struct Ent { int tok; float w; float rs; int pad; };
namespace pg8 {
typedef int v4i __attribute__((ext_vector_type(4)));
typedef int v8i __attribute__((ext_vector_type(8)));
constexpr int BM = 256, BK = 64, HALF = 128, HTB = HALF * BK * 2  , STAGE_BYTES = 8 * HTB, NXCD = 8, WGM = 8;
constexpr int RING_BYTES = 131072;
constexpr int LDSX_OFF = RING_BYTES;
constexpr int MISC_OFF = LDSX_OFF + 320;
constexpr int TAB_OFF = LDSX_OFF + 1024;
constexpr int LST_OFF = TAB_OFF + 8192;
constexpr int LDS_BYTES = 147456;

__host__ __device__ __forceinline__ int lds_byte(int r, int c) { const int st = (r >> 4) * 2 + (c >> 5), rr = r & 15, cc = c & 31, ob = rr * 64 + cc * 2; return st * 1024 + (ob ^ (((ob >> 9) & 1) << 5)); }
__host__ __device__ __forceinline__ void stage_rc(int b, int& R, int& C) { const int st = b / 1024, sb = b % 1024, swz = sb ^ (((sb >> 9) & 1) << 5); R = (st >> 1) * 16 + swz / 64; C = (st & 1) * 32 + (swz % 64) / 2; }
__host__ __device__ __forceinline__ int perm32(int rho) { const int n = rho >> 4, i = rho & 15; return 8 * (i >> 2) + 4 * n + (i & 3); }

struct Unit { int pm, pn, bt, par, lst, rk0, nl; };
struct Gemm { const bf16* A; const bf16* Bt; int M, N, K; };

struct StaticOrder {
    static constexpr bool GATHER = false;
    int nM, nN, nwg, G, c;
    __host__ __device__ void init(int M_, int N_, int G_, int c_) { nM = M_ / BM; nN = N_ / BM; nwg = nM * nN; G = G_; c = c_; }
    __host__ __device__ bool next(int i, Unit& u) const {
        const long L = (long)i * G + c; if (L >= nwg) return false;
        int wgid = (int)L; { const int q = nwg / NXCD, r = nwg % NXCD, xcd = wgid % NXCD, off = wgid / NXCD; wgid = (xcd < r ? xcd * (q + 1) : r * (q + 1) + (xcd - r) * q) + off; }
        const int nig = WGM * nN, gid = wgid / nig, fm = gid * WGM, gsz = (nM - fm) < WGM ? (nM - fm) : WGM;
        u.pm = fm + ((wgid % nig) % gsz); u.pn = (wgid % nig) / gsz; u.bt = u.pn; u.par = i & 1; u.lst = 0; u.rk0 = 0; u.nl = 0; return true;
    }
    __device__ __forceinline__ void a_ready(const Unit&) const {}
    __device__ __forceinline__ void done(const Unit&) const {}
};

struct PwOrder {
    static constexpr bool GATHER = false;
    int G, c, nr;
    __device__ __forceinline__ bool next(int i, Unit& u) const {
        int L;
        if (G == 256 && nr == 128) { if (c < nr) { if (i > 0) return false; L = 7 * (G - nr) + c; } else { if (i >= 7) return false; L = (c - nr) * 7 + i; } }
        else { L = i * G + c; if (L >= (M / BM) * (D / BM)) return false; }
        u.pm = L / (D / BM); u.pn = L % (D / BM); u.bt = u.pn; u.par = i & 1; u.lst = 0; u.rk0 = 0; u.nl = 0; return true;
    }
    __device__ __forceinline__ void a_ready(const Unit&) const {}
    __device__ __forceinline__ void done(const Unit&) const {}
};

__device__ __forceinline__ unsigned cvt_pk_bf16(float lo, float hi) { unsigned r; asm volatile("v_cvt_pk_bf16_f32 %0, %1, %2" : "=v"(r) : "v"(lo), "v"(hi)); return r; }

template <class Epi, class Sched, bool ALIGN_EPI, bool F8 = false>
__device__ __forceinline__ void gemm_phase(LAS unsigned char* lds, const Gemm g, const Sched& S, const Epi& E, const int wid) {
    const int lane = lane_id(), tid = wid * 64 + lane, wr = wid >> 2, wc = wid & 3, fr = lane & 15, fq = lane >> 4;
    const int K = g.K, nt = K / BK;
    unsigned voffA[2], voffB[2]; int R0 = 0, C0 = 0;
#pragma unroll
    for (int i = 0; i < 2; ++i) { int R, C; stage_rc(tid * 16 + i * 8192, R, C); const int Rb = Epi::PERM ? ((R & ~31) + perm32(R & 31)) : R;
        voffA[i] = (unsigned)(R * K + C) * 2u; voffB[i] = (unsigned)(Rb * K + C) * 2u; if (i == 0) { R0 = R; C0 = C; } }
    const size_t kstep = (size_t)(BK * 2);
    const size_t hstep = (size_t)HALF * K * 2;
    const size_t tstep = 2 * hstep;
    const unsigned ldsw = (unsigned)wid * 1024u;
    const int aoff = lds_byte(wr * 64 + fr, fq * 8), boff = lds_byte(wc * 32 + fr, fq * 8);
    unsigned gc[2][2] = {{0u, 0u}, {0u, 0u}}, gn[2][2] = {{0u, 0u}, {0u, 0u}}, gs[2][2] = {{0u, 0u}, {0u, 0u}};
#define PG8_TOK(par, r) (*(const LAS int*)(lds + TAB_OFF + (par) * 4096 + (r) * 16))
#define PG8_GLOAD(dst, par) do { _Pragma("unroll") for (int _h = 0; _h < 2; ++_h) _Pragma("unroll") for (int _i = 0; _i < 2; ++_i) \
        dst[_h][_i] = (unsigned)PG8_TOK(par, _h * 128 + _i * 64 + R0) * (unsigned)(K * 2) + (unsigned)(C0 * 2); } while (0)
#define PG8_SA(b, h) (((b) * 2 + (h)) * HTB)
#define PG8_SB(b, h) ((4 + (b) * 2 + (h)) * HTB)
#define PG8_STAGE(bufoff, gbase, voff) do { _Pragma("unroll") for (int _i = 0; _i < 2; ++_i) \
        __builtin_amdgcn_global_load_lds((const unsigned*)((const char*)(gbase) + (voff)[_i]), (LAS unsigned*)(lds + (bufoff) + ldsw + _i * 8192), 16, 0, 0); } while (0)
#define PG8_STAGE_A(bufoff, ub, go, h, kb) do { if constexpr (Sched::GATHER) { PG8_STAGE(bufoff, (const char*)g.A + (kb), go[h]); } else { PG8_STAGE(bufoff, (ub) + (kb) + (h) * hstep, voffA); } } while (0)
#define PG8_CAT(p_) __builtin_shufflevector(*(const LAS v4i*)(p_), *(const LAS v4i*)((p_) + 1024), 0, 1, 2, 3, 4, 5, 6, 7)
#define PG8_LDA(dst, b, h) do { if constexpr (F8) { _Pragma("unroll") for (int m = 0; m < 4; ++m) dst##8[m] = PG8_CAT(lds + PG8_SA(b, h) + aoff + m * 2048); } \
        else { _Pragma("unroll") for (int m = 0; m < 4; ++m) _Pragma("unroll") for (int k = 0; k < 2; ++k) dst[m][k] = *(const LAS bf16x8*)(lds + PG8_SA(b, h) + aoff + m * 2048 + k * 1024); } } while (0)
#define PG8_LDB(dst, b, h) do { if constexpr (F8) { _Pragma("unroll") for (int n = 0; n < 2; ++n) dst##8[n] = PG8_CAT(lds + PG8_SB(b, h) + boff + n * 2048); } \
        else { _Pragma("unroll") for (int n = 0; n < 2; ++n) _Pragma("unroll") for (int k = 0; k < 2; ++k) dst[n][k] = *(const LAS bf16x8*)(lds + PG8_SB(b, h) + boff + n * 2048 + k * 1024); } } while (0)
#define PG8_MMA(ai, bj, At, Bt) do { __builtin_amdgcn_s_setprio(1); _Pragma("unroll") for (int m = 0; m < 4; ++m) _Pragma("unroll") for (int n = 0; n < 2; ++n) { \
        if constexpr (F8) { asm volatile("v_mfma_scale_f32_16x16x128_f8f6f4 %0, %1, %2, %0, %3, %3 op_sel_hi:[0,0,0]" : "+v"(acc[ai][bj][m][n]) : "v"(Bt##8[n]), "v"(At##8[m]), "v"(f8scale)); } \
        else { _Pragma("unroll") for (int k = 0; k < 2; ++k) acc[ai][bj][m][n] = __builtin_amdgcn_mfma_f32_16x16x32_bf16(Bt[n][k], At[m][k], acc[ai][bj][m][n], 0, 0, 0); } } \
        __builtin_amdgcn_s_setprio(0); } while (0)
#define PG8_WAIT_V(n) asm volatile("s_waitcnt vmcnt(" #n ")" ::: "memory")
#define PG8_WAIT_L(n) asm volatile("s_waitcnt lgkmcnt(" #n ")" ::: "memory")
#define PG8_BAR __builtin_amdgcn_s_barrier()
#define PG8_SCHED __builtin_amdgcn_sched_barrier(0)
    Unit cur, nxt; int ui = 0;
    if (!S.next(0, cur)) return;
    f32x4 acc[2][2][4][2];
#pragma unroll
    for (int a = 0; a < 2; ++a)
#pragma unroll
        for (int b = 0; b < 2; ++b)
#pragma unroll
            for (int m = 0; m < 4; ++m)
#pragma unroll
                for (int n = 0; n < 2; ++n) acc[a][b][m][n] = (f32x4){0.f, 0.f, 0.f, 0.f};
    bf16x8 At[4][2], B0[2][2], B1[2][2];
    const int f8scale = 0x7f7f7f7f;
    v8i At8[4], B08[2], B18[2];
    const char* cA = (const char*)g.A + (size_t)cur.pm * tstep; const char* cB = (const char*)g.Bt + (size_t)cur.bt * tstep;
    S.a_ready(cur);
    if constexpr (Sched::GATHER) { PG8_GLOAD(gc, cur.par); }
    PG8_STAGE(PG8_SB(0, 0), cB, voffB); PG8_STAGE(PG8_SB(0, 1), cB + hstep, voffB); PG8_STAGE_A(PG8_SA(0, 0), cA, gc, 0, (size_t)0); PG8_STAGE_A(PG8_SA(0, 1), cA, gc, 1, (size_t)0);
    if (wr == 1) PG8_BAR;
    PG8_WAIT_V(2); PG8_BAR;
    PG8_STAGE(PG8_SB(1, 0), cB + kstep, voffB); PG8_STAGE_A(PG8_SA(1, 0), cA, gc, 0, kstep); PG8_STAGE(PG8_SB(1, 1), cB + hstep + kstep, voffB);
    PG8_WAIT_V(6); PG8_BAR;
    for (;;) {
        const bool has_next = S.next(ui + 1, nxt);
        const char* nA = has_next ? (const char*)g.A + (size_t)nxt.pm * tstep : cA; const char* nB = has_next ? (const char*)g.Bt + (size_t)nxt.bt * tstep : cB;
#pragma unroll 1
        for (int t = 0; t < nt; t += 2) {
            const bool last = (t == nt - 2);
            const size_t k1 = (size_t)(t + 1) * kstep;
            const char* sA = last ? nA : cA; const size_t k2 = last ? (size_t)0 : (size_t)(t + 2) * kstep, k3 = k2 + kstep;
            const char* b2 = last ? nB : cB + (size_t)(t + 2) * kstep; const char* b3 = b2 + kstep;
            if (last && has_next) { S.a_ready(nxt); if constexpr (Sched::GATHER) { PG8_GLOAD(gn, nxt.par); } }
            if constexpr (Sched::GATHER) {
#pragma unroll
                for (int h = 0; h < 2; ++h)
#pragma unroll
                    for (int i = 0; i < 2; ++i) gs[h][i] = (last && has_next) ? gn[h][i] : gc[h][i];
            }
            PG8_LDB(B0, 0, 0); PG8_LDB(B1, 0, 1); PG8_SCHED; PG8_LDA(At, 0, 0); PG8_STAGE_A(PG8_SA(1, 1), cA, gc, 1, k1);
            PG8_WAIT_V(8); PG8_WAIT_L(0); PG8_BAR; PG8_MMA(0, 0, At, B0); PG8_MMA(0, 1, At, B1); PG8_BAR; PG8_SCHED;
            PG8_LDA(At, 0, 1); PG8_STAGE(PG8_SB(0, 0), b2, voffB); PG8_STAGE(PG8_SB(0, 1), b2 + hstep, voffB); PG8_STAGE_A(PG8_SA(0, 0), sA, gs, 0, k2);
            PG8_WAIT_V(8); PG8_WAIT_L(0); PG8_BAR; PG8_MMA(1, 0, At, B0); PG8_MMA(1, 1, At, B1); PG8_BAR; PG8_SCHED;
            PG8_LDB(B0, 1, 0); PG8_LDB(B1, 1, 1); PG8_SCHED; PG8_LDA(At, 1, 0); PG8_STAGE_A(PG8_SA(0, 1), sA, gs, 1, k2);
            PG8_WAIT_V(8); PG8_WAIT_L(0); PG8_BAR; PG8_MMA(0, 0, At, B0); PG8_MMA(0, 1, At, B1); PG8_BAR; PG8_SCHED;
            PG8_LDA(At, 1, 1); PG8_STAGE(PG8_SB(1, 0), b3, voffB); PG8_STAGE(PG8_SB(1, 1), b3 + hstep, voffB); PG8_STAGE_A(PG8_SA(1, 0), sA, gs, 0, k3);
            PG8_WAIT_V(8); PG8_WAIT_L(0); PG8_BAR; PG8_MMA(1, 0, At, B0); PG8_MMA(1, 1, At, B1); PG8_BAR; PG8_SCHED;
        }
        if constexpr (F8) asm volatile("s_nop 15\n\ts_nop 15" ::: "memory");
        if constexpr (ALIGN_EPI) { if (wr == 0) PG8_BAR; }
        if constexpr (!Epi::AFTER_DRAIN) { E(acc, cur, wr, wc, fr, fq); S.done(cur); }
        if (!has_next) break;
#pragma unroll
        for (int a = 0; a < 2; ++a)
#pragma unroll
            for (int b = 0; b < 2; ++b)
#pragma unroll
                for (int m = 0; m < 4; ++m)
#pragma unroll
                    for (int n = 0; n < 2; ++n) acc[a][b][m][n] = (f32x4){0.f, 0.f, 0.f, 0.f};
        cur = nxt; cA = nA; cB = nB; ++ui;
        if constexpr (Sched::GATHER) {
#pragma unroll
            for (int h = 0; h < 2; ++h)
#pragma unroll
                for (int i = 0; i < 2; ++i) gc[h][i] = gn[h][i];
        }
        if constexpr (ALIGN_EPI) { if (wr == 1) PG8_BAR; }
    }
    PG8_WAIT_V(0);
    if constexpr (!ALIGN_EPI) { if (wr == 0) PG8_BAR; }
    PG8_BAR;
    if constexpr (Epi::AFTER_DRAIN) { E.fused(acc, cur, wr, wc, fr, fq, lds, wid, lane); S.done(cur); }
#undef PG8_TOK
#undef PG8_GLOAD
#undef PG8_SA
#undef PG8_SB
#undef PG8_STAGE
#undef PG8_STAGE_A
#undef PG8_CAT
#undef PG8_LDA
#undef PG8_LDB
#undef PG8_MMA
#undef PG8_WAIT_V
#undef PG8_WAIT_L
#undef PG8_BAR
#undef PG8_SCHED
}

typedef f32x4 Acc[2][2][4][2];
#define TAB_ENT(ldsx, par, r) ((const LAS Ent*)((ldsx) + TAB_OFF + (par) * 4096 + (r) * 16))

struct EpiBf16 {
    static constexpr bool PERM = true, AFTER_DRAIN = false;
    bf16* O; int ldc; const float* rs;
    __device__ __forceinline__ void operator()(const Acc& acc, const Unit& u, int wr, int wc, int fr, int fq) const {
        const int row0 = u.pm * BM + wr * 64 + fr, col0 = u.pn * BM + wc * 32 + 8 * fq;
#pragma unroll
        for (int ai = 0; ai < 2; ++ai)
#pragma unroll
            for (int m = 0; m < 4; ++m) { const int row = row0 + ai * HALF + m * 16; const float s = rs ? rs[row] : 1.f; bf16* rowp = O + (size_t)row * ldc + col0;
#pragma unroll
                for (int bj = 0; bj < 2; ++bj) { const f32x4 v0 = acc[ai][bj][m][0] * s, v1 = acc[ai][bj][m][1] * s; v4u w;
                    w.x = cvt_pk_bf16(v0[0], v0[1]); w.y = cvt_pk_bf16(v0[2], v0[3]); w.z = cvt_pk_bf16(v1[0], v1[1]); w.w = cvt_pk_bf16(v1[2], v1[3]);
                    *(v4u*)(rowp + bj * HALF) = w; } }
    }
};
struct EpiH1 {
    static constexpr bool PERM = true, AFTER_DRAIN = false;
    const bf16* xb; const float* rms; bf16* h1; float* ssp; unsigned char* h18;
    __device__ __forceinline__ void operator()(const Acc& acc, const Unit& u, int wr, int wc, int fr, int fq) const {
        const int row0 = u.pm * BM + wr * 64 + fr, col0 = u.pn * BM + wc * 32 + 8 * fq;
        v4u xv[2][2]; float rm[8];
#define H1_LOAD(g_, buf) do { const size_t off_ = (size_t)(row0 + ((g_) >> 2) * HALF + ((g_) & 3) * 16) * D + col0; xv[buf][0] = *(const v4u*)(xb + off_); xv[buf][1] = *(const v4u*)(xb + off_ + HALF); } while (0)
#pragma unroll
        for (int gi = 0; gi < 8; ++gi) rm[gi] = rms[row0 + (gi >> 2) * HALF + (gi & 3) * 16];
        H1_LOAD(0, 0);
#pragma unroll
        for (int gi = 0; gi < 8; ++gi) { const int ai = gi >> 2, m = gi & 3;
            if (gi + 1 < 8) H1_LOAD(gi + 1, (gi + 1) & 1);
            asm volatile("" ::: "memory");
            const int row = row0 + ai * HALF + m * 16; const size_t off = (size_t)row * D + col0; float ss = 0.f; const float r = rm[gi];
#pragma unroll
            for (int bj = 0; bj < 2; ++bj) { float xf[8]; unpack8(xv[gi & 1][bj], xf); float o[8];
#pragma unroll
                for (int n = 0; n < 2; ++n)
#pragma unroll
                    for (int i = 0; i < 4; ++i) { o[n * 4 + i] = xf[n * 4 + i] * r + acc[ai][bj][m][n][i]; ss += o[n * 4 + i] * o[n * 4 + i]; }
                v4u w; w.x = cvt_pk_bf16(o[0], o[1]); w.y = cvt_pk_bf16(o[2], o[3]); w.z = cvt_pk_bf16(o[4], o[5]); w.w = cvt_pk_bf16(o[6], o[7]);
                *(v4u*)(h1 + off + bj * HALF) = w; if (h18) *(v2u*)(h18 + off + bj * HALF) = pack8_f8(o, F8_ASCALE); }
            ss += __shfl_xor(ss, 16); ss += __shfl_xor(ss, 32);
            if (fq == 0) ssp[(size_t)row * 32 + u.pn * 4 + wc] = ss;
            asm volatile("" ::: "memory"); }
#undef H1_LOAD
    }
};
struct EpiRouter {
    static constexpr bool PERM = false, AFTER_DRAIN = true;
    const float* ssp; const float* bg; const float* br; float* rs1; int* eid; float* ew; Ent* ent; unsigned* cnt;
    __device__ __forceinline__ void fused(const Acc& acc, const Unit& u, int wr, int wc, int fr, int fq, LAS unsigned char* lds, int wid, int lane) const {
        LAS float* LG = (LAS float*)lds;
        LAS unsigned* HIST = (LAS unsigned*)(lds + 65536);
        LAS unsigned* BASE = (LAS unsigned*)(lds + 65536 + 256);
        const int tid = wid * 64 + lane;
        if (tid < 64) HIST[tid] = 0u;
        if (wc < 2) {
#pragma unroll
            for (int ai = 0; ai < 2; ++ai)
#pragma unroll
                for (int m = 0; m < 4; ++m) { const int r = ai * HALF + wr * 64 + m * 16 + fr;
#pragma unroll
                    for (int n = 0; n < 2; ++n) { const int c = wc * 32 + 16 * n + 4 * fq; if (c < 40) *(LAS f32x4*)(LG + r * 40 + c) = acc[ai][0][m][n]; } }
        }
        __syncthreads();
        int l0 = 0, l1 = 0; unsigned k0 = 0, k1 = 0; float w0 = 0.f, w1 = 0.f, rs = 0.f; const int row = u.pm * BM + tid;
        if (tid < 256) {
            float ss = 0.f;
#pragma unroll
            for (int j = 0; j < 8; ++j) { const f32x4 p = *(const f32x4*)(ssp + (size_t)row * 32 + 4 * j); ss += (p[0] + p[1]) + (p[2] + p[3]); }
            rs = 1.0f / sqrtf(ss * (1.0f / D) + EPS);
            const LAS float* L = LG + tid * 40;
            float gl[NGRP]; int g = 0;
#pragma unroll
            for (int j = 0; j < NGRP; ++j) gl[j] = L[j] * rs + bg[j];
            float gm = gl[0];
#pragma unroll
            for (int j = 1; j < NGRP; ++j) if (gl[j] > gm) { gm = gl[j]; g = j; }
            float gsum = 0.f;
#pragma unroll
            for (int j = 0; j < NGRP; ++j) gsum += __expf(gl[j] - gm);
            const float gw = 1.0f / gsum;
            const LAS float* E = L + NGRP + g * EPG; const float* be = br + g * EPG;
            int i1 = 0; float v1 = E[0] * rs + be[0];
            for (int j = 1; j < EPG; ++j) { const float v = E[j] * rs + be[j]; if (v > v1) { v1 = v; i1 = j; } }
            int i2 = 0; float v2 = -3.0e38f;
            for (int j = 0; j < EPG; ++j) { const float v = E[j] * rs + be[j]; if (j != i1 && v > v2) { v2 = v; i2 = j; } }
            const float e2 = __expf(v2 - v1); w0 = gw / (1.0f + e2); w1 = gw * e2 / (1.0f + e2);
            l0 = g * EPG + i1; l1 = NE + g * EPG + i2;
            eid[row * 2] = l0; eid[row * 2 + 1] = l1 - NE; ew[row * 2] = w0; ew[row * 2 + 1] = w1; rs1[row] = rs;
            k0 = __hip_atomic_fetch_add(HIST + l0, 1u, __ATOMIC_RELAXED, __HIP_MEMORY_SCOPE_WORKGROUP); k1 = __hip_atomic_fetch_add(HIST + l1, 1u, __ATOMIC_RELAXED, __HIP_MEMORY_SCOPE_WORKGROUP);
        }
        __syncthreads();
        if (tid < 64) { const unsigned n = HIST[tid]; BASE[tid] = n ? __hip_atomic_fetch_add(cnt + 64 * tid, n, __ATOMIC_RELAXED, __HIP_MEMORY_SCOPE_AGENT) : 0u; }
        __syncthreads();
        if (tid < 256) {
            *(v4u*)(ent + (size_t)l0 * LCAP + BASE[l0] + k0) = (v4u){(unsigned)row, __float_as_uint(w0), __float_as_uint(rs), 0u};
            *(v4u*)(ent + (size_t)l1 * LCAP + BASE[l1] + k1) = (v4u){(unsigned)row, __float_as_uint(w1), __float_as_uint(rs), 0u};
        }
    }
};
struct EpiGU {
    static constexpr bool PERM = true, AFTER_DRAIN = false;
    bf16* hid; LAS unsigned char* ldsx; float sc;
    __device__ __forceinline__ void operator()(const Acc& acc, const Unit& u, int wr, int wc, int fr, int fq) const {
        const int col0 = u.pn * HALF + wc * 32 + 8 * fq;
#pragma unroll
        for (int ai = 0; ai < 2; ++ai)
#pragma unroll
            for (int m = 0; m < 4; ++m) { const int r = ai * HALF + wr * 64 + m * 16 + fr; const LAS Ent* e = TAB_ENT(ldsx, u.par, r); const float w = e->w, rs = e->rs * sc;
                float o[8];
#pragma unroll
                for (int n = 0; n < 2; ++n)
#pragma unroll
                    for (int i = 0; i < 4; ++i) { const float gg = acc[ai][0][m][n][i] * rs, uu = acc[ai][1][m][n][i] * rs; o[n * 4 + i] = w * (gg / (1.0f + __expf(-gg))) * uu; }
                v4u q; q.x = cvt_pk_bf16(o[0], o[1]); q.y = cvt_pk_bf16(o[2], o[3]); q.z = cvt_pk_bf16(o[4], o[5]); q.w = cvt_pk_bf16(o[6], o[7]);
                *(v4u*)(hid + (size_t)(u.pm * BM + r) * DEXP + col0) = q; }
    }
};
template <int KK> struct EpiDown {
    static constexpr bool PERM = true, AFTER_DRAIN = false;
    const bf16* base; bf16* h2; float* ssp; LAS unsigned char* ldsx; unsigned char* h28;
    __device__ __forceinline__ void operator()(const Acc& acc, const Unit& u, int wr, int wc, int fr, int fq) const {
        const int col0 = u.pn * BM + wc * 32 + 8 * fq;
        v4u bv[2][2]; int tk[2];
#define DN_LOAD(g_, buf) do { tk[buf] = TAB_ENT(ldsx, u.par, ((g_) >> 2) * HALF + wr * 64 + ((g_) & 3) * 16 + fr)->tok; const size_t off_ = (size_t)tk[buf] * D + col0; bv[buf][0] = *(const v4u*)(base + off_); bv[buf][1] = *(const v4u*)(base + off_ + HALF); } while (0)
        DN_LOAD(0, 0);
#pragma unroll
        for (int gi = 0; gi < 8; ++gi) { const int ai = gi >> 2, m = gi & 3;
            if (gi + 1 < 8) DN_LOAD(gi + 1, (gi + 1) & 1);
            asm volatile("" ::: "memory");
            const int r = ai * HALF + wr * 64 + m * 16 + fr; const bool valid = (u.rk0 + r) < u.nl; const int tok = tk[gi & 1]; const size_t off = (size_t)tok * D + col0; float ss = 0.f;
#pragma unroll
            for (int bj = 0; bj < 2; ++bj) { float b[8]; unpack8(bv[gi & 1][bj], b);
                float o[8];
#pragma unroll
                for (int n = 0; n < 2; ++n)
#pragma unroll
                    for (int i = 0; i < 4; ++i) { o[n * 4 + i] = b[n * 4 + i] + acc[ai][bj][m][n][i]; ss += o[n * 4 + i] * o[n * 4 + i]; }
                v4u q; q.x = cvt_pk_bf16(o[0], o[1]); q.y = cvt_pk_bf16(o[2], o[3]); q.z = cvt_pk_bf16(o[4], o[5]); q.w = cvt_pk_bf16(o[6], o[7]);
                if (valid) { *(v4u*)(h2 + off + bj * HALF) = q; if (KK == 1 && h28) *(v2u*)(h28 + off + bj * HALF) = pack8_f8(o, F8_ASCALE); } }
            if (KK == 1) { ss += __shfl_xor(ss, 16); ss += __shfl_xor(ss, 32); if (fq == 0 && valid) ssp[(size_t)tok * 32 + u.pn * 4 + wc] = ss; }
            asm volatile("" ::: "memory"); }
#undef DN_LOAD
    }
};
struct EpiFinal {
    static constexpr bool PERM = true, AFTER_DRAIN = false;
    const bf16* h2; const bf16* pw; float* out; LAS unsigned char* ldsx; float sc;
    __device__ __forceinline__ void operator()(const Acc& acc, const Unit& u, int wr, int wc, int fr, int fq) const {
        const int col0 = u.pn * BM + wc * 32 + 8 * fq;
        v4u hv[2][2], pv[2][2];
#define FN_LOAD(g_, buf) do { const size_t off_ = (size_t)(u.pm * BM + ((g_) >> 2) * HALF + wr * 64 + ((g_) & 3) * 16 + fr) * D + col0; \
            hv[buf][0] = *(const v4u*)(h2 + off_); hv[buf][1] = *(const v4u*)(h2 + off_ + HALF); pv[buf][0] = *(const v4u*)(pw + off_); pv[buf][1] = *(const v4u*)(pw + off_ + HALF); } while (0)
        FN_LOAD(0, 0);
#pragma unroll
        for (int gi = 0; gi < 8; ++gi) { const int ai = gi >> 2, m = gi & 3;
            if (gi + 1 < 8) FN_LOAD(gi + 1, (gi + 1) & 1);
            asm volatile("" ::: "memory");
            const int r = ai * HALF + wr * 64 + m * 16 + fr; const float rs = TAB_ENT(ldsx, u.par, r)->rs * sc; const size_t off = (size_t)(u.pm * BM + r) * D + col0;
#pragma unroll
            for (int bj = 0; bj < 2; ++bj) { float hf[8], pf[8]; unpack8(hv[gi & 1][bj], hf); unpack8(pv[gi & 1][bj], pf);
#pragma unroll
                for (int n = 0; n < 2; ++n) { const f32x4 z = acc[ai][bj][m][n] * rs; f32x4 o;
#pragma unroll
                    for (int i = 0; i < 4; ++i) o[i] = hf[n * 4 + i] + pf[n * 4 + i] * __builtin_amdgcn_rcpf(1.0f + __expf(-z[i]));
                    *(f32x4*)(out + off + bj * HALF + n * 4) = o; } }
            asm volatile("" ::: "memory"); }
#undef FN_LOAD
    }
};

template <bool GATHER_, int NPN> struct MoeOrder {
    static constexpr bool GATHER = GATHER_;
    LAS unsigned char* ldsx; const Ent* ent; int tlo, thi, G, c, wave;
    __device__ __forceinline__ bool next(int i, Unit& u) const {
        const long L = (long)i * G + c; const int nun = (thi - tlo) * NPN; if (L >= nun) return false;
        const int tile = tlo + (int)(L / NPN); const LAS int* T0 = (const LAS int*)(ldsx + LST_OFF + 256);
        int l = 0;
        for (int j = 1; j < NLIST; ++j) l += (T0[j] <= tile) ? 1 : 0;
        l = __builtin_amdgcn_readfirstlane(l);
        u.pm = tile; u.pn = (int)(L % NPN); u.bt = (l & (NE - 1)) * NPN + u.pn; u.par = i & 1; u.lst = l; u.rk0 = (tile - __builtin_amdgcn_readfirstlane(T0[l])) * BM; u.nl = __builtin_amdgcn_readfirstlane(((const LAS int*)(ldsx + LST_OFF))[l]);
        return true;
    }
    __device__ __forceinline__ void a_ready(const Unit& u) const {
        const int tid = TIDX(wave);
        if (tid < 256) { const int rk = u.rk0 + tid; v4u e = (v4u){0u, 0u, 0u, 0u}; if (rk < u.nl) e = *(const v4u*)(ent + (size_t)u.lst * LCAP + rk);
            *(LAS v4u*)(ldsx + TAB_OFF + u.par * 4096 + tid * 16) = e; }
        if (GATHER) { asm volatile("s_waitcnt vmcnt(0) lgkmcnt(0)" ::: "memory"); __builtin_amdgcn_s_barrier(); asm volatile("" ::: "memory"); }
    }
    __device__ __forceinline__ void done(const Unit&) const {}
};
struct FinalOrder : StaticOrder {
    LAS unsigned char* ldsx; const float* ssp; int wave;
    __device__ __forceinline__ void a_ready(const Unit& u) const {
        const int tid = TIDX(wave);
        if (tid < 256) { const int row = u.pm * BM + tid; float ss = 0.f;
#pragma unroll
            for (int j = 0; j < 8; ++j) { const f32x4 p = *(const f32x4*)(ssp + (size_t)row * 32 + 4 * j); ss += (p[0] + p[1]) + (p[2] + p[3]); }
            *(LAS v4u*)(ldsx + TAB_OFF + u.par * 4096 + tid * 16) = (v4u){(unsigned)row, 0u, __float_as_uint(1.0f / sqrtf(ss * (1.0f / D) + EPS)), 0u}; }
    }
};
}
#define RLX_AGENT __ATOMIC_RELAXED, __HIP_MEMORY_SCOPE_AGENT
#define XB_TMO      128
#define XB_XCNT(j)  (256  + 64 * (j))
#define XB_XSUB(j)  (1280 + 64 * (j))
#define XB_XGEN(j)  (2304 + 64 * (j))
#define XB_TOP      3328
#define XB_TOPGEN   3392
#define XCD_BAR_WORDS 3456
#define XB_SPIN_CAP (1u << 18)

__device__ __forceinline__ unsigned xb_ld(unsigned* p)              { return __hip_atomic_load(p, __ATOMIC_RELAXED, __HIP_MEMORY_SCOPE_AGENT); }
__device__ __forceinline__ unsigned xb_add(unsigned* p, unsigned v) { return __hip_atomic_fetch_add(p, v, __ATOMIC_RELAXED, __HIP_MEMORY_SCOPE_AGENT); }
__device__ __forceinline__ unsigned xb_xcc_id() { return (unsigned)__builtin_amdgcn_s_getreg((3 << 11) | 20) & 0xFu; }
#define XB_SPIN(cond, bar) do { unsigned _sp = 0; while (cond) { __builtin_amdgcn_s_sleep(1); \
    if ((++_sp & 255u) == 0u) { if (xb_ld(&(bar)[XB_TMO])) break; if (_sp > XB_SPIN_CAP) { atomicAdd(&(bar)[XB_TMO], 1u); break; } } } } while (0)

struct XcdBarrier {
    unsigned* bar; unsigned x;
    volatile LAS unsigned* st;
};
__device__ __forceinline__ XcdBarrier xcd_barrier_post(unsigned* bar, volatile LAS unsigned* st, const int wave_) {
    XcdBarrier b; b.bar = bar; b.x = xb_xcc_id(); b.st = st;
    if (TIDX(wave_) == 0) (void)xb_add(&bar[XB_XCNT(b.x)], 1u);
    return b;
}
__device__ __forceinline__ void xcd_barrier_complete(unsigned* bar, unsigned x, unsigned& nloc, unsigned& nx) {
    const unsigned G = gridDim.x * gridDim.y * gridDim.z;
    unsigned sum, cnt, mine, sp = 0u;
    for (;;) {
        sum = 0u; cnt = 0u; mine = 0u;
#pragma unroll
        for (unsigned j = 0; j < 16; ++j) { const unsigned c = xb_ld(&bar[XB_XCNT(j)]); sum += c; cnt += (c > 0u) ? 1u : 0u; mine = (j == x) ? c : mine; }
        if (sum == G) break;
        __builtin_amdgcn_s_sleep(1);
        if ((++sp & 255u) == 0u) { if (xb_ld(&bar[XB_TMO])) break; if (sp > XB_SPIN_CAP) { atomicAdd(&bar[XB_TMO], 1u); break; } }
    }
    nloc = mine > 0u ? mine : 1u; nx = cnt > 0u ? cnt : 1u;
}
__device__ __forceinline__ void xcd_barrier(const XcdBarrier& b, const int wave_) {
    asm volatile("s_waitcnt vmcnt(0)" ::: "memory");
    __syncthreads();
    if (TIDX(wave_) == 0) {
        unsigned* bar = b.bar;
        __builtin_amdgcn_s_waitcnt(0);
        unsigned nloc = b.st[0], nx = b.st[1];
        if (nloc == 0u) { xcd_barrier_complete(bar, b.x, nloc, nx); b.st[0] = nloc; b.st[1] = nx; }
        const unsigned old = xb_add(&bar[XB_XSUB(b.x)], 1u);
        const unsigned gen = old / nloc;
        if (old + 1u == (gen + 1u) * nloc) {
            __builtin_amdgcn_fence(__ATOMIC_RELEASE, "agent");
            asm volatile("s_waitcnt vmcnt(0)" ::: "memory");
            const unsigned og = xb_add(&bar[XB_TOP], 1u);
            const unsigned tg = og / nx;
            if (og + 1u == (tg + 1u) * nx) xb_add(&bar[XB_TOPGEN], 1u);
            else XB_SPIN(xb_ld(&bar[XB_TOPGEN]) == tg, bar);
            __builtin_amdgcn_fence(__ATOMIC_ACQUIRE, "agent");
            xb_add(&bar[XB_XGEN(b.x)], 1u);
            asm volatile("s_waitcnt vmcnt(0)" ::: "memory");
        } else {
            XB_SPIN(xb_ld(&bar[XB_XGEN(b.x)]) == gen, bar);
            __builtin_amdgcn_fence(__ATOMIC_ACQUIRE, "agent");
            asm volatile("s_waitcnt vmcnt(0)" ::: "memory");
        }
    }
    __syncthreads();
}

constexpr int NWAVES = 8;
__device__ __forceinline__ void p0_transpose_item(const float* W, int K, int N, const float* g0, const float* g1, int gsplit, bf16* WT, int rowbase, int k0, int n0, LAS float* scr, int lane) {
    float v[32];
    const float* src = W + (size_t)(k0 + (lane >> 5)) * N + n0 + (lane & 31);
#pragma unroll
    for (int i = 0; i < 32; ++i) v[i] = src[(size_t)(2 * i) * N];
    const int c = lane & 7;
    float gg[8];
#pragma unroll
    for (int j = 0; j < 8; ++j) { const int k = k0 + 8 * c + j; gg[j] = g0 ? (k < gsplit ? g0[k] : g1[k - gsplit]) : 1.f; }
#pragma unroll
    for (int i = 0; i < 32; ++i) scr[(2 * i + (lane >> 5)) * 33 + (lane & 31)] = v[i];
    asm volatile("s_waitcnt lgkmcnt(0)" ::: "memory");
#pragma unroll
    for (int j = 0; j < 4; ++j) { const int n = (lane >> 3) + 8 * j; const LAS float* s = scr + (8 * c) * 33 + n;
        v4u o; o.x = pk2(s[0 * 33] * gg[0], s[1 * 33] * gg[1]); o.y = pk2(s[2 * 33] * gg[2], s[3 * 33] * gg[3]); o.z = pk2(s[4 * 33] * gg[4], s[5 * 33] * gg[5]); o.w = pk2(s[6 * 33] * gg[6], s[7 * 33] * gg[7]);
        *(v4u*)(WT + (size_t)(rowbase + n) * K + k0 + 8 * c) = o; }
    asm volatile("s_waitcnt lgkmcnt(0)" ::: "memory");
}
__device__ __forceinline__ void p0_transpose_item8(const float* W, int K, int N, const float* g0, unsigned char* WT8, int rowbase, int k0, int n0, LAS float* scr, int lane, float sc) {
    float v[32];
    const float* src = W + (size_t)(k0 + (lane >> 5)) * N + n0 + (lane & 31);
#pragma unroll
    for (int i = 0; i < 32; ++i) v[i] = src[(size_t)(2 * i) * N];
    const int c = lane & 7;
    float gg[8];
#pragma unroll
    for (int j = 0; j < 8; ++j) gg[j] = g0[k0 + 8 * c + j] * sc;
#pragma unroll
    for (int i = 0; i < 32; ++i) scr[(2 * i + (lane >> 5)) * 33 + (lane & 31)] = v[i];
    asm volatile("s_waitcnt lgkmcnt(0)" ::: "memory");
#pragma unroll
    for (int j = 0; j < 4; ++j) { const int n = (lane >> 3) + 8 * j; const LAS float* s = scr + (8 * c) * 33 + n; float f[8];
#pragma unroll
        for (int q = 0; q < 8; ++q) f[q] = s[q * 33] * gg[q];
        *(v2u*)(WT8 + (size_t)(rowbase + n) * K + k0 + 8 * c) = pack8_f8(f, 1.0f); }
    asm volatile("s_waitcnt lgkmcnt(0)" ::: "memory");
}
__device__ __forceinline__ void p0_prologue(const Ptrs& P, LAS unsigned char* lds, int vcu, int G, const int wave) {
    const int lane = lane_id(), tid = wave * 64 + lane;
    unsigned char* ws = P.ws;
    LAS float* scr = (LAS float*)(lds + wave * 16384);
    const int gw = vcu * NWAVES + wave, NGW = G * NWAVES;
    constexpr int I_IN = (D / 64) * (DIN / 32), I_OUT = (D / 64) * (D / 32), I_PLG = I_OUT, I_PLE = (PLE / 64) * (D / 32), I_RT = (D / 64) * (NE / 32);
    constexpr int I_G1 = (D / 64) * (DEXP / 32), I_D1 = (DEXP / 64) * (D / 32);
    constexpr int NITEMS = I_IN + I_OUT + I_PLG + I_PLE + I_RT + NE * (2 * I_G1 + I_D1);
    for (int it = gw; it < NITEMS; it += NGW) {
        int r = it;
        if (r < I_IN) { const int nb = DIN / 32; p0_transpose_item(P.w_in, D, DIN, P.norm_mix, nullptr, D, (bf16*)(ws + WS_WIN), (r % nb) * 32, (r / nb) * 64, (r % nb) * 32, scr, lane); continue; } r -= I_IN;
        if (r < I_OUT) { const int nb = D / 32; p0_transpose_item(P.w_out, D, D, P.onc, P.ona, DCONV, (bf16*)(ws + WS_WOUT), (r % nb) * 32, (r / nb) * 64, (r % nb) * 32, scr, lane); continue; } r -= I_OUT;
        if (r < I_PLG) { const int nb = D / 32;
            if (FP8) p0_transpose_item8(P.w_ple_gate, D, D, P.norm_ple, ws + WS_WPLG, (r % nb) * 32, (r / nb) * 64, (r % nb) * 32, scr, lane, F8_WSCALE);
            else p0_transpose_item(P.w_ple_gate, D, D, P.norm_ple, nullptr, D, (bf16*)(ws + WS_WPLG), (r % nb) * 32, (r / nb) * 64, (r % nb) * 32, scr, lane);
            continue; } r -= I_PLG;
        if (r < I_PLE) { const int nb = D / 32; p0_transpose_item(P.w_ple, PLE, D, nullptr, nullptr, 0, (bf16*)(ws + WS_WPLE), (r % nb) * 32, (r / nb) * 64, (r % nb) * 32, scr, lane); continue; } r -= I_PLE;
        if (r < I_RT) { p0_transpose_item(P.w_router, D, NE, P.norm_ffn, nullptr, D, (bf16*)(ws + WS_WR), NGRP, r * 64, 0, scr, lane); continue; } r -= I_RT;
        const int e = r / (2 * I_G1 + I_D1); r -= e * (2 * I_G1 + I_D1);
        if (r < 2 * I_G1) { const int up = r >= I_G1; r -= up * I_G1; const int nb = DEXP / 32, n0 = (r % nb) * 32, k0 = (r / nb) * 64;
            if (FP8) p0_transpose_item8((up ? P.w_up : P.w_gate) + (size_t)e * D * DEXP, D, DEXP, P.norm_ffn, ws + WS_WGU + (size_t)e * 1024 * D, (n0 >> 7) * 256 + up * 128 + (n0 & 127), k0, n0, scr, lane, F8_WSCALE);
            else p0_transpose_item((up ? P.w_up : P.w_gate) + (size_t)e * D * DEXP, D, DEXP, P.norm_ffn, nullptr, D, (bf16*)(ws + WS_WGU) + (size_t)e * 1024 * D, (n0 >> 7) * 256 + up * 128 + (n0 & 127), k0, n0, scr, lane);
            continue; }
        r -= 2 * I_G1; { const int nb = D / 32; p0_transpose_item(P.w_down + (size_t)e * DEXP * D, DEXP, D, nullptr, nullptr, 0, (bf16*)(ws + WS_WD) + (size_t)e * D * DEXP, (r % nb) * 32, (r / nb) * 64, (r % nb) * 32, scr, lane); }
    }
    { bf16* Wr = (bf16*)(ws + WS_WR); const int gt = vcu * (NWAVES * 64) + tid, NT = G * NWAVES * 64;
      for (int i = gt; i < NGRP * D; i += NT) { const int n = i / D, k = i % D; Wr[(size_t)n * D + k] = f2bf(P.norm_ffn[k] * P.w_group[(size_t)k * NGRP + n]); }
      for (int i = gt; i < (256 - NRT) * D / 8; i += NT) *(v4u*)(Wr + (size_t)NRT * D + (size_t)i * 8) = (v4u){0u, 0u, 0u, 0u}; }
    for (int m = gw; m < M; m += NGW) {
        const f32x4* xr = (const f32x4*)(P.x + (size_t)m * D) + lane; f32x4 v[8]; float s = 0.f;
#pragma unroll
        for (int j = 0; j < 8; ++j) { v[j] = xr[64 * j]; s += (v[j][0] * v[j][0] + v[j][1] * v[j][1]) + (v[j][2] * v[j][2] + v[j][3] * v[j][3]); }
        s = wsum(s);
        v2u* o8 = (v2u*)((bf16*)(ws + WS_XB) + (size_t)m * D) + lane;
        const float rstd = 1.0f / sqrtf(s * (1.0f / D) + EPS);
#pragma unroll
        for (int j = 0; j < 8; ++j) { v2u o; o.x = pk2(v[j][0] * rstd, v[j][1] * rstd); o.y = pk2(v[j][2] * rstd, v[j][3] * rstd); o8[64 * j] = o; }
        if (lane == 0) { ((float*)(ws + WS_RSX))[m] = 1.0f; ((float*)(ws + WS_RMSX))[m] = sqrtf(s * (1.0f / D) + EPS); }
    }
    { const int gt = vcu * (NWAVES * 64) + tid, NT = G * NWAVES * 64; const f32x4* src = (const f32x4*)P.p; v4u* dst = (v4u*)(ws + WS_PB);
      for (int i = gt; i < M * PLE / 8; i += NT) { const f32x4 a = src[2 * i], b = src[2 * i + 1]; v4u o; o.x = pk2(a[0], a[1]); o.y = pk2(a[2], a[3]); o.z = pk2(b[0], b[1]); o.w = pk2(b[2], b[3]); dst[i] = o; } }
}

constexpr int P2_KS = 0, P2_KROW = 144, P2_VT = 36864, P2_VROW = 528, P2_OST = 70656, P2_OROW = 144, P2_SS = 107520, P2_RSTD = 108032;
__device__ __forceinline__ int crow(int r, int hi) { return (r & 3) + 8 * (r >> 2) + 4 * hi; }
__device__ __forceinline__ void p2_unit(const Ptrs& P, LAS unsigned char* lds, int unit, const int wid) {
    const int lane = lane_id(), tid = wid * 64 + lane, l32 = lane & 31, hi = lane >> 5;
    const bf16* proj = (const bf16*)(P.ws + WS_PROJ); bf16* mixed = (bf16*)(P.ws + WS_MIX);
    const int b = unit / (SEQ / 128), qb = unit % (SEQ / 128), q0 = qb * 128; const size_t rowbase = (size_t)b * SEQ;
    LAS float* rowss = (LAS float*)(lds + P2_SS);
    __syncthreads();
    if (tid < 128) rowss[tid] = 0.f;
    const int h4 = wid & 3, half = wid >> 2;
    const int part = tid & 7;
    float kg[8];
#pragma unroll
    for (int j = 0; j < 8; ++j) kg[j] = P.k_norm[part * 8 + j];
#pragma unroll 1
    for (int g = 0; g < NKV; ++g) {
        __syncthreads();
#pragma unroll
        for (int i = 0; i < 4; ++i) {
            const int key = (tid >> 3) + 64 * i; const int kpos = q0 - 128 + key;
            v4u kraw = (v4u){0u, 0u, 0u, 0u}, vraw = (v4u){0u, 0u, 0u, 0u};
            if (kpos >= 0) { const bf16* pr = proj + (rowbase + kpos) * DIN; kraw = *(const v4u*)(pr + C_K + g * HD + part * 8); vraw = *(const v4u*)(pr + C_V + g * HD + part * 8); }
            float kf[8]; unpack8(kraw, kf); float ss = 0.f;
#pragma unroll
            for (int j = 0; j < 8; ++j) ss += kf[j] * kf[j];
            ss += __shfl_xor(ss, 1); ss += __shfl_xor(ss, 2); ss += __shfl_xor(ss, 4);
            const float rk = 1.0f / sqrtf(ss * (1.0f / HD) + EPS);
#pragma unroll
            for (int j = 0; j < 8; ++j) kf[j] = kf[j] * rk * kg[j];
            *(LAS v4u*)(lds + P2_KS + key * P2_KROW + part * 16) = pack8(kf);
            const int x = key & 15; const int pos = (key & ~15) + (x & 3) + ((x >> 3) & 1) * 4 + ((x >> 2) & 1) * 8;
            LAS bf16* vt = (LAS bf16*)(lds + P2_VT) + pos;
            const unsigned vw[4] = {vraw.x, vraw.y, vraw.z, vraw.w};
#pragma unroll
            for (int j = 0; j < 4; ++j) { vt[(part * 8 + 2 * j) * (P2_VROW / 2)] = (bf16)(vw[j] & 0xffffu); vt[(part * 8 + 2 * j + 1) * (P2_VROW / 2)] = (bf16)(vw[j] >> 16); }
        }
        __syncthreads();
        const int h = g * 4 + h4;
        const float slope2 = exp2f(-0.5f * (float)(h + 1)) * LOG2E, sink2 = P.sinks[h] * LOG2E;
#pragma unroll 1
        for (int sub = 0; sub < 2; ++sub) {
            const int qs = 64 * half + 32 * sub;
            const int kt0 = 2 * half + sub;
            const size_t qrow = rowbase + q0 + qs + l32;
            bf16x8 qf[4];
            { float qv[4][8]; float ss = 0.f;
#pragma unroll
              for (int d0 = 0; d0 < 4; ++d0) { unpack8(*(const v4u*)(proj + qrow * DIN + C_Q + h * HD + 16 * d0 + 8 * hi), qv[d0]);
#pragma unroll
                  for (int j = 0; j < 8; ++j) ss += qv[d0][j] * qv[d0][j]; }
              ss += __shfl_xor(ss, 32);
              const float rq = (1.0f / sqrtf(ss * (1.0f / HD) + EPS)) * (0.125f * LOG2E);
#pragma unroll
              for (int d0 = 0; d0 < 4; ++d0) {
#pragma unroll
                  for (int j = 0; j < 8; ++j) qv[d0][j] = qv[d0][j] * rq * P.q_norm[16 * d0 + 8 * hi + j];
                  const v4u w = pack8(qv[d0]); qf[d0] = __builtin_bit_cast(bf16x8, w); } }
            f32x16 sc[5];
#pragma unroll
            for (int jt = 0; jt < 5; ++jt) { sc[jt] = (f32x16){0.f, 0.f, 0.f, 0.f, 0.f, 0.f, 0.f, 0.f, 0.f, 0.f, 0.f, 0.f, 0.f, 0.f, 0.f, 0.f};
#pragma unroll
                for (int d0 = 0; d0 < 4; ++d0) { const bf16x8 kfr = *(const LAS bf16x8*)(lds + P2_KS + ((kt0 + jt) * 32 + l32) * P2_KROW + (16 * d0 + 8 * hi) * 2);
                    sc[jt] = __builtin_amdgcn_mfma_f32_32x32x16_bf16(kfr, qf[d0], sc[jt], 0, 0, 0); } }
            int bl = l32 - 4 * hi; asm volatile("" : "+v"(bl));
            const float ab = -slope2 * (float)bl;
            float mx = sink2;
#pragma unroll
            for (int jt = 0; jt < 5; ++jt)
#pragma unroll
                for (int r = 0; r < 16; ++r) { const int cc = 128 - 32 * jt - (r & 3) - 8 * (r >> 2);
                    float v = sc[jt][r] + (ab - slope2 * (float)cc);
                    if (jt == 0) v = (bl + cc < 128) ? v : -1.0e30f;
                    if (jt == 4) v = (bl + cc >= 0) ? v : -1.0e30f;
                    sc[jt][r] = v; }
            if (q0 == 0) {
                const int lim = 128 - qs;
#pragma unroll
                for (int jt = 0; jt < 4; ++jt)
#pragma unroll
                    for (int r = 0; r < 16; ++r) { const int kr = crow(r, hi); sc[jt][r] = (32 * jt + kr >= lim) ? sc[jt][r] : -1.0e30f; }
            }
#pragma unroll
            for (int jt = 0; jt < 5; ++jt)
#pragma unroll
                for (int r = 0; r < 16; ++r) mx = fmaxf(mx, sc[jt][r]);
            mx = fmaxf(mx, __shfl_xor(mx, 32));
            float l = 0.f;
#pragma unroll
            for (int jt = 0; jt < 5; ++jt)
#pragma unroll
                for (int r = 0; r < 16; ++r) { const float p = exp2f(sc[jt][r] - mx); sc[jt][r] = p; l += p; }
            l += __shfl_xor(l, 32); l += exp2f(sink2 - mx);
            const float rl = 1.0f / l;
            f32x16 o[2];
#pragma unroll
            for (int dh = 0; dh < 2; ++dh) { o[dh] = (f32x16){0.f, 0.f, 0.f, 0.f, 0.f, 0.f, 0.f, 0.f, 0.f, 0.f, 0.f, 0.f, 0.f, 0.f, 0.f, 0.f}; }
#pragma unroll
            for (int jt = 0; jt < 5; ++jt)
#pragma unroll
                for (int j = 0; j < 2; ++j) { v4u pw; pw.x = pk2(sc[jt][8 * j + 0], sc[jt][8 * j + 1]); pw.y = pk2(sc[jt][8 * j + 2], sc[jt][8 * j + 3]); pw.z = pk2(sc[jt][8 * j + 4], sc[jt][8 * j + 5]); pw.w = pk2(sc[jt][8 * j + 6], sc[jt][8 * j + 7]);
                    const bf16x8 pf = __builtin_bit_cast(bf16x8, pw);
#pragma unroll
                    for (int dh = 0; dh < 2; ++dh) { const bf16x8 vf = *(const LAS bf16x8*)(lds + P2_VT + (32 * dh + l32) * P2_VROW + ((kt0 + jt) * 32 + 16 * j + 8 * hi) * 2);
                        o[dh] = __builtin_amdgcn_mfma_f32_32x32x16_bf16(vf, pf, o[dh], 0, 0, 0); } }
            float ss = 0.f;
            LAS unsigned char* ost = lds + P2_OST + wid * (32 * P2_OROW);
#pragma unroll
            for (int dh = 0; dh < 2; ++dh)
#pragma unroll
                for (int r4 = 0; r4 < 4; ++r4) { float a0 = o[dh][4 * r4] * rl, a1 = o[dh][4 * r4 + 1] * rl, a2 = o[dh][4 * r4 + 2] * rl, a3 = o[dh][4 * r4 + 3] * rl;
                    ss += (a0 * a0 + a1 * a1) + (a2 * a2 + a3 * a3);
                    v2u w; w.x = pk2(a0, a1); w.y = pk2(a2, a3);
                    *(LAS v2u*)(ost + l32 * P2_OROW + (32 * dh + 8 * r4 + 4 * hi) * 2) = w; }
            ss += __shfl_xor(ss, 32);
            if (hi == 0) __hip_atomic_fetch_add(rowss + qs + l32, ss, __ATOMIC_RELAXED, __HIP_MEMORY_SCOPE_WORKGROUP);
            asm volatile("s_waitcnt lgkmcnt(0)" ::: "memory");
#pragma unroll
            for (int i = 0; i < 4; ++i) { const int rr = i * 8 + (lane >> 3), ch = lane & 7; const v4u v = *(const LAS v4u*)(ost + rr * P2_OROW + ch * 16);
                *(v4u*)(mixed + (rowbase + q0 + qs + rr) * D + DCONV + h * HD + ch * 8) = v; }
            asm volatile("s_waitcnt lgkmcnt(0)" ::: "memory");
        }
    }
    asm volatile("s_waitcnt vmcnt(0)" ::: "memory");
    __syncthreads();
    LAS float* rstd = (LAS float*)(lds + P2_RSTD);
    if (tid < 128) rstd[tid] = 1.0f / sqrtf(rowss[tid] * (1.0f / DATTN) + EPS);
    __syncthreads();
#pragma unroll 4
    for (int i = 0; i < 32; ++i) { const int rr = (tid >> 7) + 4 * i, ch = tid & 127; bf16* p = mixed + (rowbase + q0 + rr) * D + DCONV + ch * 8;
        float f[8]; unpack8(*(const v4u*)p, f); const float s = rstd[rr];
#pragma unroll
        for (int j = 0; j < 8; ++j) f[j] *= s;
        *(v4u*)p = pack8(f); }
    {
        const float* cw = P.conv_w; float w0[16], w1[16], w2[16];
#pragma unroll
        for (int j = 0; j < 16; ++j) { const int ch = (j >> 3) * 512 + lane * 8 + (j & 7); w0[j] = cw[ch]; w1[j] = cw[DCONV + ch]; w2[j] = cw[2 * DCONV + ch]; }
        float u1[16], u2[16];
        const int t0 = q0 + 16 * wid;
#pragma unroll
        for (int j = 0; j < 16; ++j) { u1[j] = 0.f; u2[j] = 0.f; }
        if (t0 >= 2) {
#pragma unroll
            for (int hf = 0; hf < 2; ++hf) { const int ch = hf * 512 + lane * 8; float c[8], hc[8];
                const bf16* pr = proj + (rowbase + t0 - 1) * DIN; unpack8(*(const v4u*)(pr + C_C + ch), c); unpack8(*(const v4u*)(pr + C_HC + ch), hc);
#pragma unroll
                for (int j = 0; j < 8; ++j) u1[hf * 8 + j] = c[j] * hc[j];
                pr -= DIN; unpack8(*(const v4u*)(pr + C_C + ch), c); unpack8(*(const v4u*)(pr + C_HC + ch), hc);
#pragma unroll
                for (int j = 0; j < 8; ++j) u2[hf * 8 + j] = c[j] * hc[j]; }
        }
#pragma unroll 2
        for (int rr = 0; rr < 16; ++rr) {
            const bf16* pr = proj + (rowbase + t0 + rr) * DIN; float y[16]; float ss = 0.f;
#pragma unroll
            for (int hf = 0; hf < 2; ++hf) { const int ch = hf * 512 + lane * 8; float bb[8], c[8], hc[8];
                unpack8(*(const v4u*)(pr + C_B + ch), bb); unpack8(*(const v4u*)(pr + C_C + ch), c); unpack8(*(const v4u*)(pr + C_HC + ch), hc);
#pragma unroll
                for (int j = 0; j < 8; ++j) { const int jj = hf * 8 + j; const float u0 = c[j] * hc[j];
                    y[jj] = bb[j] * (w0[jj] * u2[jj] + w1[jj] * u1[jj] + w2[jj] * u0); ss += y[jj] * y[jj]; u2[jj] = u1[jj]; u1[jj] = u0; } }
            ss = wsum(ss); const float rs = 1.0f / sqrtf(ss * (1.0f / DCONV) + EPS);
#pragma unroll
            for (int hf = 0; hf < 2; ++hf) { float f[8];
#pragma unroll
                for (int j = 0; j < 8; ++j) f[j] = y[hf * 8 + j] * rs;
                *(v4u*)(mixed + (rowbase + t0 + rr) * D + hf * 512 + lane * 8) = pack8(f); }
        }
    }
}
constexpr int NPHASE = 10;
struct Args { Ptrs P; int ph_lo, ph_hi; };
__device__ __forceinline__ void moe_tables(LAS unsigned char* ldsx, gu32* ctl, const int wave_) {
    const int tid = TIDX(wave_);
    __syncthreads();
    if (tid < 64) {
        const int n = (int)__hip_atomic_load(ctl + CW_CNT + 64 * tid, RLX_AGENT);
        int x = (n + 255) >> 8;
#pragma unroll
        for (int o = 1; o < 64; o <<= 1) { const int v = __shfl_up(x, o); if (tid >= o) x += v; }
        ((LAS int*)(ldsx + pg8::LST_OFF))[tid] = n;
        ((LAS int*)(ldsx + pg8::LST_OFF + 256))[tid + 1] = x;
        if (tid == 0) ((LAS int*)(ldsx + pg8::LST_OFF + 256))[0] = 0;
    }
    __syncthreads();
}
__global__ void __launch_bounds__(NWAVES * 64, 2) mk_fwd(Args args) {
    extern __shared__ __attribute__((aligned(16))) unsigned char lds_raw[];
    LAS unsigned char* lds = (LAS unsigned char*)lds_raw;
    const Ptrs& P = args.P;
    const int wave = __builtin_amdgcn_readfirstlane((int)(threadIdx.x >> 6));
    const int tid = TIDX(wave);
    const int G = gridDim.x, bx = blockIdx.x, vcu = (G % 8 == 0) ? (bx % 8) * (G / 8) + bx / 8 : bx;
    unsigned char* ws = P.ws; gu32* ctl = (gu32*)(ws + WS_CTL);
    for (int u = tid; u < (pg8::LDS_BYTES - pg8::LDSX_OFF) / 4; u += NWAVES * 64) ((LAS unsigned*)(lds + pg8::LDSX_OFF))[u] = 0u;
    __syncthreads();
    const int lo = args.ph_lo, hi = args.ph_hi;
    XcdBarrier bar; bar.bar = (unsigned*)(ctl + CW_BAR); bar.x = 0; bar.st = nullptr;
    if (hi - lo > 1) bar = xcd_barrier_post((unsigned*)(ctl + CW_BAR), (volatile LAS unsigned*)(lds + pg8::MISC_OFF) + 8, wave);
#ifdef ONLY_PHASE
#define IN(k) ((k) == ONLY_PHASE && lo <= (k) && (k) < hi)
#else
#define IN(k) (lo <= (k) && (k) < hi)
#endif
#define SEAM(k) do { if (IN(k) && IN((k) + 1) && (k) != 7 && (k) != 8) xcd_barrier(bar, wave); } while (0)
#define SEAM79() do { if (IN(7) && IN(9)) xcd_barrier(bar, wave); } while (0)
    bf16* Win = (bf16*)(ws + WS_WIN); bf16* Wout = (bf16*)(ws + WS_WOUT); bf16* Wplg = (bf16*)(ws + WS_WPLG); bf16* Wple = (bf16*)(ws + WS_WPLE);
    bf16* Wr = (bf16*)(ws + WS_WR); bf16* Wgu = (bf16*)(ws + WS_WGU); bf16* Wd = (bf16*)(ws + WS_WD);
    bf16* xb = (bf16*)(ws + WS_XB); bf16* mixed = (bf16*)(ws + WS_MIX); bf16* pb = (bf16*)(ws + WS_PB); bf16* proj = (bf16*)(ws + WS_PROJ);
    bf16* hid = (bf16*)(ws + WS_HID); bf16* pw = (bf16*)(ws + WS_PW); bf16* h1 = (bf16*)(ws + WS_H1); bf16* h2 = (bf16*)(ws + WS_H2);
    float* rsx = (float*)(ws + WS_RSX); float* rs1 = (float*)(ws + WS_RS1); float* ss1p = (float*)(ws + WS_SS1P); float* ss2p = (float*)(ws + WS_SS2P);
    int* eid = (int*)(ws + WS_EID); float* ew = (float*)(ws + WS_EW); Ent* ent = (Ent*)(ws + WS_ENT);

    if (IN(0)) { p0_prologue(P, lds, vcu, G, wave); } SEAM(0);
    if (IN(1)) { pg8::Gemm g{xb, Win, M, DIN, D}; pg8::StaticOrder S; S.init(M, DIN, G, bx); pg8::EpiBf16 E{proj, DIN, nullptr};
        pg8::gemm_phase<pg8::EpiBf16, pg8::StaticOrder, true>(lds, g, S, E, wave); } SEAM(1);
    if (IN(2)) { for (int unit = vcu; unit < BATCH * (SEQ / 128); unit += G) p2_unit(P, lds, unit, wave); __syncthreads(); } SEAM(2);
    if (IN(3)) { pg8::Gemm g{mixed, Wout, M, D, D}; pg8::StaticOrder S; S.init(M, D, G, bx); pg8::EpiH1 E{xb, (const float*)(ws + WS_RMSX), h1, ss1p, FP8 ? ws + WS_H18 : nullptr};
        pg8::gemm_phase<pg8::EpiH1, pg8::StaticOrder, true>(lds, g, S, E, wave); } SEAM(3);
    if (IN(4)) { pg8::Gemm g{h1, Wr, M, 256, D}; pg8::StaticOrder S; S.init(M, 256, G, bx); pg8::EpiRouter E{ss1p, P.b_group, P.b_router, rs1, eid, ew, ent, (unsigned*)(ctl + CW_CNT)};
        pg8::gemm_phase<pg8::EpiRouter, pg8::StaticOrder, false>(lds, g, S, E, wave);
        __syncthreads();
        pg8::Gemm g2{pb, Wple, M, D, PLE}; pg8::PwOrder S2{G, bx, M / 256}; pg8::EpiBf16 E2{pw, D, nullptr};
        pg8::gemm_phase<pg8::EpiBf16, pg8::PwOrder, true>(lds, g2, S2, E2, wave); } SEAM(4);
    if (IN(5) || IN(6) || IN(7)) moe_tables(lds, ctl, wave);
    const LAS int* T0 = (const LAS int*)(lds + pg8::LST_OFF + 256);
    if (IN(5)) { pg8::Gemm g{FP8 ? (const bf16*)(ws + WS_H18) : h1, Wgu, M, NE * 1024, FP8 ? D / 2 : D}; pg8::MoeOrder<true, 4> S{lds, ent, 0, T0[NLIST], G, vcu, wave}; pg8::EpiGU E{hid, lds, FP8 ? F8_INV : 1.f};
        pg8::gemm_phase<pg8::EpiGU, pg8::MoeOrder<true, 4>, true, FP8 != 0>(lds, g, S, E, wave); } SEAM(5);
    if (IN(6)) { pg8::Gemm g{hid, Wd, 0, NE * D, DEXP}; pg8::MoeOrder<false, 8> S{lds, ent, 0, T0[NE], G, vcu, wave}; pg8::EpiDown<0> E{h1, h2, nullptr, lds, nullptr};
        pg8::gemm_phase<pg8::EpiDown<0>, pg8::MoeOrder<false, 8>, true>(lds, g, S, E, wave); } SEAM(6);
    if (IN(7)) { pg8::Gemm g{hid, Wd, 0, NE * D, DEXP}; pg8::MoeOrder<false, 8> S{lds, ent, T0[NE], T0[NLIST], G, vcu, wave}; pg8::EpiDown<1> E{h2, h2, ss2p, lds, FP8 ? ws + WS_H28 : nullptr};
        pg8::gemm_phase<pg8::EpiDown<1>, pg8::MoeOrder<false, 8>, true>(lds, g, S, E, wave); } SEAM79();
    if (IN(9)) { pg8::Gemm g{FP8 ? (const bf16*)(ws + WS_H28) : h2, Wplg, M, D, FP8 ? D / 2 : D}; pg8::FinalOrder S; S.init(M, D, G, bx); S.ldsx = lds; S.ssp = ss2p; S.wave = wave; pg8::EpiFinal E{h2, pw, P.out, lds, FP8 ? F8_INV : 1.f};
        pg8::gemm_phase<pg8::EpiFinal, pg8::FinalOrder, true, FP8 != 0>(lds, g, S, E, wave); }
#undef IN
#undef SEAM
}
namespace nv {
struct RmId { __device__ int operator()(int n) const { return n; } };
struct RmOff { int off; __device__ int operator()(int n) const { return n + off; } };
struct RmGate { __device__ int operator()(int n) const { return (n >> 7) * 256 + (n & 127); } };
struct RmUp { __device__ int operator()(int n) const { return (n >> 7) * 256 + 128 + (n & 127); } };
template <class RM> __global__ void __launch_bounds__(256) wt(const float* W, int K, int N, const float* g0, const float* g1, int gsplit, bf16* WT, RM rm, size_t wstride, size_t tstride) {
    const size_t i = blockIdx.x * (size_t)blockDim.x + threadIdx.x; if (i >= (size_t)K * N) return;
    const int n = (int)(i / K), k = (int)(i % K);
    const float* Wz = W + blockIdx.y * wstride; bf16* Tz = WT + blockIdx.y * tstride;
    const float g = g0 ? (k < gsplit ? g0[k] : g1[k - gsplit]) : 1.f;
    Tz[(size_t)rm(n) * K + k] = f2bf(g * Wz[(size_t)k * N + n]);
}
__global__ void __launch_bounds__(256) zero_rows(bf16* p, size_t n) { const size_t i = blockIdx.x * (size_t)blockDim.x + threadIdx.x; if (i < n) p[i] = 0; }
__global__ void __launch_bounds__(256) rowcvt(const float* x, bf16* xb, float* rs) {
    const int lane = threadIdx.x & 63; const int row = blockIdx.x * 4 + (threadIdx.x >> 6); if (row >= M) return;
    float s = 0.f;
    for (int c = lane; c < D; c += 64) { const float v = x[(size_t)row * D + c]; s += v * v; xb[(size_t)row * D + c] = f2bf(v); }
    s = wsum(s); if (lane == 0) rs[row] = 1.0f / sqrtf(s / D + EPS);
}
__global__ void __launch_bounds__(256) cvt(const float* p, bf16* pb, size_t n) { const size_t i = blockIdx.x * (size_t)blockDim.x + threadIdx.x; if (i < n) pb[i] = f2bf(p[i]); }
__global__ void __launch_bounds__(256) rowrs(const bf16* h, float* rs) {
    const int lane = threadIdx.x & 63; const int row = blockIdx.x * 4 + (threadIdx.x >> 6); if (row >= M) return;
    float s = 0.f;
    for (int c = lane; c < D; c += 64) { const float v = bf2f(h[(size_t)row * D + c]); s += v * v; }
    s = wsum(s); if (lane == 0) rs[row] = 1.0f / sqrtf(s / D + EPS);
}
template <int K, int NC, class AP, class BP, class EP>
__global__ void __launch_bounds__(256) gemm(long nrows, long ncols_, AP ap, BP bp, EP ep) {
    const int ncols = (int)ncols_;
    const int lane = threadIdx.x & 63; const long wave = blockIdx.x * 4L + (threadIdx.x >> 6);
    const int ngrp = ncols / NC; if (wave >= nrows * ngrp) return;
    const long r = wave / ngrp; const int c0 = (int)(wave % ngrp) * NC;
    constexpr int NCH = (K + 511) / 512;
    float a[NCH][8];
    const bf16* A = ap(r);
#pragma unroll
    for (int ch = 0; ch < NCH; ++ch) { const int k = ch * 512 + lane * 8;
        if (k < K) unpack8(*(const v4u*)(A + k), a[ch]); else { for (int j = 0; j < 8; ++j) a[ch][j] = 0.f; } }
    float res[NC];
#pragma unroll
    for (int c = 0; c < NC; ++c) {
        const bf16* B = bp(r, c0 + c); float s = 0.f;
#pragma unroll
        for (int ch = 0; ch < NCH; ++ch) { const int k = ch * 512 + lane * 8;
            if (k < K) { float b[8]; unpack8(*(const v4u*)(B + k), b);
#pragma unroll
                for (int j = 0; j < 8; ++j) s += a[ch][j] * b[j]; } }
        res[c] = wsum(s);
    }
    if (lane == 0) {
#pragma unroll
        for (int c = 0; c < NC; ++c) ep(r, c0 + c, res[c], res[c ^ 1]);
    }
}
__global__ void __launch_bounds__(256) conv(const bf16* proj, const float* cw, bf16* mixed) {
    const int lane = threadIdx.x & 63; const int row = blockIdx.x * 4 + (threadIdx.x >> 6); if (row >= M) return;
    const int t = row % SEQ; float y[16]; float ss = 0.f;
#pragma unroll
    for (int j = 0; j < 16; ++j) {
        const int ch = lane * 16 + j; const bf16* pr = proj + (size_t)row * DIN;
        const float b = bf2f(pr[C_B + ch]);
        const float u0 = bf2f(pr[C_C + ch]) * bf2f(pr[C_HC + ch]);
        const float u1 = t >= 1 ? bf2f(pr[C_C + ch - DIN]) * bf2f(pr[C_HC + ch - DIN]) : 0.f;
        const float u2 = t >= 2 ? bf2f(pr[C_C + ch - 2 * DIN]) * bf2f(pr[C_HC + ch - 2 * DIN]) : 0.f;
        y[j] = b * (cw[ch] * u2 + cw[DCONV + ch] * u1 + cw[2 * DCONV + ch] * u0); ss += y[j] * y[j];
    }
    ss = wsum(ss); const float rstd = 1.0f / sqrtf(ss / DCONV + EPS);
#pragma unroll
    for (int j = 0; j < 16; ++j) mixed[(size_t)row * D + lane * 16 + j] = f2bf(y[j] * rstd);
}
__global__ void __launch_bounds__(256) attn(const bf16* proj, const float* qn, const float* kn, const float* sinks, float* ya) {
    const int lane = threadIdx.x & 63; const long wave = blockIdx.x * 4L + (threadIdx.x >> 6); if (wave >= (long)M * NH) return;
    const int row = (int)(wave / NH), h = (int)(wave % NH), kvh = h / (NH / NKV), t = row % SEQ;
    float q = bf2f(proj[(size_t)row * DIN + C_Q + h * HD + lane]);
    const float rq = 1.0f / sqrtf(wsum(q * q) / HD + EPS); q = q * rq * qn[lane];
    const float gk = kn[lane]; const float slope = exp2f(-0.5f * (float)(h + 1)); const float sink = sinks[h];
    float m = sink, l = 1.f, o = 0.f;
    const int s0 = t >= 127 ? t - 127 : 0;
    for (int s = s0; s <= t; ++s) {
        const size_t kr = (size_t)(row - (t - s)) * DIN;
        const float k = bf2f(proj[kr + C_K + kvh * HD + lane]); const float v = bf2f(proj[kr + C_V + kvh * HD + lane]);
        const float kk = wsum(k * k); const float rk = 1.0f / sqrtf(kk / HD + EPS);
        const float dot = wsum(q * k * gk) * rk;
        const float sc = dot * 0.125f - slope * (float)(t - s);
        const float mn = fmaxf(m, sc); const float f = __expf(m - mn), pe = __expf(sc - mn);
        l = l * f + pe; o = o * f + pe * v; m = mn;
    }
    ya[(size_t)row * DATTN + h * HD + lane] = o / l;
}
__global__ void __launch_bounds__(256) attnnorm(const float* ya, bf16* mixed) {
    const int lane = threadIdx.x & 63; const int row = blockIdx.x * 4 + (threadIdx.x >> 6); if (row >= M) return;
    float y[16]; float ss = 0.f;
#pragma unroll
    for (int j = 0; j < 16; ++j) { y[j] = ya[(size_t)row * DATTN + lane * 16 + j]; ss += y[j] * y[j]; }
    ss = wsum(ss); const float rstd = 1.0f / sqrtf(ss / DATTN + EPS);
#pragma unroll
    for (int j = 0; j < 16; ++j) mixed[(size_t)row * D + DCONV + lane * 16 + j] = f2bf(y[j] * rstd);
}
__global__ void __launch_bounds__(256) topk(const float* logits, int* eid, float* ew) {
    const int row = blockIdx.x * blockDim.x + threadIdx.x; if (row >= M) return;
    const float* L = logits + (size_t)row * 64;
    int g = 0; float gm = L[0];
    for (int j = 1; j < NGRP; ++j) if (L[j] > gm) { gm = L[j]; g = j; }
    float gs = 0.f; for (int j = 0; j < NGRP; ++j) gs += __expf(L[j] - gm);
    const float gw = 1.0f / gs;
    const float* E = L + NGRP + g * EPG;
    int i1 = 0; float v1 = E[0];
    for (int j = 1; j < EPG; ++j) if (E[j] > v1) { v1 = E[j]; i1 = j; }
    int i2 = -1; float v2 = -3.0e38f;
    for (int j = 0; j < EPG; ++j) if (j != i1 && E[j] > v2) { v2 = E[j]; i2 = j; }
    const float e2 = __expf(v2 - v1); const float w1 = 1.0f / (1.0f + e2), w2 = e2 / (1.0f + e2);
    eid[row * 2] = g * EPG + i1; eid[row * 2 + 1] = g * EPG + i2; ew[row * 2] = gw * w1; ew[row * 2 + 1] = gw * w2;
}

__global__ void __launch_bounds__(256) rs_to_part(const float* rs, float* part) {
    const int i = blockIdx.x * blockDim.x + threadIdx.x; if (i >= M * 32) return; const int row = i >> 5, j = i & 31;
    const float r = rs[row]; part[i] = j == 0 ? (1.0f / (r * r) - EPS) * (float)D : 0.f;
}
__global__ void __launch_bounds__(256) part_to_rs(const float* part, float* rs) {
    const int row = blockIdx.x * blockDim.x + threadIdx.x; if (row >= M) return; float s = 0.f;
    for (int j = 0; j < 32; ++j) s += part[(size_t)row * 32 + j];
    rs[row] = 1.0f / sqrtf(s / D + EPS);
}
__global__ void __launch_bounds__(256) build_lists(const int* eid, const float* ew, const float* rs1, Ent* ent, unsigned* cnt) {
    const int i = blockIdx.x * blockDim.x + threadIdx.x; if (i >= M * 2) return; const int tok = i >> 1, k = i & 1;
    const int l = k * NE + eid[i]; const unsigned slot = atomicAdd(cnt + 64 * l, 1u);
    Ent e; e.tok = tok; e.w = ew[i]; e.rs = rs1[tok]; e.pad = 0; ent[(size_t)l * LCAP + slot] = e;
}
}

#ifndef MK_MASK
#define MK_MASK 0x3ff
#endif
#ifndef MK_SPLIT
#define MK_SPLIT 0
#endif
template <class K, class... A> static void launch1d(K kern, size_t nthreads, int bs, hipStream_t s, A... args) {
    hipLaunchKernelGGL(kern, dim3((unsigned)((nthreads + bs - 1) / bs)), dim3(bs), 0, s, args...);
}
static void nv_stage(int st, const Ptrs& P, hipStream_t stream) {
    unsigned char* ws = P.ws;
    bf16* Win = (bf16*)(ws + WS_WIN); bf16* Wout = (bf16*)(ws + WS_WOUT); bf16* Wplg = (bf16*)(ws + WS_WPLG); bf16* Wple = (bf16*)(ws + WS_WPLE);
    bf16* Wr = (bf16*)(ws + WS_WR); bf16* Wgu = (bf16*)(ws + WS_WGU); bf16* Wd = (bf16*)(ws + WS_WD);
    bf16* xb = (bf16*)(ws + WS_XB); bf16* mixed = (bf16*)(ws + WS_MIX); bf16* pb = (bf16*)(ws + WS_PB); bf16* proj = (bf16*)(ws + WS_PROJ);
    bf16* hid = (bf16*)(ws + WS_HID); bf16* pw = (bf16*)(ws + WS_PW); bf16* h1 = (bf16*)(ws + WS_H1); bf16* h2 = (bf16*)(ws + WS_H2);
    float* rsx = (float*)(ws + WS_RSX); float* rs1 = (float*)(ws + WS_RS1); float* rs2 = (float*)(ws + WS_RS2);
    int* eid = (int*)(ws + WS_EID); float* ew = (float*)(ws + WS_EW); float* logits = (float*)(ws + WS_LOG); float* ya = (float*)(ws + WS_YA);
    const float* nul = nullptr;
    if (st == 0) {
        hipLaunchKernelGGL(nv::wt<nv::RmId>, dim3((unsigned)(((size_t)D * DIN + 255) / 256), 1), dim3(256), 0, stream, P.w_in, D, DIN, P.norm_mix, nul, D, Win, nv::RmId{}, (size_t)0, (size_t)0);
        hipLaunchKernelGGL(nv::wt<nv::RmId>, dim3((unsigned)(((size_t)D * D + 255) / 256), 1), dim3(256), 0, stream, P.w_out, D, D, P.onc, P.ona, DCONV, Wout, nv::RmId{}, (size_t)0, (size_t)0);
        hipLaunchKernelGGL(nv::wt<nv::RmId>, dim3((unsigned)(((size_t)D * D + 255) / 256), 1), dim3(256), 0, stream, P.w_ple_gate, D, D, P.norm_ple, nul, D, Wplg, nv::RmId{}, (size_t)0, (size_t)0);
        hipLaunchKernelGGL(nv::wt<nv::RmId>, dim3((unsigned)(((size_t)PLE * D + 255) / 256), 1), dim3(256), 0, stream, P.w_ple, PLE, D, nul, nul, 0, Wple, nv::RmId{}, (size_t)0, (size_t)0);
        hipLaunchKernelGGL(nv::wt<nv::RmId>, dim3((unsigned)(((size_t)D * NGRP + 255) / 256), 1), dim3(256), 0, stream, P.w_group, D, NGRP, P.norm_ffn, nul, D, Wr, nv::RmId{}, (size_t)0, (size_t)0);
        hipLaunchKernelGGL(nv::wt<nv::RmOff>, dim3((unsigned)(((size_t)D * NE + 255) / 256), 1), dim3(256), 0, stream, P.w_router, D, NE, P.norm_ffn, nul, D, Wr, nv::RmOff{NGRP}, (size_t)0, (size_t)0);
        launch1d(nv::zero_rows, (size_t)(256 - NRT) * D, 256, stream, Wr + (size_t)NRT * D, (size_t)(256 - NRT) * D);
        hipLaunchKernelGGL(nv::wt<nv::RmGate>, dim3((unsigned)(((size_t)D * DEXP + 255) / 256), NE), dim3(256), 0, stream, P.w_gate, D, DEXP, P.norm_ffn, nul, D, Wgu, nv::RmGate{}, (size_t)D * DEXP, (size_t)1024 * D);
        hipLaunchKernelGGL(nv::wt<nv::RmUp>, dim3((unsigned)(((size_t)D * DEXP + 255) / 256), NE), dim3(256), 0, stream, P.w_up, D, DEXP, P.norm_ffn, nul, D, Wgu, nv::RmUp{}, (size_t)D * DEXP, (size_t)1024 * D);
        hipLaunchKernelGGL(nv::wt<nv::RmId>, dim3((unsigned)(((size_t)DEXP * D + 255) / 256), NE), dim3(256), 0, stream, P.w_down, DEXP, D, nul, nul, 0, Wd, nv::RmId{}, (size_t)DEXP * D, (size_t)D * DEXP);
        hipLaunchKernelGGL(nv::rowcvt, dim3(M / 4), dim3(256), 0, stream, P.x, xb, rsx);
        launch1d(nv::cvt, (size_t)M * PLE, 256, stream, P.p, pb, (size_t)M * PLE);
    } else if (st == 1) {
        auto ap = [=] __device__(long r) { return xb + (size_t)r * D; };
        auto bp = [=] __device__(long r, int c) { return Win + (size_t)c * D; };
        auto ep = [=] __device__(long r, int c, float v, float vo) { proj[(size_t)r * DIN + c] = f2bf(v * rsx[r]); };
        hipLaunchKernelGGL((nv::gemm<D, 8, decltype(ap), decltype(bp), decltype(ep)>), dim3((unsigned)((size_t)M * (DIN / 8) / 4)), dim3(256), 0, stream, (long)M, (long)DIN, ap, bp, ep);
    } else if (st == 2) {
        hipLaunchKernelGGL(nv::conv, dim3(M / 4), dim3(256), 0, stream, proj, P.conv_w, mixed);
        hipLaunchKernelGGL(nv::attn, dim3((unsigned)((size_t)M * NH / 4)), dim3(256), 0, stream, proj, P.q_norm, P.k_norm, P.sinks, ya);
        hipLaunchKernelGGL(nv::attnnorm, dim3(M / 4), dim3(256), 0, stream, ya, mixed);
    } else if (st == 3) {
        const float* x = P.x;
        auto ap = [=] __device__(long r) { return mixed + (size_t)r * D; };
        auto bp = [=] __device__(long r, int c) { return Wout + (size_t)c * D; };
        auto ep = [=] __device__(long r, int c, float v, float vo) { h1[(size_t)r * D + c] = f2bf(x[(size_t)r * D + c] + v); };
        hipLaunchKernelGGL((nv::gemm<D, 8, decltype(ap), decltype(bp), decltype(ep)>), dim3((unsigned)((size_t)M * (D / 8) / 4)), dim3(256), 0, stream, (long)M, (long)D, ap, bp, ep);
        hipLaunchKernelGGL(nv::rowrs, dim3(M / 4), dim3(256), 0, stream, h1, rs1);
    } else if (st == 4) {
        const float* bg = P.b_group; const float* br = P.b_router;
        auto ap = [=] __device__(long r) { return h1 + (size_t)r * D; };
        auto bp = [=] __device__(long r, int c) { return Wr + (size_t)c * D; };
        auto ep = [=] __device__(long r, int c, float v, float vo) { logits[(size_t)r * 64 + c] = v * rs1[r] + (c < NGRP ? bg[c] : br[c - NGRP]); };
        hipLaunchKernelGGL((nv::gemm<D, 4, decltype(ap), decltype(bp), decltype(ep)>), dim3((unsigned)((size_t)M * (NRT / 4) / 4)), dim3(256), 0, stream, (long)M, (long)NRT, ap, bp, ep);
        launch1d(nv::topk, (size_t)M, 256, stream, logits, eid, ew);
    } else if (st == 5) {
        auto ap = [=] __device__(long r) { return h1 + (size_t)(r >> 1) * D; };
        auto bp = [=] __device__(long r, int c) { const int e = eid[r]; const int f = c >> 1; const int rowi = (f >> 7) * 256 + (c & 1) * 128 + (f & 127); return Wgu + ((size_t)e * 1024 + rowi) * D; };
        auto ep = [=] __device__(long r, int c, float v, float vo) {
            if (c & 1) { const float rs = rs1[r >> 1]; const int f = c >> 1; const float g = vo * rs, u = v * rs; hid[(size_t)r * DEXP + f] = f2bf(ew[r] * (g / (1.0f + __expf(-g))) * u); } };
        hipLaunchKernelGGL((nv::gemm<D, 8, decltype(ap), decltype(bp), decltype(ep)>), dim3((unsigned)((size_t)M * 2 * (1024 / 8) / 4)), dim3(256), 0, stream, (long)M * 2, (long)1024, ap, bp, ep);
    } else if (st == 6 || st == 7) {
        const long k = st - 6; const bf16* base = k == 0 ? h1 : h2;
        auto ap = [=] __device__(long r) { return hid + (size_t)(r * 2 + k) * DEXP; };
        auto bp = [=] __device__(long r, int c) { const int e = eid[r * 2 + k]; return Wd + ((size_t)e * D + c) * DEXP; };
        auto ep = [=] __device__(long r, int c, float v, float vo) { h2[(size_t)r * D + c] = f2bf(bf2f(base[(size_t)r * D + c]) + v); };
        hipLaunchKernelGGL((nv::gemm<DEXP, 8, decltype(ap), decltype(bp), decltype(ep)>), dim3((unsigned)((size_t)M * (D / 8) / 4)), dim3(256), 0, stream, (long)M, (long)D, ap, bp, ep);
        if (st == 7) hipLaunchKernelGGL(nv::rowrs, dim3(M / 4), dim3(256), 0, stream, h2, rs2);
    } else if (st == 8) {
        auto ap = [=] __device__(long r) { return pb + (size_t)r * PLE; };
        auto bp = [=] __device__(long r, int c) { return Wple + (size_t)c * PLE; };
        auto ep = [=] __device__(long r, int c, float v, float vo) { pw[(size_t)r * D + c] = f2bf(v); };
        hipLaunchKernelGGL((nv::gemm<PLE, 8, decltype(ap), decltype(bp), decltype(ep)>), dim3((unsigned)((size_t)M * (D / 8) / 4)), dim3(256), 0, stream, (long)M, (long)D, ap, bp, ep);
    } else if (st == 9) {
        float* out = P.out;
        auto ap = [=] __device__(long r) { return h2 + (size_t)r * D; };
        auto bp = [=] __device__(long r, int c) { return Wplg + (size_t)c * D; };
        auto ep = [=] __device__(long r, int c, float v, float vo) { const float z = v * rs2[r]; out[(size_t)r * D + c] = bf2f(h2[(size_t)r * D + c]) + (1.0f / (1.0f + __expf(-z))) * bf2f(pw[(size_t)r * D + c]); };
        hipLaunchKernelGGL((nv::gemm<D, 8, decltype(ap), decltype(bp), decltype(ep)>), dim3((unsigned)((size_t)M * (D / 8) / 4)), dim3(256), 0, stream, (long)M, (long)D, ap, bp, ep);
    }
}

extern "C" void kernel_launch(void* const* d_in, const int* in_sizes, int n_in, void* d_out, int out_size, void* d_ws, size_t ws_size, hipStream_t stream) {
    static int grid = 0;
    if (grid == 0) {
        if (n_in != 22 || in_sizes[0] != M * D || out_size != M * D || ws_size < WS_END) { fprintf(stderr, "kernel_launch: unexpected problem (n_in %d, in0 %d, out %d, ws %zu); nothing launched\n", n_in, n_in > 0 ? in_sizes[0] : -1, out_size, ws_size); grid = -1; return; }
        int dev = 0, cus = 0, per_cu = 0;
        if (hipGetDevice(&dev) != hipSuccess || hipDeviceGetAttribute(&cus, hipDeviceAttributeMultiprocessorCount, dev) != hipSuccess) { grid = -1; return; }
        if (hipFuncSetAttribute((const void*)mk_fwd, hipFuncAttributeMaxDynamicSharedMemorySize, pg8::LDS_BYTES) != hipSuccess) { fprintf(stderr, "kernel_launch: hipFuncSetAttribute failed\n"); grid = -1; return; }
        if (hipOccupancyMaxActiveBlocksPerMultiprocessor(&per_cu, (const void*)mk_fwd, NWAVES * 64, pg8::LDS_BYTES) != hipSuccess || per_cu < 1) { fprintf(stderr, "kernel_launch: occupancy query says %d blocks per CU\n", per_cu); (void)hipGetLastError(); grid = -1; return; }
        grid = cus;
    }
    if (grid < 0) return;
    if (hipMemsetAsync((char*)d_ws + WS_CTL, 0, CTL_ZERO_BYTES, stream) != hipSuccess) return;
    Args a{};
    { const float** pp = (const float**)&a.P; for (int i = 0; i < 22; ++i) pp[i] = (const float*)d_in[i]; }
    a.P.out = (float*)d_out; a.P.ws = (unsigned char*)d_ws;
    unsigned char* ws = a.P.ws;
    const unsigned mask = MK_MASK;
    auto is_mk = [&](int s) { return ((mask >> s) & 1u) != 0u; };
    int s = 0;
    while (s < NPHASE) {
        if (is_mk(s)) {
            int e = s + 1; if (!MK_SPLIT) while (e < NPHASE && is_mk(e)) ++e;
            if (s == 4 && !is_mk(3)) launch1d(nv::rs_to_part, (size_t)M * 32, 256, stream, (const float*)(ws + WS_RS1), (float*)(ws + WS_SS1P));
            if (s >= 5 && s <= 7 && !is_mk(4) && s == 5) launch1d(nv::build_lists, (size_t)M * 2, 256, stream, (const int*)(ws + WS_EID), (const float*)(ws + WS_EW), (const float*)(ws + WS_RS1), (Ent*)(ws + WS_ENT), (unsigned*)(ws + WS_CTL) + CW_CNT);
            if (s == 9 && !is_mk(7)) launch1d(nv::rs_to_part, (size_t)M * 32, 256, stream, (const float*)(ws + WS_RS2), (float*)(ws + WS_SS2P));
            a.ph_lo = s; a.ph_hi = e;
            hipLaunchKernelGGL(mk_fwd, dim3(grid), dim3(NWAVES * 64), pg8::LDS_BYTES, stream, a);
            s = e;
        } else {
            if (s == 4 && is_mk(3)) launch1d(nv::part_to_rs, (size_t)M, 256, stream, (const float*)(ws + WS_SS1P), (float*)(ws + WS_RS1));
            if (s == 9 && is_mk(7)) launch1d(nv::part_to_rs, (size_t)M, 256, stream, (const float*)(ws + WS_SS2P), (float*)(ws + WS_RS2));
            nv_stage(s, a.P, stream);
            if (s == 4 && is_mk(8)) nv_stage(8, a.P, stream);
            ++s;
        }
    }
}
```

```cpp
#include <hip/hip_runtime.h>
#include <cstdio>
#include <cstdint>

typedef unsigned short bf16;
typedef unsigned v4u __attribute__((ext_vector_type(4)));
typedef unsigned v2u __attribute__((ext_vector_type(2)));
typedef float f32x4 __attribute__((ext_vector_type(4)));
typedef float f32x16 __attribute__((ext_vector_type(16)));
typedef short bf16x8 __attribute__((ext_vector_type(8)));
#define GAS __attribute__((address_space(1)))
#define LAS __attribute__((address_space(3)))
typedef GAS unsigned gu32;

constexpr int BATCH = 4, SEQ = 8192, D = 2048, M = BATCH * SEQ;
constexpr int DCONV = 1024, NH = 16, NKV = 4, HD = 64, DATTN = 1024, DKV = 256, DIN = 4608;
constexpr int C_B = 0, C_C = 1024, C_HC = 2048, C_Q = 3072, C_K = 4096, C_V = 4352;
constexpr int NGRP = 4, EPG = 8, NE = 32, DEXP = 512, PLE = 256, NRT = 36;
constexpr int NLIST = 64, LCAP = 32768;
constexpr float EPS = 1e-6f;
constexpr float LOG2E = 1.4426950408889634f;

constexpr size_t MiB = 1u << 20;
constexpr size_t WS_CTL = 0, CTL_ZERO_BYTES = 1 * MiB;
constexpr size_t WS_WIN = 2 * MiB;
constexpr size_t WS_WOUT = 20 * MiB;
constexpr size_t WS_WPLG = 28 * MiB;
constexpr size_t WS_WPLE = 36 * MiB;
constexpr size_t WS_WR = 37 * MiB;
constexpr size_t WS_RSX = 38 * MiB;
constexpr size_t WS_RS1 = 38 * MiB + 256 * 1024;
constexpr size_t WS_RS2 = 38 * MiB + 512 * 1024;
constexpr size_t WS_RMSX = 38 * MiB + 768 * 1024;
constexpr size_t WS_EID = 39 * MiB;
constexpr size_t WS_EW = 39 * MiB + 512 * 1024;
constexpr size_t WS_LOG = 42 * MiB;
constexpr size_t WS_SS1P = 50 * MiB;
constexpr size_t WS_SS2P = 54 * MiB;
#ifndef FP8
#define FP8 1
#endif
#ifndef FP8O
#define FP8O 0
#endif
constexpr size_t WS_MIX8 = 816 * MiB;
#ifndef FP8QKV
#define FP8QKV 0
#endif
constexpr size_t WS_XB8 = 128 * MiB;
constexpr size_t WS_WIN8 = 20 * MiB - 3 * MiB;
constexpr int NQKV = DATTN + 2 * DKV;
constexpr float F8_ASCALE = 16.f, F8_WSCALE = 32.f, F8_INV = 1.0f / (16.f * 32.f);
constexpr float F8_HSCALE = 16.f, F8_DSCALE = 16.f, F8_DINV = 1.0f / (16.f * 16.f);
constexpr size_t WS_WGU = 64 * MiB;
constexpr size_t WS_H18 = 128 * MiB;
constexpr size_t WS_H28 = 608 * MiB;
constexpr size_t WS_WD = 192 * MiB;
constexpr size_t WS_XB = 256 * MiB;
constexpr size_t WS_MIX = 816 * MiB;
constexpr size_t WS_PB = 384 * MiB;
constexpr size_t WS_PROJ = 400 * MiB;
constexpr size_t WS_HID = 400 * MiB;
constexpr size_t WS_PW = 480 * MiB;
constexpr size_t WS_H1 = 688 * MiB;
constexpr size_t WS_H2 = 816 * MiB;
constexpr size_t WS_YA = 688 * MiB;
constexpr size_t WS_ENT = 944 * MiB;
constexpr size_t WS_END = 976 * MiB;
constexpr int CW_TMO = 0, CW_BAR = 4096, CW_CNT = 8192;

__device__ __forceinline__ float bf2f(bf16 v) { return __uint_as_float(((unsigned)v) << 16); }
__device__ __forceinline__ unsigned f2bfu(float f) { unsigned u = __float_as_uint(f); return (u + 0x7fffu + ((u >> 16) & 1u)) >> 16; }
__device__ __forceinline__ bf16 f2bf(float f) { return (bf16)f2bfu(f); }
typedef float f32x2_t __attribute__((ext_vector_type(2))); typedef __bf16 bf16x2_t __attribute__((ext_vector_type(2)));
__device__ __forceinline__ unsigned pk2(float lo, float hi) { const f32x2_t v = {lo, hi}; const bf16x2_t b = __builtin_convertvector(v, bf16x2_t); return __builtin_bit_cast(unsigned, b); }
__device__ __forceinline__ float wsum(float v) {
#pragma unroll
    for (int o = 32; o > 0; o >>= 1) v += __shfl_xor(v, o);
    return v;
}
__device__ __forceinline__ void unpack8(v4u w, float* f) {
    f[0] = __uint_as_float(w.x << 16); f[1] = __uint_as_float(w.x & 0xffff0000u);
    f[2] = __uint_as_float(w.y << 16); f[3] = __uint_as_float(w.y & 0xffff0000u);
    f[4] = __uint_as_float(w.z << 16); f[5] = __uint_as_float(w.z & 0xffff0000u);
    f[6] = __uint_as_float(w.w << 16); f[7] = __uint_as_float(w.w & 0xffff0000u);
}
__device__ __forceinline__ v2u pack8_f8(const float* f, float sc) {
    int lo = 0, hi = 0;
    lo = __builtin_amdgcn_cvt_pk_fp8_f32(f[0] * sc, f[1] * sc, lo, false); lo = __builtin_amdgcn_cvt_pk_fp8_f32(f[2] * sc, f[3] * sc, lo, true);
    hi = __builtin_amdgcn_cvt_pk_fp8_f32(f[4] * sc, f[5] * sc, hi, false); hi = __builtin_amdgcn_cvt_pk_fp8_f32(f[6] * sc, f[7] * sc, hi, true);
    v2u o; o.x = (unsigned)lo; o.y = (unsigned)hi; return o;
}
__device__ __forceinline__ v4u pack8(const float* f) { v4u o; o.x = pk2(f[0], f[1]); o.y = pk2(f[2], f[3]); o.z = pk2(f[4], f[5]); o.w = pk2(f[6], f[7]); return o; }

__device__ __forceinline__ int lane_id() { return (int)(threadIdx.x & 63u); }
__device__ __forceinline__ int lane_id_asm() { int l; asm volatile("v_mbcnt_lo_u32_b32 %0, -1, 0\n\tv_mbcnt_hi_u32_b32 %0, -1, %0" : "=v"(l)); return l & 63; }
#define TIDX(wave_) ((int)threadIdx.x)

struct Ptrs {
    const float *x, *p, *norm_mix, *w_in, *conv_w, *q_norm, *k_norm, *sinks, *onc, *ona, *w_out, *norm_ffn, *w_group, *b_group, *w_router, *b_router,
        *w_gate, *w_up, *w_down, *norm_ple, *w_ple_gate, *w_ple;
    float* out; unsigned char* ws;
};
struct Ent { int tok; float w; float rs; int pad; };
namespace pg8 {
typedef int v4i __attribute__((ext_vector_type(4)));
typedef int v8i __attribute__((ext_vector_type(8)));
constexpr int BM = 256, BK = 64, HALF = 128, HTB = HALF * BK * 2  , STAGE_BYTES = 8 * HTB, NXCD = 8, WGM = 8;
constexpr int RING_BYTES = 131072;
constexpr int LDSX_OFF = RING_BYTES;
constexpr int MISC_OFF = LDSX_OFF + 320;
constexpr int TAB_OFF = LDSX_OFF + 1024;
constexpr int LST_OFF = TAB_OFF + 8192;
constexpr int LDS_BYTES = 147456;

__host__ __device__ __forceinline__ int lds_byte(int r, int c) { const int st = (r >> 4) * 2 + (c >> 5), rr = r & 15, cc = c & 31, ob = rr * 64 + cc * 2; return st * 1024 + (ob ^ (((ob >> 9) & 1) << 5)); }
__host__ __device__ __forceinline__ void stage_rc(int b, int& R, int& C) { const int st = b / 1024, sb = b % 1024, swz = sb ^ (((sb >> 9) & 1) << 5); R = (st >> 1) * 16 + swz / 64; C = (st & 1) * 32 + (swz % 64) / 2; }
__host__ __device__ __forceinline__ int perm32(int rho) { const int n = rho >> 4, i = rho & 15; return 8 * (i >> 2) + 4 * n + (i & 3); }

struct Unit { int pm, pn, bt, par, lst, rk0, nl; };
struct Gemm { const bf16* A; const bf16* Bt; int M, N, K; };

struct StaticOrder {
    static constexpr bool GATHER = false;
    int nM, nN, nwg, G, c;
    __host__ __device__ void init(int M_, int N_, int G_, int c_) { nM = M_ / BM; nN = N_ / BM; nwg = nM * nN; G = G_; c = c_; }
    __host__ __device__ bool next(int i, Unit& u) const {
        const long L = (long)i * G + c; if (L >= nwg) return false;
        int wgid = (int)L; { const int q = nwg / NXCD, r = nwg % NXCD, xcd = wgid % NXCD, off = wgid / NXCD; wgid = (xcd < r ? xcd * (q + 1) : r * (q + 1) + (xcd - r) * q) + off; }
        const int nig = WGM * nN, gid = wgid / nig, fm = gid * WGM, gsz = (nM - fm) < WGM ? (nM - fm) : WGM;
        u.pm = fm + ((wgid % nig) % gsz); u.pn = (wgid % nig) / gsz; u.bt = u.pn; u.par = i & 1; u.lst = 0; u.rk0 = 0; u.nl = 0; return true;
    }
    __device__ __forceinline__ void a_ready(const Unit&) const {}
    __device__ __forceinline__ void done(const Unit&) const {}
};

struct PwOrder {
    static constexpr bool GATHER = false;
    int G, c, nr;
    __device__ __forceinline__ bool next(int i, Unit& u) const {
        int L;
        if (G == 256 && nr == 128) { if (c < nr || i >= 8) return false; L = (c - nr) * 8 + i; }
        else { L = i * G + c; if (L >= (M / BM) * (D / BM)) return false; }
        u.pm = L / (D / BM); u.pn = L % (D / BM); u.bt = u.pn; u.par = i & 1; u.lst = 0; u.rk0 = 0; u.nl = 0; return true;
    }
    __device__ __forceinline__ void a_ready(const Unit&) const {}
    __device__ __forceinline__ void done(const Unit&) const {}
};

__device__ __forceinline__ unsigned cvt_pk_bf16(float lo, float hi) { unsigned r; asm volatile("v_cvt_pk_bf16_f32 %0, %1, %2" : "=v"(r) : "v"(lo), "v"(hi)); return r; }

template <class Epi, class Sched, bool ALIGN_EPI, bool F8 = false>
__device__ __forceinline__ void gemm_phase(LAS unsigned char* lds, const Gemm g, const Sched& S, const Epi& E, const int wid) {
    const int lane = lane_id(), tid = wid * 64 + lane, wr = wid >> 2, wc = wid & 3, fr = lane & 15, fq = lane >> 4;
    const int K = g.K, nt = K / BK;
    unsigned voffA[2], voffB[2]; int R0 = 0, C0 = 0;
#pragma unroll
    for (int i = 0; i < 2; ++i) { int R, C; stage_rc(tid * 16 + i * 8192, R, C); const int Rb = Epi::PERM ? ((R & ~31) + perm32(R & 31)) : R;
        voffA[i] = (unsigned)(R * K + C) * 2u; voffB[i] = (unsigned)(Rb * K + C) * 2u; if (i == 0) { R0 = R; C0 = C; } }
    const size_t kstep = (size_t)(BK * 2);
    const size_t hstep = (size_t)HALF * K * 2;
    const size_t tstep = 2 * hstep;
    const unsigned ldsw = (unsigned)wid * 1024u;
    const int aoff = lds_byte(wr * 64 + fr, fq * 8), boff = lds_byte(wc * 32 + fr, fq * 8);
    unsigned gc[2][2] = {{0u, 0u}, {0u, 0u}}, gn[2][2] = {{0u, 0u}, {0u, 0u}}, gs[2][2] = {{0u, 0u}, {0u, 0u}};
#define PG8_TOK(par, r) (*(const LAS int*)(lds + TAB_OFF + (par) * 4096 + (r) * 16))
#define PG8_GLOAD(dst, par) do { _Pragma("unroll") for (int _h = 0; _h < 2; ++_h) _Pragma("unroll") for (int _i = 0; _i < 2; ++_i) \
        dst[_h][_i] = (unsigned)PG8_TOK(par, _h * 128 + _i * 64 + R0) * (unsigned)(K * 2) + (unsigned)(C0 * 2); } while (0)
#define PG8_SA(b, h) (((b) * 2 + (h)) * HTB)
#define PG8_SB(b, h) ((4 + (b) * 2 + (h)) * HTB)
#define PG8_STAGE(bufoff, gbase, voff) do { _Pragma("unroll") for (int _i = 0; _i < 2; ++_i) \
        __builtin_amdgcn_global_load_lds((const unsigned*)((const char*)(gbase) + (voff)[_i]), (LAS unsigned*)(lds + (bufoff) + ldsw + _i * 8192), 16, 0, 0); } while (0)
#define PG8_STAGE_A(bufoff, ub, go, h, kb) do { if constexpr (Sched::GATHER) { PG8_STAGE(bufoff, (const char*)g.A + (kb), go[h]); } else { PG8_STAGE(bufoff, (ub) + (kb) + (h) * hstep, voffA); } } while (0)
#define PG8_CAT(p_) __builtin_shufflevector(*(const LAS v4i*)(p_), *(const LAS v4i*)((p_) + 1024), 0, 1, 2, 3, 4, 5, 6, 7)
#define PG8_LDA(dst, b, h) do { if constexpr (F8) { _Pragma("unroll") for (int m = 0; m < 4; ++m) dst##8[m] = PG8_CAT(lds + PG8_SA(b, h) + aoff + m * 2048); } \
        else { _Pragma("unroll") for (int m = 0; m < 4; ++m) _Pragma("unroll") for (int k = 0; k < 2; ++k) dst[m][k] = *(const LAS bf16x8*)(lds + PG8_SA(b, h) + aoff + m * 2048 + k * 1024); } } while (0)
#define PG8_LDB(dst, b, h) do { if constexpr (F8) { _Pragma("unroll") for (int n = 0; n < 2; ++n) dst##8[n] = PG8_CAT(lds + PG8_SB(b, h) + boff + n * 2048); } \
        else { _Pragma("unroll") for (int n = 0; n < 2; ++n) _Pragma("unroll") for (int k = 0; k < 2; ++k) dst[n][k] = *(const LAS bf16x8*)(lds + PG8_SB(b, h) + boff + n * 2048 + k * 1024); } } while (0)
#define PG8_MMA(ai, bj, At, Bt) do { __builtin_amdgcn_s_setprio(1); _Pragma("unroll") for (int m = 0; m < 4; ++m) _Pragma("unroll") for (int n = 0; n < 2; ++n) { \
        if constexpr (F8) { asm volatile("v_mfma_scale_f32_16x16x128_f8f6f4 %0, %1, %2, %0, %3, %3 op_sel_hi:[0,0,0]" : "+v"(acc[ai][bj][m][n]) : "v"(Bt##8[n]), "v"(At##8[m]), "v"(f8scale)); } \
        else { _Pragma("unroll") for (int k = 0; k < 2; ++k) acc[ai][bj][m][n] = __builtin_amdgcn_mfma_f32_16x16x32_bf16(Bt[n][k], At[m][k], acc[ai][bj][m][n], 0, 0, 0); } } \
        __builtin_amdgcn_s_setprio(0); } while (0)
#define PG8_WAIT_V(n) asm volatile("s_waitcnt vmcnt(" #n ")" ::: "memory")
#define PG8_WAIT_L(n) asm volatile("s_waitcnt lgkmcnt(" #n ")" ::: "memory")
#define PG8_BAR __builtin_amdgcn_s_barrier()
#define PG8_SCHED __builtin_amdgcn_sched_barrier(0)
    Unit cur, nxt; int ui = 0;
    if (!S.next(0, cur)) return;
    f32x4 acc[2][2][4][2];
#pragma unroll
    for (int a = 0; a < 2; ++a)
#pragma unroll
        for (int b = 0; b < 2; ++b)
#pragma unroll
            for (int m = 0; m < 4; ++m)
#pragma unroll
                for (int n = 0; n < 2; ++n) acc[a][b][m][n] = (f32x4){0.f, 0.f, 0.f, 0.f};
    bf16x8 At[4][2], B0[2][2], B1[2][2];
    const int f8scale = 0x7f7f7f7f;
    v8i At8[4], B08[2], B18[2];
    const char* cA = (const char*)g.A + (size_t)cur.pm * tstep; const char* cB = (const char*)g.Bt + (size_t)cur.bt * tstep;
    S.a_ready(cur);
    if constexpr (Sched::GATHER) { PG8_GLOAD(gc, cur.par); }
    PG8_STAGE(PG8_SB(0, 0), cB, voffB); PG8_STAGE(PG8_SB(0, 1), cB + hstep, voffB); PG8_STAGE_A(PG8_SA(0, 0), cA, gc, 0, (size_t)0); PG8_STAGE_A(PG8_SA(0, 1), cA, gc, 1, (size_t)0);
    if (wr == 1) PG8_BAR;
    PG8_WAIT_V(2); PG8_BAR;
    PG8_STAGE(PG8_SB(1, 0), cB + kstep, voffB); PG8_STAGE_A(PG8_SA(1, 0), cA, gc, 0, kstep); PG8_STAGE(PG8_SB(1, 1), cB + hstep + kstep, voffB);
    PG8_WAIT_V(6); PG8_BAR;
    for (;;) {
        const bool has_next = S.next(ui + 1, nxt);
        const char* nA = has_next ? (const char*)g.A + (size_t)nxt.pm * tstep : cA; const char* nB = has_next ? (const char*)g.Bt + (size_t)nxt.bt * tstep : cB;
#pragma unroll 1
        for (int t = 0; t < nt; t += 2) {
            const bool last = (t == nt - 2);
            const size_t k1 = (size_t)(t + 1) * kstep;
            const char* sA = last ? nA : cA; const size_t k2 = last ? (size_t)0 : (size_t)(t + 2) * kstep, k3 = k2 + kstep;
            const char* b2 = last ? nB : cB + (size_t)(t + 2) * kstep; const char* b3 = b2 + kstep;
            if (last && has_next) { S.a_ready(nxt); if constexpr (Sched::GATHER) { PG8_GLOAD(gn, nxt.par); } }
            if constexpr (Sched::GATHER) {
#pragma unroll
                for (int h = 0; h < 2; ++h)
#pragma unroll
                    for (int i = 0; i < 2; ++i) gs[h][i] = (last && has_next) ? gn[h][i] : gc[h][i];
            }
            PG8_LDB(B0, 0, 0); PG8_LDB(B1, 0, 1); PG8_SCHED; PG8_LDA(At, 0, 0); PG8_STAGE_A(PG8_SA(1, 1), cA, gc, 1, k1);
            PG8_WAIT_V(8); PG8_WAIT_L(0); PG8_BAR; PG8_MMA(0, 0, At, B0); PG8_MMA(0, 1, At, B1); PG8_BAR; PG8_SCHED;
            PG8_LDA(At, 0, 1); PG8_STAGE(PG8_SB(0, 0), b2, voffB); PG8_STAGE(PG8_SB(0, 1), b2 + hstep, voffB); PG8_STAGE_A(PG8_SA(0, 0), sA, gs, 0, k2);
            PG8_WAIT_V(8); PG8_WAIT_L(0); PG8_BAR; PG8_MMA(1, 0, At, B0); PG8_MMA(1, 1, At, B1); PG8_BAR; PG8_SCHED;
            PG8_LDB(B0, 1, 0); PG8_LDB(B1, 1, 1); PG8_SCHED; PG8_LDA(At, 1, 0); PG8_STAGE_A(PG8_SA(0, 1), sA, gs, 1, k2);
            PG8_WAIT_V(8); PG8_WAIT_L(0); PG8_BAR; PG8_MMA(0, 0, At, B0); PG8_MMA(0, 1, At, B1); PG8_BAR; PG8_SCHED;
            PG8_LDA(At, 1, 1); PG8_STAGE(PG8_SB(1, 0), b3, voffB); PG8_STAGE(PG8_SB(1, 1), b3 + hstep, voffB); PG8_STAGE_A(PG8_SA(1, 0), sA, gs, 0, k3);
            PG8_WAIT_V(8); PG8_WAIT_L(0); PG8_BAR; PG8_MMA(1, 0, At, B0); PG8_MMA(1, 1, At, B1); PG8_BAR; PG8_SCHED;
        }
        if constexpr (F8) asm volatile("s_nop 15\n\ts_nop 15" ::: "memory");
        if constexpr (ALIGN_EPI) { if (wr == 0) PG8_BAR; }
        if constexpr (!Epi::AFTER_DRAIN) { E(acc, cur, wr, wc, fr, fq); S.done(cur); }
        if (!has_next) break;
#pragma unroll
        for (int a = 0; a < 2; ++a)
#pragma unroll
            for (int b = 0; b < 2; ++b)
#pragma unroll
                for (int m = 0; m < 4; ++m)
#pragma unroll
                    for (int n = 0; n < 2; ++n) acc[a][b][m][n] = (f32x4){0.f, 0.f, 0.f, 0.f};
        cur = nxt; cA = nA; cB = nB; ++ui;
        if constexpr (Sched::GATHER) {
#pragma unroll
            for (int h = 0; h < 2; ++h)
#pragma unroll
                for (int i = 0; i < 2; ++i) gc[h][i] = gn[h][i];
        }
        if constexpr (ALIGN_EPI) { if (wr == 1) PG8_BAR; }
    }
    PG8_WAIT_V(0);
    if constexpr (!ALIGN_EPI) { if (wr == 0) PG8_BAR; }
    PG8_BAR;
    if constexpr (Epi::AFTER_DRAIN) { E.fused(acc, cur, wr, wc, fr, fq, lds, wid, lane); S.done(cur); }
#undef PG8_TOK
#undef PG8_GLOAD
#undef PG8_SA
#undef PG8_SB
#undef PG8_STAGE
#undef PG8_STAGE_A
#undef PG8_CAT
#undef PG8_LDA
#undef PG8_LDB
#undef PG8_MMA
#undef PG8_WAIT_V
#undef PG8_WAIT_L
#undef PG8_BAR
#undef PG8_SCHED
}

typedef f32x4 Acc[2][2][4][2];
#define TAB_ENT(ldsx, par, r) ((const LAS Ent*)((ldsx) + TAB_OFF + (par) * 4096 + (r) * 16))

struct EpiBf16 {
    static constexpr bool PERM = true, AFTER_DRAIN = false;
    bf16* O; int ldc; const float* rs; float sc;
    __device__ __forceinline__ void operator()(const Acc& acc, const Unit& u, int wr, int wc, int fr, int fq) const {
        const int row0 = u.pm * BM + wr * 64 + fr, col0 = u.pn * BM + wc * 32 + 8 * fq;
#pragma unroll
        for (int ai = 0; ai < 2; ++ai)
#pragma unroll
            for (int m = 0; m < 4; ++m) { const int row = row0 + ai * HALF + m * 16; const float s = rs ? rs[row] * sc : sc; bf16* rowp = O + (size_t)row * ldc + col0;
#pragma unroll
                for (int bj = 0; bj < 2; ++bj) { const f32x4 v0 = acc[ai][bj][m][0] * s, v1 = acc[ai][bj][m][1] * s; v4u w;
                    w.x = cvt_pk_bf16(v0[0], v0[1]); w.y = cvt_pk_bf16(v0[2], v0[3]); w.z = cvt_pk_bf16(v1[0], v1[1]); w.w = cvt_pk_bf16(v1[2], v1[3]);
                    *(v4u*)(rowp + bj * HALF) = w; } }
    }
};
struct EpiH1 {
    static constexpr bool PERM = true, AFTER_DRAIN = false;
    const bf16* xb; const float* rms; bf16* h1; float* ssp; unsigned char* h18; float sc;
    __device__ __forceinline__ void operator()(const Acc& acc, const Unit& u, int wr, int wc, int fr, int fq) const {
        const int row0 = u.pm * BM + wr * 64 + fr, col0 = u.pn * BM + wc * 32 + 8 * fq;
        v4u xv[2][2]; float rm[8];
#define H1_LOAD(g_, buf) do { const size_t off_ = (size_t)(row0 + ((g_) >> 2) * HALF + ((g_) & 3) * 16) * D + col0; xv[buf][0] = *(const v4u*)(xb + off_); xv[buf][1] = *(const v4u*)(xb + off_ + HALF); } while (0)
#pragma unroll
        for (int gi = 0; gi < 8; ++gi) rm[gi] = rms[row0 + (gi >> 2) * HALF + (gi & 3) * 16];
        H1_LOAD(0, 0);
#pragma unroll
        for (int gi = 0; gi < 8; ++gi) { const int ai = gi >> 2, m = gi & 3;
            if (gi + 1 < 8) H1_LOAD(gi + 1, (gi + 1) & 1);
            asm volatile("" ::: "memory");
            const int row = row0 + ai * HALF + m * 16; const size_t off = (size_t)row * D + col0; float ss = 0.f; const float r = rm[gi];
#pragma unroll
            for (int bj = 0; bj < 2; ++bj) { float xf[8]; unpack8(xv[gi & 1][bj], xf); float o[8];
#pragma unroll
                for (int n = 0; n < 2; ++n)
#pragma unroll
                    for (int i = 0; i < 4; ++i) { o[n * 4 + i] = xf[n * 4 + i] * r + acc[ai][bj][m][n][i] * sc; ss += o[n * 4 + i] * o[n * 4 + i]; }
                v4u w; w.x = cvt_pk_bf16(o[0], o[1]); w.y = cvt_pk_bf16(o[2], o[3]); w.z = cvt_pk_bf16(o[4], o[5]); w.w = cvt_pk_bf16(o[6], o[7]);
                *(v4u*)(h1 + off + bj * HALF) = w; if (h18) *(v2u*)(h18 + off + bj * HALF) = pack8_f8(o, F8_ASCALE); }
            ss += __shfl_xor(ss, 16); ss += __shfl_xor(ss, 32);
            if (fq == 0) ssp[(size_t)row * 32 + u.pn * 4 + wc] = ss;
            asm volatile("" ::: "memory"); }
#undef H1_LOAD
    }
};
struct EpiRouter {
    static constexpr bool PERM = false, AFTER_DRAIN = true;
    const float* ssp; const float* bg; const float* br; float* rs1; int* eid; float* ew; Ent* ent; unsigned* cnt;
    __device__ __forceinline__ void fused(const Acc& acc, const Unit& u, int wr, int wc, int fr, int fq, LAS unsigned char* lds, int wid, int lane) const {
        LAS float* LG = (LAS float*)lds;
        LAS unsigned* HIST = (LAS unsigned*)(lds + 65536);
        LAS unsigned* BASE = (LAS unsigned*)(lds + 65536 + 256);
        const int tid = wid * 64 + lane;
        if (tid < 64) HIST[tid] = 0u;
        if (wc < 2) {
#pragma unroll
            for (int ai = 0; ai < 2; ++ai)
#pragma unroll
                for (int m = 0; m < 4; ++m) { const int r = ai * HALF + wr * 64 + m * 16 + fr;
#pragma unroll
                    for (int n = 0; n < 2; ++n) { const int c = wc * 32 + 16 * n + 4 * fq; if (c < 40) *(LAS f32x4*)(LG + r * 40 + c) = acc[ai][0][m][n]; } }
        }
        __syncthreads();
        int l0 = 0, l1 = 0; unsigned k0 = 0, k1 = 0; float w0 = 0.f, w1 = 0.f, rs = 0.f; const int row = u.pm * BM + tid;
        if (tid < 256) {
            float ss = 0.f;
#pragma unroll
            for (int j = 0; j < 8; ++j) { const f32x4 p = *(const f32x4*)(ssp + (size_t)row * 32 + 4 * j); ss += (p[0] + p[1]) + (p[2] + p[3]); }
            rs = 1.0f / sqrtf(ss * (1.0f / D) + EPS);
            const LAS float* L = LG + tid * 40;
            float gl[NGRP]; int g = 0;
#pragma unroll
            for (int j = 0; j < NGRP; ++j) gl[j] = L[j] * rs + bg[j];
            float gm = gl[0];
#pragma unroll
            for (int j = 1; j < NGRP; ++j) if (gl[j] > gm) { gm = gl[j]; g = j; }
            float gsum = 0.f;
#pragma unroll
            for (int j = 0; j < NGRP; ++j) gsum += __expf(gl[j] - gm);
            const float gw = 1.0f / gsum;
            const LAS float* E = L + NGRP + g * EPG; const float* be = br + g * EPG;
            int i1 = 0; float v1 = E[0] * rs + be[0];
            for (int j = 1; j < EPG; ++j) { const float v = E[j] * rs + be[j]; if (v > v1) { v1 = v; i1 = j; } }
            int i2 = 0; float v2 = -3.0e38f;
            for (int j = 0; j < EPG; ++j) { const float v = E[j] * rs + be[j]; if (j != i1 && v > v2) { v2 = v; i2 = j; } }
            const float e2 = __expf(v2 - v1); w0 = gw / (1.0f + e2); w1 = gw * e2 / (1.0f + e2);
            l0 = g * EPG + i1; l1 = NE + g * EPG + i2;
            eid[row * 2] = l0; eid[row * 2 + 1] = l1 - NE; ew[row * 2] = w0; ew[row * 2 + 1] = w1; rs1[row] = rs;
            k0 = __hip_atomic_fetch_add(HIST + l0, 1u, __ATOMIC_RELAXED, __HIP_MEMORY_SCOPE_WORKGROUP); k1 = __hip_atomic_fetch_add(HIST + l1, 1u, __ATOMIC_RELAXED, __HIP_MEMORY_SCOPE_WORKGROUP);
        }
        __syncthreads();
        if (tid < 64) { const unsigned n = HIST[tid]; BASE[tid] = n ? __hip_atomic_fetch_add(cnt + 64 * tid, n, __ATOMIC_RELAXED, __HIP_MEMORY_SCOPE_AGENT) : 0u; }
        __syncthreads();
        if (tid < 256) {
            *(v4u*)(ent + (size_t)l0 * LCAP + BASE[l0] + k0) = (v4u){(unsigned)row, __float_as_uint(w0), __float_as_uint(rs), 0u};
            *(v4u*)(ent + (size_t)l1 * LCAP + BASE[l1] + k1) = (v4u){(unsigned)row, __float_as_uint(w1), __float_as_uint(rs), 0u};
        }
    }
};
struct EpiGU {
    static constexpr bool PERM = true, AFTER_DRAIN = false;
    bf16* hid; LAS unsigned char* ldsx; float sc; unsigned char* hid8;
    __device__ __forceinline__ void operator()(const Acc& acc, const Unit& u, int wr, int wc, int fr, int fq) const {
        const int col0 = u.pn * HALF + wc * 32 + 8 * fq;
#pragma unroll
        for (int ai = 0; ai < 2; ++ai)
#pragma unroll
            for (int m = 0; m < 4; ++m) { const int r = ai * HALF + wr * 64 + m * 16 + fr; const LAS Ent* e = TAB_ENT(ldsx, u.par, r); const float w = e->w, rs = e->rs * sc;
                float o[8];
#pragma unroll
                for (int n = 0; n < 2; ++n)
#pragma unroll
                    for (int i = 0; i < 4; ++i) { const float gg = acc[ai][0][m][n][i] * rs, uu = acc[ai][1][m][n][i] * rs; o[n * 4 + i] = w * (gg / (1.0f + __expf(-gg))) * uu; }
                if (hid8) { *(v2u*)(hid8 + (size_t)(u.pm * BM + r) * DEXP + col0) = pack8_f8(o, F8_HSCALE); }
                else { v4u q; q.x = cvt_pk_bf16(o[0], o[1]); q.y = cvt_pk_bf16(o[2], o[3]); q.z = cvt_pk_bf16(o[4], o[5]); q.w = cvt_pk_bf16(o[6], o[7]);
                    *(v4u*)(hid + (size_t)(u.pm * BM + r) * DEXP + col0) = q; } }
    }
};
template <int KK> struct EpiDown {
    static constexpr bool PERM = true, AFTER_DRAIN = false;
    const bf16* base; bf16* h2; float* ssp; LAS unsigned char* ldsx; unsigned char* h28; float sc;
    __device__ __forceinline__ void operator()(const Acc& acc, const Unit& u, int wr, int wc, int fr, int fq) const {
        const int col0 = u.pn * BM + wc * 32 + 8 * fq;
        v4u bv[2][2]; int tk[2];
#define DN_LOAD(g_, buf) do { tk[buf] = TAB_ENT(ldsx, u.par, ((g_) >> 2) * HALF + wr * 64 + ((g_) & 3) * 16 + fr)->tok; const size_t off_ = (size_t)tk[buf] * D + col0; bv[buf][0] = *(const v4u*)(base + off_); bv[buf][1] = *(const v4u*)(base + off_ + HALF); } while (0)
        DN_LOAD(0, 0);
#pragma unroll
        for (int gi = 0; gi < 8; ++gi) { const int ai = gi >> 2, m = gi & 3;
            if (gi + 1 < 8) DN_LOAD(gi + 1, (gi + 1) & 1);
            asm volatile("" ::: "memory");
            const int r = ai * HALF + wr * 64 + m * 16 + fr; const bool valid = (u.rk0 + r) < u.nl; const int tok = tk[gi & 1]; const size_t off = (size_t)tok * D + col0; float ss = 0.f;
#pragma unroll
            for (int bj = 0; bj < 2; ++bj) { float b[8]; unpack8(bv[gi & 1][bj], b);
                float o[8];
#pragma unroll
                for (int n = 0; n < 2; ++n)
#pragma unroll
                    for (int i = 0; i < 4; ++i) { o[n * 4 + i] = b[n * 4 + i] + acc[ai][bj][m][n][i] * sc; ss += o[n * 4 + i] * o[n * 4 + i]; }
                v4u q; q.x = cvt_pk_bf16(o[0], o[1]); q.y = cvt_pk_bf16(o[2], o[3]); q.z = cvt_pk_bf16(o[4], o[5]); q.w = cvt_pk_bf16(o[6], o[7]);
                if (valid) { *(v4u*)(h2 + off + bj * HALF) = q; if (KK == 1 && h28) *(v2u*)(h28 + off + bj * HALF) = pack8_f8(o, F8_ASCALE); } }
            if (KK == 1) { ss += __shfl_xor(ss, 16); ss += __shfl_xor(ss, 32); if (fq == 0 && valid) ssp[(size_t)tok * 32 + u.pn * 4 + wc] = ss; }
            asm volatile("" ::: "memory"); }
#undef DN_LOAD
    }
};
struct EpiFinal {
    static constexpr bool PERM = true, AFTER_DRAIN = false;
    const bf16* h2; const bf16* pw; float* out; LAS unsigned char* ldsx; float sc;
    __device__ __forceinline__ void operator()(const Acc& acc, const Unit& u, int wr, int wc, int fr, int fq) const {
        const int col0 = u.pn * BM + wc * 32 + 8 * fq;
        v4u hv[2][2], pv[2][2];
#define FN_LOAD(g_, buf) do { const size_t off_ = (size_t)(u.pm * BM + ((g_) >> 2) * HALF + wr * 64 + ((g_) & 3) * 16 + fr) * D + col0; \
            hv[buf][0] = *(const v4u*)(h2 + off_); hv[buf][1] = *(const v4u*)(h2 + off_ + HALF); pv[buf][0] = *(const v4u*)(pw + off_); pv[buf][1] = *(const v4u*)(pw + off_ + HALF); } while (0)
        FN_LOAD(0, 0);
#pragma unroll
        for (int gi = 0; gi < 8; ++gi) { const int ai = gi >> 2, m = gi & 3;
            if (gi + 1 < 8) FN_LOAD(gi + 1, (gi + 1) & 1);
            asm volatile("" ::: "memory");
            const int r = ai * HALF + wr * 64 + m * 16 + fr; const float rs = TAB_ENT(ldsx, u.par, r)->rs * sc; const size_t off = (size_t)(u.pm * BM + r) * D + col0;
#pragma unroll
            for (int bj = 0; bj < 2; ++bj) { float hf[8], pf[8]; unpack8(hv[gi & 1][bj], hf); unpack8(pv[gi & 1][bj], pf);
#pragma unroll
                for (int n = 0; n < 2; ++n) { const f32x4 z = acc[ai][bj][m][n] * rs; f32x4 o;
#pragma unroll
                    for (int i = 0; i < 4; ++i) o[i] = hf[n * 4 + i] + pf[n * 4 + i] * __builtin_amdgcn_rcpf(1.0f + __expf(-z[i]));
                    *(f32x4*)(out + off + bj * HALF + n * 4) = o; } }
            asm volatile("" ::: "memory"); }
#undef FN_LOAD
    }
};

template <bool GATHER_, int NPN> struct MoeOrder {
    static constexpr bool GATHER = GATHER_;
    LAS unsigned char* ldsx; const Ent* ent; int tlo, thi, G, c, wave;
    __device__ __forceinline__ bool next(int i, Unit& u) const {
        const long L = (long)i * G + c; const int nun = (thi - tlo) * NPN; if (L >= nun) return false;
        const int tile = tlo + (int)(L / NPN); const LAS int* T0 = (const LAS int*)(ldsx + LST_OFF + 256);
        int l = 0;
        for (int j = 1; j < NLIST; ++j) l += (T0[j] <= tile) ? 1 : 0;
        l = __builtin_amdgcn_readfirstlane(l);
        u.pm = tile; u.pn = (int)(L % NPN); u.bt = (l & (NE - 1)) * NPN + u.pn; u.par = i & 1; u.lst = l; u.rk0 = (tile - __builtin_amdgcn_readfirstlane(T0[l])) * BM; u.nl = __builtin_amdgcn_readfirstlane(((const LAS int*)(ldsx + LST_OFF))[l]);
        return true;
    }
    __device__ __forceinline__ void a_ready(const Unit& u) const {
        const int tid = TIDX(wave);
        if (tid < 256) { const int rk = u.rk0 + tid; v4u e = (v4u){0u, 0u, 0u, 0u}; if (rk < u.nl) e = *(const v4u*)(ent + (size_t)u.lst * LCAP + rk);
            *(LAS v4u*)(ldsx + TAB_OFF + u.par * 4096 + tid * 16) = e; }
        if (GATHER) { asm volatile("s_waitcnt vmcnt(0) lgkmcnt(0)" ::: "memory"); __builtin_amdgcn_s_barrier(); asm volatile("" ::: "memory"); }
    }
    __device__ __forceinline__ void done(const Unit&) const {}
};
struct FinalOrder : StaticOrder {
    LAS unsigned char* ldsx; const float* ssp; int wave;
    __device__ __forceinline__ void a_ready(const Unit& u) const {
        const int tid = TIDX(wave);
        if (tid < 256) { const int row = u.pm * BM + tid; float ss = 0.f;
#pragma unroll
            for (int j = 0; j < 8; ++j) { const f32x4 p = *(const f32x4*)(ssp + (size_t)row * 32 + 4 * j); ss += (p[0] + p[1]) + (p[2] + p[3]); }
            *(LAS v4u*)(ldsx + TAB_OFF + u.par * 4096 + tid * 16) = (v4u){(unsigned)row, 0u, __float_as_uint(1.0f / sqrtf(ss * (1.0f / D) + EPS)), 0u}; }
    }
};
}
#define RLX_AGENT __ATOMIC_RELAXED, __HIP_MEMORY_SCOPE_AGENT
#define XB_TMO      128
#define XB_XCNT(j)  (256  + 64 * (j))
#define XB_XSUB(j)  (1280 + 64 * (j))
#define XB_XGEN(j)  (2304 + 64 * (j))
#define XB_TOP      3328
#define XB_TOPGEN   3392
#define XCD_BAR_WORDS 3456
#define XB_SPIN_CAP (1u << 18)

__device__ __forceinline__ unsigned xb_ld(unsigned* p)              { return __hip_atomic_load(p, __ATOMIC_RELAXED, __HIP_MEMORY_SCOPE_AGENT); }
__device__ __forceinline__ unsigned xb_add(unsigned* p, unsigned v) { return __hip_atomic_fetch_add(p, v, __ATOMIC_RELAXED, __HIP_MEMORY_SCOPE_AGENT); }
__device__ __forceinline__ unsigned xb_xcc_id() { return (unsigned)__builtin_amdgcn_s_getreg((3 << 11) | 20) & 0xFu; }
#define XB_SPIN(cond, bar) do { unsigned _sp = 0; while (cond) { __builtin_amdgcn_s_sleep(1); \
    if ((++_sp & 255u) == 0u) { if (xb_ld(&(bar)[XB_TMO])) break; if (_sp > XB_SPIN_CAP) { atomicAdd(&(bar)[XB_TMO], 1u); break; } } } } while (0)

struct XcdBarrier {
    unsigned* bar; unsigned x;
    volatile LAS unsigned* st;
};
__device__ __forceinline__ XcdBarrier xcd_barrier_post(unsigned* bar, volatile LAS unsigned* st, const int wave_) {
    XcdBarrier b; b.bar = bar; b.x = xb_xcc_id(); b.st = st;
    if (TIDX(wave_) == 0) (void)xb_add(&bar[XB_XCNT(b.x)], 1u);
    return b;
}
__device__ __forceinline__ void xcd_barrier_complete(unsigned* bar, unsigned x, unsigned& nloc, unsigned& nx) {
    const unsigned G = gridDim.x * gridDim.y * gridDim.z;
    unsigned sum, cnt, mine, sp = 0u;
    for (;;) {
        sum = 0u; cnt = 0u; mine = 0u;
#pragma unroll
        for (unsigned j = 0; j < 16; ++j) { const unsigned c = xb_ld(&bar[XB_XCNT(j)]); sum += c; cnt += (c > 0u) ? 1u : 0u; mine = (j == x) ? c : mine; }
        if (sum == G) break;
        __builtin_amdgcn_s_sleep(1);
        if ((++sp & 255u) == 0u) { if (xb_ld(&bar[XB_TMO])) break; if (sp > XB_SPIN_CAP) { atomicAdd(&bar[XB_TMO], 1u); break; } }
    }
    nloc = mine > 0u ? mine : 1u; nx = cnt > 0u ? cnt : 1u;
}
__device__ __forceinline__ void xcd_barrier(const XcdBarrier& b, const int wave_) {
    asm volatile("s_waitcnt vmcnt(0)" ::: "memory");
    __syncthreads();
    if (TIDX(wave_) == 0) {
        unsigned* bar = b.bar;
        __builtin_amdgcn_s_waitcnt(0);
        unsigned nloc = b.st[0], nx = b.st[1];
        if (nloc == 0u) { xcd_barrier_complete(bar, b.x, nloc, nx); b.st[0] = nloc; b.st[1] = nx; }
        const unsigned old = xb_add(&bar[XB_XSUB(b.x)], 1u);
        const unsigned gen = old / nloc;
        if (old + 1u == (gen + 1u) * nloc) {
            __builtin_amdgcn_fence(__ATOMIC_RELEASE, "agent");
            asm volatile("s_waitcnt vmcnt(0)" ::: "memory");
            const unsigned og = xb_add(&bar[XB_TOP], 1u);
            const unsigned tg = og / nx;
            if (og + 1u == (tg + 1u) * nx) xb_add(&bar[XB_TOPGEN], 1u);
            else XB_SPIN(xb_ld(&bar[XB_TOPGEN]) == tg, bar);
            __builtin_amdgcn_fence(__ATOMIC_ACQUIRE, "agent");
            xb_add(&bar[XB_XGEN(b.x)], 1u);
            asm volatile("s_waitcnt vmcnt(0)" ::: "memory");
        } else {
            XB_SPIN(xb_ld(&bar[XB_XGEN(b.x)]) == gen, bar);
            __builtin_amdgcn_fence(__ATOMIC_ACQUIRE, "agent");
            asm volatile("s_waitcnt vmcnt(0)" ::: "memory");
        }
    }
    __syncthreads();
}

constexpr int NWAVES = 8;
__device__ __forceinline__ void p0_transpose_item(const float* W, int K, int N, const float* g0, const float* g1, int gsplit, bf16* WT, int rowbase, int k0, int n0, LAS float* scr, int lane) {
    float v[32];
    const float* src = W + (size_t)(k0 + (lane >> 5)) * N + n0 + (lane & 31);
#pragma unroll
    for (int i = 0; i < 32; ++i) v[i] = src[(size_t)(2 * i) * N];
    const int c = lane & 7;
    float gg[8];
#pragma unroll
    for (int j = 0; j < 8; ++j) { const int k = k0 + 8 * c + j; gg[j] = g0 ? (k < gsplit ? g0[k] : g1[k - gsplit]) : 1.f; }
#pragma unroll
    for (int i = 0; i < 32; ++i) scr[(2 * i + (lane >> 5)) * 33 + (lane & 31)] = v[i];
    asm volatile("s_waitcnt lgkmcnt(0)" ::: "memory");
#pragma unroll
    for (int j = 0; j < 4; ++j) { const int n = (lane >> 3) + 8 * j; const LAS float* s = scr + (8 * c) * 33 + n;
        v4u o; o.x = pk2(s[0 * 33] * gg[0], s[1 * 33] * gg[1]); o.y = pk2(s[2 * 33] * gg[2], s[3 * 33] * gg[3]); o.z = pk2(s[4 * 33] * gg[4], s[5 * 33] * gg[5]); o.w = pk2(s[6 * 33] * gg[6], s[7 * 33] * gg[7]);
        *(v4u*)(WT + (size_t)(rowbase + n) * K + k0 + 8 * c) = o; }
    asm volatile("s_waitcnt lgkmcnt(0)" ::: "memory");
}
__device__ __forceinline__ void p0_transpose_item8(const float* W, int K, int N, const float* g0, unsigned char* WT8, int rowbase, int k0, int n0, LAS float* scr, int lane, float sc) {
    float v[32];
    const float* src = W + (size_t)(k0 + (lane >> 5)) * N + n0 + (lane & 31);
#pragma unroll
    for (int i = 0; i < 32; ++i) v[i] = src[(size_t)(2 * i) * N];
    const int c = lane & 7;
    float gg[8];
#pragma unroll
    for (int j = 0; j < 8; ++j) gg[j] = (g0 ? g0[k0 + 8 * c + j] : 1.f) * sc;
#pragma unroll
    for (int i = 0; i < 32; ++i) scr[(2 * i + (lane >> 5)) * 33 + (lane & 31)] = v[i];
    asm volatile("s_waitcnt lgkmcnt(0)" ::: "memory");
#pragma unroll
    for (int j = 0; j < 4; ++j) { const int n = (lane >> 3) + 8 * j; const LAS float* s = scr + (8 * c) * 33 + n; float f[8];
#pragma unroll
        for (int q = 0; q < 8; ++q) f[q] = s[q * 33] * gg[q];
        *(v2u*)(WT8 + (size_t)(rowbase + n) * K + k0 + 8 * c) = pack8_f8(f, 1.0f); }
    asm volatile("s_waitcnt lgkmcnt(0)" ::: "memory");
}
__device__ __forceinline__ void p0_prologue(const Ptrs& P, LAS unsigned char* lds, int vcu, int G, const int wave) {
    const int lane = lane_id(), tid = wave * 64 + lane;
    unsigned char* ws = P.ws;
    LAS float* scr = (LAS float*)(lds + wave * 16384);
    const int gw = vcu * NWAVES + wave, NGW = G * NWAVES;
    constexpr int I_IN = (D / 64) * (DIN / 32), I_OUT = (D / 64) * (D / 32), I_PLG = I_OUT, I_PLE = (PLE / 64) * (D / 32), I_RT = (D / 64) * (NE / 32);
    constexpr int I_G1 = (D / 64) * (DEXP / 32), I_D1 = (DEXP / 64) * (D / 32);
    constexpr int NITEMS = I_IN + I_OUT + I_PLG + I_PLE + I_RT + NE * (2 * I_G1 + I_D1);
    for (int it = gw; it < NITEMS; it += NGW) {
        int r = it;
        if (r < I_IN) { const int nb = DIN / 32; const int n0 = (r % nb) * 32, k0 = (r / nb) * 64;
            if (FP8QKV && n0 >= C_Q) p0_transpose_item8(P.w_in, D, DIN, P.norm_mix, ws + WS_WIN8, n0 - C_Q, k0, n0, scr, lane, F8_WSCALE);
            else p0_transpose_item(P.w_in, D, DIN, P.norm_mix, nullptr, D, (bf16*)(ws + WS_WIN), n0, k0, n0, scr, lane);
            continue; } r -= I_IN;
        if (r < I_OUT) { const int nb = D / 32; const int k0 = (r / nb) * 64;
            if (FP8O) p0_transpose_item8(P.w_out, D, D, k0 < DCONV ? P.onc : P.ona - DCONV, ws + WS_WOUT, (r % nb) * 32, k0, (r % nb) * 32, scr, lane, F8_WSCALE);
            else p0_transpose_item(P.w_out, D, D, P.onc, P.ona, DCONV, (bf16*)(ws + WS_WOUT), (r % nb) * 32, k0, (r % nb) * 32, scr, lane);
            continue; } r -= I_OUT;
        if (r < I_PLG) { const int nb = D / 32;
            if (FP8) p0_transpose_item8(P.w_ple_gate, D, D, P.norm_ple, ws + WS_WPLG, (r % nb) * 32, (r / nb) * 64, (r % nb) * 32, scr, lane, F8_WSCALE);
            else p0_transpose_item(P.w_ple_gate, D, D, P.norm_ple, nullptr, D, (bf16*)(ws + WS_WPLG), (r % nb) * 32, (r / nb) * 64, (r % nb) * 32, scr, lane);
            continue; } r -= I_PLG;
        if (r < I_PLE) { const int nb = D / 32; p0_transpose_item(P.w_ple, PLE, D, nullptr, nullptr, 0, (bf16*)(ws + WS_WPLE), (r % nb) * 32, (r / nb) * 64, (r % nb) * 32, scr, lane); continue; } r -= I_PLE;
        if (r < I_RT) { p0_transpose_item(P.w_router, D, NE, P.norm_ffn, nullptr, D, (bf16*)(ws + WS_WR), NGRP, r * 64, 0, scr, lane); continue; } r -= I_RT;
        const int e = r / (2 * I_G1 + I_D1); r -= e * (2 * I_G1 + I_D1);
        if (r < 2 * I_G1) { const int up = r >= I_G1; r -= up * I_G1; const int nb = DEXP / 32, n0 = (r % nb) * 32, k0 = (r / nb) * 64;
            if (FP8) p0_transpose_item8((up ? P.w_up : P.w_gate) + (size_t)e * D * DEXP, D, DEXP, P.norm_ffn, ws + WS_WGU + (size_t)e * 1024 * D, (n0 >> 7) * 256 + up * 128 + (n0 & 127), k0, n0, scr, lane, F8_WSCALE);
            else p0_transpose_item((up ? P.w_up : P.w_gate) + (size_t)e * D * DEXP, D, DEXP, P.norm_ffn, nullptr, D, (bf16*)(ws + WS_WGU) + (size_t)e * 1024 * D, (n0 >> 7) * 256 + up * 128 + (n0 & 127), k0, n0, scr, lane);
            continue; }
        r -= 2 * I_G1; { const int nb = D / 32;
            if (FP8) p0_transpose_item8(P.w_down + (size_t)e * DEXP * D, DEXP, D, nullptr, ws + WS_WD + (size_t)e * D * DEXP, (r % nb) * 32, (r / nb) * 64, (r % nb) * 32, scr, lane, F8_DSCALE);
            else p0_transpose_item(P.w_down + (size_t)e * DEXP * D, DEXP, D, nullptr, nullptr, 0, (bf16*)(ws + WS_WD) + (size_t)e * D * DEXP, (r % nb) * 32, (r / nb) * 64, (r % nb) * 32, scr, lane); }
    }
    { bf16* Wr = (bf16*)(ws + WS_WR); const int gt = vcu * (NWAVES * 64) + tid, NT = G * NWAVES * 64;
      for (int i = gt; i < NGRP * D; i += NT) { const int n = i / D, k = i % D; Wr[(size_t)n * D + k] = f2bf(P.norm_ffn[k] * P.w_group[(size_t)k * NGRP + n]); }
      for (int i = gt; i < (256 - NRT) * D / 8; i += NT) *(v4u*)(Wr + (size_t)NRT * D + (size_t)i * 8) = (v4u){0u, 0u, 0u, 0u}; }
    for (int m = gw; m < M; m += NGW) {
        const f32x4* xr = (const f32x4*)(P.x + (size_t)m * D) + lane; f32x4 v[8]; float s = 0.f;
#pragma unroll
        for (int j = 0; j < 8; ++j) { v[j] = xr[64 * j]; s += (v[j][0] * v[j][0] + v[j][1] * v[j][1]) + (v[j][2] * v[j][2] + v[j][3] * v[j][3]); }
        s = wsum(s);
        v2u* o8 = (v2u*)((bf16*)(ws + WS_XB) + (size_t)m * D) + lane;
        const float rstd = 1.0f / sqrtf(s * (1.0f / D) + EPS);
#pragma unroll
        for (int j = 0; j < 8; ++j) { v2u o; o.x = pk2(v[j][0] * rstd, v[j][1] * rstd); o.y = pk2(v[j][2] * rstd, v[j][3] * rstd); o8[64 * j] = o; }
        if (FP8QKV) { unsigned* o4 = (unsigned*)(ws + WS_XB8 + (size_t)m * D) + lane; const float r16 = rstd * F8_ASCALE;
#pragma unroll
            for (int j = 0; j < 8; ++j) { int w = 0; w = __builtin_amdgcn_cvt_pk_fp8_f32(v[j][0] * r16, v[j][1] * r16, w, false); w = __builtin_amdgcn_cvt_pk_fp8_f32(v[j][2] * r16, v[j][3] * r16, w, true); o4[64 * j] = (unsigned)w; } }
        if (lane == 0) { ((float*)(ws + WS_RSX))[m] = 1.0f; ((float*)(ws + WS_RMSX))[m] = sqrtf(s * (1.0f / D) + EPS); }
    }
    { const int gt = vcu * (NWAVES * 64) + tid, NT = G * NWAVES * 64; const f32x4* src = (const f32x4*)P.p; v4u* dst = (v4u*)(ws + WS_PB);
      for (int i = gt; i < M * PLE / 8; i += NT) { const f32x4 a = src[2 * i], b = src[2 * i + 1]; v4u o; o.x = pk2(a[0], a[1]); o.y = pk2(a[2], a[3]); o.z = pk2(b[0], b[1]); o.w = pk2(b[2], b[3]); dst[i] = o; } }
}

#ifndef CONVR
#define CONVR 2
#endif
constexpr int P2_KS = 0, P2_KROW = 144, P2_VT = 36864, P2_VROW = 528, P2_OST = 70656, P2_OROW = 144, P2_SS = 107520, P2_RSTD = 108032, P2_QG = 108544;
__device__ __forceinline__ int crow(int r, int hi) { return (r & 3) + 8 * (r >> 2) + 4 * hi; }
__device__ __forceinline__ void p2_unit(const Ptrs& P, LAS unsigned char* lds, int unit, const int wid, const bool conv_first) {
    int lane_ = lane_id_asm(); asm volatile("" : "+v"(lane_));
    const int lane = lane_ & 63, tid = wid * 64 + lane, l32 = lane & 31, hi = lane >> 5;
    const bf16* proj = (const bf16*)(P.ws + WS_PROJ); bf16* mixed = (bf16*)(P.ws + WS_MIX); unsigned char* mixed8 = P.ws + WS_MIX8;
    bf16* osc = FP8O ? (bf16*)(P.ws + WS_MIX + 64 * MiB) : mixed + DCONV; constexpr int OLD = FP8O ? DATTN : D;
    const int b = unit / (SEQ / 128), qb = unit % (SEQ / 128), q0 = qb * 128; const size_t rowbase = (size_t)b * SEQ;
    LAS float* rowss = (LAS float*)(lds + P2_SS); LAS float* qg = (LAS float*)(lds + P2_QG);
    __syncthreads();
    if (tid < 128) rowss[tid] = 0.f;
    if (tid < 64) qg[tid] = P.q_norm[tid] * (0.125f * LOG2E);
    if (conv_first) {
    {
        int lc_ = lane_id_asm(); asm volatile("" : "+v"(lc_)); const int lane = lc_ & 63;
        const float* cw = P.conv_w; float w0[16], w1[16], w2[16];
#pragma unroll
        for (int j = 0; j < 16; ++j) { const int ch = (j >> 3) * 512 + lane * 8 + (j & 7); w0[j] = cw[ch]; w1[j] = cw[DCONV + ch]; w2[j] = cw[2 * DCONV + ch]; }
        float u1[16], u2[16];
        const int t0 = q0 + 16 * wid;
#pragma unroll
        for (int j = 0; j < 16; ++j) { u1[j] = 0.f; u2[j] = 0.f; }
        if (t0 >= 2) {
#pragma unroll
            for (int hf = 0; hf < 2; ++hf) { const int ch = hf * 512 + lane * 8; float c[8], hc[8];
                const bf16* pr = proj + (rowbase + t0 - 1) * DIN; unpack8(*(const v4u*)(pr + C_C + ch), c); unpack8(*(const v4u*)(pr + C_HC + ch), hc);
#pragma unroll
                for (int j = 0; j < 8; ++j) u1[hf * 8 + j] = c[j] * hc[j];
                pr -= DIN; unpack8(*(const v4u*)(pr + C_C + ch), c); unpack8(*(const v4u*)(pr + C_HC + ch), hc);
#pragma unroll
                for (int j = 0; j < 8; ++j) u2[hf * 8 + j] = c[j] * hc[j]; }
        }
#pragma unroll 1
        for (int r0 = 0; r0 < 16; r0 += CONVR) {
            v4u rb[CONVR][2], rc[CONVR][2], rh[CONVR][2];
#pragma unroll
            for (int rr = 0; rr < CONVR; ++rr) { const bf16* pr = proj + (rowbase + t0 + r0 + rr) * DIN + lane * 8;
#pragma unroll
                for (int hf = 0; hf < 2; ++hf) { rb[rr][hf] = *(const v4u*)(pr + C_B + hf * 512); rc[rr][hf] = *(const v4u*)(pr + C_C + hf * 512); rh[rr][hf] = *(const v4u*)(pr + C_HC + hf * 512); } }
#pragma unroll
            for (int rr = 0; rr < CONVR; ++rr) { float y[16]; float ss = 0.f;
#pragma unroll
                for (int hf = 0; hf < 2; ++hf) { float bb[8], c[8], hc[8]; unpack8(rb[rr][hf], bb); unpack8(rc[rr][hf], c); unpack8(rh[rr][hf], hc);
#pragma unroll
                    for (int j = 0; j < 8; ++j) { const int jj = hf * 8 + j; const float u0 = c[j] * hc[j];
                        y[jj] = bb[j] * (w0[jj] * u2[jj] + w1[jj] * u1[jj] + w2[jj] * u0); ss += y[jj] * y[jj]; u2[jj] = u1[jj]; u1[jj] = u0; } }
                ss = wsum(ss); const float rs = 1.0f / sqrtf(ss * (1.0f / DCONV) + EPS);
#pragma unroll
                for (int hf = 0; hf < 2; ++hf) { float f[8];
#pragma unroll
                    for (int j = 0; j < 8; ++j) f[j] = y[hf * 8 + j] * rs;
                    if (FP8O) *(v2u*)(mixed8 + (rowbase + t0 + r0 + rr) * D + hf * 512 + lane * 8) = pack8_f8(f, F8_ASCALE);
                    else *(v4u*)(mixed + (rowbase + t0 + r0 + rr) * D + hf * 512 + lane * 8) = pack8(f); } }
        }
    }
    }
    const int h4 = wid & 3, half = wid >> 2;
    const int part = tid & 7;
    float kg[8];
#pragma unroll
    for (int j = 0; j < 8; ++j) kg[j] = P.k_norm[part * 8 + j];
    v4u kraw[4], vraw[4], qraw[4];
    const int kvoff = (tid >> 3) * DIN + part * 8, qoff = l32 * DIN + 8 * hi;
#define P2_LOAD_KV(g_) do { _Pragma("unroll") for (int i = 0; i < 4; ++i) { kraw[i] = (v4u){0u, 0u, 0u, 0u}; vraw[i] = (v4u){0u, 0u, 0u, 0u}; \
        if (q0 > 0 || i >= 2) { const bf16* ub = proj + (rowbase + q0 - 128 + 64 * i) * DIN + (g_) * HD; kraw[i] = *(const v4u*)(ub + C_K + kvoff); vraw[i] = *(const v4u*)(ub + C_V + kvoff); } } } while (0)
#define P2_LOAD_Q(g_, sub_) do { const bf16* ub = proj + (rowbase + q0 + 64 * half + 32 * (sub_)) * DIN + C_Q + ((g_) * 4 + h4) * HD; \
        _Pragma("unroll") for (int d0 = 0; d0 < 4; ++d0) qraw[d0] = *(const v4u*)(ub + 16 * d0 + qoff); } while (0)
    P2_LOAD_KV(0); P2_LOAD_Q(0, 0);
#pragma unroll 1
    for (int g = 0; g < NKV; ++g) {
        int lg_ = lane_id_asm(); asm volatile("" : "+v"(lg_));
        const int lane = lg_ & 63, tid = wid * 64 + lane, l32 = lane & 31, hi = lane >> 5, part = tid & 7;
        const int kvoff = (tid >> 3) * DIN + part * 8, qoff = l32 * DIN + 8 * hi, ooffo = (lane >> 3) * OLD + (lane & 7) * 8;
        __syncthreads();
#pragma unroll
        for (int i = 0; i < 4; ++i) {
            const int key = (tid >> 3) + 64 * i;
            float kf[8]; unpack8(kraw[i], kf); float ss = 0.f;
#pragma unroll
            for (int j = 0; j < 8; ++j) ss += kf[j] * kf[j];
            ss += __shfl_xor(ss, 1); ss += __shfl_xor(ss, 2); ss += __shfl_xor(ss, 4);
            const float rk = 1.0f / sqrtf(ss * (1.0f / HD) + EPS);
#pragma unroll
            for (int j = 0; j < 8; ++j) kf[j] = kf[j] * rk * kg[j];
            *(LAS v4u*)(lds + P2_KS + key * P2_KROW + part * 16) = pack8(kf);
            const int x = key & 15; const int pos = (key & ~15) + (x & 3) + ((x >> 3) & 1) * 4 + ((x >> 2) & 1) * 8;
            LAS bf16* vt = (LAS bf16*)(lds + P2_VT) + pos;
            const unsigned vw[4] = {vraw[i].x, vraw[i].y, vraw[i].z, vraw[i].w};
#pragma unroll
            for (int j = 0; j < 4; ++j) { vt[(part * 8 + 2 * j) * (P2_VROW / 2)] = (bf16)(vw[j] & 0xffffu); vt[(part * 8 + 2 * j + 1) * (P2_VROW / 2)] = (bf16)(vw[j] >> 16); }
        }
        if (g + 1 < NKV) { P2_LOAD_KV(g + 1); }
        __syncthreads();
        const int h = g * 4 + h4;
        const float slope2 = exp2f(-0.5f * (float)(h + 1)) * LOG2E, sink2 = P.sinks[h] * LOG2E;
#pragma unroll
        for (int sub = 0; sub < 2; ++sub) {
            const int qs = 64 * half + 32 * sub;
            const int kt0 = 2 * half + sub;
            bf16x8 qf[4];
            { float qv[4][8]; float ss = 0.f;
#pragma unroll
              for (int d0 = 0; d0 < 4; ++d0) { unpack8(qraw[d0], qv[d0]);
#pragma unroll
                  for (int j = 0; j < 8; ++j) ss += qv[d0][j] * qv[d0][j]; }
              ss += __shfl_xor(ss, 32);
              const float rq = 1.0f / sqrtf(ss * (1.0f / HD) + EPS);
#pragma unroll
              for (int d0 = 0; d0 < 4; ++d0) {
#pragma unroll
                  for (int j = 0; j < 8; ++j) qv[d0][j] = qv[d0][j] * rq * qg[16 * d0 + 8 * hi + j];
                  const v4u w = pack8(qv[d0]); qf[d0] = __builtin_bit_cast(bf16x8, w); } }
            if (sub == 0) { P2_LOAD_Q(g, 1); } else if (g + 1 < NKV) { P2_LOAD_Q(g + 1, 0); }
            f32x16 sc[5];
#pragma unroll
            for (int jt = 0; jt < 5; ++jt) { sc[jt] = (f32x16){0.f, 0.f, 0.f, 0.f, 0.f, 0.f, 0.f, 0.f, 0.f, 0.f, 0.f, 0.f, 0.f, 0.f, 0.f, 0.f};
#pragma unroll
                for (int d0 = 0; d0 < 4; ++d0) { const bf16x8 kfr = *(const LAS bf16x8*)(lds + P2_KS + ((kt0 + jt) * 32 + l32) * P2_KROW + (16 * d0 + 8 * hi) * 2);
                    sc[jt] = __builtin_amdgcn_mfma_f32_32x32x16_bf16(kfr, qf[d0], sc[jt], 0, 0, 0); } }
            int bl = l32 - 4 * hi; asm volatile("" : "+v"(bl));
            const float ab = -slope2 * (float)bl;
            float mx = sink2;
#pragma unroll
            for (int jt = 0; jt < 5; ++jt)
#pragma unroll
                for (int r = 0; r < 16; ++r) { const int cc = 128 - 32 * jt - (r & 3) - 8 * (r >> 2);
                    float v = sc[jt][r] + (ab - slope2 * (float)cc);
                    if (jt == 0) v = (bl + cc < 128) ? v : -1.0e30f;
                    if (jt == 4) v = (bl + cc >= 0) ? v : -1.0e30f;
                    sc[jt][r] = v; }
            if (q0 == 0) {
                const int lim = 128 - qs;
#pragma unroll
                for (int jt = 0; jt < 4; ++jt)
#pragma unroll
                    for (int r = 0; r < 16; ++r) { const int kr = crow(r, hi); sc[jt][r] = (32 * jt + kr >= lim) ? sc[jt][r] : -1.0e30f; }
            }
#pragma unroll
            for (int jt = 0; jt < 5; ++jt)
#pragma unroll
                for (int r = 0; r < 16; r += 2) mx = fmaxf(mx, fmaxf(sc[jt][r], sc[jt][r + 1]));
            mx = fmaxf(mx, __shfl_xor(mx, 32));
            float l = 0.f;
#pragma unroll
            for (int jt = 0; jt < 5; ++jt)
#pragma unroll
                for (int r = 0; r < 16; ++r) { const float p = __builtin_amdgcn_exp2f(sc[jt][r] - mx); sc[jt][r] = p; l += p; }
            l += __shfl_xor(l, 32); l += __builtin_amdgcn_exp2f(sink2 - mx);
            const float rl = __builtin_amdgcn_rcpf(l);
            f32x16 o[2];
#pragma unroll
            for (int dh = 0; dh < 2; ++dh) { o[dh] = (f32x16){0.f, 0.f, 0.f, 0.f, 0.f, 0.f, 0.f, 0.f, 0.f, 0.f, 0.f, 0.f, 0.f, 0.f, 0.f, 0.f}; }
#pragma unroll
            for (int jt = 0; jt < 5; ++jt)
#pragma unroll
                for (int j = 0; j < 2; ++j) { v4u pw; pw.x = pk2(sc[jt][8 * j + 0], sc[jt][8 * j + 1]); pw.y = pk2(sc[jt][8 * j + 2], sc[jt][8 * j + 3]); pw.z = pk2(sc[jt][8 * j + 4], sc[jt][8 * j + 5]); pw.w = pk2(sc[jt][8 * j + 6], sc[jt][8 * j + 7]);
                    const bf16x8 pf = __builtin_bit_cast(bf16x8, pw);
#pragma unroll
                    for (int dh = 0; dh < 2; ++dh) { const bf16x8 vf = *(const LAS bf16x8*)(lds + P2_VT + (32 * dh + l32) * P2_VROW + ((kt0 + jt) * 32 + 16 * j + 8 * hi) * 2);
                        o[dh] = __builtin_amdgcn_mfma_f32_32x32x16_bf16(vf, pf, o[dh], 0, 0, 0); } }
            float ss = 0.f;
            LAS unsigned char* ost = lds + P2_OST + wid * (32 * P2_OROW);
#pragma unroll
            for (int dh = 0; dh < 2; ++dh)
#pragma unroll
                for (int r4 = 0; r4 < 4; ++r4) { float a0 = o[dh][4 * r4] * rl, a1 = o[dh][4 * r4 + 1] * rl, a2 = o[dh][4 * r4 + 2] * rl, a3 = o[dh][4 * r4 + 3] * rl;
                    ss += (a0 * a0 + a1 * a1) + (a2 * a2 + a3 * a3);
                    v2u w; w.x = pk2(a0, a1); w.y = pk2(a2, a3);
                    *(LAS v2u*)(ost + l32 * P2_OROW + (32 * dh + 8 * r4 + 4 * hi) * 2) = w; }
            ss += __shfl_xor(ss, 32);
            if (hi == 0) __hip_atomic_fetch_add(rowss + qs + l32, ss, __ATOMIC_RELAXED, __HIP_MEMORY_SCOPE_WORKGROUP);
            asm volatile("s_waitcnt lgkmcnt(0)" ::: "memory");
#pragma unroll
            for (int i = 0; i < 4; ++i) { const int rr = i * 8 + (lane >> 3), ch = lane & 7; const v4u v = *(const LAS v4u*)(ost + rr * P2_OROW + ch * 16);
                bf16* ub = osc + (rowbase + q0 + qs + 8 * i) * OLD + h * HD; *(v4u*)(ub + ooffo) = v; }
            asm volatile("s_waitcnt lgkmcnt(0)" ::: "memory");
            __builtin_amdgcn_sched_barrier(0);
        }
    }
#undef P2_LOAD_KV
#undef P2_LOAD_Q
    asm volatile("s_waitcnt vmcnt(0)" ::: "memory");
    __syncthreads();
    LAS float* rstd = (LAS float*)(lds + P2_RSTD);
    if (tid < 128) rstd[tid] = 1.0f / sqrtf(rowss[tid] * (1.0f / DATTN) + EPS);
    __syncthreads();
    { int lf_ = lane_id_asm(); asm volatile("" : "+v"(lf_)); const int tid = wid * 64 + (lf_ & 63);
#pragma unroll 8
    for (int i = 0; i < 32; ++i) { const int rr = (tid >> 7) + 4 * i, ch = tid & 127; bf16* p = osc + (rowbase + q0 + rr) * OLD + ch * 8;
        float f[8]; unpack8(*(const v4u*)p, f); const float s = rstd[rr];
#pragma unroll
        for (int j = 0; j < 8; ++j) f[j] *= s;
        if (FP8O) *(v2u*)(mixed8 + (rowbase + q0 + rr) * D + DCONV + ch * 8) = pack8_f8(f, F8_ASCALE); else *(v4u*)p = pack8(f); } }
    if (!conv_first) {
    {
        int lc_ = lane_id_asm(); asm volatile("" : "+v"(lc_)); const int lane = lc_ & 63;
        const float* cw = P.conv_w; float w0[16], w1[16], w2[16];
#pragma unroll
        for (int j = 0; j < 16; ++j) { const int ch = (j >> 3) * 512 + lane * 8 + (j & 7); w0[j] = cw[ch]; w1[j] = cw[DCONV + ch]; w2[j] = cw[2 * DCONV + ch]; }
        float u1[16], u2[16];
        const int t0 = q0 + 16 * wid;
#pragma unroll
        for (int j = 0; j < 16; ++j) { u1[j] = 0.f; u2[j] = 0.f; }
        if (t0 >= 2) {
#pragma unroll
            for (int hf = 0; hf < 2; ++hf) { const int ch = hf * 512 + lane * 8; float c[8], hc[8];
                const bf16* pr = proj + (rowbase + t0 - 1) * DIN; unpack8(*(const v4u*)(pr + C_C + ch), c); unpack8(*(const v4u*)(pr + C_HC + ch), hc);
#pragma unroll
                for (int j = 0; j < 8; ++j) u1[hf * 8 + j] = c[j] * hc[j];
                pr -= DIN; unpack8(*(const v4u*)(pr + C_C + ch), c); unpack8(*(const v4u*)(pr + C_HC + ch), hc);
#pragma unroll
                for (int j = 0; j < 8; ++j) u2[hf * 8 + j] = c[j] * hc[j]; }
        }
#pragma unroll 1
        for (int r0 = 0; r0 < 16; r0 += CONVR) {
            v4u rb[CONVR][2], rc[CONVR][2], rh[CONVR][2];
#pragma unroll
            for (int rr = 0; rr < CONVR; ++rr) { const bf16* pr = proj + (rowbase + t0 + r0 + rr) * DIN + lane * 8;
#pragma unroll
                for (int hf = 0; hf < 2; ++hf) { rb[rr][hf] = *(const v4u*)(pr + C_B + hf * 512); rc[rr][hf] = *(const v4u*)(pr + C_C + hf * 512); rh[rr][hf] = *(const v4u*)(pr + C_HC + hf * 512); } }
#pragma unroll
            for (int rr = 0; rr < CONVR; ++rr) { float y[16]; float ss = 0.f;
#pragma unroll
                for (int hf = 0; hf < 2; ++hf) { float bb[8], c[8], hc[8]; unpack8(rb[rr][hf], bb); unpack8(rc[rr][hf], c); unpack8(rh[rr][hf], hc);
#pragma unroll
                    for (int j = 0; j < 8; ++j) { const int jj = hf * 8 + j; const float u0 = c[j] * hc[j];
                        y[jj] = bb[j] * (w0[jj] * u2[jj] + w1[jj] * u1[jj] + w2[jj] * u0); ss += y[jj] * y[jj]; u2[jj] = u1[jj]; u1[jj] = u0; } }
                ss = wsum(ss); const float rs = 1.0f / sqrtf(ss * (1.0f / DCONV) + EPS);
#pragma unroll
                for (int hf = 0; hf < 2; ++hf) { float f[8];
#pragma unroll
                    for (int j = 0; j < 8; ++j) f[j] = y[hf * 8 + j] * rs;
                    if (FP8O) *(v2u*)(mixed8 + (rowbase + t0 + r0 + rr) * D + hf * 512 + lane * 8) = pack8_f8(f, F8_ASCALE);
                    else *(v4u*)(mixed + (rowbase + t0 + r0 + rr) * D + hf * 512 + lane * 8) = pack8(f); } }
        }
    }
    }
}
constexpr int NPHASE = 10;
struct Args { Ptrs P; int ph_lo, ph_hi; };
__device__ __forceinline__ void moe_tables(LAS unsigned char* ldsx, gu32* ctl, const int wave_) {
    const int tid = TIDX(wave_);
    __syncthreads();
    if (tid < 64) {
        const int n = (int)__hip_atomic_load(ctl + CW_CNT + 64 * tid, RLX_AGENT);
        int x = (n + 255) >> 8;
#pragma unroll
        for (int o = 1; o < 64; o <<= 1) { const int v = __shfl_up(x, o); if (tid >= o) x += v; }
        ((LAS int*)(ldsx + pg8::LST_OFF))[tid] = n;
        ((LAS int*)(ldsx + pg8::LST_OFF + 256))[tid + 1] = x;
        if (tid == 0) ((LAS int*)(ldsx + pg8::LST_OFF + 256))[0] = 0;
    }
    __syncthreads();
}
__global__ void __launch_bounds__(NWAVES * 64, 2) mk_fwd(Args args) {
    extern __shared__ __attribute__((aligned(16))) unsigned char lds_raw[];
    LAS unsigned char* lds = (LAS unsigned char*)lds_raw;
    const Ptrs& P = args.P;
    const int wave = __builtin_amdgcn_readfirstlane((int)(threadIdx.x >> 6));
    const int tid = TIDX(wave);
    const int G = gridDim.x, bx = blockIdx.x, vcu = (G % 8 == 0) ? (bx % 8) * (G / 8) + bx / 8 : bx;
    unsigned char* ws = P.ws; gu32* ctl = (gu32*)(ws + WS_CTL);
    for (int u = tid; u < (pg8::LDS_BYTES - pg8::LDSX_OFF) / 4; u += NWAVES * 64) ((LAS unsigned*)(lds + pg8::LDSX_OFF))[u] = 0u;
    __syncthreads();
    const int lo = args.ph_lo, hi = args.ph_hi;
    XcdBarrier bar; bar.bar = (unsigned*)(ctl + CW_BAR); bar.x = 0; bar.st = nullptr;
    if (hi - lo > 1) bar = xcd_barrier_post((unsigned*)(ctl + CW_BAR), (volatile LAS unsigned*)(lds + pg8::MISC_OFF) + 8, wave);
#ifdef ONLY_PHASE
#define IN(k) ((k) == ONLY_PHASE && lo <= (k) && (k) < hi)
#else
#define IN(k) (lo <= (k) && (k) < hi)
#endif
#define SEAM(k) do { if (IN(k) && IN((k) + 1) && (k) != 7 && (k) != 8) xcd_barrier(bar, wave); } while (0)
#define SEAM79() do { if (IN(7) && IN(9)) xcd_barrier(bar, wave); } while (0)
    bf16* Win = (bf16*)(ws + WS_WIN); bf16* Wout = (bf16*)(ws + WS_WOUT); bf16* Wplg = (bf16*)(ws + WS_WPLG); bf16* Wple = (bf16*)(ws + WS_WPLE);
    bf16* Wr = (bf16*)(ws + WS_WR); bf16* Wgu = (bf16*)(ws + WS_WGU); bf16* Wd = (bf16*)(ws + WS_WD);
    bf16* xb = (bf16*)(ws + WS_XB); bf16* mixed = (bf16*)(ws + WS_MIX); bf16* pb = (bf16*)(ws + WS_PB); bf16* proj = (bf16*)(ws + WS_PROJ);
    bf16* hid = (bf16*)(ws + WS_HID); bf16* pw = (bf16*)(ws + WS_PW); bf16* h1 = (bf16*)(ws + WS_H1); bf16* h2 = (bf16*)(ws + WS_H2);
    float* rsx = (float*)(ws + WS_RSX); float* rs1 = (float*)(ws + WS_RS1); float* ss1p = (float*)(ws + WS_SS1P); float* ss2p = (float*)(ws + WS_SS2P);
    int* eid = (int*)(ws + WS_EID); float* ew = (float*)(ws + WS_EW); Ent* ent = (Ent*)(ws + WS_ENT);

    if (IN(0)) { p0_prologue(P, lds, vcu, G, wave); } SEAM(0);
    if (IN(1)) { pg8::Gemm g{xb, Win, M, FP8QKV ? C_Q : DIN, D}; pg8::StaticOrder S; S.init(M, FP8QKV ? C_Q : DIN, G, bx); pg8::EpiBf16 E{proj, DIN, nullptr, 1.f};
        pg8::gemm_phase<pg8::EpiBf16, pg8::StaticOrder, true>(lds, g, S, E, wave);
        if (FP8QKV) { pg8::Gemm g8{(const bf16*)(ws + WS_XB8), (const bf16*)(ws + WS_WIN8), M, NQKV, D / 2}; pg8::StaticOrder S8; S8.init(M, NQKV, G, bx); pg8::EpiBf16 E8{proj + C_Q, DIN, nullptr, F8_INV};
            pg8::gemm_phase<pg8::EpiBf16, pg8::StaticOrder, true, true>(lds, g8, S8, E8, wave); } } SEAM(1);
    if (IN(2)) { for (int unit = vcu; unit < BATCH * (SEQ / 128); unit += G) p2_unit(P, lds, unit, wave, (vcu & 1) != 0);     __syncthreads(); } SEAM(2);
    if (IN(3)) { pg8::Gemm g{FP8O ? (const bf16*)(ws + WS_MIX8) : mixed, Wout, M, D, FP8O ? D / 2 : D}; pg8::StaticOrder S; S.init(M, D, G, bx); pg8::EpiH1 E{xb, (const float*)(ws + WS_RMSX), h1, ss1p, FP8 ? ws + WS_H18 : nullptr, FP8O ? F8_INV : 1.f};
        pg8::gemm_phase<pg8::EpiH1, pg8::StaticOrder, true, FP8O != 0>(lds, g, S, E, wave); } SEAM(3);
    if (IN(4)) { pg8::Gemm g{h1, Wr, M, 256, D}; pg8::StaticOrder S; S.init(M, 256, G, bx); pg8::EpiRouter E{ss1p, P.b_group, P.b_router, rs1, eid, ew, ent, (unsigned*)(ctl + CW_CNT)};
        pg8::gemm_phase<pg8::EpiRouter, pg8::StaticOrder, false>(lds, g, S, E, wave);
        __syncthreads();
        pg8::Gemm g2{pb, Wple, M, D, PLE}; pg8::PwOrder S2{G, bx, M / 256}; pg8::EpiBf16 E2{pw, D, nullptr, 1.f};
        pg8::gemm_phase<pg8::EpiBf16, pg8::PwOrder, true>(lds, g2, S2, E2, wave); } SEAM(4);
    if (IN(5) || IN(6) || IN(7)) moe_tables(lds, ctl, wave);
    const LAS int* T0 = (const LAS int*)(lds + pg8::LST_OFF + 256);
    if (IN(5)) { pg8::Gemm g{FP8 ? (const bf16*)(ws + WS_H18) : h1, Wgu, M, NE * 1024, FP8 ? D / 2 : D}; pg8::MoeOrder<true, 4> S{lds, ent, 0, T0[NLIST], G, vcu, wave}; pg8::EpiGU E{hid, lds, FP8 ? F8_INV : 1.f, FP8 ? (unsigned char*)hid : nullptr};
        pg8::gemm_phase<pg8::EpiGU, pg8::MoeOrder<true, 4>, true, FP8 != 0>(lds, g, S, E, wave); } SEAM(5);
    if (IN(6)) { pg8::Gemm g{hid, Wd, 0, NE * D, FP8 ? DEXP / 2 : DEXP}; pg8::MoeOrder<false, 8> S{lds, ent, 0, T0[NE], G, vcu, wave}; pg8::EpiDown<0> E{h1, h2, nullptr, lds, nullptr, FP8 ? F8_DINV : 1.f};
        pg8::gemm_phase<pg8::EpiDown<0>, pg8::MoeOrder<false, 8>, true, FP8 != 0>(lds, g, S, E, wave); } SEAM(6);
    if (IN(7)) { pg8::Gemm g{hid, Wd, 0, NE * D, FP8 ? DEXP / 2 : DEXP}; pg8::MoeOrder<false, 8> S{lds, ent, T0[NE], T0[NLIST], G, vcu, wave}; pg8::EpiDown<1> E{h2, h2, ss2p, lds, FP8 ? ws + WS_H28 : nullptr, FP8 ? F8_DINV : 1.f};
        pg8::gemm_phase<pg8::EpiDown<1>, pg8::MoeOrder<false, 8>, true, FP8 != 0>(lds, g, S, E, wave); } SEAM79();
    if (IN(9)) { pg8::Gemm g{FP8 ? (const bf16*)(ws + WS_H28) : h2, Wplg, M, D, FP8 ? D / 2 : D}; pg8::FinalOrder S; S.init(M, D, G, bx); S.ldsx = lds; S.ssp = ss2p; S.wave = wave; pg8::EpiFinal E{h2, pw, P.out, lds, FP8 ? F8_INV : 1.f};
        pg8::gemm_phase<pg8::EpiFinal, pg8::FinalOrder, true, FP8 != 0>(lds, g, S, E, wave); }
#undef IN
#undef SEAM
}
namespace nv {
struct RmId { __device__ int operator()(int n) const { return n; } };
struct RmOff { int off; __device__ int operator()(int n) const { return n + off; } };
struct RmGate { __device__ int operator()(int n) const { return (n >> 7) * 256 + (n & 127); } };
struct RmUp { __device__ int operator()(int n) const { return (n >> 7) * 256 + 128 + (n & 127); } };
template <class RM> __global__ void __launch_bounds__(256) wt(const float* W, int K, int N, const float* g0, const float* g1, int gsplit, bf16* WT, RM rm, size_t wstride, size_t tstride) {
    const size_t i = blockIdx.x * (size_t)blockDim.x + threadIdx.x; if (i >= (size_t)K * N) return;
    const int n = (int)(i / K), k = (int)(i % K);
    const float* Wz = W + blockIdx.y * wstride; bf16* Tz = WT + blockIdx.y * tstride;
    const float g = g0 ? (k < gsplit ? g0[k] : g1[k - gsplit]) : 1.f;
    Tz[(size_t)rm(n) * K + k] = f2bf(g * Wz[(size_t)k * N + n]);
}
__global__ void __launch_bounds__(256) zero_rows(bf16* p, size_t n) { const size_t i = blockIdx.x * (size_t)blockDim.x + threadIdx.x; if (i < n) p[i] = 0; }
__global__ void __launch_bounds__(256) rowcvt(const float* x, bf16* xb, float* rs) {
    const int lane = threadIdx.x & 63; const int row = blockIdx.x * 4 + (threadIdx.x >> 6); if (row >= M) return;
    float s = 0.f;
    for (int c = lane; c < D; c += 64) { const float v = x[(size_t)row * D + c]; s += v * v; xb[(size_t)row * D + c] = f2bf(v); }
    s = wsum(s); if (lane == 0) rs[row] = 1.0f / sqrtf(s / D + EPS);
}
__global__ void __launch_bounds__(256) cvt(const float* p, bf16* pb, size_t n) { const size_t i = blockIdx.x * (size_t)blockDim.x + threadIdx.x; if (i < n) pb[i] = f2bf(p[i]); }
__global__ void __launch_bounds__(256) rowrs(const bf16* h, float* rs) {
    const int lane = threadIdx.x & 63; const int row = blockIdx.x * 4 + (threadIdx.x >> 6); if (row >= M) return;
    float s = 0.f;
    for (int c = lane; c < D; c += 64) { const float v = bf2f(h[(size_t)row * D + c]); s += v * v; }
    s = wsum(s); if (lane == 0) rs[row] = 1.0f / sqrtf(s / D + EPS);
}
template <int K, int NC, class AP, class BP, class EP>
__global__ void __launch_bounds__(256) gemm(long nrows, long ncols_, AP ap, BP bp, EP ep) {
    const int ncols = (int)ncols_;
    const int lane = threadIdx.x & 63; const long wave = blockIdx.x * 4L + (threadIdx.x >> 6);
    const int ngrp = ncols / NC; if (wave >= nrows * ngrp) return;
    const long r = wave / ngrp; const int c0 = (int)(wave % ngrp) * NC;
    constexpr int NCH = (K + 511) / 512;
    float a[NCH][8];
    const bf16* A = ap(r);
#pragma unroll
    for (int ch = 0; ch < NCH; ++ch) { const int k = ch * 512 + lane * 8;
        if (k < K) unpack8(*(const v4u*)(A + k), a[ch]); else { for (int j = 0; j < 8; ++j) a[ch][j] = 0.f; } }
    float res[NC];
#pragma unroll
    for (int c = 0; c < NC; ++c) {
        const bf16* B = bp(r, c0 + c); float s = 0.f;
#pragma unroll
        for (int ch = 0; ch < NCH; ++ch) { const int k = ch * 512 + lane * 8;
            if (k < K) { float b[8]; unpack8(*(const v4u*)(B + k), b);
#pragma unroll
                for (int j = 0; j < 8; ++j) s += a[ch][j] * b[j]; } }
        res[c] = wsum(s);
    }
    if (lane == 0) {
#pragma unroll
        for (int c = 0; c < NC; ++c) ep(r, c0 + c, res[c], res[c ^ 1]);
    }
}
__global__ void __launch_bounds__(256) conv(const bf16* proj, const float* cw, bf16* mixed) {
    const int lane = threadIdx.x & 63; const int row = blockIdx.x * 4 + (threadIdx.x >> 6); if (row >= M) return;
    const int t = row % SEQ; float y[16]; float ss = 0.f;
#pragma unroll
    for (int j = 0; j < 16; ++j) {
        const int ch = lane * 16 + j; const bf16* pr = proj + (size_t)row * DIN;
        const float b = bf2f(pr[C_B + ch]);
        const float u0 = bf2f(pr[C_C + ch]) * bf2f(pr[C_HC + ch]);
        const float u1 = t >= 1 ? bf2f(pr[C_C + ch - DIN]) * bf2f(pr[C_HC + ch - DIN]) : 0.f;
        const float u2 = t >= 2 ? bf2f(pr[C_C + ch - 2 * DIN]) * bf2f(pr[C_HC + ch - 2 * DIN]) : 0.f;
        y[j] = b * (cw[ch] * u2 + cw[DCONV + ch] * u1 + cw[2 * DCONV + ch] * u0); ss += y[j] * y[j];
    }
    ss = wsum(ss); const float rstd = 1.0f / sqrtf(ss / DCONV + EPS);
#pragma unroll
    for (int j = 0; j < 16; ++j) mixed[(size_t)row * D + lane * 16 + j] = f2bf(y[j] * rstd);
}
__global__ void __launch_bounds__(256) attn(const bf16* proj, const float* qn, const float* kn, const float* sinks, float* ya) {
    const int lane = threadIdx.x & 63; const long wave = blockIdx.x * 4L + (threadIdx.x >> 6); if (wave >= (long)M * NH) return;
    const int row = (int)(wave / NH), h = (int)(wave % NH), kvh = h / (NH / NKV), t = row % SEQ;
    float q = bf2f(proj[(size_t)row * DIN + C_Q + h * HD + lane]);
    const float rq = 1.0f / sqrtf(wsum(q * q) / HD + EPS); q = q * rq * qn[lane];
    const float gk = kn[lane]; const float slope = exp2f(-0.5f * (float)(h + 1)); const float sink = sinks[h];
    float m = sink, l = 1.f, o = 0.f;
    const int s0 = t >= 127 ? t - 127 : 0;
    for (int s = s0; s <= t; ++s) {
        const size_t kr = (size_t)(row - (t - s)) * DIN;
        const float k = bf2f(proj[kr + C_K + kvh * HD + lane]); const float v = bf2f(proj[kr + C_V + kvh * HD + lane]);
        const float kk = wsum(k * k); const float rk = 1.0f / sqrtf(kk / HD + EPS);
        const float dot = wsum(q * k * gk) * rk;
        const float sc = dot * 0.125f - slope * (float)(t - s);
        const float mn = fmaxf(m, sc); const float f = __expf(m - mn), pe = __expf(sc - mn);
        l = l * f + pe; o = o * f + pe * v; m = mn;
    }
    ya[(size_t)row * DATTN + h * HD + lane] = o / l;
}
__global__ void __launch_bounds__(256) attnnorm(const float* ya, bf16* mixed) {
    const int lane = threadIdx.x & 63; const int row = blockIdx.x * 4 + (threadIdx.x >> 6); if (row >= M) return;
    float y[16]; float ss = 0.f;
#pragma unroll
    for (int j = 0; j < 16; ++j) { y[j] = ya[(size_t)row * DATTN + lane * 16 + j]; ss += y[j] * y[j]; }
    ss = wsum(ss); const float rstd = 1.0f / sqrtf(ss / DATTN + EPS);
#pragma unroll
    for (int j = 0; j < 16; ++j) mixed[(size_t)row * D + DCONV + lane * 16 + j] = f2bf(y[j] * rstd);
}
__global__ void __launch_bounds__(256) topk(const float* logits, int* eid, float* ew) {
    const int row = blockIdx.x * blockDim.x + threadIdx.x; if (row >= M) return;
    const float* L = logits + (size_t)row * 64;
    int g = 0; float gm = L[0];
    for (int j = 1; j < NGRP; ++j) if (L[j] > gm) { gm = L[j]; g = j; }
    float gs = 0.f; for (int j = 0; j < NGRP; ++j) gs += __expf(L[j] - gm);
    const float gw = 1.0f / gs;
    const float* E = L + NGRP + g * EPG;
    int i1 = 0; float v1 = E[0];
    for (int j = 1; j < EPG; ++j) if (E[j] > v1) { v1 = E[j]; i1 = j; }
    int i2 = -1; float v2 = -3.0e38f;
    for (int j = 0; j < EPG; ++j) if (j != i1 && E[j] > v2) { v2 = E[j]; i2 = j; }
    const float e2 = __expf(v2 - v1); const float w1 = 1.0f / (1.0f + e2), w2 = e2 / (1.0f + e2);
    eid[row * 2] = g * EPG + i1; eid[row * 2 + 1] = g * EPG + i2; ew[row * 2] = gw * w1; ew[row * 2 + 1] = gw * w2;
}

__global__ void __launch_bounds__(256) rs_to_part(const float* rs, float* part) {
    const int i = blockIdx.x * blockDim.x + threadIdx.x; if (i >= M * 32) return; const int row = i >> 5, j = i & 31;
    const float r = rs[row]; part[i] = j == 0 ? (1.0f / (r * r) - EPS) * (float)D : 0.f;
}
__global__ void __launch_bounds__(256) part_to_rs(const float* part, float* rs) {
    const int row = blockIdx.x * blockDim.x + threadIdx.x; if (row >= M) return; float s = 0.f;
    for (int j = 0; j < 32; ++j) s += part[(size_t)row * 32 + j];
    rs[row] = 1.0f / sqrtf(s / D + EPS);
}
__global__ void __launch_bounds__(256) build_lists(const int* eid, const float* ew, const float* rs1, Ent* ent, unsigned* cnt) {
    const int i = blockIdx.x * blockDim.x + threadIdx.x; if (i >= M * 2) return; const int tok = i >> 1, k = i & 1;
    const int l = k * NE + eid[i]; const unsigned slot = atomicAdd(cnt + 64 * l, 1u);
    Ent e; e.tok = tok; e.w = ew[i]; e.rs = rs1[tok]; e.pad = 0; ent[(size_t)l * LCAP + slot] = e;
}
}

#ifndef MK_MASK
#define MK_MASK 0x3ff
#endif
#ifndef MK_SPLIT
#define MK_SPLIT 0
#endif
template <class K, class... A> static void launch1d(K kern, size_t nthreads, int bs, hipStream_t s, A... args) {
    hipLaunchKernelGGL(kern, dim3((unsigned)((nthreads + bs - 1) / bs)), dim3(bs), 0, s, args...);
}
static void nv_stage(int st, const Ptrs& P, hipStream_t stream) {
    unsigned char* ws = P.ws;
    bf16* Win = (bf16*)(ws + WS_WIN); bf16* Wout = (bf16*)(ws + WS_WOUT); bf16* Wplg = (bf16*)(ws + WS_WPLG); bf16* Wple = (bf16*)(ws + WS_WPLE);
    bf16* Wr = (bf16*)(ws + WS_WR); bf16* Wgu = (bf16*)(ws + WS_WGU); bf16* Wd = (bf16*)(ws + WS_WD);
    bf16* xb = (bf16*)(ws + WS_XB); bf16* mixed = (bf16*)(ws + WS_MIX); bf16* pb = (bf16*)(ws + WS_PB); bf16* proj = (bf16*)(ws + WS_PROJ);
    bf16* hid = (bf16*)(ws + WS_HID); bf16* pw = (bf16*)(ws + WS_PW); bf16* h1 = (bf16*)(ws + WS_H1); bf16* h2 = (bf16*)(ws + WS_H2);
    float* rsx = (float*)(ws + WS_RSX); float* rs1 = (float*)(ws + WS_RS1); float* rs2 = (float*)(ws + WS_RS2);
    int* eid = (int*)(ws + WS_EID); float* ew = (float*)(ws + WS_EW); float* logits = (float*)(ws + WS_LOG); float* ya = (float*)(ws + WS_YA);
    const float* nul = nullptr;
    if (st == 0) {
        hipLaunchKernelGGL(nv::wt<nv::RmId>, dim3((unsigned)(((size_t)D * DIN + 255) / 256), 1), dim3(256), 0, stream, P.w_in, D, DIN, P.norm_mix, nul, D, Win, nv::RmId{}, (size_t)0, (size_t)0);
        hipLaunchKernelGGL(nv::wt<nv::RmId>, dim3((unsigned)(((size_t)D * D + 255) / 256), 1), dim3(256), 0, stream, P.w_out, D, D, P.onc, P.ona, DCONV, Wout, nv::RmId{}, (size_t)0, (size_t)0);
        hipLaunchKernelGGL(nv::wt<nv::RmId>, dim3((unsigned)(((size_t)D * D + 255) / 256), 1), dim3(256), 0, stream, P.w_ple_gate, D, D, P.norm_ple, nul, D, Wplg, nv::RmId{}, (size_t)0, (size_t)0);
        hipLaunchKernelGGL(nv::wt<nv::RmId>, dim3((unsigned)(((size_t)PLE * D + 255) / 256), 1), dim3(256), 0, stream, P.w_ple, PLE, D, nul, nul, 0, Wple, nv::RmId{}, (size_t)0, (size_t)0);
        hipLaunchKernelGGL(nv::wt<nv::RmId>, dim3((unsigned)(((size_t)D * NGRP + 255) / 256), 1), dim3(256), 0, stream, P.w_group, D, NGRP, P.norm_ffn, nul, D, Wr, nv::RmId{}, (size_t)0, (size_t)0);
        hipLaunchKernelGGL(nv::wt<nv::RmOff>, dim3((unsigned)(((size_t)D * NE + 255) / 256), 1), dim3(256), 0, stream, P.w_router, D, NE, P.norm_ffn, nul, D, Wr, nv::RmOff{NGRP}, (size_t)0, (size_t)0);
        launch1d(nv::zero_rows, (size_t)(256 - NRT) * D, 256, stream, Wr + (size_t)NRT * D, (size_t)(256 - NRT) * D);
        hipLaunchKernelGGL(nv::wt<nv::RmGate>, dim3((unsigned)(((size_t)D * DEXP + 255) / 256), NE), dim3(256), 0, stream, P.w_gate, D, DEXP, P.norm_ffn, nul, D, Wgu, nv::RmGate{}, (size_t)D * DEXP, (size_t)1024 * D);
        hipLaunchKernelGGL(nv::wt<nv::RmUp>, dim3((unsigned)(((size_t)D * DEXP + 255) / 256), NE), dim3(256), 0, stream, P.w_up, D, DEXP, P.norm_ffn, nul, D, Wgu, nv::RmUp{}, (size_t)D * DEXP, (size_t)1024 * D);
        hipLaunchKernelGGL(nv::wt<nv::RmId>, dim3((unsigned)(((size_t)DEXP * D + 255) / 256), NE), dim3(256), 0, stream, P.w_down, DEXP, D, nul, nul, 0, Wd, nv::RmId{}, (size_t)DEXP * D, (size_t)D * DEXP);
        hipLaunchKernelGGL(nv::rowcvt, dim3(M / 4), dim3(256), 0, stream, P.x, xb, rsx);
        launch1d(nv::cvt, (size_t)M * PLE, 256, stream, P.p, pb, (size_t)M * PLE);
    } else if (st == 1) {
        auto ap = [=] __device__(long r) { return xb + (size_t)r * D; };
        auto bp = [=] __device__(long r, int c) { return Win + (size_t)c * D; };
        auto ep = [=] __device__(long r, int c, float v, float vo) { proj[(size_t)r * DIN + c] = f2bf(v * rsx[r]); };
        hipLaunchKernelGGL((nv::gemm<D, 8, decltype(ap), decltype(bp), decltype(ep)>), dim3((unsigned)((size_t)M * (DIN / 8) / 4)), dim3(256), 0, stream, (long)M, (long)DIN, ap, bp, ep);
    } else if (st == 2) {
        hipLaunchKernelGGL(nv::conv, dim3(M / 4), dim3(256), 0, stream, proj, P.conv_w, mixed);
        hipLaunchKernelGGL(nv::attn, dim3((unsigned)((size_t)M * NH / 4)), dim3(256), 0, stream, proj, P.q_norm, P.k_norm, P.sinks, ya);
        hipLaunchKernelGGL(nv::attnnorm, dim3(M / 4), dim3(256), 0, stream, ya, mixed);
    } else if (st == 3) {
        const float* x = P.x;
        auto ap = [=] __device__(long r) { return mixed + (size_t)r * D; };
        auto bp = [=] __device__(long r, int c) { return Wout + (size_t)c * D; };
        auto ep = [=] __device__(long r, int c, float v, float vo) { h1[(size_t)r * D + c] = f2bf(x[(size_t)r * D + c] + v); };
        hipLaunchKernelGGL((nv::gemm<D, 8, decltype(ap), decltype(bp), decltype(ep)>), dim3((unsigned)((size_t)M * (D / 8) / 4)), dim3(256), 0, stream, (long)M, (long)D, ap, bp, ep);
        hipLaunchKernelGGL(nv::rowrs, dim3(M / 4), dim3(256), 0, stream, h1, rs1);
    } else if (st == 4) {
        const float* bg = P.b_group; const float* br = P.b_router;
        auto ap = [=] __device__(long r) { return h1 + (size_t)r * D; };
        auto bp = [=] __device__(long r, int c) { return Wr + (size_t)c * D; };
        auto ep = [=] __device__(long r, int c, float v, float vo) { logits[(size_t)r * 64 + c] = v * rs1[r] + (c < NGRP ? bg[c] : br[c - NGRP]); };
        hipLaunchKernelGGL((nv::gemm<D, 4, decltype(ap), decltype(bp), decltype(ep)>), dim3((unsigned)((size_t)M * (NRT / 4) / 4)), dim3(256), 0, stream, (long)M, (long)NRT, ap, bp, ep);
        launch1d(nv::topk, (size_t)M, 256, stream, logits, eid, ew);
    } else if (st == 5) {
        auto ap = [=] __device__(long r) { return h1 + (size_t)(r >> 1) * D; };
        auto bp = [=] __device__(long r, int c) { const int e = eid[r]; const int f = c >> 1; const int rowi = (f >> 7) * 256 + (c & 1) * 128 + (f & 127); return Wgu + ((size_t)e * 1024 + rowi) * D; };
        auto ep = [=] __device__(long r, int c, float v, float vo) {
            if (c & 1) { const float rs = rs1[r >> 1]; const int f = c >> 1; const float g = vo * rs, u = v * rs; hid[(size_t)r * DEXP + f] = f2bf(ew[r] * (g / (1.0f + __expf(-g))) * u); } };
        hipLaunchKernelGGL((nv::gemm<D, 8, decltype(ap), decltype(bp), decltype(ep)>), dim3((unsigned)((size_t)M * 2 * (1024 / 8) / 4)), dim3(256), 0, stream, (long)M * 2, (long)1024, ap, bp, ep);
    } else if (st == 6 || st == 7) {
        const long k = st - 6; const bf16* base = k == 0 ? h1 : h2;
        auto ap = [=] __device__(long r) { return hid + (size_t)(r * 2 + k) * DEXP; };
        auto bp = [=] __device__(long r, int c) { const int e = eid[r * 2 + k]; return Wd + ((size_t)e * D + c) * DEXP; };
        auto ep = [=] __device__(long r, int c, float v, float vo) { h2[(size_t)r * D + c] = f2bf(bf2f(base[(size_t)r * D + c]) + v); };
        hipLaunchKernelGGL((nv::gemm<DEXP, 8, decltype(ap), decltype(bp), decltype(ep)>), dim3((unsigned)((size_t)M * (D / 8) / 4)), dim3(256), 0, stream, (long)M, (long)D, ap, bp, ep);
        if (st == 7) hipLaunchKernelGGL(nv::rowrs, dim3(M / 4), dim3(256), 0, stream, h2, rs2);
    } else if (st == 8) {
        auto ap = [=] __device__(long r) { return pb + (size_t)r * PLE; };
        auto bp = [=] __device__(long r, int c) { return Wple + (size_t)c * PLE; };
        auto ep = [=] __device__(long r, int c, float v, float vo) { pw[(size_t)r * D + c] = f2bf(v); };
        hipLaunchKernelGGL((nv::gemm<PLE, 8, decltype(ap), decltype(bp), decltype(ep)>), dim3((unsigned)((size_t)M * (D / 8) / 4)), dim3(256), 0, stream, (long)M, (long)D, ap, bp, ep);
    } else if (st == 9) {
        float* out = P.out;
        auto ap = [=] __device__(long r) { return h2 + (size_t)r * D; };
        auto bp = [=] __device__(long r, int c) { return Wplg + (size_t)c * D; };
        auto ep = [=] __device__(long r, int c, float v, float vo) { const float z = v * rs2[r]; out[(size_t)r * D + c] = bf2f(h2[(size_t)r * D + c]) + (1.0f / (1.0f + __expf(-z))) * bf2f(pw[(size_t)r * D + c]); };
        hipLaunchKernelGGL((nv::gemm<D, 8, decltype(ap), decltype(bp), decltype(ep)>), dim3((unsigned)((size_t)M * (D / 8) / 4)), dim3(256), 0, stream, (long)M, (long)D, ap, bp, ep);
    }
}

extern "C" void kernel_launch(void* const* d_in, const int* in_sizes, int n_in, void* d_out, int out_size, void* d_ws, size_t ws_size, hipStream_t stream) {
    static int grid = 0;
    if (grid == 0) {
        if (n_in != 22 || in_sizes[0] != M * D || out_size != M * D || ws_size < WS_END) { fprintf(stderr, "kernel_launch: unexpected problem (n_in %d, in0 %d, out %d, ws %zu); nothing launched\n", n_in, n_in > 0 ? in_sizes[0] : -1, out_size, ws_size); grid = -1; return; }
        int dev = 0, cus = 0, per_cu = 0;
        if (hipGetDevice(&dev) != hipSuccess || hipDeviceGetAttribute(&cus, hipDeviceAttributeMultiprocessorCount, dev) != hipSuccess) { grid = -1; return; }
        if (hipFuncSetAttribute((const void*)mk_fwd, hipFuncAttributeMaxDynamicSharedMemorySize, pg8::LDS_BYTES) != hipSuccess) { fprintf(stderr, "kernel_launch: hipFuncSetAttribute failed\n"); grid = -1; return; }
        if (hipOccupancyMaxActiveBlocksPerMultiprocessor(&per_cu, (const void*)mk_fwd, NWAVES * 64, pg8::LDS_BYTES) != hipSuccess || per_cu < 1) { fprintf(stderr, "kernel_launch: occupancy query says %d blocks per CU\n", per_cu); (void)hipGetLastError(); grid = -1; return; }
        grid = cus;
    }
    if (grid < 0) return;
    if (hipMemsetAsync((char*)d_ws + WS_CTL, 0, CTL_ZERO_BYTES, stream) != hipSuccess) return;
    Args a{};
    { const float** pp = (const float**)&a.P; for (int i = 0; i < 22; ++i) pp[i] = (const float*)d_in[i]; }
    a.P.out = (float*)d_out; a.P.ws = (unsigned char*)d_ws;
    unsigned char* ws = a.P.ws;
    const unsigned mask = MK_MASK;
    auto is_mk = [&](int s) { return ((mask >> s) & 1u) != 0u; };
    int s = 0;
    while (s < NPHASE) {
        if (is_mk(s)) {
            int e = s + 1; if (!MK_SPLIT) while (e < NPHASE && is_mk(e)) ++e;
            if (s == 4 && !is_mk(3)) launch1d(nv::rs_to_part, (size_t)M * 32, 256, stream, (const float*)(ws + WS_RS1), (float*)(ws + WS_SS1P));
            if (s >= 5 && s <= 7 && !is_mk(4) && s == 5) launch1d(nv::build_lists, (size_t)M * 2, 256, stream, (const int*)(ws + WS_EID), (const float*)(ws + WS_EW), (const float*)(ws + WS_RS1), (Ent*)(ws + WS_ENT), (unsigned*)(ws + WS_CTL) + CW_CNT);
            if (s == 9 && !is_mk(7)) launch1d(nv::rs_to_part, (size_t)M * 32, 256, stream, (const float*)(ws + WS_RS2), (float*)(ws + WS_SS2P));
            a.ph_lo = s; a.ph_hi = e;
            hipLaunchKernelGGL(mk_fwd, dim3(grid), dim3(NWAVES * 64), pg8::LDS_BYTES, stream, a);
            s = e;
        } else {
            if (s == 4 && is_mk(3)) launch1d(nv::part_to_rs, (size_t)M, 256, stream, (const float*)(ws + WS_SS1P), (float*)(ws + WS_RS1));
            if (s == 9 && is_mk(7)) launch1d(nv::part_to_rs, (size_t)M, 256, stream, (const float*)(ws + WS_SS2P), (float*)(ws + WS_RS2));
            nv_stage(s, a.P, stream);
            if (s == 4 && is_mk(8)) nv_stage(8, a.P, stream);
            ++s;
        }
    }
}
```

```cpp
#include <hip/hip_runtime.h>
#include <cstdio>
#include <cstdint>

typedef unsigned short bf16;
typedef unsigned v4u __attribute__((ext_vector_type(4)));
typedef unsigned v2u __attribute__((ext_vector_type(2)));
typedef float f32x4 __attribute__((ext_vector_type(4)));
typedef float f32x16 __attribute__((ext_vector_type(16)));
typedef short bf16x8 __attribute__((ext_vector_type(8)));
#define GAS __attribute__((address_space(1)))
#define LAS __attribute__((address_space(3)))
typedef GAS unsigned gu32;

constexpr int BATCH = 4, SEQ = 8192, D = 2048, M = BATCH * SEQ;
constexpr int DCONV = 1024, NH = 16, NKV = 4, HD = 64, DATTN = 1024, DKV = 256, DIN = 4608;
constexpr int C_B = 0, C_C = 1024, C_HC = 2048, C_Q = 3072, C_K = 4096, C_V = 4352;
constexpr int NGRP = 4, EPG = 8, NE = 32, DEXP = 512, PLE = 256, NRT = 36;
constexpr int NLIST = 64, LCAP = 32768;
constexpr float EPS = 1e-6f;
constexpr float LOG2E = 1.4426950408889634f;

constexpr size_t MiB = 1u << 20;
constexpr size_t WS_CTL = 0, CTL_ZERO_BYTES = 1 * MiB;
constexpr size_t WS_WIN = 2 * MiB;
constexpr size_t WS_WOUT = 20 * MiB;
constexpr size_t WS_WPLG = 28 * MiB;
constexpr size_t WS_WPLE = 36 * MiB;
constexpr size_t WS_WR = 37 * MiB;
constexpr size_t WS_RSX = 38 * MiB;
constexpr size_t WS_RS1 = 38 * MiB + 256 * 1024;
constexpr size_t WS_RS2 = 38 * MiB + 512 * 1024;
constexpr size_t WS_RMSX = 38 * MiB + 768 * 1024;
constexpr size_t WS_EID = 39 * MiB;
constexpr size_t WS_EW = 39 * MiB + 512 * 1024;
constexpr size_t WS_LOG = 42 * MiB;
constexpr size_t WS_SS1P = 50 * MiB;
constexpr size_t WS_SS2P = 54 * MiB;
#ifndef FP8
#define FP8 1
#endif
#ifndef FP8O
#define FP8O 0
#endif
constexpr size_t WS_MIX8 = 816 * MiB;
#ifndef FP8QKV
#define FP8QKV 0
#endif
constexpr size_t WS_XB8 = 128 * MiB;
constexpr size_t WS_WIN8 = 20 * MiB - 3 * MiB;
constexpr int NQKV = DATTN + 2 * DKV;
constexpr float F8_ASCALE = 16.f, F8_WSCALE = 32.f, F8_INV = 1.0f / (16.f * 32.f);
constexpr float F8_HSCALE = 16.f, F8_DSCALE = 16.f, F8_DINV = 1.0f / (16.f * 16.f);
constexpr float F8_PSCALE = 16.f, F8_PINV = 1.0f / 16.f;
constexpr float F8_YSCALE = 64.f, F8_YINV = 1.0f / 64.f;
constexpr size_t WS_WGU = 64 * MiB;
constexpr size_t WS_H18 = 128 * MiB;
constexpr size_t WS_H28 = 608 * MiB;
constexpr size_t WS_WD = 192 * MiB;
constexpr size_t WS_XB = 256 * MiB;
constexpr size_t WS_MIX = 816 * MiB;
constexpr size_t WS_PB = 384 * MiB;
constexpr size_t WS_PROJ = 400 * MiB;
constexpr size_t WS_HID = 400 * MiB;
constexpr size_t WS_PW = 480 * MiB;
constexpr size_t WS_H1 = 688 * MiB;
constexpr size_t WS_H2 = 816 * MiB;
constexpr size_t WS_YA = 688 * MiB;
constexpr size_t WS_ENT = 944 * MiB;
constexpr size_t WS_END = 976 * MiB;
constexpr int CW_TMO = 0, CW_BAR = 4096, CW_CNT = 8192, CW_ZERO = 16384;

__device__ __forceinline__ float bf2f(bf16 v) { return __uint_as_float(((unsigned)v) << 16); }
__device__ __forceinline__ unsigned f2bfu(float f) { unsigned u = __float_as_uint(f); return (u + 0x7fffu + ((u >> 16) & 1u)) >> 16; }
__device__ __forceinline__ bf16 f2bf(float f) { return (bf16)f2bfu(f); }
typedef float f32x2_t __attribute__((ext_vector_type(2))); typedef __bf16 bf16x2_t __attribute__((ext_vector_type(2)));
__device__ __forceinline__ unsigned pk2(float lo, float hi) { const f32x2_t v = {lo, hi}; const bf16x2_t b = __builtin_convertvector(v, bf16x2_t); return __builtin_bit_cast(unsigned, b); }
__device__ __forceinline__ float xsum32(float v) { const auto r = __builtin_amdgcn_permlane32_swap(__float_as_uint(v), __float_as_uint(v), false, false); return __uint_as_float(r[0]) + __uint_as_float(r[1]); }
__device__ __forceinline__ float xmax32(float v) { const auto r = __builtin_amdgcn_permlane32_swap(__float_as_uint(v), __float_as_uint(v), false, false); return fmaxf(__uint_as_float(r[0]), __uint_as_float(r[1])); }
__device__ __forceinline__ float rsqf(float x) { return __builtin_amdgcn_rsqf(x); }
__device__ __forceinline__ float wsum(float v) {
#pragma unroll
    for (int o = 32; o > 0; o >>= 1) v += __shfl_xor(v, o);
    return v;
}
__device__ __forceinline__ void unpack8(v4u w, float* f) {
    f[0] = __uint_as_float(w.x << 16); f[1] = __uint_as_float(w.x & 0xffff0000u);
    f[2] = __uint_as_float(w.y << 16); f[3] = __uint_as_float(w.y & 0xffff0000u);
    f[4] = __uint_as_float(w.z << 16); f[5] = __uint_as_float(w.z & 0xffff0000u);
    f[6] = __uint_as_float(w.w << 16); f[7] = __uint_as_float(w.w & 0xffff0000u);
}
__device__ __forceinline__ v2u pack8_f8(const float* f, float sc) {
    float c[8];
#pragma unroll
    for (int j = 0; j < 8; ++j) c[j] = __builtin_amdgcn_fmed3f(f[j] * sc, -448.f, 448.f);
    int lo = 0, hi = 0;
    lo = __builtin_amdgcn_cvt_pk_fp8_f32(c[0], c[1], lo, false); lo = __builtin_amdgcn_cvt_pk_fp8_f32(c[2], c[3], lo, true);
    hi = __builtin_amdgcn_cvt_pk_fp8_f32(c[4], c[5], hi, false); hi = __builtin_amdgcn_cvt_pk_fp8_f32(c[6], c[7], hi, true);
    v2u o; o.x = (unsigned)lo; o.y = (unsigned)hi; return o;
}
__device__ __forceinline__ v4u pack8(const float* f) { v4u o; o.x = pk2(f[0], f[1]); o.y = pk2(f[2], f[3]); o.z = pk2(f[4], f[5]); o.w = pk2(f[6], f[7]); return o; }

__device__ __forceinline__ int lane_id_asm() { int l; asm volatile("v_mbcnt_lo_u32_b32 %0, -1, 0\n\tv_mbcnt_hi_u32_b32 %0, -1, %0" : "=v"(l)); return l & 63; }
__device__ __forceinline__ int lane_id() { return lane_id_asm(); }
#define TIDX(wave_) (((wave_) & 7) * 64 + lane_id_asm())

#ifndef DEFER_CVT
#define DEFER_CVT 1
#endif
#ifndef CVT_SLOTS
#define CVT_SLOTS 8
#endif
#ifndef CVT_SPLIT
#define CVT_SPLIT 0
#endif
struct Ptrs {
    const float *x, *p, *norm_mix, *w_in, *conv_w, *q_norm, *k_norm, *sinks, *onc, *ona, *w_out, *norm_ffn, *w_group, *b_group, *w_router, *b_router,
        *w_gate, *w_up, *w_down, *norm_ple, *w_ple_gate, *w_ple;
    float* out; unsigned char* ws;
};
struct Ent { int tok; float w; float rs; int pad; };
#ifndef BALK
#define BALK 0
#endif
#ifndef DMAFIRST
#define DMAFIRST 0
#endif
namespace pg8 {
typedef int v4i __attribute__((ext_vector_type(4)));
typedef int v8i __attribute__((ext_vector_type(8)));
constexpr int BM = 256, BK = 64, HALF = 128, HTB = HALF * BK * 2  , STAGE_BYTES = 8 * HTB, NXCD = 8;
#ifndef WGM_
#define WGM_ 4
#endif
constexpr int WGM = WGM_;
constexpr int RING_BYTES = 131072;
constexpr int LDSX_OFF = RING_BYTES;
constexpr int MISC_OFF = LDSX_OFF + 320;
constexpr int TAB_OFF = LDSX_OFF + 1024;
constexpr int LST_OFF = TAB_OFF + 8192;
constexpr int LDS_BYTES = 147456;

__host__ __device__ __forceinline__ int lds_byte(int r, int c) { const int st = (r >> 4) * 2 + (c >> 5), rr = r & 15, cc = c & 31, ob = rr * 64 + cc * 2; return st * 1024 + (ob ^ (((ob >> 9) & 1) << 5)); }
__host__ __device__ __forceinline__ void stage_rc(int b, int& R, int& C) { const int st = b / 1024, sb = b % 1024, swz = sb ^ (((sb >> 9) & 1) << 5); R = (st >> 1) * 16 + swz / 64; C = (st & 1) * 32 + (swz % 64) / 2; }
__host__ __device__ __forceinline__ int perm32(int rho) { const int n = rho >> 4, i = rho & 15; return 8 * (i >> 2) + 4 * n + (i & 3); }

struct Unit { int pm, pn, bt, par, lst, rk0, nl; };
struct Gemm { const bf16* A; const bf16* Bt; int M, N, K; };

struct StaticOrder {
    static constexpr bool GATHER = false;
    int nM, nN, nwg, G, c;
    __host__ __device__ void init(int M_, int N_, int G_, int c_) { nM = M_ / BM; nN = N_ / BM; nwg = nM * nN; G = G_; c = c_; }
    __host__ __device__ bool next(int i, Unit& u) const {
        const long L = (long)i * G + c; if (L >= nwg) return false;
        int wgid = (int)L; { const int q = nwg / NXCD, r = nwg % NXCD, xcd = wgid % NXCD, off = wgid / NXCD; wgid = (xcd < r ? xcd * (q + 1) : r * (q + 1) + (xcd - r) * q) + off; }
        const int nig = WGM * nN, gid = wgid / nig, fm = gid * WGM, gsz = (nM - fm) < WGM ? (nM - fm) : WGM;
        u.pm = fm + ((wgid % nig) % gsz); u.pn = (wgid % nig) / gsz; u.bt = u.pn; u.par = i & 1; u.lst = 0; u.rk0 = 0; u.nl = 0; return true;
    }
    __device__ __forceinline__ void a_prefetch(const Unit&) const {}
    __device__ __forceinline__ void a_first() const {}
    __device__ __forceinline__ void a_ready(const Unit&) const {}
    __device__ __forceinline__ void done(const Unit&) const {}
    __device__ __forceinline__ void between(int, int) const {}
};

struct SameTileOrder : StaticOrder { __host__ __device__ bool next(int i, Unit& u) const { if (!StaticOrder::next(i, u)) return false; u.pm = c & 7; u.pn = 0; u.bt = 0; return true; } };
struct PwOrder {
    static constexpr bool GATHER = false;
    int G, c, nr;
    __device__ __forceinline__ bool next(int i, Unit& u) const {
        int L;
        if (G == 256 && nr == 128) { if (c < nr || i >= 8) return false; L = (c - nr) * 8 + i; }
        else { L = i * G + c; if (L >= (M / BM) * (D / BM)) return false; }
        u.pm = L / (D / BM); u.pn = L % (D / BM); u.bt = u.pn; u.par = i & 1; u.lst = 0; u.rk0 = 0; u.nl = 0; return true;
    }
    __device__ __forceinline__ void a_prefetch(const Unit&) const {}
    __device__ __forceinline__ void a_first() const {}
    __device__ __forceinline__ void a_ready(const Unit&) const {}
    __device__ __forceinline__ void done(const Unit&) const {}
    __device__ __forceinline__ void between(int, int) const {}
};

template <bool GU> __device__ __forceinline__ void cvt_item(const float* W, const float* g0, unsigned char* WT8, int k0, int n0, int up, int lane) {
    constexpr int K = GU ? D : DEXP, N = GU ? DEXP : D;
    const int q = lane & 3, c4 = lane >> 2;
    f32x4 v[32];
    const __attribute__((address_space(1))) f32x4* src = (const __attribute__((address_space(1))) f32x4*)(W + (size_t)(k0 + 16 * q) * N + n0) + c4;
#pragma unroll
    for (int i = 0; i < 32; ++i) v[i] = __builtin_nontemporal_load(src + (size_t)((i & 15) + 64 * (i >> 4)) * (N / 4));
    float gg[32];
#pragma unroll
    for (int t = 0; t < 8; ++t) { f32x4 g4 = (f32x4){1.f, 1.f, 1.f, 1.f}; if (GU) g4 = *(const f32x4*)(g0 + k0 + 16 * q + 64 * (t >> 2) + 4 * (t & 3));
#pragma unroll
        for (int u = 0; u < 4; ++u) gg[4 * t + u] = g4[u] * (GU ? F8_WSCALE : F8_DSCALE); }
    const int n = n0 + 4 * c4;
    const int row = GU ? (n >> 7) * 256 + ((n & 127) >> 3) * 16 + up * 8 + (n & 7) : n;
    unsigned char* dst = WT8 + (size_t)row * K + k0 + 16 * q;
#pragma unroll
    for (int j = 0; j < 4; ++j) { v2u qv[4];
#pragma unroll
        for (int b = 0; b < 4; ++b) { float f[8];
#pragma unroll
            for (int t = 0; t < 8; ++t) f[t] = v[b * 8 + t][j] * gg[b * 8 + t];
            qv[b] = pack8_f8(f, 1.0f); }
        __builtin_nontemporal_store((v4u){qv[0].x, qv[0].y, qv[1].x, qv[1].y}, (v4u*)(dst + (size_t)j * K));
        __builtin_nontemporal_store((v4u){qv[2].x, qv[2].y, qv[3].x, qv[3].y}, (v4u*)(dst + (size_t)j * K + 64)); }
}
struct CvtWork {
    const float *w_gate, *w_up, *w_down, *norm_ffn; unsigned char* ws; int vcu, G;
    static constexpr int NGU = NE * 2 * (DEXP / 64) * (D / 128), ND = NE * (D / 64) * (DEXP / 128), NIT = NGU + ND;
    __device__ __forceinline__ void run(int wid, int lo, int hi) const {
        const int lane = lane_id_asm();
        const float* wg_ = w_gate; const float* wu_ = w_up; asm volatile("" : "+s"(wg_), "+s"(wu_));
        const int n = hi - lo, per = (n + G - 1) / G, perw = (per + 7) / 8, lim = lo + ((vcu + 1) * per < n ? (vcu + 1) * per : n);
        const int base = lo + vcu * per + wid * perw, top = base + perw < lim ? base + perw : lim;
#pragma unroll 1
        for (int it0 = base; it0 < top; ++it0) { const int it = __builtin_amdgcn_readfirstlane(it0);
            if (it < NGU) { const int kb = it & 15, nb = (it >> 4) & 7, up = (it >> 7) & 1, e = it >> 8;
                cvt_item<true>((up ? wu_ : wg_) + (size_t)e * D * DEXP, norm_ffn, ws + WS_WGU + (size_t)e * 1024 * D, kb * 128, nb * 64, up, lane); }
            else { const int j = it - NGU, kb = j & 3, nb = (j >> 2) & 31, e = j >> 7;
                cvt_item<false>(w_down + (size_t)e * DEXP * D, nullptr, ws + WS_WD + (size_t)e * D * DEXP, kb * 128, nb * 64, 0, lane); } }
    }
};
struct CvtOrder : StaticOrder {
    CvtWork w; int slot, lo, hi;
    __device__ __forceinline__ void between(int ui, int wid) const { if (ui == slot) w.run(wid, lo, hi); }
    __device__ __forceinline__ int nunits() const { return c < nwg ? (nwg - 1 - c) / G + 1 : 0; }
};

__device__ __forceinline__ unsigned cvt_pk_bf16(float lo, float hi) { unsigned r; asm volatile("v_cvt_pk_bf16_f32 %0, %1, %2" : "=v"(r) : "v"(lo), "v"(hi)); return r; }

template <class Epi, class Sched, bool ALIGN_EPI, bool F8 = false, int MMAMASK = 15>
__device__ __forceinline__ void gemm_phase(LAS unsigned char* lds, const Gemm g, const Sched& S, const Epi& E, const int wid) {
    const int lane = lane_id(), tid = wid * 64 + lane, wr = wid >> 2, wc = wid & 3, fr = lane & 15, fq = lane >> 4;
    const int K = g.K, nt = K / BK;
    unsigned voffA[2], voffB[2]; int R0 = 0, C0 = 0;
#pragma unroll
    for (int i = 0; i < 2; ++i) { int R, C; stage_rc(tid * 16 + i * 8192, R, C); const int Rb = Epi::PERM ? (64 * (R >> 5) + 16 * ((R & 15) >> 2) + 4 * ((R >> 4) & 1) + (R & 3)) : R;
        voffA[i] = (unsigned)(R * K + C) * 2u; voffB[i] = (unsigned)(Rb * K + C) * 2u; if (i == 0) { R0 = R; C0 = C; } }
    const size_t kstep = (size_t)(BK * 2);
    const size_t hstep = (size_t)HALF * K * 2;
    const size_t tstep = 2 * hstep;
    const size_t hstepB = Epi::PERM ? (size_t)8 * K * 2 : hstep;
    const unsigned ldsw = (unsigned)wid * 1024u;
    const int aoff = lds_byte(wr * 64 + fr, fq * 8), boff = lds_byte(wc * 32 + fr, fq * 8);
    unsigned gc[2][2] = {{0u, 0u}, {0u, 0u}}, gn[2][2] = {{0u, 0u}, {0u, 0u}}, gs[2][2] = {{0u, 0u}, {0u, 0u}};
#define PG8_TOK(par, r) (*(const LAS int*)(lds + TAB_OFF + (par) * 4096 + (r) * 16))
#define PG8_GLOAD(dst, par) do { _Pragma("unroll") for (int _h = 0; _h < 2; ++_h) _Pragma("unroll") for (int _i = 0; _i < 2; ++_i) \
        dst[_h][_i] = (unsigned)PG8_TOK(par, _h * 128 + _i * 64 + R0) * (unsigned)(K * 2) + (unsigned)(C0 * 2); } while (0)
#define PG8_SA(b, h) (((b) * 2 + (h)) * HTB)
#define PG8_SB(b, h) ((4 + (b) * 2 + (h)) * HTB)
#define PG8_STAGE(bufoff, gbase, voff) do { _Pragma("unroll") for (int _i = 0; _i < 2; ++_i) \
        __builtin_amdgcn_global_load_lds((const unsigned*)((const char*)(gbase) + (voff)[_i]), (LAS unsigned*)(lds + (bufoff) + ldsw + _i * 8192), 16, 0, 0); } while (0)
#define PG8_STAGE_A(bufoff, ub, go, h, kb) do { if constexpr (Sched::GATHER) { PG8_STAGE(bufoff, (const char*)g.A + (kb), go[h]); } else { PG8_STAGE(bufoff, (ub) + (kb) + (h) * hstep, voffA); } } while (0)
#define PG8_CAT(p_) __builtin_shufflevector(*(const LAS v4i*)(p_), *(const LAS v4i*)((p_) + 1024), 0, 1, 2, 3, 4, 5, 6, 7)
#define PG8_LDA(dst, b, h) do { if constexpr (F8) { _Pragma("unroll") for (int m = 0; m < 4; ++m) dst##8[m] = PG8_CAT(lds + PG8_SA(b, h) + aoff + m * 2048); } \
        else { _Pragma("unroll") for (int m = 0; m < 4; ++m) _Pragma("unroll") for (int k = 0; k < 2; ++k) dst[m][k] = *(const LAS bf16x8*)(lds + PG8_SA(b, h) + aoff + m * 2048 + k * 1024); } } while (0)
#define PG8_LDB(dst, b, h) do { if constexpr (F8) { _Pragma("unroll") for (int n = 0; n < 2; ++n) dst##8[n] = PG8_CAT(lds + PG8_SB(b, h) + boff + n * 2048); } \
        else { _Pragma("unroll") for (int n = 0; n < 2; ++n) _Pragma("unroll") for (int k = 0; k < 2; ++k) dst[n][k] = *(const LAS bf16x8*)(lds + PG8_SB(b, h) + boff + n * 2048 + k * 1024); } } while (0)
#define PG8_MMA(ai, bj, At, Bt) do { if constexpr (((MMAMASK >> ((ai) * 2 + (bj))) & 1) == 0) break; __builtin_amdgcn_s_setprio(1); _Pragma("unroll") for (int m = 0; m < 4; ++m) _Pragma("unroll") for (int n = 0; n < 2; ++n) { \
        if constexpr (F8) { asm volatile("v_mfma_scale_f32_16x16x128_f8f6f4 %0, %1, %2, %0, %3, %3 op_sel_hi:[0,0,0]" : "+v"(acc[ai][bj][m][n]) : "v"(Bt##8[n]), "v"(At##8[m]), "v"(f8scale)); } \
        else { _Pragma("unroll") for (int k = 0; k < 2; ++k) acc[ai][bj][m][n] = __builtin_amdgcn_mfma_f32_16x16x32_bf16(Bt[n][k], At[m][k], acc[ai][bj][m][n], 0, 0, 0); } } \
        __builtin_amdgcn_s_setprio(0); } while (0)
#define PG8_WAIT_V(n) asm volatile("s_waitcnt vmcnt(" #n ")" ::: "memory")
#define PG8_WAIT_L(n) asm volatile("s_waitcnt lgkmcnt(" #n ")" ::: "memory")
#define PG8_BAR __builtin_amdgcn_s_barrier()
#define PG8_SCHED __builtin_amdgcn_sched_barrier(0)
    Unit cur, nxt; int ui = 0;
    if (!S.next(0, cur)) return;
    f32x4 acc[2][2][4][2];
#pragma unroll
    for (int a = 0; a < 2; ++a)
#pragma unroll
        for (int b = 0; b < 2; ++b)
#pragma unroll
            for (int m = 0; m < 4; ++m)
#pragma unroll
                for (int n = 0; n < 2; ++n) acc[a][b][m][n] = (f32x4){0.f, 0.f, 0.f, 0.f};
    bf16x8 At[4][2], B0[2][2], B1[2][2];
    const int f8scale = 0x7f7f7f7f;
    v8i At8[4], B08[2], B18[2];
    const char* cA = (const char*)g.A + (size_t)cur.pm * tstep; const char* cB = (const char*)g.Bt + (size_t)cur.bt * tstep;
    S.a_prefetch(cur); S.a_first(); S.a_ready(cur);
    if constexpr (Sched::GATHER) { PG8_GLOAD(gc, cur.par); }
    PG8_STAGE(PG8_SB(0, 0), cB, voffB); PG8_STAGE(PG8_SB(0, 1), cB + hstepB, voffB); PG8_STAGE_A(PG8_SA(0, 0), cA, gc, 0, (size_t)0); PG8_STAGE_A(PG8_SA(0, 1), cA, gc, 1, (size_t)0);
    if (wr == 1) PG8_BAR;
    PG8_WAIT_V(2); PG8_BAR;
    PG8_STAGE(PG8_SB(1, 0), cB + kstep, voffB); PG8_STAGE_A(PG8_SA(1, 0), cA, gc, 0, kstep); PG8_STAGE(PG8_SB(1, 1), cB + hstepB + kstep, voffB);
    PG8_WAIT_V(6); PG8_BAR;
    for (;;) {
        const bool has_next = S.next(ui + 1, nxt);
        const char* nA = has_next ? (const char*)g.A + (size_t)nxt.pm * tstep : cA; const char* nB = has_next ? (const char*)g.Bt + (size_t)nxt.bt * tstep : cB;
#pragma unroll 1
        for (int t = 0; t < nt; t += 2) {
            const bool last = (t == nt - 2);
            const size_t k1 = (size_t)(t + 1) * kstep;
            const char* sA = last ? nA : cA; const size_t k2 = last ? (size_t)0 : (size_t)(t + 2) * kstep, k3 = k2 + kstep;
            const char* b2 = last ? nB : cB + (size_t)(t + 2) * kstep; const char* b3 = b2 + kstep;
            if (last && has_next) { S.a_ready(nxt); if constexpr (Sched::GATHER) { PG8_GLOAD(gn, nxt.par); } }
            if constexpr (Sched::GATHER) {
#pragma unroll
                for (int h = 0; h < 2; ++h)
#pragma unroll
                    for (int i = 0; i < 2; ++i) gs[h][i] = (last && has_next) ? gn[h][i] : gc[h][i];
            }
#if BALK
            PG8_LDB(B0, 0, 0); PG8_LDB(B1, 0, 1); PG8_SCHED; PG8_LDA(At, 0, 0); PG8_STAGE_A(PG8_SA(1, 1), cA, gc, 1, k1);
            PG8_WAIT_V(8); PG8_WAIT_L(0); PG8_BAR; PG8_MMA(0, 0, At, B0); PG8_MMA(0, 1, At, B1); PG8_BAR; PG8_SCHED;
            if (has_next && t == nt - 4) S.a_prefetch(nxt);
            PG8_LDA(At, 0, 1); PG8_STAGE(PG8_SB(0, 0), b2, voffB); PG8_STAGE(PG8_SB(0, 1), b2 + hstepB, voffB);
            PG8_WAIT_V(6); PG8_WAIT_L(0); PG8_BAR; PG8_MMA(1, 0, At, B0); PG8_STAGE_A(PG8_SA(0, 0), sA, gs, 0, k2); PG8_MMA(1, 1, At, B1); PG8_BAR; PG8_SCHED;
            PG8_LDB(B0, 1, 0); PG8_LDB(B1, 1, 1); PG8_SCHED; PG8_LDA(At, 1, 0); PG8_STAGE_A(PG8_SA(0, 1), sA, gs, 1, k2);
            PG8_WAIT_V(8); PG8_WAIT_L(0); PG8_BAR; PG8_MMA(0, 0, At, B0); PG8_MMA(0, 1, At, B1); PG8_BAR; PG8_SCHED;
            PG8_LDA(At, 1, 1); PG8_STAGE(PG8_SB(1, 0), b3, voffB); PG8_STAGE(PG8_SB(1, 1), b3 + hstepB, voffB);
            PG8_WAIT_V(6); PG8_WAIT_L(0); PG8_BAR; PG8_MMA(1, 0, At, B0); PG8_STAGE_A(PG8_SA(1, 0), sA, gs, 0, k3); PG8_MMA(1, 1, At, B1); PG8_BAR; PG8_SCHED;
#else
#if DMAFIRST
            PG8_LDB(B0, 0, 0); PG8_LDB(B1, 0, 1); PG8_SCHED; PG8_LDA(At, 0, 0); PG8_WAIT_L(0); PG8_SCHED; PG8_STAGE_A(PG8_SA(1, 1), cA, gc, 1, k1);
            PG8_WAIT_V(8); PG8_BAR; PG8_MMA(0, 0, At, B0); PG8_MMA(0, 1, At, B1); PG8_BAR; PG8_SCHED;
            if (has_next && t == nt - 4) S.a_prefetch(nxt);
            PG8_LDA(At, 0, 1); PG8_WAIT_L(0); PG8_SCHED; PG8_STAGE(PG8_SB(0, 0), b2, voffB); PG8_STAGE(PG8_SB(0, 1), b2 + hstepB, voffB); PG8_STAGE_A(PG8_SA(0, 0), sA, gs, 0, k2);
            PG8_WAIT_V(8); PG8_BAR; PG8_MMA(1, 0, At, B0); PG8_MMA(1, 1, At, B1); PG8_BAR; PG8_SCHED;
            PG8_LDB(B0, 1, 0); PG8_LDB(B1, 1, 1); PG8_SCHED; PG8_LDA(At, 1, 0); PG8_WAIT_L(0); PG8_SCHED; PG8_STAGE_A(PG8_SA(0, 1), sA, gs, 1, k2);
            PG8_WAIT_V(8); PG8_BAR; PG8_MMA(0, 0, At, B0); PG8_MMA(0, 1, At, B1); PG8_BAR; PG8_SCHED;
            PG8_LDA(At, 1, 1); PG8_WAIT_L(0); PG8_SCHED; PG8_STAGE(PG8_SB(1, 0), b3, voffB); PG8_STAGE(PG8_SB(1, 1), b3 + hstepB, voffB); PG8_STAGE_A(PG8_SA(1, 0), sA, gs, 0, k3);
            PG8_WAIT_V(8); PG8_BAR; PG8_MMA(1, 0, At, B0); PG8_MMA(1, 1, At, B1); PG8_BAR; PG8_SCHED;
#else
            PG8_LDB(B0, 0, 0); PG8_LDB(B1, 0, 1); PG8_SCHED; PG8_LDA(At, 0, 0); PG8_STAGE_A(PG8_SA(1, 1), cA, gc, 1, k1);
            PG8_WAIT_V(8); PG8_WAIT_L(0); PG8_BAR; PG8_MMA(0, 0, At, B0); PG8_MMA(0, 1, At, B1); PG8_BAR; PG8_SCHED;
            if (has_next && t == nt - 4) S.a_prefetch(nxt);
            PG8_LDA(At, 0, 1); PG8_STAGE(PG8_SB(0, 0), b2, voffB); PG8_STAGE(PG8_SB(0, 1), b2 + hstepB, voffB); PG8_STAGE_A(PG8_SA(0, 0), sA, gs, 0, k2);
            PG8_WAIT_V(8); PG8_WAIT_L(0); PG8_BAR; PG8_MMA(1, 0, At, B0); PG8_MMA(1, 1, At, B1); PG8_BAR; PG8_SCHED;
            PG8_LDB(B0, 1, 0); PG8_LDB(B1, 1, 1); PG8_SCHED; PG8_LDA(At, 1, 0); PG8_STAGE_A(PG8_SA(0, 1), sA, gs, 1, k2);
            PG8_WAIT_V(8); PG8_WAIT_L(0); PG8_BAR; PG8_MMA(0, 0, At, B0); PG8_MMA(0, 1, At, B1); PG8_BAR; PG8_SCHED;
            PG8_LDA(At, 1, 1); PG8_STAGE(PG8_SB(1, 0), b3, voffB); PG8_STAGE(PG8_SB(1, 1), b3 + hstepB, voffB); PG8_STAGE_A(PG8_SA(1, 0), sA, gs, 0, k3);
            PG8_WAIT_V(8); PG8_WAIT_L(0); PG8_BAR; PG8_MMA(1, 0, At, B0); PG8_MMA(1, 1, At, B1); PG8_BAR; PG8_SCHED;
#endif
#endif
        }
        if constexpr (F8) asm volatile("s_nop 15\n\ts_nop 15" ::: "memory");
        if constexpr (ALIGN_EPI) { if (wr == 0) PG8_BAR; }
        if constexpr (!Epi::AFTER_DRAIN) { E(acc, cur, wr, wc, fr, fq); S.done(cur); }
        if (!has_next) break;
        S.between(ui, wid);
#pragma unroll
        for (int a = 0; a < 2; ++a)
#pragma unroll
            for (int b = 0; b < 2; ++b)
#pragma unroll
                for (int m = 0; m < 4; ++m)
#pragma unroll
                    for (int n = 0; n < 2; ++n) acc[a][b][m][n] = (f32x4){0.f, 0.f, 0.f, 0.f};
        cur = nxt; cA = nA; cB = nB; ++ui;
        if constexpr (Sched::GATHER) {
#pragma unroll
            for (int h = 0; h < 2; ++h)
#pragma unroll
                for (int i = 0; i < 2; ++i) gc[h][i] = gn[h][i];
        }
        if constexpr (ALIGN_EPI) { if (wr == 1) PG8_BAR; }
    }
    PG8_WAIT_V(0);
    if constexpr (!ALIGN_EPI) { if (wr == 0) PG8_BAR; }
    PG8_BAR;
    if constexpr (Epi::AFTER_DRAIN) { E.fused(acc, cur, wr, wc, fr, fq, lds, wid, lane); S.done(cur); }
#undef PG8_TOK
#undef PG8_GLOAD
#undef PG8_SA
#undef PG8_SB
#undef PG8_STAGE
#undef PG8_STAGE_A
#undef PG8_CAT
#undef PG8_LDA
#undef PG8_LDB
#undef PG8_MMA
#undef PG8_WAIT_V
#undef PG8_WAIT_L
#undef PG8_BAR
#undef PG8_SCHED
}

typedef f32x4 Acc[2][2][4][2];
#define TAB_ENT(ldsx, par, r) ((const LAS Ent*)((ldsx) + TAB_OFF + (par) * 4096 + (r) * 16))

#ifndef NTS_PROJ
#define NTS_PROJ 0
#endif
struct EpiBf16 {
    static constexpr bool PERM = true, AFTER_DRAIN = false, NTS = NTS_PROJ != 0;
    bf16* O; int ldc; const float* rs; float sc;
    __device__ __forceinline__ void operator()(const Acc& acc, const Unit& u, int wr, int wc, int fr, int fq) const {
        const int row0 = u.pm * BM + wr * 64 + fr, col0 = u.pn * BM + wc * 64 + 16 * fq;
#pragma unroll
        for (int ai = 0; ai < 2; ++ai)
#pragma unroll
            for (int m = 0; m < 4; ++m) { const int row = row0 + ai * HALF + m * 16; const float s = rs ? rs[row] * sc : sc; bf16* rowp = O + (size_t)row * ldc + col0;
#pragma unroll
                for (int bj = 0; bj < 2; ++bj) { const f32x4 v0 = acc[ai][bj][m][0] * s, v1 = acc[ai][bj][m][1] * s; v4u w;
                    w.x = cvt_pk_bf16(v0[0], v0[1]); w.y = cvt_pk_bf16(v0[2], v0[3]); w.z = cvt_pk_bf16(v1[0], v1[1]); w.w = cvt_pk_bf16(v1[2], v1[3]);
                    if (NTS) __builtin_nontemporal_store(w, (v4u*)(rowp + bj * 8)); else *(v4u*)(rowp + bj * 8) = w; } }
    }
};
struct EpiF8 {
    static constexpr bool PERM = true, AFTER_DRAIN = false;
    unsigned char* O; int ldc; float sc;
    __device__ __forceinline__ void operator()(const Acc& acc, const Unit& u, int wr, int wc, int fr, int fq) const {
        const int row0 = u.pm * BM + wr * 64 + fr, col0 = u.pn * BM + wc * 64 + 16 * fq;
#pragma unroll
        for (int ai = 0; ai < 2; ++ai)
#pragma unroll
            for (int m = 0; m < 4; ++m) { const int row = row0 + ai * HALF + m * 16; v2u f8[2];
#pragma unroll
                for (int bj = 0; bj < 2; ++bj) { float o[8];
#pragma unroll
                    for (int n = 0; n < 2; ++n)
#pragma unroll
                        for (int i = 0; i < 4; ++i) o[n * 4 + i] = acc[ai][bj][m][n][i];
                    f8[bj] = pack8_f8(o, sc); }
                *(v4u*)(O + (size_t)row * ldc + col0) = (v4u){f8[0].x, f8[0].y, f8[1].x, f8[1].y}; }
    }
};
struct EpiH1 {
    static constexpr bool PERM = true, AFTER_DRAIN = false;
    const bf16* xb; const float* rms; bf16* h1; float* ssp; unsigned char* h18; float sc;
    __device__ __forceinline__ void operator()(const Acc& acc, const Unit& u, int wr, int wc, int fr, int fq) const {
        const int row0 = u.pm * BM + wr * 64 + fr, col0 = u.pn * BM + wc * 64 + 16 * fq;
        v4u xv[8][2]; float rm[8];
#define H1_LOAD(g_) do { const size_t off_ = (size_t)(row0 + ((g_) >> 2) * HALF + ((g_) & 3) * 16) * D + col0; xv[g_][0] = *(const v4u*)(xb + off_); xv[g_][1] = *(const v4u*)(xb + off_ + 8); } while (0)
#pragma unroll
        for (int gi = 0; gi < 8; ++gi) { rm[gi] = rms[row0 + (gi >> 2) * HALF + (gi & 3) * 16]; H1_LOAD(gi); }
        asm volatile("" ::: "memory");
#pragma unroll
        for (int gi = 0; gi < 8; ++gi) { const int ai = gi >> 2, m = gi & 3;
            const int row = row0 + ai * HALF + m * 16; const size_t off = (size_t)row * D + col0; float ss = 0.f; const float r = rm[gi]; v2u f8[2];
#pragma unroll
            for (int bj = 0; bj < 2; ++bj) { float xf[8]; unpack8(xv[gi][bj], xf); float o[8];
#pragma unroll
                for (int n = 0; n < 2; ++n)
#pragma unroll
                    for (int i = 0; i < 4; ++i) { o[n * 4 + i] = xf[n * 4 + i] * r + acc[ai][bj][m][n][i] * sc; ss += o[n * 4 + i] * o[n * 4 + i]; }
                v4u w; w.x = cvt_pk_bf16(o[0], o[1]); w.y = cvt_pk_bf16(o[2], o[3]); w.z = cvt_pk_bf16(o[4], o[5]); w.w = cvt_pk_bf16(o[6], o[7]);
                *(v4u*)(h1 + off + bj * 8) = w; if (h18) f8[bj] = pack8_f8(o, F8_ASCALE); }
            if (h18) *(v4u*)(h18 + off) = (v4u){f8[0].x, f8[0].y, f8[1].x, f8[1].y};
            ss += __shfl_xor(ss, 16); ss = xsum32(ss);
            if (fq == 0) ssp[(size_t)row * 32 + u.pn * 4 + wc] = ss; }
#undef H1_LOAD
    }
};
struct EpiRouter {
    static constexpr bool PERM = false, AFTER_DRAIN = true;
    const float* ssp; const float* bg; const float* br; float* rs1; int* eid; float* ew; Ent* ent; unsigned* cnt;
    __device__ __forceinline__ void fused(const Acc& acc, const Unit& u, int wr, int wc, int fr, int fq, LAS unsigned char* lds, int wid, int lane) const {
        LAS float* LG = (LAS float*)lds;
        LAS unsigned* HIST = (LAS unsigned*)(lds + 65536);
        LAS unsigned* BASE = (LAS unsigned*)(lds + 65536 + 256);
        const int tid = wid * 64 + lane;
        if (tid < 64) HIST[tid] = 0u;
        if (wc < 2) {
#pragma unroll
            for (int ai = 0; ai < 2; ++ai)
#pragma unroll
                for (int m = 0; m < 4; ++m) { const int r = ai * HALF + wr * 64 + m * 16 + fr;
#pragma unroll
                    for (int n = 0; n < 2; ++n) { const int c = wc * 32 + 16 * n + 4 * fq; if (c < 40) *(LAS f32x4*)(LG + r * 40 + c) = acc[ai][0][m][n]; } }
        }
        __syncthreads();
        int l0 = 0, l1 = 0; unsigned k0 = 0, k1 = 0; float w0 = 0.f, w1 = 0.f, rs = 0.f; const int row = u.pm * BM + tid;
        if (tid < 256) {
            float ss = 0.f;
#pragma unroll
            for (int j = 0; j < 8; ++j) { const f32x4 p = *(const f32x4*)(ssp + (size_t)row * 32 + 4 * j); ss += (p[0] + p[1]) + (p[2] + p[3]); }
            rs = 1.0f / sqrtf(ss * (1.0f / D) + EPS);
            const LAS float* L = LG + tid * 40;
            float gl[NGRP]; int g = 0;
#pragma unroll
            for (int j = 0; j < NGRP; ++j) gl[j] = L[j] * rs + bg[j];
            float gm = gl[0];
#pragma unroll
            for (int j = 1; j < NGRP; ++j) if (gl[j] > gm) { gm = gl[j]; g = j; }
            float gsum = 0.f;
#pragma unroll
            for (int j = 0; j < NGRP; ++j) gsum += __expf(gl[j] - gm);
            const float gw = 1.0f / gsum;
            const LAS float* E = L + NGRP + g * EPG; const float* be = br + g * EPG;
            int i1 = 0; float v1 = E[0] * rs + be[0];
            for (int j = 1; j < EPG; ++j) { const float v = E[j] * rs + be[j]; if (v > v1) { v1 = v; i1 = j; } }
            int i2 = 0; float v2 = -3.0e38f;
            for (int j = 0; j < EPG; ++j) { const float v = E[j] * rs + be[j]; if (j != i1 && v > v2) { v2 = v; i2 = j; } }
            const float e2 = __expf(v2 - v1); w0 = gw / (1.0f + e2); w1 = gw * e2 / (1.0f + e2);
            l0 = g * EPG + i1; l1 = NE + g * EPG + i2;
            eid[row * 2] = l0; eid[row * 2 + 1] = l1 - NE; ew[row * 2] = w0; ew[row * 2 + 1] = w1; rs1[row] = rs;
            k0 = __hip_atomic_fetch_add(HIST + l0, 1u, __ATOMIC_RELAXED, __HIP_MEMORY_SCOPE_WORKGROUP); k1 = __hip_atomic_fetch_add(HIST + l1, 1u, __ATOMIC_RELAXED, __HIP_MEMORY_SCOPE_WORKGROUP);
        }
        __syncthreads();
        if (tid < 64) { const unsigned n = HIST[tid]; BASE[tid] = n ? __hip_atomic_fetch_add(cnt + 64 * tid, n, __ATOMIC_RELAXED, __HIP_MEMORY_SCOPE_AGENT) : 0u; }
        __syncthreads();
        if (tid < 256) {
            *(v4u*)(ent + (size_t)l0 * LCAP + BASE[l0] + k0) = (v4u){(unsigned)row, __float_as_uint(w0), __float_as_uint(rs), 0u};
            *(v4u*)(ent + (size_t)l1 * LCAP + BASE[l1] + k1) = (v4u){(unsigned)row, __float_as_uint(w1), __float_as_uint(rs), 0u};
        }
    }
};
struct EpiGU {
    static constexpr bool PERM = true, AFTER_DRAIN = false;
    bf16* hid; LAS unsigned char* ldsx; float sc; unsigned char* hid8;
    __device__ __forceinline__ void operator()(const Acc& acc, const Unit& u, int wr, int wc, int fr, int fq) const {
        const int col0 = u.pn * HALF + wc * 32 + 8 * fq;
#pragma unroll
        for (int ai = 0; ai < 2; ++ai)
#pragma unroll
            for (int m = 0; m < 4; ++m) { const int r = ai * HALF + wr * 64 + m * 16 + fr; const LAS Ent* e = TAB_ENT(ldsx, u.par, r); const float w = e->w, rs = e->rs * sc;
                float o[8];
#pragma unroll
                for (int n = 0; n < 2; ++n)
#pragma unroll
                    for (int i = 0; i < 4; ++i) { const float gg = acc[ai][0][m][n][i] * rs, uu = acc[ai][1][m][n][i] * rs; o[n * 4 + i] = w * (gg * __builtin_amdgcn_rcpf(1.0f + __expf(-gg))) * uu; }
                if (hid8) { *(v2u*)(hid8 + (size_t)(u.pm * BM + r) * DEXP + col0) = pack8_f8(o, F8_HSCALE); }
                else { v4u q; q.x = cvt_pk_bf16(o[0], o[1]); q.y = cvt_pk_bf16(o[2], o[3]); q.z = cvt_pk_bf16(o[4], o[5]); q.w = cvt_pk_bf16(o[6], o[7]);
                    *(v4u*)(hid + (size_t)(u.pm * BM + r) * DEXP + col0) = q; } }
    }
};
template <int KK> struct EpiDown;
template <> struct EpiDown<0> {
    static constexpr bool PERM = true, AFTER_DRAIN = false;
    unsigned char* y8; LAS unsigned char* ldsx; float sc;
    __device__ __forceinline__ void operator()(const Acc& acc, const Unit& u, int wr, int wc, int fr, int fq) const {
        const int col0 = u.pn * BM + wc * 64 + 16 * fq; const float s64 = sc * F8_YSCALE;
#pragma unroll
        for (int gi = 0; gi < 8; ++gi) { const int ai = gi >> 2, m = gi & 3;
            const int r = ai * HALF + wr * 64 + m * 16 + fr; const bool valid = (u.rk0 + r) < u.nl; const int tok = TAB_ENT(ldsx, u.par, r)->tok; v2u f8[2];
#pragma unroll
            for (int bj = 0; bj < 2; ++bj) { float o[8];
#pragma unroll
                for (int n = 0; n < 2; ++n)
#pragma unroll
                    for (int i = 0; i < 4; ++i) o[n * 4 + i] = acc[ai][bj][m][n][i];
                f8[bj] = pack8_f8(o, s64); }
            if (valid) *(v4u*)(y8 + (size_t)tok * D + col0) = (v4u){f8[0].x, f8[0].y, f8[1].x, f8[1].y}; }
    }
};
template <> struct EpiDown<1> {
    static constexpr bool PERM = true, AFTER_DRAIN = false;
    const bf16* base; bf16* h2; float* ssp; LAS unsigned char* ldsx; unsigned char* h28; float sc;
    __device__ __forceinline__ void operator()(const Acc& acc, const Unit& u, int wr, int wc, int fr, int fq) const {
        const int col0 = u.pn * BM + wc * 64 + 16 * fq;
#pragma unroll
        for (int hb = 0; hb < 2; ++hb) {
            v4u bv[4][2], yv[4]; int tk[4];
#pragma unroll
            for (int q = 0; q < 4; ++q) { const int gi = hb * 4 + q; tk[q] = TAB_ENT(ldsx, u.par, (gi >> 2) * HALF + wr * 64 + (gi & 3) * 16 + fr)->tok; const size_t off_ = (size_t)tk[q] * D + col0;
                bv[q][0] = *(const v4u*)(base + off_); bv[q][1] = *(const v4u*)(base + off_ + 8); yv[q] = *(const v4u*)(h28 + off_); }
            asm volatile("" ::: "memory");
#pragma unroll
            for (int q = 0; q < 4; ++q) { const int gi = hb * 4 + q, ai = gi >> 2, m = gi & 3;
                const int r = ai * HALF + wr * 64 + m * 16 + fr; const bool valid = (u.rk0 + r) < u.nl; const int tok = tk[q]; const size_t off = (size_t)tok * D + col0; float ss = 0.f; v2u f8[2];
                const unsigned yw[4] = {yv[q].x, yv[q].y, yv[q].z, yv[q].w};
#pragma unroll
                for (int bj = 0; bj < 2; ++bj) { float b[8]; unpack8(bv[q][bj], b); float o[8];
#pragma unroll
                    for (int n = 0; n < 2; ++n) { const unsigned w = yw[bj * 2 + n];
                        const float y0 = __builtin_amdgcn_cvt_f32_fp8((int)w, 0), y1 = __builtin_amdgcn_cvt_f32_fp8((int)w, 1), y2 = __builtin_amdgcn_cvt_f32_fp8((int)w, 2), y3 = __builtin_amdgcn_cvt_f32_fp8((int)w, 3);
                        const float yy[4] = {y0, y1, y2, y3};
#pragma unroll
                        for (int i = 0; i < 4; ++i) { o[n * 4 + i] = b[n * 4 + i] + yy[i] * F8_YINV + acc[ai][bj][m][n][i] * sc; ss += o[n * 4 + i] * o[n * 4 + i]; } }
                    v4u qv; qv.x = cvt_pk_bf16(o[0], o[1]); qv.y = cvt_pk_bf16(o[2], o[3]); qv.z = cvt_pk_bf16(o[4], o[5]); qv.w = cvt_pk_bf16(o[6], o[7]);
                    if (valid) *(v4u*)(h2 + off + bj * 8) = qv;
                    f8[bj] = pack8_f8(o, F8_ASCALE); }
                if (valid) *(v4u*)(h28 + off) = (v4u){f8[0].x, f8[0].y, f8[1].x, f8[1].y};
                ss += __shfl_xor(ss, 16); ss = xsum32(ss); if (fq == 0 && valid) ssp[(size_t)tok * 32 + u.pn * 4 + wc] = ss; }
            asm volatile("" ::: "memory"); }
    }
};
template <int MODE> struct EpiDownProbe {
    static constexpr bool PERM = true, AFTER_DRAIN = false;
    const bf16* base; bf16* h2; LAS unsigned char* ldsx; float sc;
    __device__ __forceinline__ void operator()(const Acc& acc, const Unit& u, int wr, int wc, int fr, int fq) const {
        const int col0 = u.pn * BM + wc * 64 + 16 * fq;
        v4u bv[8][2]; int tk[8];
#pragma unroll
        for (int gi = 0; gi < 8; ++gi) { tk[gi] = TAB_ENT(ldsx, u.par, (gi >> 2) * HALF + wr * 64 + (gi & 3) * 16 + fr)->tok; const size_t off_ = (size_t)tk[gi] * D + col0;
            if (MODE == 0) { bv[gi][0] = *(const v4u*)(base + off_); bv[gi][1] = *(const v4u*)(base + off_ + 8); } else { bv[gi][0] = (v4u){0u, 0u, 0u, 0u}; bv[gi][1] = (v4u){0u, 0u, 0u, 0u}; } }
        asm volatile("" ::: "memory");
#pragma unroll
        for (int gi = 0; gi < 8; ++gi) { const int ai = gi >> 2, m = gi & 3;
            const int r = ai * HALF + wr * 64 + m * 16 + fr; const bool valid = (u.rk0 + r) < u.nl; const size_t off = (size_t)tk[gi] * D + col0;
#pragma unroll
            for (int bj = 0; bj < 2; ++bj) { float b[8]; unpack8(bv[gi][bj], b); float o[8];
#pragma unroll
                for (int n = 0; n < 2; ++n)
#pragma unroll
                    for (int i = 0; i < 4; ++i) o[n * 4 + i] = b[n * 4 + i] + acc[ai][bj][m][n][i] * sc;
                v4u q; q.x = cvt_pk_bf16(o[0], o[1]); q.y = cvt_pk_bf16(o[2], o[3]); q.z = cvt_pk_bf16(o[4], o[5]); q.w = cvt_pk_bf16(o[6], o[7]);
                if (MODE == 2) { if (gi > 0) asm volatile("" :: "v"(q)); }
                if (valid && (MODE < 2 || gi == 0)) *(v4u*)(h2 + off + bj * 8) = q; } }
    }
};
struct EpiFinal {
    static constexpr bool PERM = true, AFTER_DRAIN = false;
    const bf16* h2; const unsigned char* pw8; float* out; LAS unsigned char* ldsx; float sc;
    __device__ __forceinline__ void operator()(const Acc& acc, const Unit& u, int wr, int wc, int fr, int fq) const {
        const int col0 = u.pn * BM + wc * 64 + 16 * fq;
        v4u hv[2][2], pv[2];
#define FN_LOAD(g_, buf) do { const size_t off_ = (size_t)(u.pm * BM + ((g_) >> 2) * HALF + wr * 64 + ((g_) & 3) * 16 + fr) * D + col0; \
            hv[buf][0] = *(const v4u*)(h2 + off_); hv[buf][1] = *(const v4u*)(h2 + off_ + 8); pv[buf] = *(const v4u*)(pw8 + off_); } while (0)
#pragma unroll
        for (int half_ = 0; half_ < 4; ++half_) {
#pragma unroll
            for (int q = 0; q < 2; ++q) FN_LOAD(half_ * 2 + q, q);
            asm volatile("" ::: "memory");
#pragma unroll
            for (int q = 0; q < 2; ++q) { const int gi = half_ * 2 + q, ai = gi >> 2, m = gi & 3;
                const int r = ai * HALF + wr * 64 + m * 16 + fr; const float rs = TAB_ENT(ldsx, u.par, r)->rs * sc; const size_t off = (size_t)(u.pm * BM + r) * D + col0;
                const unsigned pwd[4] = {pv[q].x, pv[q].y, pv[q].z, pv[q].w};
#pragma unroll
                for (int bj = 0; bj < 2; ++bj) { float hf[8]; unpack8(hv[q][bj], hf);
#pragma unroll
                    for (int n = 0; n < 2; ++n) { const f32x4 z = acc[ai][bj][m][n] * rs; f32x4 o; const int w = (int)pwd[bj * 2 + n];
                        const float pf[4] = {__builtin_amdgcn_cvt_f32_fp8(w, 0), __builtin_amdgcn_cvt_f32_fp8(w, 1), __builtin_amdgcn_cvt_f32_fp8(w, 2), __builtin_amdgcn_cvt_f32_fp8(w, 3)};
#pragma unroll
                        for (int i = 0; i < 4; ++i) o[i] = hf[n * 4 + i] + (pf[i] * F8_PINV) * __builtin_amdgcn_rcpf(1.0f + __expf(-z[i]));
                        *(f32x4*)(out + off + bj * 8 + n * 4) = o; } } }
            asm volatile("" ::: "memory"); }
#undef FN_LOAD
    }
};

template <int MODE> struct EpiFinalProbe {
    static constexpr bool PERM = true, AFTER_DRAIN = false;
    const bf16* h2; const unsigned char* pw8; float* out; LAS unsigned char* ldsx; float sc;
    __device__ __forceinline__ void operator()(const Acc& acc, const Unit& u, int wr, int wc, int fr, int fq) const {
        const int col0 = u.pn * BM + wc * 64 + 16 * fq;
        v4u hv[2][2], pv[2];
#pragma unroll
        for (int half_ = 0; half_ < 4; ++half_) {
#pragma unroll
            for (int q = 0; q < 2; ++q) { const int g_ = half_ * 2 + q; const size_t off_ = (size_t)(u.pm * BM + (g_ >> 2) * HALF + wr * 64 + (g_ & 3) * 16 + fr) * D + col0;
                if (MODE == 0 || MODE == 3) { hv[q][0] = *(const v4u*)(h2 + off_); hv[q][1] = *(const v4u*)(h2 + off_ + 8); pv[q] = *(const v4u*)(pw8 + off_); }
                else { hv[q][0] = (v4u){0u, 0u, 0u, 0u}; hv[q][1] = hv[q][0]; pv[q] = hv[q][0]; } }
            asm volatile("" ::: "memory");
#pragma unroll
            for (int q = 0; q < 2; ++q) { const int gi = half_ * 2 + q, ai = gi >> 2, m = gi & 3;
                const int r = ai * HALF + wr * 64 + m * 16 + fr; const float rs = TAB_ENT(ldsx, u.par, r)->rs * sc; const size_t off = (size_t)(u.pm * BM + r) * 1024 + (col0 & 1023);
                const unsigned pwd[4] = {pv[q].x, pv[q].y, pv[q].z, pv[q].w};
#pragma unroll
                for (int bj = 0; bj < 2; ++bj) { float hf[8]; unpack8(hv[q][bj], hf);
#pragma unroll
                    for (int n = 0; n < 2; ++n) { const f32x4 z = acc[ai][bj][m][n] * rs; f32x4 o; const int w = (int)pwd[bj * 2 + n];
                        const float pf[4] = {__builtin_amdgcn_cvt_f32_fp8(w, 0), __builtin_amdgcn_cvt_f32_fp8(w, 1), __builtin_amdgcn_cvt_f32_fp8(w, 2), __builtin_amdgcn_cvt_f32_fp8(w, 3)};
#pragma unroll
                        for (int i = 0; i < 4; ++i) o[i] = (MODE == 3) ? hf[n * 4 + i] + (pf[i] * F8_PINV) * z[i] : hf[n * 4 + i] + (pf[i] * F8_PINV) * __builtin_amdgcn_rcpf(1.0f + __expf(-z[i]));
                        if (MODE == 2 && gi > 0) { asm volatile("" :: "v"(o)); } else *(f32x4*)(out + off + bj * 8 + n * 4) = o; } } }
            asm volatile("" ::: "memory"); }
    }
};
template <int MODE> struct EpiBf16Probe {
    static constexpr bool PERM = true, AFTER_DRAIN = false;
    bf16* O; int ldc;
    __device__ __forceinline__ void operator()(const Acc& acc, const Unit& u, int wr, int wc, int fr, int fq) const {
        const int row0 = u.pm * BM + wr * 64 + fr, col0 = u.pn * BM + wc * 64 + 16 * fq;
#pragma unroll
        for (int ai = 0; ai < 2; ++ai)
#pragma unroll
            for (int m = 0; m < 4; ++m) { const int row = row0 + ai * HALF + m * 16; bf16* rowp = O + (size_t)row * ldc + col0;
#pragma unroll
                for (int bj = 0; bj < 2; ++bj) { const f32x4 v0 = acc[ai][bj][m][0], v1 = acc[ai][bj][m][1]; v4u w;
                    w.x = cvt_pk_bf16(v0[0], v0[1]); w.y = cvt_pk_bf16(v0[2], v0[3]); w.z = cvt_pk_bf16(v1[0], v1[1]); w.w = cvt_pk_bf16(v1[2], v1[3]);
                    if (MODE == 1 && (ai || m)) { asm volatile("" :: "v"(w)); } else *(v4u*)(rowp + bj * 8) = w; } }
    }
};
template <bool GATHER_, int NPN> struct MoeOrder {
    static constexpr bool GATHER = GATHER_;
    LAS unsigned char* ldsx; const Ent* ent; int tlo, thi, G, c, wave; const Ent* zero;
    CvtWork w{}; int slot = -1;
    __device__ __forceinline__ int nunits() const { const int nun = (thi - tlo) * NPN; return c < nun ? (nun - 1 - c) / G + 1 : 0; }
    __device__ __forceinline__ bool next(int i, Unit& u) const {
        const long L = (long)i * G + c; const int nun = (thi - tlo) * NPN; if (L >= nun) return false;
        const int tile = tlo + (int)(L / NPN); const LAS int* T0 = (const LAS int*)(ldsx + LST_OFF + 256);
        int l = 0;
        for (int j = 1; j < NLIST; ++j) l += (T0[j] <= tile) ? 1 : 0;
        l = __builtin_amdgcn_readfirstlane(l);
        u.pm = tile; u.pn = (int)(L % NPN); u.bt = (l & (NE - 1)) * NPN + u.pn; u.par = i & 1; u.lst = l; u.rk0 = (tile - __builtin_amdgcn_readfirstlane(T0[l])) * BM; u.nl = __builtin_amdgcn_readfirstlane(((const LAS int*)(ldsx + LST_OFF))[l]);
        return true;
    }
    __device__ __forceinline__ void a_prefetch(const Unit& u) const {
        if (wave < 4) { const int tid = TIDX(wave); const int rk = u.rk0 + tid; const Ent* src = rk < u.nl ? ent + (size_t)u.lst * LCAP + rk : zero;
            __builtin_amdgcn_global_load_lds((const unsigned*)src, (LAS unsigned*)(ldsx + TAB_OFF + u.par * 4096 + wave * 1024), 16, 0, 0); }
    }
    __device__ __forceinline__ void a_first() const { asm volatile("s_waitcnt vmcnt(0)" ::: "memory"); __builtin_amdgcn_s_barrier(); asm volatile("" ::: "memory"); }
    __device__ __forceinline__ void a_ready(const Unit&) const {}
    __device__ __forceinline__ void done(const Unit&) const {}
    __device__ __forceinline__ void between(int ui, int wid) const { if (GATHER_ && ui == slot) w.run(wid, CvtWork::NGU, CvtWork::NIT); }
};
struct FinalOrder : StaticOrder {
    LAS unsigned char* ldsx; const float* ssp; int wave;
    __device__ __forceinline__ void a_prefetch(const Unit&) const {}
    __device__ __forceinline__ void a_first() const {}
    __device__ __forceinline__ void a_ready(const Unit& u) const {
        const int tid = TIDX(wave);
        if (tid < 256) { const int row = u.pm * BM + tid; float ss = 0.f;
#pragma unroll
            for (int j = 0; j < 8; ++j) { const f32x4 p = *(const f32x4*)(ssp + (size_t)row * 32 + 4 * j); ss += (p[0] + p[1]) + (p[2] + p[3]); }
            *(LAS v4u*)(ldsx + TAB_OFF + u.par * 4096 + tid * 16) = (v4u){(unsigned)row, 0u, __float_as_uint(1.0f / sqrtf(ss * (1.0f / D) + EPS)), 0u}; }
    }
};
}
#define RLX_AGENT __ATOMIC_RELAXED, __HIP_MEMORY_SCOPE_AGENT
#define XB_TMO      128
#define XB_XCNT(j)  (256  + 64 * (j))
#define XB_XSUB(j)  (1280 + 64 * (j))
#define XB_XGEN(j)  (2304 + 64 * (j))
#define XB_TOP      3328
#define XB_TOPGEN   3392
#define XCD_BAR_WORDS 3456
#define XB_SPIN_CAP (1u << 18)

__device__ __forceinline__ unsigned xb_ld(unsigned* p)              { return __hip_atomic_load(p, __ATOMIC_RELAXED, __HIP_MEMORY_SCOPE_AGENT); }
__device__ __forceinline__ unsigned xb_add(unsigned* p, unsigned v) { return __hip_atomic_fetch_add(p, v, __ATOMIC_RELAXED, __HIP_MEMORY_SCOPE_AGENT); }
__device__ __forceinline__ unsigned xb_xcc_id() { return (unsigned)__builtin_amdgcn_s_getreg((3 << 11) | 20) & 0xFu; }
#define XB_SPIN(cond, bar) do { unsigned _sp = 0; while (cond) { __builtin_amdgcn_s_sleep(1); \
    if ((++_sp & 255u) == 0u) { if (xb_ld(&(bar)[XB_TMO])) break; if (_sp > XB_SPIN_CAP) { atomicAdd(&(bar)[XB_TMO], 1u); break; } } } } while (0)

struct XcdBarrier {
    unsigned* bar; unsigned x;
    volatile LAS unsigned* st;
};
__device__ __forceinline__ XcdBarrier xcd_barrier_post(unsigned* bar, volatile LAS unsigned* st, const int wave_) {
    XcdBarrier b; b.bar = bar; b.x = xb_xcc_id(); b.st = st;
    if (TIDX(wave_) == 0) (void)xb_add(&bar[XB_XCNT(b.x)], 1u);
    return b;
}
__device__ __forceinline__ void xcd_barrier_complete(unsigned* bar, unsigned x, unsigned& nloc, unsigned& nx) {
    const unsigned G = gridDim.x * gridDim.y * gridDim.z;
    unsigned sum, cnt, mine, sp = 0u;
    for (;;) {
        sum = 0u; cnt = 0u; mine = 0u;
#pragma unroll
        for (unsigned j = 0; j < 16; ++j) { const unsigned c = xb_ld(&bar[XB_XCNT(j)]); sum += c; cnt += (c > 0u) ? 1u : 0u; mine = (j == x) ? c : mine; }
        if (sum == G) break;
        __builtin_amdgcn_s_sleep(1);
        if ((++sp & 255u) == 0u) { if (xb_ld(&bar[XB_TMO])) break; if (sp > XB_SPIN_CAP) { atomicAdd(&bar[XB_TMO], 1u); break; } }
    }
    nloc = mine > 0u ? mine : 1u; nx = cnt > 0u ? cnt : 1u;
}
__device__ __forceinline__ void xcd_barrier(const XcdBarrier& b, const int wave_) {
    asm volatile("s_waitcnt vmcnt(0)" ::: "memory");
    __syncthreads();
    if (TIDX(wave_) == 0) {
        unsigned* bar = b.bar;
        __builtin_amdgcn_s_waitcnt(0);
        unsigned nloc = b.st[0], nx = b.st[1];
        if (nloc == 0u) { xcd_barrier_complete(bar, b.x, nloc, nx); b.st[0] = nloc; b.st[1] = nx; }
        const unsigned old = xb_add(&bar[XB_XSUB(b.x)], 1u);
        const unsigned gen = old / nloc;
        if (old + 1u == (gen + 1u) * nloc) {
            __builtin_amdgcn_fence(__ATOMIC_RELEASE, "agent");
            asm volatile("s_waitcnt vmcnt(0)" ::: "memory");
            const unsigned og = xb_add(&bar[XB_TOP], 1u);
            const unsigned tg = og / nx;
            if (og + 1u == (tg + 1u) * nx) xb_add(&bar[XB_TOPGEN], 1u);
            else XB_SPIN(xb_ld(&bar[XB_TOPGEN]) == tg, bar);
            __builtin_amdgcn_fence(__ATOMIC_ACQUIRE, "agent");
            xb_add(&bar[XB_XGEN(b.x)], 1u);
            asm volatile("s_waitcnt vmcnt(0)" ::: "memory");
        } else {
            XB_SPIN(xb_ld(&bar[XB_XGEN(b.x)]) == gen, bar);
            __builtin_amdgcn_fence(__ATOMIC_ACQUIRE, "agent");
            asm volatile("s_waitcnt vmcnt(0)" ::: "memory");
        }
    }
    __syncthreads();
}

constexpr int NWAVES = 8;
__device__ __forceinline__ void p0_transpose_item(const float* W, int K, int N, const float* g0, const float* g1, int gsplit, bf16* WT, int rowbase, int k0, int n0, LAS float* scr, int lane) {
    float v[32];
    const float* src = W + (size_t)(k0 + (lane >> 5)) * N + n0 + (lane & 31);
#pragma unroll
    for (int i = 0; i < 32; ++i) v[i] = __builtin_nontemporal_load(src + (size_t)(2 * i) * N);
    const int c = lane & 7;
    float gg[8];
#pragma unroll
    for (int j = 0; j < 8; ++j) { const int k = k0 + 8 * c + j; gg[j] = g0 ? (k < gsplit ? g0[k] : g1[k - gsplit]) : 1.f; }
#pragma unroll
    for (int i = 0; i < 32; ++i) scr[(2 * i + (lane >> 5)) * 33 + (lane & 31)] = v[i];
    asm volatile("s_waitcnt lgkmcnt(0)" ::: "memory");
#pragma unroll
    for (int j = 0; j < 4; ++j) { const int n = (lane >> 3) + 8 * j; const LAS float* s = scr + (8 * c) * 33 + n;
        v4u o; o.x = pk2(s[0 * 33] * gg[0], s[1 * 33] * gg[1]); o.y = pk2(s[2 * 33] * gg[2], s[3 * 33] * gg[3]); o.z = pk2(s[4 * 33] * gg[4], s[5 * 33] * gg[5]); o.w = pk2(s[6 * 33] * gg[6], s[7 * 33] * gg[7]);
        *(v4u*)(WT + (size_t)(rowbase + n) * K + k0 + 8 * c) = o; }
    asm volatile("s_waitcnt lgkmcnt(0)" ::: "memory");
}
__device__ __forceinline__ void p0_transpose_item8(const float* W, int K, int N, const float* g0, unsigned char* WT8, int rowbase, int k0, int n0, LAS float* scr, int lane, float sc, int rs8 = 8) {
    float v[32];
    const float* src = W + (size_t)(k0 + (lane >> 5)) * N + n0 + (lane & 31);
#pragma unroll
    for (int i = 0; i < 32; ++i) v[i] = __builtin_nontemporal_load(src + (size_t)(2 * i) * N);
    const int c = lane & 7;
    float gg[8];
#pragma unroll
    for (int j = 0; j < 8; ++j) gg[j] = (g0 ? g0[k0 + 8 * c + j] : 1.f) * sc;
#pragma unroll
    for (int i = 0; i < 32; ++i) scr[(2 * i + (lane >> 5)) * 33 + (lane & 31)] = v[i];
    asm volatile("s_waitcnt lgkmcnt(0)" ::: "memory");
#pragma unroll
    for (int j = 0; j < 4; ++j) { const int n = (lane >> 3) + 8 * j; const LAS float* s = scr + (8 * c) * 33 + n; float f[8];
#pragma unroll
        for (int q = 0; q < 8; ++q) f[q] = s[q * 33] * gg[q];
        *(v2u*)(WT8 + (size_t)(rowbase + j * rs8 + (lane >> 3)) * K + k0 + 8 * c) = pack8_f8(f, 1.0f); }
    asm volatile("s_waitcnt lgkmcnt(0)" ::: "memory");
}
__device__ __forceinline__ void p0_prologue(const Ptrs& P, LAS unsigned char* lds, int vcu, int G, const int wave) {
    const int lane = lane_id(), tid = wave * 64 + lane;
    unsigned char* ws = P.ws;
    LAS float* scr = (LAS float*)(lds + wave * 16384);
    const int gw = vcu * NWAVES + wave, NGW = G * NWAVES;
    constexpr int I_IN = (D / 64) * (DIN / 32), I_OUT = (D / 64) * (D / 32), I_PLG = I_OUT, I_PLE = (PLE / 64) * (D / 32), I_RT = (D / 64) * (NE / 32);
    constexpr int I_G1 = (D / 64) * (DEXP / 32), I_D1 = (DEXP / 64) * (D / 32);
    constexpr int NITEMS = I_IN + I_OUT + I_PLG + I_PLE + I_RT + (DEFER_CVT ? 0 : NE * (2 * I_G1 + I_D1));
    for (int it = gw; it < NITEMS; it += NGW) {
        int r = it;
        if (r < I_IN) { const int nb = DIN / 32; const int n0 = (r % nb) * 32, k0 = (r / nb) * 64;
            if (FP8QKV && n0 >= C_Q) p0_transpose_item8(P.w_in, D, DIN, P.norm_mix, ws + WS_WIN8, n0 - C_Q, k0, n0, scr, lane, F8_WSCALE);
            else p0_transpose_item(P.w_in, D, DIN, P.norm_mix, nullptr, D, (bf16*)(ws + WS_WIN), n0, k0, n0, scr, lane);
            continue; } r -= I_IN;
        if (r < I_OUT) { const int nb = D / 32; const int k0 = (r / nb) * 64;
            if (FP8O) p0_transpose_item8(P.w_out, D, D, k0 < DCONV ? P.onc : P.ona - DCONV, ws + WS_WOUT, (r % nb) * 32, k0, (r % nb) * 32, scr, lane, F8_WSCALE);
            else p0_transpose_item(P.w_out, D, D, P.onc, P.ona, DCONV, (bf16*)(ws + WS_WOUT), (r % nb) * 32, k0, (r % nb) * 32, scr, lane);
            continue; } r -= I_OUT;
        if (r < I_PLG) { const int nb = D / 32;
            if (FP8) p0_transpose_item8(P.w_ple_gate, D, D, P.norm_ple, ws + WS_WPLG, (r % nb) * 32, (r / nb) * 64, (r % nb) * 32, scr, lane, F8_WSCALE);
            else p0_transpose_item(P.w_ple_gate, D, D, P.norm_ple, nullptr, D, (bf16*)(ws + WS_WPLG), (r % nb) * 32, (r / nb) * 64, (r % nb) * 32, scr, lane);
            continue; } r -= I_PLG;
        if (r < I_PLE) { const int nb = D / 32; p0_transpose_item(P.w_ple, PLE, D, nullptr, nullptr, 0, (bf16*)(ws + WS_WPLE), (r % nb) * 32, (r / nb) * 64, (r % nb) * 32, scr, lane); continue; } r -= I_PLE;
        if (r < I_RT) { p0_transpose_item(P.w_router, D, NE, P.norm_ffn, nullptr, D, (bf16*)(ws + WS_WR), NGRP, r * 64, 0, scr, lane); continue; } r -= I_RT;
        const int e = r / (2 * I_G1 + I_D1); r -= e * (2 * I_G1 + I_D1);
        if (r < 2 * I_G1) { const int up = r >= I_G1; r -= up * I_G1; const int nb = DEXP / 32, n0 = (r % nb) * 32, k0 = (r / nb) * 64;
            if (FP8) p0_transpose_item8((up ? P.w_up : P.w_gate) + (size_t)e * D * DEXP, D, DEXP, P.norm_ffn, ws + WS_WGU + (size_t)e * 1024 * D, (n0 >> 7) * 256 + 2 * (n0 & 127) + up * 8, k0, n0, scr, lane, F8_WSCALE, 16);
            else p0_transpose_item((up ? P.w_up : P.w_gate) + (size_t)e * D * DEXP, D, DEXP, P.norm_ffn, nullptr, D, (bf16*)(ws + WS_WGU) + (size_t)e * 1024 * D, (n0 >> 7) * 256 + up * 128 + (n0 & 127), k0, n0, scr, lane);
            continue; }
        r -= 2 * I_G1; { const int nb = D / 32;
            if (FP8) p0_transpose_item8(P.w_down + (size_t)e * DEXP * D, DEXP, D, nullptr, ws + WS_WD + (size_t)e * D * DEXP, (r % nb) * 32, (r / nb) * 64, (r % nb) * 32, scr, lane, F8_DSCALE);
            else p0_transpose_item(P.w_down + (size_t)e * DEXP * D, DEXP, D, nullptr, nullptr, 0, (bf16*)(ws + WS_WD) + (size_t)e * D * DEXP, (r % nb) * 32, (r / nb) * 64, (r % nb) * 32, scr, lane); }
    }
    { bf16* Wr = (bf16*)(ws + WS_WR); const int gt = vcu * (NWAVES * 64) + tid, NT = G * NWAVES * 64;
      for (int i = gt; i < NGRP * D; i += NT) { const int n = i / D, k = i % D; Wr[(size_t)n * D + k] = f2bf(P.norm_ffn[k] * P.w_group[(size_t)k * NGRP + n]); }
      for (int i = gt; i < (256 - NRT) * D / 8; i += NT) *(v4u*)(Wr + (size_t)NRT * D + (size_t)i * 8) = (v4u){0u, 0u, 0u, 0u}; }
    for (int m = gw; m < M; m += NGW) {
        const f32x4* xr = (const f32x4*)(P.x + (size_t)m * D) + lane; f32x4 v[8]; float s = 0.f;
#pragma unroll
        for (int j = 0; j < 8; ++j) { v[j] = __builtin_nontemporal_load(xr + 64 * j); s += (v[j][0] * v[j][0] + v[j][1] * v[j][1]) + (v[j][2] * v[j][2] + v[j][3] * v[j][3]); }
        s = wsum(s);
        v2u* o8 = (v2u*)((bf16*)(ws + WS_XB) + (size_t)m * D) + lane;
        const float rstd = 1.0f / sqrtf(s * (1.0f / D) + EPS);
#pragma unroll
        for (int j = 0; j < 8; ++j) { v2u o; o.x = pk2(v[j][0] * rstd, v[j][1] * rstd); o.y = pk2(v[j][2] * rstd, v[j][3] * rstd); o8[64 * j] = o; }
        if (FP8QKV) { unsigned* o4 = (unsigned*)(ws + WS_XB8 + (size_t)m * D) + lane; const float r16 = rstd * F8_ASCALE;
#pragma unroll
            for (int j = 0; j < 8; ++j) { int w = 0; w = __builtin_amdgcn_cvt_pk_fp8_f32(v[j][0] * r16, v[j][1] * r16, w, false); w = __builtin_amdgcn_cvt_pk_fp8_f32(v[j][2] * r16, v[j][3] * r16, w, true); o4[64 * j] = (unsigned)w; } }
        if (lane == 0) { ((float*)(ws + WS_RSX))[m] = 1.0f; ((float*)(ws + WS_RMSX))[m] = sqrtf(s * (1.0f / D) + EPS); }
    }
    { const int gt = vcu * (NWAVES * 64) + tid, NT = G * NWAVES * 64; const f32x4* src = (const f32x4*)P.p; v4u* dst = (v4u*)(ws + WS_PB);
      for (int i = gt; i < M * PLE / 8; i += NT) { const f32x4 a = __builtin_nontemporal_load(src + 2 * i), b = __builtin_nontemporal_load(src + 2 * i + 1); v4u o; o.x = pk2(a[0], a[1]); o.y = pk2(a[2], a[3]); o.z = pk2(b[0], b[1]); o.w = pk2(b[2], b[3]); dst[i] = o; } }
}

#ifndef CONVR
#define CONVR 4
#endif
constexpr int P2_KS = 0, P2_KROW = 144, P2_VT = 36864, P2_VROW = 528, P2_OST = 70656, P2_OROW = 144, P2_SS = 107520, P2_RSTD = 108032, P2_QG = 108544;
__device__ __forceinline__ int crow(int r, int hi) { return (r & 3) + 8 * (r >> 2) + 4 * hi; }
__device__ __forceinline__ void p2_unit(const Ptrs& P, LAS unsigned char* lds, int unit, const int wid, const bool conv_first) {
    int lane_ = lane_id_asm(); asm volatile("" : "+v"(lane_));
    const int lane = lane_ & 63, tid = wid * 64 + lane, l32 = lane & 31, hi = lane >> 5;
    const bf16* proj = (const bf16*)(P.ws + WS_PROJ); bf16* mixed = (bf16*)(P.ws + WS_MIX); unsigned char* mixed8 = P.ws + WS_MIX8;
    bf16* osc = FP8O ? (bf16*)(P.ws + WS_MIX + 64 * MiB) : mixed + DCONV; constexpr int OLD = FP8O ? DATTN : D;
    const int b = unit / (SEQ / 128), qb = unit % (SEQ / 128), q0 = qb * 128; const size_t rowbase = (size_t)b * SEQ;
    LAS float* rowss = (LAS float*)(lds + P2_SS); LAS float* qg = (LAS float*)(lds + P2_QG);
    __syncthreads();
    if (tid < 128) rowss[tid] = 0.f;
    if (tid < 64) qg[tid] = P.q_norm[tid] * (0.125f * LOG2E);
    if (conv_first) {
    {
        int lc_ = lane_id_asm(); asm volatile("" : "+v"(lc_)); const int lane = lc_ & 63;
        const float* cw = P.conv_w; float w0[16], w1[16], w2[16];
#pragma unroll
        for (int j = 0; j < 16; ++j) { const int ch = (j >> 3) * 512 + lane * 8 + (j & 7); w0[j] = cw[ch]; w1[j] = cw[DCONV + ch]; w2[j] = cw[2 * DCONV + ch]; }
        float u1[16], u2[16];
        const int t0 = q0 + 16 * wid;
#pragma unroll
        for (int j = 0; j < 16; ++j) { u1[j] = 0.f; u2[j] = 0.f; }
        if (t0 >= 2) {
#pragma unroll
            for (int hf = 0; hf < 2; ++hf) { const int ch = hf * 512 + lane * 8; float c[8], hc[8];
                const bf16* pr = proj + (rowbase + t0 - 1) * DIN; unpack8(*(const v4u*)(pr + C_C + ch), c); unpack8(*(const v4u*)(pr + C_HC + ch), hc);
#pragma unroll
                for (int j = 0; j < 8; ++j) u1[hf * 8 + j] = c[j] * hc[j];
                pr -= DIN; unpack8(*(const v4u*)(pr + C_C + ch), c); unpack8(*(const v4u*)(pr + C_HC + ch), hc);
#pragma unroll
                for (int j = 0; j < 8; ++j) u2[hf * 8 + j] = c[j] * hc[j]; }
        }
#pragma unroll 1
        for (int r0 = 0; r0 < 16; r0 += CONVR) {
            v4u rb[CONVR][2], rc[CONVR][2], rh[CONVR][2];
#pragma unroll
            for (int rr = 0; rr < CONVR; ++rr) { const bf16* pr = proj + (rowbase + t0 + r0 + rr) * DIN + lane * 8;
#pragma unroll
                for (int hf = 0; hf < 2; ++hf) { rb[rr][hf] = __builtin_nontemporal_load((const v4u*)(pr + C_B + hf * 512)); rc[rr][hf] = __builtin_nontemporal_load((const v4u*)(pr + C_C + hf * 512)); rh[rr][hf] = __builtin_nontemporal_load((const v4u*)(pr + C_HC + hf * 512)); } }
#pragma unroll
            for (int rr = 0; rr < CONVR; ++rr) { float y[16]; float ss = 0.f;
#pragma unroll
                for (int hf = 0; hf < 2; ++hf) { float bb[8], c[8], hc[8]; unpack8(rb[rr][hf], bb); unpack8(rc[rr][hf], c); unpack8(rh[rr][hf], hc);
#pragma unroll
                    for (int j = 0; j < 8; ++j) { const int jj = hf * 8 + j; const float u0 = c[j] * hc[j];
                        y[jj] = bb[j] * (w0[jj] * u2[jj] + w1[jj] * u1[jj] + w2[jj] * u0); ss += y[jj] * y[jj]; u2[jj] = u1[jj]; u1[jj] = u0; } }
                ss = wsum(ss); const float rs = rsqf(ss * (1.0f / DCONV) + EPS);
#pragma unroll
                for (int hf = 0; hf < 2; ++hf) { float f[8];
#pragma unroll
                    for (int j = 0; j < 8; ++j) f[j] = y[hf * 8 + j] * rs;
                    if (FP8O) *(v2u*)(mixed8 + (rowbase + t0 + r0 + rr) * D + hf * 512 + lane * 8) = pack8_f8(f, F8_ASCALE);
                    else *(v4u*)(mixed + (rowbase + t0 + r0 + rr) * D + hf * 512 + lane * 8) = pack8(f); } }
        }
    }
    }
    const int h4 = wid & 3, half = wid >> 2;
    const int part = tid & 7;
    float kg[8];
#pragma unroll
    for (int j = 0; j < 8; ++j) kg[j] = P.k_norm[part * 8 + j];
    v4u kraw[4], vraw[4], qraw[4];
    const int kvoff = (tid >> 3) * DIN + part * 8, qoff = l32 * DIN + 8 * hi;
#define P2_LOAD_KV(g_) do { _Pragma("unroll") for (int i = 0; i < 4; ++i) { kraw[i] = (v4u){0u, 0u, 0u, 0u}; vraw[i] = (v4u){0u, 0u, 0u, 0u}; \
        if (q0 > 0 || i >= 2) { const bf16* ub = proj + (rowbase + q0 - 128 + 64 * i) * DIN + (g_) * HD; kraw[i] = *(const v4u*)(ub + C_K + kvoff); vraw[i] = *(const v4u*)(ub + C_V + kvoff); } } } while (0)
#define P2_LOAD_Q(g_, sub_) do { const bf16* ub = proj + (rowbase + q0 + 64 * half + 32 * (sub_)) * DIN + C_Q + ((g_) * 4 + h4) * HD; \
        _Pragma("unroll") for (int d0 = 0; d0 < 4; ++d0) qraw[d0] = __builtin_nontemporal_load((const v4u*)(ub + 16 * d0 + qoff)); } while (0)
    P2_LOAD_KV(0); P2_LOAD_Q(0, 0);
#pragma unroll 1
    for (int g = 0; g < NKV; ++g) {
        int lg_ = lane_id_asm(); asm volatile("" : "+v"(lg_));
        const int lane = lg_ & 63, tid = wid * 64 + lane, l32 = lane & 31, hi = lane >> 5, part = tid & 7;
        const int kvoff = (tid >> 3) * DIN + part * 8, qoff = l32 * DIN + 8 * hi, ooffo = (lane >> 3) * OLD + (lane & 7) * 8;
        __syncthreads();
#pragma unroll
        for (int i = 0; i < 4; ++i) {
            const int key = (tid >> 3) + 64 * i;
            float kf[8]; unpack8(kraw[i], kf); float ss = 0.f;
#pragma unroll
            for (int j = 0; j < 8; ++j) ss += kf[j] * kf[j];
            ss += __shfl_xor(ss, 1); ss += __shfl_xor(ss, 2); ss += __shfl_xor(ss, 4);
            const float rk = rsqf(ss * (1.0f / HD) + EPS);
#pragma unroll
            for (int j = 0; j < 8; ++j) kf[j] = kf[j] * rk * kg[j];
            *(LAS v4u*)(lds + P2_KS + key * P2_KROW + part * 16) = pack8(kf);
            const int x = key & 15; const int pos = (key & ~15) + (x & 3) + ((x >> 3) & 1) * 4 + ((x >> 2) & 1) * 8;
            LAS bf16* vt = (LAS bf16*)(lds + P2_VT) + pos;
            const unsigned vw[4] = {vraw[i].x, vraw[i].y, vraw[i].z, vraw[i].w};
#pragma unroll
            for (int j = 0; j < 4; ++j) { vt[(part * 8 + 2 * j) * (P2_VROW / 2)] = (bf16)(vw[j] & 0xffffu); vt[(part * 8 + 2 * j + 1) * (P2_VROW / 2)] = (bf16)(vw[j] >> 16); }
        }
        if (g + 1 < NKV) { P2_LOAD_KV(g + 1); }
        __syncthreads();
        const int h = g * 4 + h4;
        const float slope2 = exp2f(-0.5f * (float)(h + 1)) * LOG2E, sink2 = P.sinks[h] * LOG2E;
#pragma unroll
        for (int sub = 0; sub < 2; ++sub) {
            const int qs = 64 * half + 32 * sub;
            const int kt0 = 2 * half + sub;
            bf16x8 qf[4];
            { float qv[4][8]; float ss = 0.f;
#pragma unroll
              for (int d0 = 0; d0 < 4; ++d0) { unpack8(qraw[d0], qv[d0]);
#pragma unroll
                  for (int j = 0; j < 8; ++j) ss += qv[d0][j] * qv[d0][j]; }
              ss = xsum32(ss);
              const float rq = rsqf(ss * (1.0f / HD) + EPS);
#pragma unroll
              for (int d0 = 0; d0 < 4; ++d0) {
#pragma unroll
                  for (int j = 0; j < 8; ++j) qv[d0][j] = qv[d0][j] * rq * qg[16 * d0 + 8 * hi + j];
                  const v4u w = pack8(qv[d0]); qf[d0] = __builtin_bit_cast(bf16x8, w); } }
            if (sub == 0) { P2_LOAD_Q(g, 1); } else if (g + 1 < NKV) { P2_LOAD_Q(g + 1, 0); }
            f32x16 sc[5];
#pragma unroll
            for (int jt = 0; jt < 5; ++jt) { sc[jt] = (f32x16){0.f, 0.f, 0.f, 0.f, 0.f, 0.f, 0.f, 0.f, 0.f, 0.f, 0.f, 0.f, 0.f, 0.f, 0.f, 0.f};
#pragma unroll
                for (int d0 = 0; d0 < 4; ++d0) { const bf16x8 kfr = *(const LAS bf16x8*)(lds + P2_KS + ((kt0 + jt) * 32 + l32) * P2_KROW + (16 * d0 + 8 * hi) * 2);
                    sc[jt] = __builtin_amdgcn_mfma_f32_32x32x16_bf16(kfr, qf[d0], sc[jt], 0, 0, 0); } }
            int bl = l32 - 4 * hi; asm volatile("" : "+v"(bl));
            const float ab = -slope2 * (float)bl;
            const f32x2_t ns2 = (f32x2_t){-slope2, -slope2};
#pragma unroll
            for (int jt = 0; jt < 5; ++jt)
#pragma unroll
                for (int r = 0; r < 16; r += 2) { const int c0 = 128 - 32 * jt - (r & 3) - 8 * (r >> 2), c1 = 128 - 32 * jt - ((r + 1) & 3) - 8 * ((r + 1) >> 2);
                    f32x2_t v = (f32x2_t){(float)c0, (float)c1} * ns2 + (f32x2_t){sc[jt][r], sc[jt][r + 1]};
                    if (jt == 0) { v.x = (bl + c0 < 128) ? v.x : -1.0e30f; v.y = (bl + c1 < 128) ? v.y : -1.0e30f; }
                    if (jt == 4) { v.x = (bl + c0 >= 0) ? v.x : -1.0e30f; v.y = (bl + c1 >= 0) ? v.y : -1.0e30f; }
                    sc[jt][r] = v.x; sc[jt][r + 1] = v.y; }
            if (q0 == 0) {
                const int lim = 128 - qs;
#pragma unroll
                for (int jt = 0; jt < 4; ++jt)
#pragma unroll
                    for (int r = 0; r < 16; ++r) { const int kr = crow(r, hi); sc[jt][r] = (32 * jt + kr >= lim) ? sc[jt][r] : -1.0e30f; }
            }
            float mxt = -3.0e38f;
#pragma unroll
            for (int jt = 0; jt < 5; ++jt)
#pragma unroll
                for (int r = 0; r < 16; r += 2) mxt = fmaxf(mxt, fmaxf(sc[jt][r], sc[jt][r + 1]));
            float mx = fmaxf(sink2, mxt + ab); mx = xmax32(mx);
            f32x2_t l2 = (f32x2_t){0.f, 0.f}; const f32x2_t mx2 = (f32x2_t){mx - ab, mx - ab};
#pragma unroll
            for (int jt = 0; jt < 5; ++jt)
#pragma unroll
                for (int r = 0; r < 16; r += 2) { const f32x2_t d = (f32x2_t){sc[jt][r], sc[jt][r + 1]} - mx2; f32x2_t p; p.x = __builtin_amdgcn_exp2f(d.x); p.y = __builtin_amdgcn_exp2f(d.y); sc[jt][r] = p.x; sc[jt][r + 1] = p.y; l2 += p; }
            float l = l2.x + l2.y;
            l = xsum32(l); l += __builtin_amdgcn_exp2f(sink2 - mx);
            const float rl = __builtin_amdgcn_rcpf(l);
            f32x16 o[2];
#pragma unroll
            for (int dh = 0; dh < 2; ++dh) { o[dh] = (f32x16){0.f, 0.f, 0.f, 0.f, 0.f, 0.f, 0.f, 0.f, 0.f, 0.f, 0.f, 0.f, 0.f, 0.f, 0.f, 0.f}; }
#pragma unroll
            for (int jt = 0; jt < 5; ++jt)
#pragma unroll
                for (int j = 0; j < 2; ++j) { v4u pw; pw.x = pk2(sc[jt][8 * j + 0], sc[jt][8 * j + 1]); pw.y = pk2(sc[jt][8 * j + 2], sc[jt][8 * j + 3]); pw.z = pk2(sc[jt][8 * j + 4], sc[jt][8 * j + 5]); pw.w = pk2(sc[jt][8 * j + 6], sc[jt][8 * j + 7]);
                    const bf16x8 pf = __builtin_bit_cast(bf16x8, pw);
#pragma unroll
                    for (int dh = 0; dh < 2; ++dh) { const bf16x8 vf = *(const LAS bf16x8*)(lds + P2_VT + (32 * dh + l32) * P2_VROW + ((kt0 + jt) * 32 + 16 * j + 8 * hi) * 2);
                        o[dh] = __builtin_amdgcn_mfma_f32_32x32x16_bf16(vf, pf, o[dh], 0, 0, 0); } }
            float ss = 0.f;
            LAS unsigned char* ost = lds + P2_OST + wid * (32 * P2_OROW);
#pragma unroll
            for (int dh = 0; dh < 2; ++dh)
#pragma unroll
                for (int r4 = 0; r4 < 4; ++r4) { float a0 = o[dh][4 * r4] * rl, a1 = o[dh][4 * r4 + 1] * rl, a2 = o[dh][4 * r4 + 2] * rl, a3 = o[dh][4 * r4 + 3] * rl;
                    ss += (a0 * a0 + a1 * a1) + (a2 * a2 + a3 * a3);
                    v2u w; w.x = pk2(a0, a1); w.y = pk2(a2, a3);
                    *(LAS v2u*)(ost + l32 * P2_OROW + (32 * dh + 8 * r4 + 4 * hi) * 2) = w; }
            ss = xsum32(ss);
            if (hi == 0) __hip_atomic_fetch_add(rowss + qs + l32, ss, __ATOMIC_RELAXED, __HIP_MEMORY_SCOPE_WORKGROUP);
            asm volatile("s_waitcnt lgkmcnt(0)" ::: "memory");
#pragma unroll
            for (int i = 0; i < 4; ++i) { const int rr = i * 8 + (lane >> 3), ch = lane & 7; const v4u v = *(const LAS v4u*)(ost + rr * P2_OROW + ch * 16);
                bf16* ub = osc + (rowbase + q0 + qs + 8 * i) * OLD + h * HD; *(v4u*)(ub + ooffo) = v; }
            asm volatile("s_waitcnt lgkmcnt(0)" ::: "memory");
            __builtin_amdgcn_sched_barrier(0);
        }
    }
#undef P2_LOAD_KV
#undef P2_LOAD_Q
    asm volatile("s_waitcnt vmcnt(0)" ::: "memory");
    __syncthreads();
    LAS float* rstd = (LAS float*)(lds + P2_RSTD);
    if (tid < 128) rstd[tid] = rsqf(rowss[tid] * (1.0f / DATTN) + EPS);
    __syncthreads();
    { int lf_ = lane_id_asm(); asm volatile("" : "+v"(lf_)); const int tid = wid * 64 + (lf_ & 63);
#pragma unroll 8
    for (int i = 0; i < 32; ++i) { const int rr = (tid >> 7) + 4 * i, ch = tid & 127; bf16* p = osc + (rowbase + q0 + rr) * OLD + ch * 8;
        float f[8]; unpack8(*(const v4u*)p, f); const float s = rstd[rr];
#pragma unroll
        for (int j = 0; j < 8; ++j) f[j] *= s;
        if (FP8O) *(v2u*)(mixed8 + (rowbase + q0 + rr) * D + DCONV + ch * 8) = pack8_f8(f, F8_ASCALE); else *(v4u*)p = pack8(f); } }
    if (!conv_first) {
    {
        int lc_ = lane_id_asm(); asm volatile("" : "+v"(lc_)); const int lane = lc_ & 63;
        const float* cw = P.conv_w; float w0[16], w1[16], w2[16];
#pragma unroll
        for (int j = 0; j < 16; ++j) { const int ch = (j >> 3) * 512 + lane * 8 + (j & 7); w0[j] = cw[ch]; w1[j] = cw[DCONV + ch]; w2[j] = cw[2 * DCONV + ch]; }
        float u1[16], u2[16];
        const int t0 = q0 + 16 * wid;
#pragma unroll
        for (int j = 0; j < 16; ++j) { u1[j] = 0.f; u2[j] = 0.f; }
        if (t0 >= 2) {
#pragma unroll
            for (int hf = 0; hf < 2; ++hf) { const int ch = hf * 512 + lane * 8; float c[8], hc[8];
                const bf16* pr = proj + (rowbase + t0 - 1) * DIN; unpack8(*(const v4u*)(pr + C_C + ch), c); unpack8(*(const v4u*)(pr + C_HC + ch), hc);
#pragma unroll
                for (int j = 0; j < 8; ++j) u1[hf * 8 + j] = c[j] * hc[j];
                pr -= DIN; unpack8(*(const v4u*)(pr + C_C + ch), c); unpack8(*(const v4u*)(pr + C_HC + ch), hc);
#pragma unroll
                for (int j = 0; j < 8; ++j) u2[hf * 8 + j] = c[j] * hc[j]; }
        }
#pragma unroll 1
        for (int r0 = 0; r0 < 16; r0 += CONVR) {
            v4u rb[CONVR][2], rc[CONVR][2], rh[CONVR][2];
#pragma unroll
            for (int rr = 0; rr < CONVR; ++rr) { const bf16* pr = proj + (rowbase + t0 + r0 + rr) * DIN + lane * 8;
#pragma unroll
                for (int hf = 0; hf < 2; ++hf) { rb[rr][hf] = __builtin_nontemporal_load((const v4u*)(pr + C_B + hf * 512)); rc[rr][hf] = __builtin_nontemporal_load((const v4u*)(pr + C_C + hf * 512)); rh[rr][hf] = __builtin_nontemporal_load((const v4u*)(pr + C_HC + hf * 512)); } }
#pragma unroll
            for (int rr = 0; rr < CONVR; ++rr) { float y[16]; float ss = 0.f;
#pragma unroll
                for (int hf = 0; hf < 2; ++hf) { float bb[8], c[8], hc[8]; unpack8(rb[rr][hf], bb); unpack8(rc[rr][hf], c); unpack8(rh[rr][hf], hc);
#pragma unroll
                    for (int j = 0; j < 8; ++j) { const int jj = hf * 8 + j; const float u0 = c[j] * hc[j];
                        y[jj] = bb[j] * (w0[jj] * u2[jj] + w1[jj] * u1[jj] + w2[jj] * u0); ss += y[jj] * y[jj]; u2[jj] = u1[jj]; u1[jj] = u0; } }
                ss = wsum(ss); const float rs = rsqf(ss * (1.0f / DCONV) + EPS);
#pragma unroll
                for (int hf = 0; hf < 2; ++hf) { float f[8];
#pragma unroll
                    for (int j = 0; j < 8; ++j) f[j] = y[hf * 8 + j] * rs;
                    if (FP8O) *(v2u*)(mixed8 + (rowbase + t0 + r0 + rr) * D + hf * 512 + lane * 8) = pack8_f8(f, F8_ASCALE);
                    else *(v4u*)(mixed + (rowbase + t0 + r0 + rr) * D + hf * 512 + lane * 8) = pack8(f); } }
        }
    }
    }
}
constexpr int NPHASE = 10;
struct Args { Ptrs P; int ph_lo, ph_hi; };
__device__ __forceinline__ void moe_tables(LAS unsigned char* ldsx, gu32* ctl, const int wave_) {
    const int tid = TIDX(wave_);
    __syncthreads();
    if (tid < 64) {
        const int n = (int)__hip_atomic_load(ctl + CW_CNT + 64 * tid, RLX_AGENT);
        int x = (n + 255) >> 8;
#pragma unroll
        for (int o = 1; o < 64; o <<= 1) { const int v = __shfl_up(x, o); if (tid >= o) x += v; }
        ((LAS int*)(ldsx + pg8::LST_OFF))[tid] = n;
        ((LAS int*)(ldsx + pg8::LST_OFF + 256))[tid + 1] = x;
        if (tid == 0) ((LAS int*)(ldsx + pg8::LST_OFF + 256))[0] = 0;
    }
    __syncthreads();
}
#ifndef STAG6
#define STAG6 0
#endif
#ifndef STAG9
#define STAG9 0
#endif
__device__ __forceinline__ void stagger(int vcu, int us) {
    if ((vcu & 1) && us > 0) { const unsigned long long t0 = __builtin_amdgcn_s_memrealtime(); while (__builtin_amdgcn_s_memrealtime() - t0 < (unsigned long long)us * 100ull) __builtin_amdgcn_s_sleep(16); }
}
__global__ void __launch_bounds__(NWAVES * 64, 2) mk_fwd(Args args) {
    extern __shared__ __attribute__((aligned(16))) unsigned char lds_raw[];
    LAS unsigned char* lds = (LAS unsigned char*)lds_raw;
    const Ptrs& P = args.P;
    const int wave = __builtin_amdgcn_readfirstlane((int)(threadIdx.x >> 6));
    const int tid = TIDX(wave);
    const int G = gridDim.x, bx = blockIdx.x, vcu = (G % 8 == 0) ? (bx % 8) * (G / 8) + bx / 8 : bx;
    unsigned char* ws = P.ws; gu32* ctl = (gu32*)(ws + WS_CTL);
    for (int u = tid; u < (pg8::LDS_BYTES - pg8::LDSX_OFF) / 4; u += NWAVES * 64) ((LAS unsigned*)(lds + pg8::LDSX_OFF))[u] = 0u;
    __syncthreads();
    const int lo = args.ph_lo, hi = args.ph_hi;
    XcdBarrier bar; bar.bar = (unsigned*)(ctl + CW_BAR); bar.x = 0; bar.st = nullptr;
    if (hi - lo > 1) bar = xcd_barrier_post((unsigned*)(ctl + CW_BAR), (volatile LAS unsigned*)(lds + pg8::MISC_OFF) + 8, wave);
#ifdef ONLY_PHASE
#define IN(k) ((k) == ONLY_PHASE && lo <= (k) && (k) < hi)
#else
#define IN(k) (lo <= (k) && (k) < hi)
#endif
#define SEAM(k) do { if (IN(k) && IN((k) + 1) && (k) != 7 && (k) != 8) xcd_barrier(bar, wave); } while (0)
#define SEAM79() do { if (IN(7) && IN(9)) xcd_barrier(bar, wave); } while (0)
    bf16* Win = (bf16*)(ws + WS_WIN); bf16* Wout = (bf16*)(ws + WS_WOUT); bf16* Wplg = (bf16*)(ws + WS_WPLG); bf16* Wple = (bf16*)(ws + WS_WPLE);
    bf16* Wr = (bf16*)(ws + WS_WR); bf16* Wgu = (bf16*)(ws + WS_WGU); bf16* Wd = (bf16*)(ws + WS_WD);
    bf16* xb = (bf16*)(ws + WS_XB); bf16* mixed = (bf16*)(ws + WS_MIX); bf16* pb = (bf16*)(ws + WS_PB); bf16* proj = (bf16*)(ws + WS_PROJ);
    bf16* hid = (bf16*)(ws + WS_HID); bf16* pw = (bf16*)(ws + WS_PW); bf16* h1 = (bf16*)(ws + WS_H1); bf16* h2 = (bf16*)(ws + WS_H2);
    float* rsx = (float*)(ws + WS_RSX); float* rs1 = (float*)(ws + WS_RS1); float* ss1p = (float*)(ws + WS_SS1P); float* ss2p = (float*)(ws + WS_SS2P);
    int* eid = (int*)(ws + WS_EID); float* ew = (float*)(ws + WS_EW); Ent* ent = (Ent*)(ws + WS_ENT);

    if (IN(0)) { p0_prologue(P, lds, vcu, G, wave); } SEAM(0);
    if (IN(1)) { pg8::Gemm g{xb, Win, M, FP8QKV ? C_Q : DIN, D}; pg8::CvtOrder S; S.init(M, FP8QKV ? C_Q : DIN, G, bx); pg8::EpiBf16 E{proj, DIN, nullptr, 1.f};
        S.w = pg8::CvtWork{P.w_gate, P.w_up, P.w_down, P.norm_ffn, ws, vcu, G}; S.slot = DEFER_CVT ? (((vcu & 31) >> 2) % CVT_SLOTS) : -1; S.lo = 0; S.hi = CVT_SPLIT ? pg8::CvtWork::NGU : pg8::CvtWork::NIT;
        pg8::gemm_phase<pg8::EpiBf16, pg8::CvtOrder, true>(lds, g, S, E, wave);
        if (DEFER_CVT && S.nunits() - 1 <= S.slot) S.w.run(wave, S.lo, S.hi);
        if (FP8QKV) { pg8::Gemm g8{(const bf16*)(ws + WS_XB8), (const bf16*)(ws + WS_WIN8), M, NQKV, D / 2}; pg8::StaticOrder S8; S8.init(M, NQKV, G, bx); pg8::EpiBf16 E8{proj + C_Q, DIN, nullptr, F8_INV};
            pg8::gemm_phase<pg8::EpiBf16, pg8::StaticOrder, true, true>(lds, g8, S8, E8, wave); } } SEAM(1);
    if (IN(2)) { for (int unit = vcu; unit < BATCH * (SEQ / 128); unit += G) p2_unit(P, lds, unit, wave, (vcu & 1) != 0);     __syncthreads(); } SEAM(2);
    if (IN(3)) { pg8::Gemm g{FP8O ? (const bf16*)(ws + WS_MIX8) : mixed, Wout, M, D, FP8O ? D / 2 : D}; pg8::CvtOrder S; S.init(M, D, G, bx); pg8::EpiH1 E{xb, (const float*)(ws + WS_RMSX), h1, ss1p, FP8 ? ws + WS_H18 : nullptr, FP8O ? F8_INV : 1.f};
        S.w = pg8::CvtWork{P.w_gate, P.w_up, P.w_down, P.norm_ffn, ws, vcu, G}; S.slot = (DEFER_CVT && CVT_SPLIT == 2) ? (((vcu & 31) >> 2) % 3) : -1; S.lo = pg8::CvtWork::NGU; S.hi = pg8::CvtWork::NIT;
        pg8::gemm_phase<pg8::EpiH1, pg8::CvtOrder, true, FP8O != 0>(lds, g, S, E, wave);
        if (DEFER_CVT && CVT_SPLIT == 2 && S.nunits() - 1 <= S.slot) S.w.run(wave, S.lo, S.hi); } SEAM(3);
    if (IN(4)) { pg8::Gemm g{h1, Wr, M, 256, D}; pg8::StaticOrder S; S.init(M, 256, G, bx); pg8::EpiRouter E{ss1p, P.b_group, P.b_router, rs1, eid, ew, ent, (unsigned*)(ctl + CW_CNT)};
        pg8::gemm_phase<pg8::EpiRouter, pg8::StaticOrder, false>(lds, g, S, E, wave);
        __syncthreads();
        pg8::Gemm g2{pb, Wple, M, D, PLE}; pg8::PwOrder S2{G, bx, M / 256}; pg8::EpiF8 E2{(unsigned char*)pw, D, F8_PSCALE};
        pg8::gemm_phase<pg8::EpiF8, pg8::PwOrder, true>(lds, g2, S2, E2, wave); } SEAM(4);
    if (IN(5) || IN(6) || IN(7)) moe_tables(lds, ctl, wave);
    const LAS int* T0 = (const LAS int*)(lds + pg8::LST_OFF + 256);
    if (IN(5)) { pg8::Gemm g{FP8 ? (const bf16*)(ws + WS_H18) : h1, Wgu, M, NE * 1024, FP8 ? D / 2 : D}; pg8::MoeOrder<true, 4> S{lds, ent, 0, T0[NLIST], G, vcu, wave, (const Ent*)(ctl + CW_ZERO)}; pg8::EpiGU E{hid, lds, FP8 ? F8_INV : 1.f, FP8 ? (unsigned char*)hid : nullptr};
        if (DEFER_CVT && CVT_SPLIT == 1) { S.w = pg8::CvtWork{P.w_gate, P.w_up, P.w_down, P.norm_ffn, ws, vcu, G}; S.slot = (vcu >> 2) % 3; }
        pg8::gemm_phase<pg8::EpiGU, pg8::MoeOrder<true, 4>, true, FP8 != 0>(lds, g, S, E, wave);
        if (DEFER_CVT && CVT_SPLIT == 1 && S.nunits() - 1 <= S.slot) S.w.run(wave, pg8::CvtWork::NGU, pg8::CvtWork::NIT); } SEAM(5);
    if (IN(6)) { stagger(vcu, STAG6); pg8::Gemm g{hid, Wd, 0, NE * D, FP8 ? DEXP / 2 : DEXP}; pg8::MoeOrder<false, 8> S{lds, ent, 0, T0[NE], G, vcu, wave, (const Ent*)(ctl + CW_ZERO)}; pg8::EpiDown<0> E{ws + WS_H28, lds, F8_DINV};
        pg8::gemm_phase<pg8::EpiDown<0>, pg8::MoeOrder<false, 8>, true, FP8 != 0>(lds, g, S, E, wave); } SEAM(6);
    if (IN(7)) { stagger(vcu, STAG6); pg8::Gemm g{hid, Wd, 0, NE * D, FP8 ? DEXP / 2 : DEXP}; pg8::MoeOrder<false, 8> S{lds, ent, T0[NE], T0[NLIST], G, vcu, wave, (const Ent*)(ctl + CW_ZERO)}; pg8::EpiDown<1> E{h1, h2, ss2p, lds, ws + WS_H28, F8_DINV};
        pg8::gemm_phase<pg8::EpiDown<1>, pg8::MoeOrder<false, 8>, true, FP8 != 0>(lds, g, S, E, wave); } SEAM79();
    if (IN(9)) { stagger(vcu, STAG9); pg8::Gemm g{FP8 ? (const bf16*)(ws + WS_H28) : h2, Wplg, M, D, FP8 ? D / 2 : D}; pg8::FinalOrder S; S.init(M, D, G, bx); S.ldsx = lds; S.ssp = ss2p; S.wave = wave; pg8::EpiFinal E{h2, (const unsigned char*)pw, P.out, lds, FP8 ? F8_INV : 1.f};
        pg8::gemm_phase<pg8::EpiFinal, pg8::FinalOrder, true, FP8 != 0>(lds, g, S, E, wave); }
#undef IN
#undef SEAM
}
extern "C" void kernel_launch(void* const* d_in, const int* in_sizes, int n_in, void* d_out, int out_size, void* d_ws, size_t ws_size, hipStream_t stream) {
    static int grid = 0;
    if (grid == 0) {
        if (n_in != 22 || in_sizes[0] != M * D || out_size != M * D || ws_size < WS_END) { fprintf(stderr, "kernel_launch: unexpected problem (n_in %d, in0 %d, out %d, ws %zu); nothing launched\n", n_in, n_in > 0 ? in_sizes[0] : -1, out_size, ws_size); grid = -1; return; }
        int dev = 0, cus = 0, per_cu = 0;
        if (hipGetDevice(&dev) != hipSuccess || hipDeviceGetAttribute(&cus, hipDeviceAttributeMultiprocessorCount, dev) != hipSuccess) { grid = -1; return; }
        if (hipFuncSetAttribute((const void*)mk_fwd, hipFuncAttributeMaxDynamicSharedMemorySize, pg8::LDS_BYTES) != hipSuccess) { fprintf(stderr, "kernel_launch: hipFuncSetAttribute failed\n"); grid = -1; return; }
        if (hipOccupancyMaxActiveBlocksPerMultiprocessor(&per_cu, (const void*)mk_fwd, NWAVES * 64, pg8::LDS_BYTES) != hipSuccess || per_cu < 1) { fprintf(stderr, "kernel_launch: occupancy query says %d workgroups per CU\n", per_cu); (void)hipGetLastError(); grid = -1; return; }
        grid = cus;
    }
    if (grid < 0) return;
    if (hipMemsetAsync((char*)d_ws + WS_CTL, 0, CTL_ZERO_BYTES, stream) != hipSuccess) return;
    Args a{};
    { const float** pp = (const float**)&a.P; for (int i = 0; i < 22; ++i) pp[i] = (const float*)d_in[i]; }
    a.P.out = (float*)d_out; a.P.ws = (unsigned char*)d_ws;
    a.ph_lo = 0; a.ph_hi = NPHASE;
    hipLaunchKernelGGL(mk_fwd, dim3(grid), dim3(NWAVES * 64), pg8::LDS_BYTES, stream, a);
}
```

```cpp
#include <hip/hip_runtime.h>
#include <cstdio>
#include <cstdint>

typedef unsigned short bf16;
typedef unsigned v4u __attribute__((ext_vector_type(4)));
typedef unsigned v2u __attribute__((ext_vector_type(2)));
typedef float f32x4 __attribute__((ext_vector_type(4)));
typedef float f32x16 __attribute__((ext_vector_type(16)));
typedef short bf16x8 __attribute__((ext_vector_type(8)));
#define GAS __attribute__((address_space(1)))
#define LAS __attribute__((address_space(3)))
typedef GAS unsigned gu32;

constexpr int BATCH = 4, SEQ = 8192, D = 2048, M = BATCH * SEQ;
constexpr int DCONV = 1024, NH = 16, NKV = 4, HD = 64, DATTN = 1024, DKV = 256, DIN = 4608;
constexpr int C_B = 0, C_C = 1024, C_HC = 2048, C_Q = 3072, C_K = 4096, C_V = 4352;
constexpr int NGRP = 4, EPG = 8, NE = 32, DEXP = 512, PLE = 256, NRT = 36;
constexpr int NLIST = 64, LCAP = 32768;
constexpr float EPS = 1e-6f;
constexpr float LOG2E = 1.4426950408889634f;

constexpr size_t MiB = 1u << 20;
constexpr size_t WS_CTL = 0, CTL_ZERO_BYTES = 1 * MiB;
constexpr size_t WS_WIN = 2 * MiB;
constexpr size_t WS_WOUT = 20 * MiB;
constexpr size_t WS_WPLG = 28 * MiB;
constexpr size_t WS_WPLE = 36 * MiB;
constexpr size_t WS_WR = 37 * MiB;
constexpr size_t WS_RSX = 38 * MiB;
constexpr size_t WS_RS1 = 38 * MiB + 256 * 1024;
constexpr size_t WS_RS2 = 38 * MiB + 512 * 1024;
constexpr size_t WS_RMSX = 38 * MiB + 768 * 1024;
constexpr size_t WS_EID = 39 * MiB;
constexpr size_t WS_EW = 39 * MiB + 512 * 1024;
constexpr size_t WS_LOG = 42 * MiB;
constexpr size_t WS_SS1P = 50 * MiB;
constexpr size_t WS_SS2P = 54 * MiB;
#ifndef FP8
#define FP8 1
#endif
#ifndef FP8O
#define FP8O 0
#endif
constexpr size_t WS_MIX8 = 816 * MiB;
#ifndef FP8QKV
#define FP8QKV 0
#endif
constexpr size_t WS_XB8 = 128 * MiB;
constexpr size_t WS_WIN8 = 20 * MiB - 3 * MiB;
constexpr int NQKV = DATTN + 2 * DKV;
constexpr float F8_ASCALE = 16.f, F8_WSCALE = 32.f, F8_INV = 1.0f / (16.f * 32.f);
constexpr float F8_HSCALE = 16.f, F8_DSCALE = 16.f, F8_DINV = 1.0f / (16.f * 16.f);
constexpr float F8_PSCALE = 16.f, F8_PINV = 1.0f / 16.f;
constexpr float F8_YSCALE = 64.f, F8_YINV = 1.0f / 64.f;
constexpr size_t WS_WGU = 64 * MiB;
constexpr size_t WS_H18 = 128 * MiB;
constexpr size_t WS_H28 = 608 * MiB;
constexpr size_t WS_WD = 192 * MiB;
constexpr size_t WS_XB = 256 * MiB;
constexpr size_t WS_MIX = 816 * MiB;
constexpr size_t WS_PB = 384 * MiB;
constexpr size_t WS_PROJ = 400 * MiB;
constexpr size_t WS_HID = 400 * MiB;
constexpr size_t WS_PW = 480 * MiB;
constexpr size_t WS_H1 = 688 * MiB;
constexpr size_t WS_H2 = 816 * MiB;
constexpr size_t WS_YA = 688 * MiB;
constexpr size_t WS_ENT = 944 * MiB;
constexpr size_t WS_END = 976 * MiB;
constexpr int CW_TMO = 0, CW_BAR = 4096, CW_CNT = 8192, CW_ZERO = 16384, CW_RANK = 24576  , CW_TD = 32768  ;

__device__ __forceinline__ float bf2f(bf16 v) { return __uint_as_float(((unsigned)v) << 16); }
__device__ __forceinline__ unsigned f2bfu(float f) { unsigned u = __float_as_uint(f); return (u + 0x7fffu + ((u >> 16) & 1u)) >> 16; }
__device__ __forceinline__ bf16 f2bf(float f) { return (bf16)f2bfu(f); }
typedef float f32x2_t __attribute__((ext_vector_type(2))); typedef __bf16 bf16x2_t __attribute__((ext_vector_type(2)));
__device__ __forceinline__ unsigned pk2(float lo, float hi) { const f32x2_t v = {lo, hi}; const bf16x2_t b = __builtin_convertvector(v, bf16x2_t); return __builtin_bit_cast(unsigned, b); }
__device__ __forceinline__ float xsum32(float v) { const auto r = __builtin_amdgcn_permlane32_swap(__float_as_uint(v), __float_as_uint(v), false, false); return __uint_as_float(r[0]) + __uint_as_float(r[1]); }
__device__ __forceinline__ float xmax32(float v) { const auto r = __builtin_amdgcn_permlane32_swap(__float_as_uint(v), __float_as_uint(v), false, false); return fmaxf(__uint_as_float(r[0]), __uint_as_float(r[1])); }
__device__ __forceinline__ float rsqf(float x) { return __builtin_amdgcn_rsqf(x); }
__device__ __forceinline__ float wsum(float v) {
#pragma unroll
    for (int o = 32; o > 0; o >>= 1) v += __shfl_xor(v, o);
    return v;
}
__device__ __forceinline__ void unpack8(v4u w, float* f) {
    f[0] = __uint_as_float(w.x << 16); f[1] = __uint_as_float(w.x & 0xffff0000u);
    f[2] = __uint_as_float(w.y << 16); f[3] = __uint_as_float(w.y & 0xffff0000u);
    f[4] = __uint_as_float(w.z << 16); f[5] = __uint_as_float(w.z & 0xffff0000u);
    f[6] = __uint_as_float(w.w << 16); f[7] = __uint_as_float(w.w & 0xffff0000u);
}
__device__ __forceinline__ v2u pack8_f8(const float* f, float sc) {
    float c[8];
#pragma unroll
    for (int j = 0; j < 8; ++j) c[j] = __builtin_amdgcn_fmed3f(f[j] * sc, -448.f, 448.f);
    int lo = 0, hi = 0;
    lo = __builtin_amdgcn_cvt_pk_fp8_f32(c[0], c[1], lo, false); lo = __builtin_amdgcn_cvt_pk_fp8_f32(c[2], c[3], lo, true);
    hi = __builtin_amdgcn_cvt_pk_fp8_f32(c[4], c[5], hi, false); hi = __builtin_amdgcn_cvt_pk_fp8_f32(c[6], c[7], hi, true);
    v2u o; o.x = (unsigned)lo; o.y = (unsigned)hi; return o;
}
__device__ __forceinline__ v4u pack8(const float* f) { v4u o; o.x = pk2(f[0], f[1]); o.y = pk2(f[2], f[3]); o.z = pk2(f[4], f[5]); o.w = pk2(f[6], f[7]); return o; }

__device__ __forceinline__ int lane_id_asm() { int l; asm volatile("v_mbcnt_lo_u32_b32 %0, -1, 0\n\tv_mbcnt_hi_u32_b32 %0, -1, %0" : "=v"(l)); return l & 63; }
__device__ __forceinline__ int lane_id() { return lane_id_asm(); }
#define TIDX(wave_) (((wave_) & 7) * 64 + lane_id_asm())

#ifndef DEFER_CVT
#define DEFER_CVT 1
#endif
#ifndef CVT_SLOTS
#define CVT_SLOTS 8
#endif
#ifndef CVT_SPLIT
#define CVT_SPLIT 0
#endif
#ifndef XSEAM5
#define XSEAM5 1
#endif
struct Ptrs {
    const float *x, *p, *norm_mix, *w_in, *conv_w, *q_norm, *k_norm, *sinks, *onc, *ona, *w_out, *norm_ffn, *w_group, *b_group, *w_router, *b_router,
        *w_gate, *w_up, *w_down, *norm_ple, *w_ple_gate, *w_ple;
    float* out; unsigned char* ws;
};
struct Ent { int tok; float w; float rs; int pad; };
#ifndef BALK
#define BALK 0
#endif
#ifndef DMAFIRST
#define DMAFIRST 0
#endif
namespace pg8 {
typedef int v4i __attribute__((ext_vector_type(4)));
typedef int v8i __attribute__((ext_vector_type(8)));
constexpr int BM = 256, BK = 64, HALF = 128, HTB = HALF * BK * 2  , STAGE_BYTES = 8 * HTB, NXCD = 8;
#ifndef WGM_
#define WGM_ 4
#endif
constexpr int WGM = WGM_;
constexpr int RING_BYTES = 131072;
constexpr int LDSX_OFF = RING_BYTES;
constexpr int MISC_OFF = LDSX_OFF + 320;
constexpr int TAB_OFF = LDSX_OFF + 1024;
constexpr int LST_OFF = TAB_OFF + 8192;
constexpr int LDS_BYTES = 147456;

__host__ __device__ __forceinline__ int lds_byte(int r, int c) { const int st = (r >> 4) * 2 + (c >> 5), rr = r & 15, cc = c & 31, ob = rr * 64 + cc * 2; return st * 1024 + (ob ^ (((ob >> 9) & 1) << 5)); }
__host__ __device__ __forceinline__ void stage_rc(int b, int& R, int& C) { const int st = b / 1024, sb = b % 1024, swz = sb ^ (((sb >> 9) & 1) << 5); R = (st >> 1) * 16 + swz / 64; C = (st & 1) * 32 + (swz % 64) / 2; }
__host__ __device__ __forceinline__ int perm32(int rho) { const int n = rho >> 4, i = rho & 15; return 8 * (i >> 2) + 4 * n + (i & 3); }

struct Unit { int pm, pn, bt, par, lst, rk0, nl; };
struct Gemm { const bf16* A; const bf16* Bt; int M, N, K; };

struct StaticOrder {
    static constexpr bool GATHER = false;
    int nM, nN, nwg, G, c;
    __host__ __device__ void init(int M_, int N_, int G_, int c_) { nM = M_ / BM; nN = N_ / BM; nwg = nM * nN; G = G_; c = c_; }
    __host__ __device__ bool next(int i, Unit& u) const {
        const long L = (long)i * G + c; if (L >= nwg) return false;
        int wgid = (int)L; { const int q = nwg / NXCD, r = nwg % NXCD, xcd = wgid % NXCD, off = wgid / NXCD; wgid = (xcd < r ? xcd * (q + 1) : r * (q + 1) + (xcd - r) * q) + off; }
        const int nig = WGM * nN, gid = wgid / nig, fm = gid * WGM, gsz = (nM - fm) < WGM ? (nM - fm) : WGM;
        u.pm = fm + ((wgid % nig) % gsz); u.pn = (wgid % nig) / gsz; u.bt = u.pn; u.par = i & 1; u.lst = 0; u.rk0 = 0; u.nl = 0; return true;
    }
    __device__ __forceinline__ void a_prefetch(const Unit&) const {}
    __device__ __forceinline__ void a_first() const {}
    __device__ __forceinline__ void a_ready(const Unit&) const {}
    __device__ __forceinline__ void done(const Unit&) const {}
    __device__ __forceinline__ void between(int, int) const {}
    __device__ __forceinline__ void signal(int) const {}
};

struct SameTileOrder : StaticOrder { __host__ __device__ bool next(int i, Unit& u) const { if (!StaticOrder::next(i, u)) return false; u.pm = c & 7; u.pn = 0; u.bt = 0; return true; } };
struct PwOrder {
    static constexpr bool GATHER = false;
    int G, c, nr;
    __device__ __forceinline__ bool next(int i, Unit& u) const {
        int L;
        if (G == 256 && nr == 128) { if (c < nr || i >= 8) return false; L = (c - nr) * 8 + i; }
        else { L = i * G + c; if (L >= (M / BM) * (D / BM)) return false; }
        u.pm = L / (D / BM); u.pn = L % (D / BM); u.bt = u.pn; u.par = i & 1; u.lst = 0; u.rk0 = 0; u.nl = 0; return true;
    }
    __device__ __forceinline__ void a_prefetch(const Unit&) const {}
    __device__ __forceinline__ void a_first() const {}
    __device__ __forceinline__ void a_ready(const Unit&) const {}
    __device__ __forceinline__ void done(const Unit&) const {}
    __device__ __forceinline__ void between(int, int) const {}
    __device__ __forceinline__ void signal(int) const {}
};

template <bool GU> __device__ __forceinline__ void cvt_item(const float* W, const float* g0, unsigned char* WT8, int k0, int n0, int up, int lane) {
    constexpr int K = GU ? D : DEXP, N = GU ? DEXP : D;
    const int q = lane & 3, c4 = lane >> 2;
    f32x4 v[32];
    const __attribute__((address_space(1))) f32x4* src = (const __attribute__((address_space(1))) f32x4*)(W + (size_t)(k0 + 16 * q) * N + n0) + c4;
#pragma unroll
    for (int i = 0; i < 32; ++i) v[i] = __builtin_nontemporal_load(src + (size_t)((i & 15) + 64 * (i >> 4)) * (N / 4));
    float gg[32];
#pragma unroll
    for (int t = 0; t < 8; ++t) { f32x4 g4 = (f32x4){1.f, 1.f, 1.f, 1.f}; if (GU) g4 = *(const f32x4*)(g0 + k0 + 16 * q + 64 * (t >> 2) + 4 * (t & 3));
#pragma unroll
        for (int u = 0; u < 4; ++u) gg[4 * t + u] = g4[u] * (GU ? F8_WSCALE : F8_DSCALE); }
    const int n = n0 + 4 * c4;
    const int row = GU ? (n >> 7) * 256 + ((n & 127) >> 3) * 16 + up * 8 + (n & 7) : n;
    unsigned char* dst = WT8 + (size_t)row * K + k0 + 16 * q;
#pragma unroll
    for (int j = 0; j < 4; ++j) { v2u qv[4];
#pragma unroll
        for (int b = 0; b < 4; ++b) { float f[8];
#pragma unroll
            for (int t = 0; t < 8; ++t) f[t] = v[b * 8 + t][j] * gg[b * 8 + t];
            qv[b] = pack8_f8(f, 1.0f); }
        __builtin_nontemporal_store((v4u){qv[0].x, qv[0].y, qv[1].x, qv[1].y}, (v4u*)(dst + (size_t)j * K));
        __builtin_nontemporal_store((v4u){qv[2].x, qv[2].y, qv[3].x, qv[3].y}, (v4u*)(dst + (size_t)j * K + 64)); }
}
struct CvtWork {
    const float *w_gate, *w_up, *w_down, *norm_ffn; unsigned char* ws; int vcu, G;
    static constexpr int NGU = NE * 2 * (DEXP / 64) * (D / 128), ND = NE * (D / 64) * (DEXP / 128), NIT = NGU + ND;
    __device__ __forceinline__ void run(int wid, int lo, int hi) const {
        const int lane = lane_id_asm();
        const float* wg_ = w_gate; const float* wu_ = w_up; asm volatile("" : "+s"(wg_), "+s"(wu_));
        const int n = hi - lo, per = (n + G - 1) / G, perw = (per + 7) / 8, lim = lo + ((vcu + 1) * per < n ? (vcu + 1) * per : n);
        const int base = lo + vcu * per + wid * perw, top = base + perw < lim ? base + perw : lim;
#pragma unroll 1
        for (int it0 = base; it0 < top; ++it0) { const int it = __builtin_amdgcn_readfirstlane(it0);
            if (it < NGU) { const int kb = it & 15, nb = (it >> 4) & 7, up = (it >> 7) & 1, e = it >> 8;
                cvt_item<true>((up ? wu_ : wg_) + (size_t)e * D * DEXP, norm_ffn, ws + WS_WGU + (size_t)e * 1024 * D, kb * 128, nb * 64, up, lane); }
            else { const int j = it - NGU, kb = j & 3, nb = (j >> 2) & 31, e = j >> 7;
                cvt_item<false>(w_down + (size_t)e * DEXP * D, nullptr, ws + WS_WD + (size_t)e * D * DEXP, kb * 128, nb * 64, 0, lane); } }
    }
};
struct CvtOrder : StaticOrder {
    CvtWork w; int slot, lo, hi;
    __device__ __forceinline__ void between(int ui, int wid) const { if (ui == slot) w.run(wid, lo, hi); }
    __device__ __forceinline__ int nunits() const { return c < nwg ? (nwg - 1 - c) / G + 1 : 0; }
};

__device__ __forceinline__ unsigned cvt_pk_bf16(float lo, float hi) { unsigned r; asm volatile("v_cvt_pk_bf16_f32 %0, %1, %2" : "=v"(r) : "v"(lo), "v"(hi)); return r; }

template <class Epi, class Sched, bool ALIGN_EPI, bool F8 = false, int MMAMASK = 15>
__device__ __forceinline__ void gemm_phase(LAS unsigned char* lds, const Gemm g, const Sched& S, const Epi& E, const int wid) {
    const int lane = lane_id(), tid = wid * 64 + lane, wr = wid >> 2, wc = wid & 3, fr = lane & 15, fq = lane >> 4;
    const int K = g.K, nt = K / BK;
    unsigned voffA[2], voffB[2]; int R0 = 0, C0 = 0;
#pragma unroll
    for (int i = 0; i < 2; ++i) { int R, C; stage_rc(tid * 16 + i * 8192, R, C); const int Rb = Epi::PERM ? (64 * (R >> 5) + 16 * ((R & 15) >> 2) + 4 * ((R >> 4) & 1) + (R & 3)) : R;
        voffA[i] = (unsigned)(R * K + C) * 2u; voffB[i] = (unsigned)(Rb * K + C) * 2u; if (i == 0) { R0 = R; C0 = C; } }
    const size_t kstep = (size_t)(BK * 2);
    const size_t hstep = (size_t)HALF * K * 2;
    const size_t tstep = 2 * hstep;
    const size_t hstepB = Epi::PERM ? (size_t)8 * K * 2 : hstep;
    const unsigned ldsw = (unsigned)wid * 1024u;
    const int aoff = lds_byte(wr * 64 + fr, fq * 8), boff = lds_byte(wc * 32 + fr, fq * 8);
    unsigned gc[2][2] = {{0u, 0u}, {0u, 0u}}, gn[2][2] = {{0u, 0u}, {0u, 0u}}, gs[2][2] = {{0u, 0u}, {0u, 0u}};
#define PG8_TOK(par, r) (*(const LAS int*)(lds + TAB_OFF + (par) * 4096 + (r) * 16))
#define PG8_GLOAD(dst, par) do { _Pragma("unroll") for (int _h = 0; _h < 2; ++_h) _Pragma("unroll") for (int _i = 0; _i < 2; ++_i) \
        dst[_h][_i] = (unsigned)PG8_TOK(par, _h * 128 + _i * 64 + R0) * (unsigned)(K * 2) + (unsigned)(C0 * 2); } while (0)
#define PG8_SA(b, h) (((b) * 2 + (h)) * HTB)
#define PG8_SB(b, h) ((4 + (b) * 2 + (h)) * HTB)
#define PG8_STAGE(bufoff, gbase, voff) do { _Pragma("unroll") for (int _i = 0; _i < 2; ++_i) \
        __builtin_amdgcn_global_load_lds((const unsigned*)((const char*)(gbase) + (voff)[_i]), (LAS unsigned*)(lds + (bufoff) + ldsw + _i * 8192), 16, 0, 0); } while (0)
#define PG8_STAGE_A(bufoff, ub, go, h, kb) do { if constexpr (Sched::GATHER) { PG8_STAGE(bufoff, (const char*)g.A + (kb), go[h]); } else { PG8_STAGE(bufoff, (ub) + (kb) + (h) * hstep, voffA); } } while (0)
#define PG8_CAT(p_) __builtin_shufflevector(*(const LAS v4i*)(p_), *(const LAS v4i*)((p_) + 1024), 0, 1, 2, 3, 4, 5, 6, 7)
#define PG8_LDA(dst, b, h) do { if constexpr (F8) { _Pragma("unroll") for (int m = 0; m < 4; ++m) dst##8[m] = PG8_CAT(lds + PG8_SA(b, h) + aoff + m * 2048); } \
        else { _Pragma("unroll") for (int m = 0; m < 4; ++m) _Pragma("unroll") for (int k = 0; k < 2; ++k) dst[m][k] = *(const LAS bf16x8*)(lds + PG8_SA(b, h) + aoff + m * 2048 + k * 1024); } } while (0)
#define PG8_LDB(dst, b, h) do { if constexpr (F8) { _Pragma("unroll") for (int n = 0; n < 2; ++n) dst##8[n] = PG8_CAT(lds + PG8_SB(b, h) + boff + n * 2048); } \
        else { _Pragma("unroll") for (int n = 0; n < 2; ++n) _Pragma("unroll") for (int k = 0; k < 2; ++k) dst[n][k] = *(const LAS bf16x8*)(lds + PG8_SB(b, h) + boff + n * 2048 + k * 1024); } } while (0)
#define PG8_MMA(ai, bj, At, Bt) do { if constexpr (((MMAMASK >> ((ai) * 2 + (bj))) & 1) == 0) break; __builtin_amdgcn_s_setprio(1); _Pragma("unroll") for (int m = 0; m < 4; ++m) _Pragma("unroll") for (int n = 0; n < 2; ++n) { \
        if constexpr (F8) { asm volatile("v_mfma_scale_f32_16x16x128_f8f6f4 %0, %1, %2, %0, %3, %3 op_sel_hi:[0,0,0]" : "+v"(acc[ai][bj][m][n]) : "v"(Bt##8[n]), "v"(At##8[m]), "v"(f8scale)); } \
        else { _Pragma("unroll") for (int k = 0; k < 2; ++k) acc[ai][bj][m][n] = __builtin_amdgcn_mfma_f32_16x16x32_bf16(Bt[n][k], At[m][k], acc[ai][bj][m][n], 0, 0, 0); } } \
        __builtin_amdgcn_s_setprio(0); } while (0)
#define PG8_WAIT_V(n) asm volatile("s_waitcnt vmcnt(" #n ")" ::: "memory")
#define PG8_WAIT_L(n) asm volatile("s_waitcnt lgkmcnt(" #n ")" ::: "memory")
#define PG8_BAR __builtin_amdgcn_s_barrier()
#define PG8_SCHED __builtin_amdgcn_sched_barrier(0)
    Unit cur, nxt; int ui = 0, prev_pm = 0;
    if (!S.next(0, cur)) return;
    f32x4 acc[2][2][4][2];
#pragma unroll
    for (int a = 0; a < 2; ++a)
#pragma unroll
        for (int b = 0; b < 2; ++b)
#pragma unroll
            for (int m = 0; m < 4; ++m)
#pragma unroll
                for (int n = 0; n < 2; ++n) acc[a][b][m][n] = (f32x4){0.f, 0.f, 0.f, 0.f};
    bf16x8 At[4][2], B0[2][2], B1[2][2];
    const int f8scale = 0x7f7f7f7f;
    v8i At8[4], B08[2], B18[2];
    const char* cA = (const char*)g.A + (size_t)cur.pm * tstep; const char* cB = (const char*)g.Bt + (size_t)cur.bt * tstep;
    S.a_prefetch(cur); S.a_first(); S.a_ready(cur);
    if constexpr (Sched::GATHER) { PG8_GLOAD(gc, cur.par); }
    PG8_STAGE(PG8_SB(0, 0), cB, voffB); PG8_STAGE(PG8_SB(0, 1), cB + hstepB, voffB); PG8_STAGE_A(PG8_SA(0, 0), cA, gc, 0, (size_t)0); PG8_STAGE_A(PG8_SA(0, 1), cA, gc, 1, (size_t)0);
    if (wr == 1) PG8_BAR;
    PG8_WAIT_V(2); PG8_BAR;
    PG8_STAGE(PG8_SB(1, 0), cB + kstep, voffB); PG8_STAGE_A(PG8_SA(1, 0), cA, gc, 0, kstep); PG8_STAGE(PG8_SB(1, 1), cB + hstepB + kstep, voffB);
    PG8_WAIT_V(6); PG8_BAR;
    for (;;) {
        const bool has_next = S.next(ui + 1, nxt);
        const char* nA = has_next ? (const char*)g.A + (size_t)nxt.pm * tstep : cA; const char* nB = has_next ? (const char*)g.Bt + (size_t)nxt.bt * tstep : cB;
#pragma unroll 1
        for (int t = 0; t < nt; t += 2) {
            const bool last = (t == nt - 2);
            const size_t k1 = (size_t)(t + 1) * kstep;
            const char* sA = last ? nA : cA; const size_t k2 = last ? (size_t)0 : (size_t)(t + 2) * kstep, k3 = k2 + kstep;
            const char* b2 = last ? nB : cB + (size_t)(t + 2) * kstep; const char* b3 = b2 + kstep;
            if (last && has_next) { S.a_ready(nxt); if constexpr (Sched::GATHER) { PG8_GLOAD(gn, nxt.par); } }
            if constexpr (Sched::GATHER) {
#pragma unroll
                for (int h = 0; h < 2; ++h)
#pragma unroll
                    for (int i = 0; i < 2; ++i) gs[h][i] = (last && has_next) ? gn[h][i] : gc[h][i];
            }
#if BALK
            PG8_LDB(B0, 0, 0); PG8_LDB(B1, 0, 1); PG8_SCHED; PG8_LDA(At, 0, 0); PG8_STAGE_A(PG8_SA(1, 1), cA, gc, 1, k1);
            PG8_WAIT_V(8); PG8_WAIT_L(0); PG8_BAR; PG8_MMA(0, 0, At, B0); PG8_MMA(0, 1, At, B1); PG8_BAR; PG8_SCHED;
            if (has_next && t == nt - 4) S.a_prefetch(nxt);
            PG8_LDA(At, 0, 1); PG8_STAGE(PG8_SB(0, 0), b2, voffB); PG8_STAGE(PG8_SB(0, 1), b2 + hstepB, voffB);
            PG8_WAIT_V(6); PG8_WAIT_L(0); PG8_BAR; PG8_MMA(1, 0, At, B0); PG8_STAGE_A(PG8_SA(0, 0), sA, gs, 0, k2); PG8_MMA(1, 1, At, B1); PG8_BAR; PG8_SCHED;
            PG8_LDB(B0, 1, 0); PG8_LDB(B1, 1, 1); PG8_SCHED; PG8_LDA(At, 1, 0); PG8_STAGE_A(PG8_SA(0, 1), sA, gs, 1, k2);
            PG8_WAIT_V(8); PG8_WAIT_L(0); PG8_BAR; PG8_MMA(0, 0, At, B0); PG8_MMA(0, 1, At, B1); PG8_BAR; PG8_SCHED;
            PG8_LDA(At, 1, 1); PG8_STAGE(PG8_SB(1, 0), b3, voffB); PG8_STAGE(PG8_SB(1, 1), b3 + hstepB, voffB);
            PG8_WAIT_V(6); PG8_WAIT_L(0); PG8_BAR; PG8_MMA(1, 0, At, B0); PG8_STAGE_A(PG8_SA(1, 0), sA, gs, 0, k3); PG8_MMA(1, 1, At, B1); PG8_BAR; PG8_SCHED;
#else
#if DMAFIRST
            PG8_LDB(B0, 0, 0); PG8_LDB(B1, 0, 1); PG8_SCHED; PG8_LDA(At, 0, 0); PG8_WAIT_L(0); PG8_SCHED; PG8_STAGE_A(PG8_SA(1, 1), cA, gc, 1, k1);
            PG8_WAIT_V(8); PG8_BAR; PG8_MMA(0, 0, At, B0); PG8_MMA(0, 1, At, B1); PG8_BAR; PG8_SCHED;
            if (has_next && t == nt - 4) S.a_prefetch(nxt);
            PG8_LDA(At, 0, 1); PG8_WAIT_L(0); PG8_SCHED; PG8_STAGE(PG8_SB(0, 0), b2, voffB); PG8_STAGE(PG8_SB(0, 1), b2 + hstepB, voffB); PG8_STAGE_A(PG8_SA(0, 0), sA, gs, 0, k2);
            PG8_WAIT_V(8); PG8_BAR; PG8_MMA(1, 0, At, B0); PG8_MMA(1, 1, At, B1); PG8_BAR; PG8_SCHED;
            PG8_LDB(B0, 1, 0); PG8_LDB(B1, 1, 1); PG8_SCHED; PG8_LDA(At, 1, 0); PG8_WAIT_L(0); PG8_SCHED; PG8_STAGE_A(PG8_SA(0, 1), sA, gs, 1, k2);
            PG8_WAIT_V(8); PG8_BAR; PG8_MMA(0, 0, At, B0); PG8_MMA(0, 1, At, B1); PG8_BAR; PG8_SCHED;
            PG8_LDA(At, 1, 1); PG8_WAIT_L(0); PG8_SCHED; PG8_STAGE(PG8_SB(1, 0), b3, voffB); PG8_STAGE(PG8_SB(1, 1), b3 + hstepB, voffB); PG8_STAGE_A(PG8_SA(1, 0), sA, gs, 0, k3);
            PG8_WAIT_V(8); PG8_BAR; PG8_MMA(1, 0, At, B0); PG8_MMA(1, 1, At, B1); PG8_BAR; PG8_SCHED;
#else
            PG8_LDB(B0, 0, 0); PG8_LDB(B1, 0, 1); PG8_SCHED; PG8_LDA(At, 0, 0); PG8_STAGE_A(PG8_SA(1, 1), cA, gc, 1, k1);
            PG8_WAIT_V(8); PG8_WAIT_L(0); PG8_BAR; PG8_MMA(0, 0, At, B0); PG8_MMA(0, 1, At, B1); PG8_BAR; PG8_SCHED;
            if (has_next && t == nt - 4) S.a_prefetch(nxt);
            PG8_LDA(At, 0, 1); PG8_STAGE(PG8_SB(0, 0), b2, voffB); PG8_STAGE(PG8_SB(0, 1), b2 + hstepB, voffB); PG8_STAGE_A(PG8_SA(0, 0), sA, gs, 0, k2);
            PG8_WAIT_V(8); PG8_WAIT_L(0); PG8_BAR; PG8_MMA(1, 0, At, B0); PG8_MMA(1, 1, At, B1); PG8_BAR; PG8_SCHED;
            if (t == 0 && ui > 0) S.signal(prev_pm);
            PG8_LDB(B0, 1, 0); PG8_LDB(B1, 1, 1); PG8_SCHED; PG8_LDA(At, 1, 0); PG8_STAGE_A(PG8_SA(0, 1), sA, gs, 1, k2);
            PG8_WAIT_V(8); PG8_WAIT_L(0); PG8_BAR; PG8_MMA(0, 0, At, B0); PG8_MMA(0, 1, At, B1); PG8_BAR; PG8_SCHED;
            PG8_LDA(At, 1, 1); PG8_STAGE(PG8_SB(1, 0), b3, voffB); PG8_STAGE(PG8_SB(1, 1), b3 + hstepB, voffB); PG8_STAGE_A(PG8_SA(1, 0), sA, gs, 0, k3);
            PG8_WAIT_V(8); PG8_WAIT_L(0); PG8_BAR; PG8_MMA(1, 0, At, B0); PG8_MMA(1, 1, At, B1); PG8_BAR; PG8_SCHED;
#endif
#endif
        }
        if constexpr (F8) asm volatile("s_nop 15\n\ts_nop 15" ::: "memory");
        if constexpr (ALIGN_EPI) { if (wr == 0) PG8_BAR; }
        if constexpr (!Epi::AFTER_DRAIN) { E(acc, cur, wr, wc, fr, fq); S.done(cur); }
        if (!has_next) break;
        S.between(ui, wid);
#pragma unroll
        for (int a = 0; a < 2; ++a)
#pragma unroll
            for (int b = 0; b < 2; ++b)
#pragma unroll
                for (int m = 0; m < 4; ++m)
#pragma unroll
                    for (int n = 0; n < 2; ++n) acc[a][b][m][n] = (f32x4){0.f, 0.f, 0.f, 0.f};
        prev_pm = cur.pm; cur = nxt; cA = nA; cB = nB; ++ui;
        if constexpr (Sched::GATHER) {
#pragma unroll
            for (int h = 0; h < 2; ++h)
#pragma unroll
                for (int i = 0; i < 2; ++i) gc[h][i] = gn[h][i];
        }
        if constexpr (ALIGN_EPI) { if (wr == 1) PG8_BAR; }
    }
    PG8_WAIT_V(0);
    if constexpr (!ALIGN_EPI) { if (wr == 0) PG8_BAR; }
    PG8_BAR;
    if constexpr (!Epi::AFTER_DRAIN) S.signal(cur.pm);
    if constexpr (Epi::AFTER_DRAIN) { E.fused(acc, cur, wr, wc, fr, fq, lds, wid, lane); S.done(cur); }
#undef PG8_TOK
#undef PG8_GLOAD
#undef PG8_SA
#undef PG8_SB
#undef PG8_STAGE
#undef PG8_STAGE_A
#undef PG8_CAT
#undef PG8_LDA
#undef PG8_LDB
#undef PG8_MMA
#undef PG8_WAIT_V
#undef PG8_WAIT_L
#undef PG8_BAR
#undef PG8_SCHED
}

typedef f32x4 Acc[2][2][4][2];
#define TAB_ENT(ldsx, par, r) ((const LAS Ent*)((ldsx) + TAB_OFF + (par) * 4096 + (r) * 16))

#ifndef NTS_PROJ
#define NTS_PROJ 0
#endif
struct EpiBf16 {
    static constexpr bool PERM = true, AFTER_DRAIN = false, NTS = NTS_PROJ != 0;
    bf16* O; int ldc; const float* rs; float sc;
    __device__ __forceinline__ void operator()(const Acc& acc, const Unit& u, int wr, int wc, int fr, int fq) const {
        const int row0 = u.pm * BM + wr * 64 + fr, col0 = u.pn * BM + wc * 64 + 16 * fq;
#pragma unroll
        for (int ai = 0; ai < 2; ++ai)
#pragma unroll
            for (int m = 0; m < 4; ++m) { const int row = row0 + ai * HALF + m * 16; const float s = rs ? rs[row] * sc : sc; bf16* rowp = O + (size_t)row * ldc + col0;
#pragma unroll
                for (int bj = 0; bj < 2; ++bj) { const f32x4 v0 = acc[ai][bj][m][0] * s, v1 = acc[ai][bj][m][1] * s; v4u w;
                    w.x = cvt_pk_bf16(v0[0], v0[1]); w.y = cvt_pk_bf16(v0[2], v0[3]); w.z = cvt_pk_bf16(v1[0], v1[1]); w.w = cvt_pk_bf16(v1[2], v1[3]);
                    if (NTS) __builtin_nontemporal_store(w, (v4u*)(rowp + bj * 8)); else *(v4u*)(rowp + bj * 8) = w; } }
    }
};
struct EpiF8 {
    static constexpr bool PERM = true, AFTER_DRAIN = false;
    unsigned char* O; int ldc; float sc;
    __device__ __forceinline__ void operator()(const Acc& acc, const Unit& u, int wr, int wc, int fr, int fq) const {
        const int row0 = u.pm * BM + wr * 64 + fr, col0 = u.pn * BM + wc * 64 + 16 * fq;
#pragma unroll
        for (int ai = 0; ai < 2; ++ai)
#pragma unroll
            for (int m = 0; m < 4; ++m) { const int row = row0 + ai * HALF + m * 16; v2u f8[2];
#pragma unroll
                for (int bj = 0; bj < 2; ++bj) { float o[8];
#pragma unroll
                    for (int n = 0; n < 2; ++n)
#pragma unroll
                        for (int i = 0; i < 4; ++i) o[n * 4 + i] = acc[ai][bj][m][n][i];
                    f8[bj] = pack8_f8(o, sc); }
                *(v4u*)(O + (size_t)row * ldc + col0) = (v4u){f8[0].x, f8[0].y, f8[1].x, f8[1].y}; }
    }
};
struct EpiH1 {
    static constexpr bool PERM = true, AFTER_DRAIN = false;
    const bf16* xb; const float* rms; bf16* h1; float* ssp; unsigned char* h18; float sc;
    __device__ __forceinline__ void operator()(const Acc& acc, const Unit& u, int wr, int wc, int fr, int fq) const {
        const int row0 = u.pm * BM + wr * 64 + fr, col0 = u.pn * BM + wc * 64 + 16 * fq;
        v4u xv[8][2]; float rm[8];
#define H1_LOAD(g_) do { const size_t off_ = (size_t)(row0 + ((g_) >> 2) * HALF + ((g_) & 3) * 16) * D + col0; xv[g_][0] = *(const v4u*)(xb + off_); xv[g_][1] = *(const v4u*)(xb + off_ + 8); } while (0)
#pragma unroll
        for (int gi = 0; gi < 8; ++gi) { rm[gi] = rms[row0 + (gi >> 2) * HALF + (gi & 3) * 16]; H1_LOAD(gi); }
        asm volatile("" ::: "memory");
#pragma unroll
        for (int gi = 0; gi < 8; ++gi) { const int ai = gi >> 2, m = gi & 3;
            const int row = row0 + ai * HALF + m * 16; const size_t off = (size_t)row * D + col0; float ss = 0.f; const float r = rm[gi]; v2u f8[2];
#pragma unroll
            for (int bj = 0; bj < 2; ++bj) { float xf[8]; unpack8(xv[gi][bj], xf); float o[8];
#pragma unroll
                for (int n = 0; n < 2; ++n)
#pragma unroll
                    for (int i = 0; i < 4; ++i) { o[n * 4 + i] = xf[n * 4 + i] * r + acc[ai][bj][m][n][i] * sc; ss += o[n * 4 + i] * o[n * 4 + i]; }
                v4u w; w.x = cvt_pk_bf16(o[0], o[1]); w.y = cvt_pk_bf16(o[2], o[3]); w.z = cvt_pk_bf16(o[4], o[5]); w.w = cvt_pk_bf16(o[6], o[7]);
                *(v4u*)(h1 + off + bj * 8) = w; if (h18) f8[bj] = pack8_f8(o, F8_ASCALE); }
            if (h18) *(v4u*)(h18 + off) = (v4u){f8[0].x, f8[0].y, f8[1].x, f8[1].y};
            ss += __shfl_xor(ss, 16); ss = xsum32(ss);
            if (fq == 0) ssp[(size_t)row * 32 + u.pn * 4 + wc] = ss; }
#undef H1_LOAD
    }
};
struct EpiRouter {
    static constexpr bool PERM = false, AFTER_DRAIN = true;
    const float* ssp; const float* bg; const float* br; float* rs1; int* eid; float* ew; Ent* ent; unsigned* cnt;
    __device__ __forceinline__ void fused(const Acc& acc, const Unit& u, int wr, int wc, int fr, int fq, LAS unsigned char* lds, int wid, int lane) const {
        LAS float* LG = (LAS float*)lds;
        LAS unsigned* HIST = (LAS unsigned*)(lds + 65536);
        LAS unsigned* BASE = (LAS unsigned*)(lds + 65536 + 256);
        const int tid = wid * 64 + lane;
        if (tid < 64) HIST[tid] = 0u;
        if (wc < 2) {
#pragma unroll
            for (int ai = 0; ai < 2; ++ai)
#pragma unroll
                for (int m = 0; m < 4; ++m) { const int r = ai * HALF + wr * 64 + m * 16 + fr;
#pragma unroll
                    for (int n = 0; n < 2; ++n) { const int c = wc * 32 + 16 * n + 4 * fq; if (c < 40) *(LAS f32x4*)(LG + r * 40 + c) = acc[ai][0][m][n]; } }
        }
        __syncthreads();
        int l0 = 0, l1 = 0; unsigned k0 = 0, k1 = 0; float w0 = 0.f, w1 = 0.f, rs = 0.f; const int row = u.pm * BM + tid;
        if (tid < 256) {
            float ss = 0.f;
#pragma unroll
            for (int j = 0; j < 8; ++j) { const f32x4 p = *(const f32x4*)(ssp + (size_t)row * 32 + 4 * j); ss += (p[0] + p[1]) + (p[2] + p[3]); }
            rs = 1.0f / sqrtf(ss * (1.0f / D) + EPS);
            const LAS float* L = LG + tid * 40;
            float gl[NGRP]; int g = 0;
#pragma unroll
            for (int j = 0; j < NGRP; ++j) gl[j] = L[j] * rs + bg[j];
            float gm = gl[0];
#pragma unroll
            for (int j = 1; j < NGRP; ++j) if (gl[j] > gm) { gm = gl[j]; g = j; }
            float gsum = 0.f;
#pragma unroll
            for (int j = 0; j < NGRP; ++j) gsum += __expf(gl[j] - gm);
            const float gw = 1.0f / gsum;
            const LAS float* E = L + NGRP + g * EPG; const float* be = br + g * EPG;
            int i1 = 0; float v1 = E[0] * rs + be[0];
            for (int j = 1; j < EPG; ++j) { const float v = E[j] * rs + be[j]; if (v > v1) { v1 = v; i1 = j; } }
            int i2 = 0; float v2 = -3.0e38f;
            for (int j = 0; j < EPG; ++j) { const float v = E[j] * rs + be[j]; if (j != i1 && v > v2) { v2 = v; i2 = j; } }
            const float e2 = __expf(v2 - v1); w0 = gw / (1.0f + e2); w1 = gw * e2 / (1.0f + e2);
            l0 = g * EPG + i1; l1 = NE + g * EPG + i2;
            eid[row * 2] = l0; eid[row * 2 + 1] = l1 - NE; ew[row * 2] = w0; ew[row * 2 + 1] = w1; rs1[row] = rs;
            k0 = __hip_atomic_fetch_add(HIST + l0, 1u, __ATOMIC_RELAXED, __HIP_MEMORY_SCOPE_WORKGROUP); k1 = __hip_atomic_fetch_add(HIST + l1, 1u, __ATOMIC_RELAXED, __HIP_MEMORY_SCOPE_WORKGROUP);
        }
        __syncthreads();
        if (tid < 64) { const unsigned n = HIST[tid]; BASE[tid] = n ? __hip_atomic_fetch_add(cnt + 64 * tid, n, __ATOMIC_RELAXED, __HIP_MEMORY_SCOPE_AGENT) : 0u; }
        __syncthreads();
        if (tid < 256) {
            *(v4u*)(ent + (size_t)l0 * LCAP + BASE[l0] + k0) = (v4u){(unsigned)row, __float_as_uint(w0), __float_as_uint(rs), 0u};
            *(v4u*)(ent + (size_t)l1 * LCAP + BASE[l1] + k1) = (v4u){(unsigned)row, __float_as_uint(w1), __float_as_uint(rs), 0u};
        }
    }
};
struct EpiGU {
    static constexpr bool PERM = true, AFTER_DRAIN = false;
    bf16* hid; LAS unsigned char* ldsx; float sc; unsigned char* hid8;
    __device__ __forceinline__ void operator()(const Acc& acc, const Unit& u, int wr, int wc, int fr, int fq) const {
        const int col0 = u.pn * HALF + wc * 32 + 8 * fq;
#pragma unroll
        for (int ai = 0; ai < 2; ++ai)
#pragma unroll
            for (int m = 0; m < 4; ++m) { const int r = ai * HALF + wr * 64 + m * 16 + fr; const LAS Ent* e = TAB_ENT(ldsx, u.par, r); const float w = e->w, rs = e->rs * sc;
                float o[8];
#pragma unroll
                for (int n = 0; n < 2; ++n)
#pragma unroll
                    for (int i = 0; i < 4; ++i) { const float gg = acc[ai][0][m][n][i] * rs, uu = acc[ai][1][m][n][i] * rs; o[n * 4 + i] = w * (gg * __builtin_amdgcn_rcpf(1.0f + __expf(-gg))) * uu; }
                if (hid8) { *(v2u*)(hid8 + (size_t)(u.pm * BM + r) * DEXP + col0) = pack8_f8(o, F8_HSCALE); }
                else { v4u q; q.x = cvt_pk_bf16(o[0], o[1]); q.y = cvt_pk_bf16(o[2], o[3]); q.z = cvt_pk_bf16(o[4], o[5]); q.w = cvt_pk_bf16(o[6], o[7]);
                    *(v4u*)(hid + (size_t)(u.pm * BM + r) * DEXP + col0) = q; } }
    }
};
template <int KK> struct EpiDown;
template <> struct EpiDown<0> {
    static constexpr bool PERM = true, AFTER_DRAIN = false;
    unsigned char* y8; LAS unsigned char* ldsx; float sc;
    __device__ __forceinline__ void operator()(const Acc& acc, const Unit& u, int wr, int wc, int fr, int fq) const {
        const int col0 = u.pn * BM + wc * 64 + 16 * fq; const float s64 = sc * F8_YSCALE;
#pragma unroll
        for (int gi = 0; gi < 8; ++gi) { const int ai = gi >> 2, m = gi & 3;
            const int r = ai * HALF + wr * 64 + m * 16 + fr; const bool valid = (u.rk0 + r) < u.nl; const int tok = TAB_ENT(ldsx, u.par, r)->tok; v2u f8[2];
#pragma unroll
            for (int bj = 0; bj < 2; ++bj) { float o[8];
#pragma unroll
                for (int n = 0; n < 2; ++n)
#pragma unroll
                    for (int i = 0; i < 4; ++i) o[n * 4 + i] = acc[ai][bj][m][n][i];
                f8[bj] = pack8_f8(o, s64); }
            if (valid) *(v4u*)(y8 + (size_t)tok * D + col0) = (v4u){f8[0].x, f8[0].y, f8[1].x, f8[1].y}; }
    }
};
template <> struct EpiDown<1> {
    static constexpr bool PERM = true, AFTER_DRAIN = false;
    const bf16* base; bf16* h2; float* ssp; LAS unsigned char* ldsx; unsigned char* h28; float sc;
    __device__ __forceinline__ void operator()(const Acc& acc, const Unit& u, int wr, int wc, int fr, int fq) const {
        const int col0 = u.pn * BM + wc * 64 + 16 * fq;
#pragma unroll
        for (int hb = 0; hb < 2; ++hb) {
            v4u bv[4][2], yv[4]; int tk[4];
#pragma unroll
            for (int q = 0; q < 4; ++q) { const int gi = hb * 4 + q; tk[q] = TAB_ENT(ldsx, u.par, (gi >> 2) * HALF + wr * 64 + (gi & 3) * 16 + fr)->tok; const size_t off_ = (size_t)tk[q] * D + col0;
                bv[q][0] = *(const v4u*)(base + off_); bv[q][1] = *(const v4u*)(base + off_ + 8); yv[q] = *(const v4u*)(h28 + off_); }
            asm volatile("" ::: "memory");
#pragma unroll
            for (int q = 0; q < 4; ++q) { const int gi = hb * 4 + q, ai = gi >> 2, m = gi & 3;
                const int r = ai * HALF + wr * 64 + m * 16 + fr; const bool valid = (u.rk0 + r) < u.nl; const int tok = tk[q]; const size_t off = (size_t)tok * D + col0; float ss = 0.f; v2u f8[2];
                const unsigned yw[4] = {yv[q].x, yv[q].y, yv[q].z, yv[q].w};
#pragma unroll
                for (int bj = 0; bj < 2; ++bj) { float b[8]; unpack8(bv[q][bj], b); float o[8];
#pragma unroll
                    for (int n = 0; n < 2; ++n) { const unsigned w = yw[bj * 2 + n];
                        const float y0 = __builtin_amdgcn_cvt_f32_fp8((int)w, 0), y1 = __builtin_amdgcn_cvt_f32_fp8((int)w, 1), y2 = __builtin_amdgcn_cvt_f32_fp8((int)w, 2), y3 = __builtin_amdgcn_cvt_f32_fp8((int)w, 3);
                        const float yy[4] = {y0, y1, y2, y3};
#pragma unroll
                        for (int i = 0; i < 4; ++i) { o[n * 4 + i] = b[n * 4 + i] + yy[i] * F8_YINV + acc[ai][bj][m][n][i] * sc; ss += o[n * 4 + i] * o[n * 4 + i]; } }
                    v4u qv; qv.x = cvt_pk_bf16(o[0], o[1]); qv.y = cvt_pk_bf16(o[2], o[3]); qv.z = cvt_pk_bf16(o[4], o[5]); qv.w = cvt_pk_bf16(o[6], o[7]);
                    if (valid) *(v4u*)(h2 + off + bj * 8) = qv;
                    f8[bj] = pack8_f8(o, F8_ASCALE); }
                if (valid) *(v4u*)(h28 + off) = (v4u){f8[0].x, f8[0].y, f8[1].x, f8[1].y};
                ss += __shfl_xor(ss, 16); ss = xsum32(ss); if (fq == 0 && valid) ssp[(size_t)tok * 32 + u.pn * 4 + wc] = ss; }
            asm volatile("" ::: "memory"); }
    }
};
template <int MODE> struct EpiDownProbe {
    static constexpr bool PERM = true, AFTER_DRAIN = false;
    const bf16* base; bf16* h2; LAS unsigned char* ldsx; float sc;
    __device__ __forceinline__ void operator()(const Acc& acc, const Unit& u, int wr, int wc, int fr, int fq) const {
        const int col0 = u.pn * BM + wc * 64 + 16 * fq;
        v4u bv[8][2]; int tk[8];
#pragma unroll
        for (int gi = 0; gi < 8; ++gi) { tk[gi] = TAB_ENT(ldsx, u.par, (gi >> 2) * HALF + wr * 64 + (gi & 3) * 16 + fr)->tok; const size_t off_ = (size_t)tk[gi] * D + col0;
            if (MODE == 0) { bv[gi][0] = *(const v4u*)(base + off_); bv[gi][1] = *(const v4u*)(base + off_ + 8); } else { bv[gi][0] = (v4u){0u, 0u, 0u, 0u}; bv[gi][1] = (v4u){0u, 0u, 0u, 0u}; } }
        asm volatile("" ::: "memory");
#pragma unroll
        for (int gi = 0; gi < 8; ++gi) { const int ai = gi >> 2, m = gi & 3;
            const int r = ai * HALF + wr * 64 + m * 16 + fr; const bool valid = (u.rk0 + r) < u.nl; const size_t off = (size_t)tk[gi] * D + col0;
#pragma unroll
            for (int bj = 0; bj < 2; ++bj) { float b[8]; unpack8(bv[gi][bj], b); float o[8];
#pragma unroll
                for (int n = 0; n < 2; ++n)
#pragma unroll
                    for (int i = 0; i < 4; ++i) o[n * 4 + i] = b[n * 4 + i] + acc[ai][bj][m][n][i] * sc;
                v4u q; q.x = cvt_pk_bf16(o[0], o[1]); q.y = cvt_pk_bf16(o[2], o[3]); q.z = cvt_pk_bf16(o[4], o[5]); q.w = cvt_pk_bf16(o[6], o[7]);
                if (MODE == 2) { if (gi > 0) asm volatile("" :: "v"(q)); }
                if (valid && (MODE < 2 || gi == 0)) *(v4u*)(h2 + off + bj * 8) = q; } }
    }
};
struct EpiFinal {
    static constexpr bool PERM = true, AFTER_DRAIN = false;
    const bf16* h2; const unsigned char* pw8; float* out; LAS unsigned char* ldsx; float sc;
    __device__ __forceinline__ void operator()(const Acc& acc, const Unit& u, int wr, int wc, int fr, int fq) const {
        const int col0 = u.pn * BM + wc * 64 + 16 * fq;
        v4u hv[2][2], pv[2];
#define FN_LOAD(g_, buf) do { const size_t off_ = (size_t)(u.pm * BM + ((g_) >> 2) * HALF + wr * 64 + ((g_) & 3) * 16 + fr) * D + col0; \
            hv[buf][0] = *(const v4u*)(h2 + off_); hv[buf][1] = *(const v4u*)(h2 + off_ + 8); pv[buf] = *(const v4u*)(pw8 + off_); } while (0)
#pragma unroll
        for (int half_ = 0; half_ < 4; ++half_) {
#pragma unroll
            for (int q = 0; q < 2; ++q) FN_LOAD(half_ * 2 + q, q);
            asm volatile("" ::: "memory");
#pragma unroll
            for (int q = 0; q < 2; ++q) { const int gi = half_ * 2 + q, ai = gi >> 2, m = gi & 3;
                const int r = ai * HALF + wr * 64 + m * 16 + fr; const float rs = TAB_ENT(ldsx, u.par, r)->rs * sc; const size_t off = (size_t)(u.pm * BM + r) * D + col0;
                const unsigned pwd[4] = {pv[q].x, pv[q].y, pv[q].z, pv[q].w};
#pragma unroll
                for (int bj = 0; bj < 2; ++bj) { float hf[8]; unpack8(hv[q][bj], hf);
#pragma unroll
                    for (int n = 0; n < 2; ++n) { const f32x4 z = acc[ai][bj][m][n] * rs; f32x4 o; const int w = (int)pwd[bj * 2 + n];
                        const float pf[4] = {__builtin_amdgcn_cvt_f32_fp8(w, 0), __builtin_amdgcn_cvt_f32_fp8(w, 1), __builtin_amdgcn_cvt_f32_fp8(w, 2), __builtin_amdgcn_cvt_f32_fp8(w, 3)};
#pragma unroll
                        for (int i = 0; i < 4; ++i) o[i] = hf[n * 4 + i] + (pf[i] * F8_PINV) * __builtin_amdgcn_rcpf(1.0f + __expf(-z[i]));
                        *(f32x4*)(out + off + bj * 8 + n * 4) = o; } } }
            asm volatile("" ::: "memory"); }
#undef FN_LOAD
    }
};

template <int MODE> struct EpiFinalProbe {
    static constexpr bool PERM = true, AFTER_DRAIN = false;
    const bf16* h2; const unsigned char* pw8; float* out; LAS unsigned char* ldsx; float sc;
    __device__ __forceinline__ void operator()(const Acc& acc, const Unit& u, int wr, int wc, int fr, int fq) const {
        const int col0 = u.pn * BM + wc * 64 + 16 * fq;
        v4u hv[2][2], pv[2];
#pragma unroll
        for (int half_ = 0; half_ < 4; ++half_) {
#pragma unroll
            for (int q = 0; q < 2; ++q) { const int g_ = half_ * 2 + q; const size_t off_ = (size_t)(u.pm * BM + (g_ >> 2) * HALF + wr * 64 + (g_ & 3) * 16 + fr) * D + col0;
                if (MODE == 0 || MODE == 3) { hv[q][0] = *(const v4u*)(h2 + off_); hv[q][1] = *(const v4u*)(h2 + off_ + 8); pv[q] = *(const v4u*)(pw8 + off_); }
                else { hv[q][0] = (v4u){0u, 0u, 0u, 0u}; hv[q][1] = hv[q][0]; pv[q] = hv[q][0]; } }
            asm volatile("" ::: "memory");
#pragma unroll
            for (int q = 0; q < 2; ++q) { const int gi = half_ * 2 + q, ai = gi >> 2, m = gi & 3;
                const int r = ai * HALF + wr * 64 + m * 16 + fr; const float rs = TAB_ENT(ldsx, u.par, r)->rs * sc; const size_t off = (size_t)(u.pm * BM + r) * 1024 + (col0 & 1023);
                const unsigned pwd[4] = {pv[q].x, pv[q].y, pv[q].z, pv[q].w};
#pragma unroll
                for (int bj = 0; bj < 2; ++bj) { float hf[8]; unpack8(hv[q][bj], hf);
#pragma unroll
                    for (int n = 0; n < 2; ++n) { const f32x4 z = acc[ai][bj][m][n] * rs; f32x4 o; const int w = (int)pwd[bj * 2 + n];
                        const float pf[4] = {__builtin_amdgcn_cvt_f32_fp8(w, 0), __builtin_amdgcn_cvt_f32_fp8(w, 1), __builtin_amdgcn_cvt_f32_fp8(w, 2), __builtin_amdgcn_cvt_f32_fp8(w, 3)};
#pragma unroll
                        for (int i = 0; i < 4; ++i) o[i] = (MODE == 3) ? hf[n * 4 + i] + (pf[i] * F8_PINV) * z[i] : hf[n * 4 + i] + (pf[i] * F8_PINV) * __builtin_amdgcn_rcpf(1.0f + __expf(-z[i]));
                        if (MODE == 2 && gi > 0) { asm volatile("" :: "v"(o)); } else *(f32x4*)(out + off + bj * 8 + n * 4) = o; } } }
            asm volatile("" ::: "memory"); }
    }
};
template <int MODE> struct EpiBf16Probe {
    static constexpr bool PERM = true, AFTER_DRAIN = false;
    bf16* O; int ldc;
    __device__ __forceinline__ void operator()(const Acc& acc, const Unit& u, int wr, int wc, int fr, int fq) const {
        const int row0 = u.pm * BM + wr * 64 + fr, col0 = u.pn * BM + wc * 64 + 16 * fq;
#pragma unroll
        for (int ai = 0; ai < 2; ++ai)
#pragma unroll
            for (int m = 0; m < 4; ++m) { const int row = row0 + ai * HALF + m * 16; bf16* rowp = O + (size_t)row * ldc + col0;
#pragma unroll
                for (int bj = 0; bj < 2; ++bj) { const f32x4 v0 = acc[ai][bj][m][0], v1 = acc[ai][bj][m][1]; v4u w;
                    w.x = cvt_pk_bf16(v0[0], v0[1]); w.y = cvt_pk_bf16(v0[2], v0[3]); w.z = cvt_pk_bf16(v1[0], v1[1]); w.w = cvt_pk_bf16(v1[2], v1[3]);
                    if (MODE == 1 && (ai || m)) { asm volatile("" :: "v"(w)); } else *(v4u*)(rowp + bj * 8) = w; } }
    }
};
template <bool GATHER_, int NPN> struct MoeOrder {
    static constexpr bool GATHER = GATHER_;
    LAS unsigned char* ldsx; const Ent* ent; int tlo, thi, G, c, wave; const Ent* zero;
    CvtWork w{}; int slot = -1;
    int xm = 0; unsigned* tsig = nullptr; unsigned* twait = nullptr;
    __device__ __forceinline__ int nunits() const { const int nun = (thi - tlo) * NPN; return c < nun ? (nun - 1 - c) / G + 1 : 0; }
    __device__ __forceinline__ bool next(int i, Unit& u) const {
        int tile, pn_;
        if (xm) { const int x = c >> 5, j = c & 31;
            if (NPN == 4) { tile = tlo + 64 * i + 8 * (j >> 2) + x; pn_ = j & 3; } else { const int l = 32 * i + (31 - j); tile = tlo + 8 * (l >> 3) + x; pn_ = l & 7; }
            if (tile >= thi) return false; }
        else { const long L = (long)i * G + c; const int nun = (thi - tlo) * NPN; if (L >= nun) return false; tile = tlo + (int)(L / NPN); pn_ = (int)(L % NPN); }
        const LAS int* T0 = (const LAS int*)(ldsx + LST_OFF + 256);
        int l = 0;
        for (int j = 1; j < NLIST; ++j) l += (T0[j] <= tile) ? 1 : 0;
        l = __builtin_amdgcn_readfirstlane(l);
        u.pm = tile; u.pn = pn_; u.bt = (l & (NE - 1)) * NPN + u.pn; u.par = i & 1; u.lst = l; u.rk0 = (tile - __builtin_amdgcn_readfirstlane(T0[l])) * BM; u.nl = __builtin_amdgcn_readfirstlane(((const LAS int*)(ldsx + LST_OFF))[l]);
        return true;
    }
    __device__ __forceinline__ void a_prefetch(const Unit& u) const {
        if (wave < 4) { const int tid = TIDX(wave); const int rk = u.rk0 + tid; const Ent* src = rk < u.nl ? ent + (size_t)u.lst * LCAP + rk : zero;
            __builtin_amdgcn_global_load_lds((const unsigned*)src, (LAS unsigned*)(ldsx + TAB_OFF + u.par * 4096 + wave * 1024), 16, 0, 0); }
    }
    __device__ __forceinline__ void a_first() const { asm volatile("s_waitcnt vmcnt(0)" ::: "memory"); __builtin_amdgcn_s_barrier(); asm volatile("" ::: "memory"); }
    __device__ __forceinline__ void a_ready(const Unit& u) const {
        if (twait) { unsigned sp = 0; while (__hip_atomic_load(twait + u.pm, __ATOMIC_RELAXED, __HIP_MEMORY_SCOPE_AGENT) < 4u) { __builtin_amdgcn_s_sleep(1); if (++sp > (1u << 22)) break; } asm volatile("" ::: "memory"); } }
    __device__ __forceinline__ void done(const Unit&) const {}
    __device__ __forceinline__ void between(int ui, int wid) const { if (GATHER_ && ui == slot) w.run(wid, CvtWork::NGU, CvtWork::NIT); }
    __device__ __forceinline__ void signal(int tile) const { if (tsig && TIDX(wave) == 0) (void)__hip_atomic_fetch_add(tsig + tile, 1u, __ATOMIC_RELAXED, __HIP_MEMORY_SCOPE_AGENT); }
};
struct FinalOrder : StaticOrder {
    LAS unsigned char* ldsx; const float* ssp; int wave;
    __device__ __forceinline__ void a_prefetch(const Unit&) const {}
    __device__ __forceinline__ void a_first() const {}
    __device__ __forceinline__ void a_ready(const Unit& u) const {
        const int tid = TIDX(wave);
        if (tid < 256) { const int row = u.pm * BM + tid; float ss = 0.f;
#pragma unroll
            for (int j = 0; j < 8; ++j) { const f32x4 p = *(const f32x4*)(ssp + (size_t)row * 32 + 4 * j); ss += (p[0] + p[1]) + (p[2] + p[3]); }
            *(LAS v4u*)(ldsx + TAB_OFF + u.par * 4096 + tid * 16) = (v4u){(unsigned)row, 0u, __float_as_uint(1.0f / sqrtf(ss * (1.0f / D) + EPS)), 0u}; }
    }
};
}
#define RLX_AGENT __ATOMIC_RELAXED, __HIP_MEMORY_SCOPE_AGENT
#define XB_TMO      128
#define XB_XCNT(j)  (256  + 64 * (j))
#define XB_XSUB(j)  (1280 + 64 * (j))
#define XB_XGEN(j)  (2304 + 64 * (j))
#define XB_TOP      3328
#define XB_TOPGEN   3392
#define XCD_BAR_WORDS 3456
#define XB_SPIN_CAP (1u << 18)

__device__ __forceinline__ unsigned xb_ld(unsigned* p)              { return __hip_atomic_load(p, __ATOMIC_RELAXED, __HIP_MEMORY_SCOPE_AGENT); }
__device__ __forceinline__ unsigned xb_add(unsigned* p, unsigned v) { return __hip_atomic_fetch_add(p, v, __ATOMIC_RELAXED, __HIP_MEMORY_SCOPE_AGENT); }
__device__ __forceinline__ unsigned xb_xcc_id() { return (unsigned)__builtin_amdgcn_s_getreg((3 << 11) | 20) & 0xFu; }
#define XB_SPIN(cond, bar) do { unsigned _sp = 0; while (cond) { __builtin_amdgcn_s_sleep(1); \
    if ((++_sp & 255u) == 0u) { if (xb_ld(&(bar)[XB_TMO])) break; if (_sp > XB_SPIN_CAP) { atomicAdd(&(bar)[XB_TMO], 1u); break; } } } } while (0)

struct XcdBarrier {
    unsigned* bar; unsigned x;
    volatile LAS unsigned* st;
};
__device__ __forceinline__ XcdBarrier xcd_barrier_post(unsigned* bar, volatile LAS unsigned* st, const int wave_) {
    XcdBarrier b; b.bar = bar; b.x = xb_xcc_id(); b.st = st;
    if (TIDX(wave_) == 0) (void)xb_add(&bar[XB_XCNT(b.x)], 1u);
    return b;
}
__device__ __forceinline__ void xcd_barrier_complete(unsigned* bar, unsigned x, unsigned& nloc, unsigned& nx) {
    const unsigned G = gridDim.x * gridDim.y * gridDim.z;
    unsigned sum, cnt, mine, sp = 0u;
    for (;;) {
        sum = 0u; cnt = 0u; mine = 0u;
#pragma unroll
        for (unsigned j = 0; j < 16; ++j) { const unsigned c = xb_ld(&bar[XB_XCNT(j)]); sum += c; cnt += (c > 0u) ? 1u : 0u; mine = (j == x) ? c : mine; }
        if (sum == G) break;
        __builtin_amdgcn_s_sleep(1);
        if ((++sp & 255u) == 0u) { if (xb_ld(&bar[XB_TMO])) break; if (sp > XB_SPIN_CAP) { atomicAdd(&bar[XB_TMO], 1u); break; } }
    }
    nloc = mine > 0u ? mine : 1u; nx = cnt > 0u ? cnt : 1u;
}
__device__ __forceinline__ void xcd_barrier(const XcdBarrier& b, const int wave_) {
    asm volatile("s_waitcnt vmcnt(0)" ::: "memory");
    __syncthreads();
    if (TIDX(wave_) == 0) {
        unsigned* bar = b.bar;
        __builtin_amdgcn_s_waitcnt(0);
        unsigned nloc = b.st[0], nx = b.st[1];
        if (nloc == 0u) { xcd_barrier_complete(bar, b.x, nloc, nx); b.st[0] = nloc; b.st[1] = nx; }
        const unsigned old = xb_add(&bar[XB_XSUB(b.x)], 1u);
        const unsigned gen = old / nloc;
        if (old + 1u == (gen + 1u) * nloc) {
            __builtin_amdgcn_fence(__ATOMIC_RELEASE, "agent");
            asm volatile("s_waitcnt vmcnt(0)" ::: "memory");
            const unsigned og = xb_add(&bar[XB_TOP], 1u);
            const unsigned tg = og / nx;
            if (og + 1u == (tg + 1u) * nx) xb_add(&bar[XB_TOPGEN], 1u);
            else XB_SPIN(xb_ld(&bar[XB_TOPGEN]) == tg, bar);
            __builtin_amdgcn_fence(__ATOMIC_ACQUIRE, "agent");
            xb_add(&bar[XB_XGEN(b.x)], 1u);
            asm volatile("s_waitcnt vmcnt(0)" ::: "memory");
        } else {
            XB_SPIN(xb_ld(&bar[XB_XGEN(b.x)]) == gen, bar);
            __builtin_amdgcn_fence(__ATOMIC_ACQUIRE, "agent");
            asm volatile("s_waitcnt vmcnt(0)" ::: "memory");
        }
    }
    __syncthreads();
}

constexpr int NWAVES = 8;
__device__ __forceinline__ void p0_transpose_item(const float* W, int K, int N, const float* g0, const float* g1, int gsplit, bf16* WT, int rowbase, int k0, int n0, LAS float* scr, int lane) {
    float v[32];
    const float* src = W + (size_t)(k0 + (lane >> 5)) * N + n0 + (lane & 31);
#pragma unroll
    for (int i = 0; i < 32; ++i) v[i] = __builtin_nontemporal_load(src + (size_t)(2 * i) * N);
    const int c = lane & 7;
    float gg[8];
#pragma unroll
    for (int j = 0; j < 8; ++j) { const int k = k0 + 8 * c + j; gg[j] = g0 ? (k < gsplit ? g0[k] : g1[k - gsplit]) : 1.f; }
#pragma unroll
    for (int i = 0; i < 32; ++i) scr[(2 * i + (lane >> 5)) * 33 + (lane & 31)] = v[i];
    asm volatile("s_waitcnt lgkmcnt(0)" ::: "memory");
#pragma unroll
    for (int j = 0; j < 4; ++j) { const int n = (lane >> 3) + 8 * j; const LAS float* s = scr + (8 * c) * 33 + n;
        v4u o; o.x = pk2(s[0 * 33] * gg[0], s[1 * 33] * gg[1]); o.y = pk2(s[2 * 33] * gg[2], s[3 * 33] * gg[3]); o.z = pk2(s[4 * 33] * gg[4], s[5 * 33] * gg[5]); o.w = pk2(s[6 * 33] * gg[6], s[7 * 33] * gg[7]);
        *(v4u*)(WT + (size_t)(rowbase + n) * K + k0 + 8 * c) = o; }
    asm volatile("s_waitcnt lgkmcnt(0)" ::: "memory");
}
__device__ __forceinline__ void p0_transpose_item8(const float* W, int K, int N, const float* g0, unsigned char* WT8, int rowbase, int k0, int n0, LAS float* scr, int lane, float sc, int rs8 = 8) {
    float v[32];
    const float* src = W + (size_t)(k0 + (lane >> 5)) * N + n0 + (lane & 31);
#pragma unroll
    for (int i = 0; i < 32; ++i) v[i] = __builtin_nontemporal_load(src + (size_t)(2 * i) * N);
    const int c = lane & 7;
    float gg[8];
#pragma unroll
    for (int j = 0; j < 8; ++j) gg[j] = (g0 ? g0[k0 + 8 * c + j] : 1.f) * sc;
#pragma unroll
    for (int i = 0; i < 32; ++i) scr[(2 * i + (lane >> 5)) * 33 + (lane & 31)] = v[i];
    asm volatile("s_waitcnt lgkmcnt(0)" ::: "memory");
#pragma unroll
    for (int j = 0; j < 4; ++j) { const int n = (lane >> 3) + 8 * j; const LAS float* s = scr + (8 * c) * 33 + n; float f[8];
#pragma unroll
        for (int q = 0; q < 8; ++q) f[q] = s[q * 33] * gg[q];
        *(v2u*)(WT8 + (size_t)(rowbase + j * rs8 + (lane >> 3)) * K + k0 + 8 * c) = pack8_f8(f, 1.0f); }
    asm volatile("s_waitcnt lgkmcnt(0)" ::: "memory");
}
__device__ __forceinline__ void p0_prologue(const Ptrs& P, LAS unsigned char* lds, int vcu, int G, const int wave) {
    const int lane = lane_id(), tid = wave * 64 + lane;
    unsigned char* ws = P.ws;
    LAS float* scr = (LAS float*)(lds + wave * 16384);
    const int gw = vcu * NWAVES + wave, NGW = G * NWAVES;
    constexpr int I_IN = (D / 64) * (DIN / 32), I_OUT = (D / 64) * (D / 32), I_PLG = I_OUT, I_PLE = (PLE / 64) * (D / 32), I_RT = (D / 64) * (NE / 32);
    constexpr int I_G1 = (D / 64) * (DEXP / 32), I_D1 = (DEXP / 64) * (D / 32);
    constexpr int NITEMS = I_IN + I_OUT + I_PLG + I_PLE + I_RT + (DEFER_CVT ? 0 : NE * (2 * I_G1 + I_D1));
    for (int it = gw; it < NITEMS; it += NGW) {
        int r = it;
        if (r < I_IN) { const int nb = DIN / 32; const int n0 = (r % nb) * 32, k0 = (r / nb) * 64;
            if (FP8QKV && n0 >= C_Q) p0_transpose_item8(P.w_in, D, DIN, P.norm_mix, ws + WS_WIN8, n0 - C_Q, k0, n0, scr, lane, F8_WSCALE);
            else p0_transpose_item(P.w_in, D, DIN, P.norm_mix, nullptr, D, (bf16*)(ws + WS_WIN), n0, k0, n0, scr, lane);
            continue; } r -= I_IN;
        if (r < I_OUT) { const int nb = D / 32; const int k0 = (r / nb) * 64;
            if (FP8O) p0_transpose_item8(P.w_out, D, D, k0 < DCONV ? P.onc : P.ona - DCONV, ws + WS_WOUT, (r % nb) * 32, k0, (r % nb) * 32, scr, lane, F8_WSCALE);
            else p0_transpose_item(P.w_out, D, D, P.onc, P.ona, DCONV, (bf16*)(ws + WS_WOUT), (r % nb) * 32, k0, (r % nb) * 32, scr, lane);
            continue; } r -= I_OUT;
        if (r < I_PLG) { const int nb = D / 32;
            if (FP8) p0_transpose_item8(P.w_ple_gate, D, D, P.norm_ple, ws + WS_WPLG, (r % nb) * 32, (r / nb) * 64, (r % nb) * 32, scr, lane, F8_WSCALE);
            else p0_transpose_item(P.w_ple_gate, D, D, P.norm_ple, nullptr, D, (bf16*)(ws + WS_WPLG), (r % nb) * 32, (r / nb) * 64, (r % nb) * 32, scr, lane);
            continue; } r -= I_PLG;
        if (r < I_PLE) { const int nb = D / 32; p0_transpose_item(P.w_ple, PLE, D, nullptr, nullptr, 0, (bf16*)(ws + WS_WPLE), (r % nb) * 32, (r / nb) * 64, (r % nb) * 32, scr, lane); continue; } r -= I_PLE;
        if (r < I_RT) { p0_transpose_item(P.w_router, D, NE, P.norm_ffn, nullptr, D, (bf16*)(ws + WS_WR), NGRP, r * 64, 0, scr, lane); continue; } r -= I_RT;
        const int e = r / (2 * I_G1 + I_D1); r -= e * (2 * I_G1 + I_D1);
        if (r < 2 * I_G1) { const int up = r >= I_G1; r -= up * I_G1; const int nb = DEXP / 32, n0 = (r % nb) * 32, k0 = (r / nb) * 64;
            if (FP8) p0_transpose_item8((up ? P.w_up : P.w_gate) + (size_t)e * D * DEXP, D, DEXP, P.norm_ffn, ws + WS_WGU + (size_t)e * 1024 * D, (n0 >> 7) * 256 + 2 * (n0 & 127) + up * 8, k0, n0, scr, lane, F8_WSCALE, 16);
            else p0_transpose_item((up ? P.w_up : P.w_gate) + (size_t)e * D * DEXP, D, DEXP, P.norm_ffn, nullptr, D, (bf16*)(ws + WS_WGU) + (size_t)e * 1024 * D, (n0 >> 7) * 256 + up * 128 + (n0 & 127), k0, n0, scr, lane);
            continue; }
        r -= 2 * I_G1; { const int nb = D / 32;
            if (FP8) p0_transpose_item8(P.w_down + (size_t)e * DEXP * D, DEXP, D, nullptr, ws + WS_WD + (size_t)e * D * DEXP, (r % nb) * 32, (r / nb) * 64, (r % nb) * 32, scr, lane, F8_DSCALE);
            else p0_transpose_item(P.w_down + (size_t)e * DEXP * D, DEXP, D, nullptr, nullptr, 0, (bf16*)(ws + WS_WD) + (size_t)e * D * DEXP, (r % nb) * 32, (r / nb) * 64, (r % nb) * 32, scr, lane); }
    }
    { bf16* Wr = (bf16*)(ws + WS_WR); const int gt = vcu * (NWAVES * 64) + tid, NT = G * NWAVES * 64;
      for (int i = gt; i < NGRP * D; i += NT) { const int n = i / D, k = i % D; Wr[(size_t)n * D + k] = f2bf(P.norm_ffn[k] * P.w_group[(size_t)k * NGRP + n]); }
      for (int i = gt; i < (256 - NRT) * D / 8; i += NT) *(v4u*)(Wr + (size_t)NRT * D + (size_t)i * 8) = (v4u){0u, 0u, 0u, 0u}; }
    for (int m = gw; m < M; m += NGW) {
        const f32x4* xr = (const f32x4*)(P.x + (size_t)m * D) + lane; f32x4 v[8]; float s = 0.f;
#pragma unroll
        for (int j = 0; j < 8; ++j) { v[j] = __builtin_nontemporal_load(xr + 64 * j); s += (v[j][0] * v[j][0] + v[j][1] * v[j][1]) + (v[j][2] * v[j][2] + v[j][3] * v[j][3]); }
        s = wsum(s);
        v2u* o8 = (v2u*)((bf16*)(ws + WS_XB) + (size_t)m * D) + lane;
        const float rstd = 1.0f / sqrtf(s * (1.0f / D) + EPS);
#pragma unroll
        for (int j = 0; j < 8; ++j) { v2u o; o.x = pk2(v[j][0] * rstd, v[j][1] * rstd); o.y = pk2(v[j][2] * rstd, v[j][3] * rstd); o8[64 * j] = o; }
        if (FP8QKV) { unsigned* o4 = (unsigned*)(ws + WS_XB8 + (size_t)m * D) + lane; const float r16 = rstd * F8_ASCALE;
#pragma unroll
            for (int j = 0; j < 8; ++j) { int w = 0; w = __builtin_amdgcn_cvt_pk_fp8_f32(v[j][0] * r16, v[j][1] * r16, w, false); w = __builtin_amdgcn_cvt_pk_fp8_f32(v[j][2] * r16, v[j][3] * r16, w, true); o4[64 * j] = (unsigned)w; } }
        if (lane == 0) { ((float*)(ws + WS_RSX))[m] = 1.0f; ((float*)(ws + WS_RMSX))[m] = sqrtf(s * (1.0f / D) + EPS); }
    }
    { const int gt = vcu * (NWAVES * 64) + tid, NT = G * NWAVES * 64; const f32x4* src = (const f32x4*)P.p; v4u* dst = (v4u*)(ws + WS_PB);
      for (int i = gt; i < M * PLE / 8; i += NT) { const f32x4 a = __builtin_nontemporal_load(src + 2 * i), b = __builtin_nontemporal_load(src + 2 * i + 1); v4u o; o.x = pk2(a[0], a[1]); o.y = pk2(a[2], a[3]); o.z = pk2(b[0], b[1]); o.w = pk2(b[2], b[3]); dst[i] = o; } }
}

#ifndef CONVR
#define CONVR 4
#endif
constexpr int P2_KS = 0, P2_KROW = 144, P2_VT = 36864, P2_VROW = 528, P2_OST = 70656, P2_OROW = 144, P2_SS = 107520, P2_RSTD = 108032, P2_QG = 108544;
__device__ __forceinline__ int crow(int r, int hi) { return (r & 3) + 8 * (r >> 2) + 4 * hi; }
__device__ __forceinline__ void p2_unit(const Ptrs& P, LAS unsigned char* lds, int unit, const int wid, const bool conv_first) {
    int lane_ = lane_id_asm(); asm volatile("" : "+v"(lane_));
    const int lane = lane_ & 63, tid = wid * 64 + lane, l32 = lane & 31, hi = lane >> 5;
    const bf16* proj = (const bf16*)(P.ws + WS_PROJ); bf16* mixed = (bf16*)(P.ws + WS_MIX); unsigned char* mixed8 = P.ws + WS_MIX8;
    bf16* osc = FP8O ? (bf16*)(P.ws + WS_MIX + 64 * MiB) : mixed + DCONV; constexpr int OLD = FP8O ? DATTN : D;
    const int b = unit / (SEQ / 128), qb = unit % (SEQ / 128), q0 = qb * 128; const size_t rowbase = (size_t)b * SEQ;
    LAS float* rowss = (LAS float*)(lds + P2_SS); LAS float* qg = (LAS float*)(lds + P2_QG);
    __syncthreads();
    if (tid < 128) rowss[tid] = 0.f;
    if (tid < 64) qg[tid] = P.q_norm[tid] * (0.125f * LOG2E);
    if (conv_first) {
    {
        int lc_ = lane_id_asm(); asm volatile("" : "+v"(lc_)); const int lane = lc_ & 63;
        const float* cw = P.conv_w; float w0[16], w1[16], w2[16];
#pragma unroll
        for (int j = 0; j < 16; ++j) { const int ch = (j >> 3) * 512 + lane * 8 + (j & 7); w0[j] = cw[ch]; w1[j] = cw[DCONV + ch]; w2[j] = cw[2 * DCONV + ch]; }
        float u1[16], u2[16];
        const int t0 = q0 + 16 * wid;
#pragma unroll
        for (int j = 0; j < 16; ++j) { u1[j] = 0.f; u2[j] = 0.f; }
        if (t0 >= 2) {
#pragma unroll
            for (int hf = 0; hf < 2; ++hf) { const int ch = hf * 512 + lane * 8; float c[8], hc[8];
                const bf16* pr = proj + (rowbase + t0 - 1) * DIN; unpack8(*(const v4u*)(pr + C_C + ch), c); unpack8(*(const v4u*)(pr + C_HC + ch), hc);
#pragma unroll
                for (int j = 0; j < 8; ++j) u1[hf * 8 + j] = c[j] * hc[j];
                pr -= DIN; unpack8(*(const v4u*)(pr + C_C + ch), c); unpack8(*(const v4u*)(pr + C_HC + ch), hc);
#pragma unroll
                for (int j = 0; j < 8; ++j) u2[hf * 8 + j] = c[j] * hc[j]; }
        }
#pragma unroll 1
        for (int r0 = 0; r0 < 16; r0 += CONVR) {
            v4u rb[CONVR][2], rc[CONVR][2], rh[CONVR][2];
#pragma unroll
            for (int rr = 0; rr < CONVR; ++rr) { const bf16* pr = proj + (rowbase + t0 + r0 + rr) * DIN + lane * 8;
#pragma unroll
                for (int hf = 0; hf < 2; ++hf) { rb[rr][hf] = __builtin_nontemporal_load((const v4u*)(pr + C_B + hf * 512)); rc[rr][hf] = __builtin_nontemporal_load((const v4u*)(pr + C_C + hf * 512)); rh[rr][hf] = __builtin_nontemporal_load((const v4u*)(pr + C_HC + hf * 512)); } }
#pragma unroll
            for (int rr = 0; rr < CONVR; ++rr) { float y[16]; float ss = 0.f;
#pragma unroll
                for (int hf = 0; hf < 2; ++hf) { float bb[8], c[8], hc[8]; unpack8(rb[rr][hf], bb); unpack8(rc[rr][hf], c); unpack8(rh[rr][hf], hc);
#pragma unroll
                    for (int j = 0; j < 8; ++j) { const int jj = hf * 8 + j; const float u0 = c[j] * hc[j];
                        y[jj] = bb[j] * (w0[jj] * u2[jj] + w1[jj] * u1[jj] + w2[jj] * u0); ss += y[jj] * y[jj]; u2[jj] = u1[jj]; u1[jj] = u0; } }
                ss = wsum(ss); const float rs = rsqf(ss * (1.0f / DCONV) + EPS);
#pragma unroll
                for (int hf = 0; hf < 2; ++hf) { float f[8];
#pragma unroll
                    for (int j = 0; j < 8; ++j) f[j] = y[hf * 8 + j] * rs;
                    if (FP8O) *(v2u*)(mixed8 + (rowbase + t0 + r0 + rr) * D + hf * 512 + lane * 8) = pack8_f8(f, F8_ASCALE);
                    else *(v4u*)(mixed + (rowbase + t0 + r0 + rr) * D + hf * 512 + lane * 8) = pack8(f); } }
        }
    }
    }
    const int h4 = wid & 3, half = wid >> 2;
    const int part = tid & 7;
    float kg[8];
#pragma unroll
    for (int j = 0; j < 8; ++j) kg[j] = P.k_norm[part * 8 + j];
    v4u kraw[4], vraw[4], qraw[4];
    const int kvoff = (tid >> 3) * DIN + part * 8, qoff = l32 * DIN + 8 * hi;
#define P2_LOAD_KV(g_) do { _Pragma("unroll") for (int i = 0; i < 4; ++i) { kraw[i] = (v4u){0u, 0u, 0u, 0u}; vraw[i] = (v4u){0u, 0u, 0u, 0u}; \
        if (q0 > 0 || i >= 2) { const bf16* ub = proj + (rowbase + q0 - 128 + 64 * i) * DIN + (g_) * HD; kraw[i] = *(const v4u*)(ub + C_K + kvoff); vraw[i] = *(const v4u*)(ub + C_V + kvoff); } } } while (0)
#define P2_LOAD_Q(g_, sub_) do { const bf16* ub = proj + (rowbase + q0 + 64 * half + 32 * (sub_)) * DIN + C_Q + ((g_) * 4 + h4) * HD; \
        _Pragma("unroll") for (int d0 = 0; d0 < 4; ++d0) qraw[d0] = __builtin_nontemporal_load((const v4u*)(ub + 16 * d0 + qoff)); } while (0)
    P2_LOAD_KV(0); P2_LOAD_Q(0, 0);
#pragma unroll 1
    for (int g = 0; g < NKV; ++g) {
        int lg_ = lane_id_asm(); asm volatile("" : "+v"(lg_));
        const int lane = lg_ & 63, tid = wid * 64 + lane, l32 = lane & 31, hi = lane >> 5, part = tid & 7;
        const int kvoff = (tid >> 3) * DIN + part * 8, qoff = l32 * DIN + 8 * hi, ooffo = (lane >> 3) * OLD + (lane & 7) * 8;
        __syncthreads();
#pragma unroll
        for (int i = 0; i < 4; ++i) {
            const int key = (tid >> 3) + 64 * i;
            float kf[8]; unpack8(kraw[i], kf); float ss = 0.f;
#pragma unroll
            for (int j = 0; j < 8; ++j) ss += kf[j] * kf[j];
            ss += __shfl_xor(ss, 1); ss += __shfl_xor(ss, 2); ss += __shfl_xor(ss, 4);
            const float rk = rsqf(ss * (1.0f / HD) + EPS);
#pragma unroll
            for (int j = 0; j < 8; ++j) kf[j] = kf[j] * rk * kg[j];
            *(LAS v4u*)(lds + P2_KS + key * P2_KROW + part * 16) = pack8(kf);
            const int x = key & 15; const int pos = (key & ~15) + (x & 3) + ((x >> 3) & 1) * 4 + ((x >> 2) & 1) * 8;
            LAS bf16* vt = (LAS bf16*)(lds + P2_VT) + pos;
            const unsigned vw[4] = {vraw[i].x, vraw[i].y, vraw[i].z, vraw[i].w};
#pragma unroll
            for (int j = 0; j < 4; ++j) { vt[(part * 8 + 2 * j) * (P2_VROW / 2)] = (bf16)(vw[j] & 0xffffu); vt[(part * 8 + 2 * j + 1) * (P2_VROW / 2)] = (bf16)(vw[j] >> 16); }
        }
        if (g + 1 < NKV) { P2_LOAD_KV(g + 1); }
        __syncthreads();
        const int h = g * 4 + h4;
        const float slope2 = exp2f(-0.5f * (float)(h + 1)) * LOG2E, sink2 = P.sinks[h] * LOG2E;
#pragma unroll
        for (int sub = 0; sub < 2; ++sub) {
            const int qs = 64 * half + 32 * sub;
            const int kt0 = 2 * half + sub;
            bf16x8 qf[4];
            { float qv[4][8]; float ss = 0.f;
#pragma unroll
              for (int d0 = 0; d0 < 4; ++d0) { unpack8(qraw[d0], qv[d0]);
#pragma unroll
                  for (int j = 0; j < 8; ++j) ss += qv[d0][j] * qv[d0][j]; }
              ss = xsum32(ss);
              const float rq = rsqf(ss * (1.0f / HD) + EPS);
#pragma unroll
              for (int d0 = 0; d0 < 4; ++d0) {
#pragma unroll
                  for (int j = 0; j < 8; ++j) qv[d0][j] = qv[d0][j] * rq * qg[16 * d0 + 8 * hi + j];
                  const v4u w = pack8(qv[d0]); qf[d0] = __builtin_bit_cast(bf16x8, w); } }
            if (sub == 0) { P2_LOAD_Q(g, 1); } else if (g + 1 < NKV) { P2_LOAD_Q(g + 1, 0); }
            f32x16 sc[5];
#pragma unroll
            for (int jt = 0; jt < 5; ++jt) { sc[jt] = (f32x16){0.f, 0.f, 0.f, 0.f, 0.f, 0.f, 0.f, 0.f, 0.f, 0.f, 0.f, 0.f, 0.f, 0.f, 0.f, 0.f};
#pragma unroll
                for (int d0 = 0; d0 < 4; ++d0) { const bf16x8 kfr = *(const LAS bf16x8*)(lds + P2_KS + ((kt0 + jt) * 32 + l32) * P2_KROW + (16 * d0 + 8 * hi) * 2);
                    sc[jt] = __builtin_amdgcn_mfma_f32_32x32x16_bf16(kfr, qf[d0], sc[jt], 0, 0, 0); } }
            int bl = l32 - 4 * hi; asm volatile("" : "+v"(bl));
            const float ab = -slope2 * (float)bl;
            const f32x2_t ns2 = (f32x2_t){-slope2, -slope2};
#pragma unroll
            for (int jt = 0; jt < 5; ++jt)
#pragma unroll
                for (int r = 0; r < 16; r += 2) { const int c0 = 128 - 32 * jt - (r & 3) - 8 * (r >> 2), c1 = 128 - 32 * jt - ((r + 1) & 3) - 8 * ((r + 1) >> 2);
                    f32x2_t v = (f32x2_t){(float)c0, (float)c1} * ns2 + (f32x2_t){sc[jt][r], sc[jt][r + 1]};
                    if (jt == 0) { v.x = (bl + c0 < 128) ? v.x : -1.0e30f; v.y = (bl + c1 < 128) ? v.y : -1.0e30f; }
                    if (jt == 4) { v.x = (bl + c0 >= 0) ? v.x : -1.0e30f; v.y = (bl + c1 >= 0) ? v.y : -1.0e30f; }
                    sc[jt][r] = v.x; sc[jt][r + 1] = v.y; }
            if (q0 == 0) {
                const int lim = 128 - qs;
#pragma unroll
                for (int jt = 0; jt < 4; ++jt)
#pragma unroll
                    for (int r = 0; r < 16; ++r) { const int kr = crow(r, hi); sc[jt][r] = (32 * jt + kr >= lim) ? sc[jt][r] : -1.0e30f; }
            }
            float mxt = -3.0e38f;
#pragma unroll
            for (int jt = 0; jt < 5; ++jt)
#pragma unroll
                for (int r = 0; r < 16; r += 2) mxt = fmaxf(mxt, fmaxf(sc[jt][r], sc[jt][r + 1]));
            float mx = fmaxf(sink2, mxt + ab); mx = xmax32(mx);
            f32x2_t l2 = (f32x2_t){0.f, 0.f}; const f32x2_t mx2 = (f32x2_t){mx - ab, mx - ab};
#pragma unroll
            for (int jt = 0; jt < 5; ++jt)
#pragma unroll
                for (int r = 0; r < 16; r += 2) { const f32x2_t d = (f32x2_t){sc[jt][r], sc[jt][r + 1]} - mx2; f32x2_t p; p.x = __builtin_amdgcn_exp2f(d.x); p.y = __builtin_amdgcn_exp2f(d.y); sc[jt][r] = p.x; sc[jt][r + 1] = p.y; l2 += p; }
            float l = l2.x + l2.y;
            l = xsum32(l); l += __builtin_amdgcn_exp2f(sink2 - mx);
            const float rl = __builtin_amdgcn_rcpf(l);
            f32x16 o[2];
#pragma unroll
            for (int dh = 0; dh < 2; ++dh) { o[dh] = (f32x16){0.f, 0.f, 0.f, 0.f, 0.f, 0.f, 0.f, 0.f, 0.f, 0.f, 0.f, 0.f, 0.f, 0.f, 0.f, 0.f}; }
#pragma unroll
            for (int jt = 0; jt < 5; ++jt)
#pragma unroll
                for (int j = 0; j < 2; ++j) { v4u pw; pw.x = pk2(sc[jt][8 * j + 0], sc[jt][8 * j + 1]); pw.y = pk2(sc[jt][8 * j + 2], sc[jt][8 * j + 3]); pw.z = pk2(sc[jt][8 * j + 4], sc[jt][8 * j + 5]); pw.w = pk2(sc[jt][8 * j + 6], sc[jt][8 * j + 7]);
                    const bf16x8 pf = __builtin_bit_cast(bf16x8, pw);
#pragma unroll
                    for (int dh = 0; dh < 2; ++dh) { const bf16x8 vf = *(const LAS bf16x8*)(lds + P2_VT + (32 * dh + l32) * P2_VROW + ((kt0 + jt) * 32 + 16 * j + 8 * hi) * 2);
                        o[dh] = __builtin_amdgcn_mfma_f32_32x32x16_bf16(vf, pf, o[dh], 0, 0, 0); } }
            float ss = 0.f;
            LAS unsigned char* ost = lds + P2_OST + wid * (32 * P2_OROW);
#pragma unroll
            for (int dh = 0; dh < 2; ++dh)
#pragma unroll
                for (int r4 = 0; r4 < 4; ++r4) { float a0 = o[dh][4 * r4] * rl, a1 = o[dh][4 * r4 + 1] * rl, a2 = o[dh][4 * r4 + 2] * rl, a3 = o[dh][4 * r4 + 3] * rl;
                    ss += (a0 * a0 + a1 * a1) + (a2 * a2 + a3 * a3);
                    v2u w; w.x = pk2(a0, a1); w.y = pk2(a2, a3);
                    *(LAS v2u*)(ost + l32 * P2_OROW + (32 * dh + 8 * r4 + 4 * hi) * 2) = w; }
            ss = xsum32(ss);
            if (hi == 0) __hip_atomic_fetch_add(rowss + qs + l32, ss, __ATOMIC_RELAXED, __HIP_MEMORY_SCOPE_WORKGROUP);
            asm volatile("s_waitcnt lgkmcnt(0)" ::: "memory");
#pragma unroll
            for (int i = 0; i < 4; ++i) { const int rr = i * 8 + (lane >> 3), ch = lane & 7; const v4u v = *(const LAS v4u*)(ost + rr * P2_OROW + ch * 16);
                bf16* ub = osc + (rowbase + q0 + qs + 8 * i) * OLD + h * HD; *(v4u*)(ub + ooffo) = v; }
            asm volatile("s_waitcnt lgkmcnt(0)" ::: "memory");
            __builtin_amdgcn_sched_barrier(0);
        }
    }
#undef P2_LOAD_KV
#undef P2_LOAD_Q
    asm volatile("s_waitcnt vmcnt(0)" ::: "memory");
    __syncthreads();
    LAS float* rstd = (LAS float*)(lds + P2_RSTD);
    if (tid < 128) rstd[tid] = rsqf(rowss[tid] * (1.0f / DATTN) + EPS);
    __syncthreads();
    { int lf_ = lane_id_asm(); asm volatile("" : "+v"(lf_)); const int tid = wid * 64 + (lf_ & 63);
#pragma unroll 8
    for (int i = 0; i < 32; ++i) { const int rr = (tid >> 7) + 4 * i, ch = tid & 127; bf16* p = osc + (rowbase + q0 + rr) * OLD + ch * 8;
        float f[8]; unpack8(*(const v4u*)p, f); const float s = rstd[rr];
#pragma unroll
        for (int j = 0; j < 8; ++j) f[j] *= s;
        if (FP8O) *(v2u*)(mixed8 + (rowbase + q0 + rr) * D + DCONV + ch * 8) = pack8_f8(f, F8_ASCALE); else *(v4u*)p = pack8(f); } }
    if (!conv_first) {
    {
        int lc_ = lane_id_asm(); asm volatile("" : "+v"(lc_)); const int lane = lc_ & 63;
        const float* cw = P.conv_w; float w0[16], w1[16], w2[16];
#pragma unroll
        for (int j = 0; j < 16; ++j) { const int ch = (j >> 3) * 512 + lane * 8 + (j & 7); w0[j] = cw[ch]; w1[j] = cw[DCONV + ch]; w2[j] = cw[2 * DCONV + ch]; }
        float u1[16], u2[16];
        const int t0 = q0 + 16 * wid;
#pragma unroll
        for (int j = 0; j < 16; ++j) { u1[j] = 0.f; u2[j] = 0.f; }
        if (t0 >= 2) {
#pragma unroll
            for (int hf = 0; hf < 2; ++hf) { const int ch = hf * 512 + lane * 8; float c[8], hc[8];
                const bf16* pr = proj + (rowbase + t0 - 1) * DIN; unpack8(*(const v4u*)(pr + C_C + ch), c); unpack8(*(const v4u*)(pr + C_HC + ch), hc);
#pragma unroll
                for (int j = 0; j < 8; ++j) u1[hf * 8 + j] = c[j] * hc[j];
                pr -= DIN; unpack8(*(const v4u*)(pr + C_C + ch), c); unpack8(*(const v4u*)(pr + C_HC + ch), hc);
#pragma unroll
                for (int j = 0; j < 8; ++j) u2[hf * 8 + j] = c[j] * hc[j]; }
        }
#pragma unroll 1
        for (int r0 = 0; r0 < 16; r0 += CONVR) {
            v4u rb[CONVR][2], rc[CONVR][2], rh[CONVR][2];
#pragma unroll
            for (int rr = 0; rr < CONVR; ++rr) { const bf16* pr = proj + (rowbase + t0 + r0 + rr) * DIN + lane * 8;
#pragma unroll
                for (int hf = 0; hf < 2; ++hf) { rb[rr][hf] = __builtin_nontemporal_load((const v4u*)(pr + C_B + hf * 512)); rc[rr][hf] = __builtin_nontemporal_load((const v4u*)(pr + C_C + hf * 512)); rh[rr][hf] = __builtin_nontemporal_load((const v4u*)(pr + C_HC + hf * 512)); } }
#pragma unroll
            for (int rr = 0; rr < CONVR; ++rr) { float y[16]; float ss = 0.f;
#pragma unroll
                for (int hf = 0; hf < 2; ++hf) { float bb[8], c[8], hc[8]; unpack8(rb[rr][hf], bb); unpack8(rc[rr][hf], c); unpack8(rh[rr][hf], hc);
#pragma unroll
                    for (int j = 0; j < 8; ++j) { const int jj = hf * 8 + j; const float u0 = c[j] * hc[j];
                        y[jj] = bb[j] * (w0[jj] * u2[jj] + w1[jj] * u1[jj] + w2[jj] * u0); ss += y[jj] * y[jj]; u2[jj] = u1[jj]; u1[jj] = u0; } }
                ss = wsum(ss); const float rs = rsqf(ss * (1.0f / DCONV) + EPS);
#pragma unroll
                for (int hf = 0; hf < 2; ++hf) { float f[8];
#pragma unroll
                    for (int j = 0; j < 8; ++j) f[j] = y[hf * 8 + j] * rs;
                    if (FP8O) *(v2u*)(mixed8 + (rowbase + t0 + r0 + rr) * D + hf * 512 + lane * 8) = pack8_f8(f, F8_ASCALE);
                    else *(v4u*)(mixed + (rowbase + t0 + r0 + rr) * D + hf * 512 + lane * 8) = pack8(f); } }
        }
    }
    }
}
constexpr int NPHASE = 10;
struct Args { Ptrs P; int ph_lo, ph_hi; };
__device__ __forceinline__ void moe_tables(LAS unsigned char* ldsx, gu32* ctl, const int wave_) {
    const int tid = TIDX(wave_);
    __syncthreads();
    if (tid < 64) {
        const int n = (int)__hip_atomic_load(ctl + CW_CNT + 64 * tid, RLX_AGENT);
        int x = (n + 255) >> 8;
#pragma unroll
        for (int o = 1; o < 64; o <<= 1) { const int v = __shfl_up(x, o); if (tid >= o) x += v; }
        ((LAS int*)(ldsx + pg8::LST_OFF))[tid] = n;
        ((LAS int*)(ldsx + pg8::LST_OFF + 256))[tid + 1] = x;
        if (tid == 0) ((LAS int*)(ldsx + pg8::LST_OFF + 256))[0] = 0;
    }
    __syncthreads();
}
#ifndef STAG6
#define STAG6 0
#endif
#ifndef STAG9
#define STAG9 0
#endif
__device__ __forceinline__ void stagger(int vcu, int us) {
    if ((vcu & 1) && us > 0) { const unsigned long long t0 = __builtin_amdgcn_s_memrealtime(); while (__builtin_amdgcn_s_memrealtime() - t0 < (unsigned long long)us * 100ull) __builtin_amdgcn_s_sleep(16); }
}
__global__ void __launch_bounds__(NWAVES * 64, 2) mk_fwd(Args args) {
    extern __shared__ __attribute__((aligned(16))) unsigned char lds_raw[];
    LAS unsigned char* lds = (LAS unsigned char*)lds_raw;
    const Ptrs& P = args.P;
    const int wave = __builtin_amdgcn_readfirstlane((int)(threadIdx.x >> 6));
    const int tid = TIDX(wave);
    const int G = gridDim.x, bx = blockIdx.x, vcu = (G % 8 == 0) ? (bx % 8) * (G / 8) + bx / 8 : bx;
    unsigned char* ws = P.ws; gu32* ctl = (gu32*)(ws + WS_CTL);
    for (int u = tid; u < (pg8::LDS_BYTES - pg8::LDSX_OFF) / 4; u += NWAVES * 64) ((LAS unsigned*)(lds + pg8::LDSX_OFF))[u] = 0u;
    __syncthreads();
    if (tid == 0) *((volatile LAS unsigned*)(lds + pg8::MISC_OFF) + 10) = __hip_atomic_fetch_add((unsigned*)ctl + CW_RANK + 64 * xb_xcc_id(), 1u, __ATOMIC_RELAXED, __HIP_MEMORY_SCOPE_AGENT);
    __syncthreads();
    const int xc = __builtin_amdgcn_readfirstlane((int)(xb_xcc_id() * 32u + *((volatile LAS unsigned*)(lds + pg8::MISC_OFF) + 10)));
    const int lo = args.ph_lo, hi = args.ph_hi;
    XcdBarrier bar; bar.bar = (unsigned*)(ctl + CW_BAR); bar.x = 0; bar.st = nullptr;
    if (hi - lo > 1) bar = xcd_barrier_post((unsigned*)(ctl + CW_BAR), (volatile LAS unsigned*)(lds + pg8::MISC_OFF) + 8, wave);
#ifdef ONLY_PHASE
#define IN(k) ((k) == ONLY_PHASE && lo <= (k) && (k) < hi)
#else
#define IN(k) (lo <= (k) && (k) < hi)
#endif
#define SEAM(k) do { if (IN(k) && IN((k) + 1) && (k) != 7 && (k) != 8) xcd_barrier(bar, wave); } while (0)
#define SEAM79() do { if (IN(7) && IN(9)) xcd_barrier(bar, wave); } while (0)
    bf16* Win = (bf16*)(ws + WS_WIN); bf16* Wout = (bf16*)(ws + WS_WOUT); bf16* Wplg = (bf16*)(ws + WS_WPLG); bf16* Wple = (bf16*)(ws + WS_WPLE);
    bf16* Wr = (bf16*)(ws + WS_WR); bf16* Wgu = (bf16*)(ws + WS_WGU); bf16* Wd = (bf16*)(ws + WS_WD);
    bf16* xb = (bf16*)(ws + WS_XB); bf16* mixed = (bf16*)(ws + WS_MIX); bf16* pb = (bf16*)(ws + WS_PB); bf16* proj = (bf16*)(ws + WS_PROJ);
    bf16* hid = (bf16*)(ws + WS_HID); bf16* pw = (bf16*)(ws + WS_PW); bf16* h1 = (bf16*)(ws + WS_H1); bf16* h2 = (bf16*)(ws + WS_H2);
    float* rsx = (float*)(ws + WS_RSX); float* rs1 = (float*)(ws + WS_RS1); float* ss1p = (float*)(ws + WS_SS1P); float* ss2p = (float*)(ws + WS_SS2P);
    int* eid = (int*)(ws + WS_EID); float* ew = (float*)(ws + WS_EW); Ent* ent = (Ent*)(ws + WS_ENT);

    if (IN(0)) { p0_prologue(P, lds, vcu, G, wave); } SEAM(0);
    if (IN(1)) { pg8::Gemm g{xb, Win, M, FP8QKV ? C_Q : DIN, D}; pg8::CvtOrder S; S.init(M, FP8QKV ? C_Q : DIN, G, bx); pg8::EpiBf16 E{proj, DIN, nullptr, 1.f};
        S.w = pg8::CvtWork{P.w_gate, P.w_up, P.w_down, P.norm_ffn, ws, vcu, G}; S.slot = DEFER_CVT ? (((vcu & 31) >> 2) % CVT_SLOTS) : -1; S.lo = 0; S.hi = CVT_SPLIT ? pg8::CvtWork::NGU : pg8::CvtWork::NIT;
        pg8::gemm_phase<pg8::EpiBf16, pg8::CvtOrder, true>(lds, g, S, E, wave);
        if (DEFER_CVT && S.nunits() - 1 <= S.slot) S.w.run(wave, S.lo, S.hi);
        if (FP8QKV) { pg8::Gemm g8{(const bf16*)(ws + WS_XB8), (const bf16*)(ws + WS_WIN8), M, NQKV, D / 2}; pg8::StaticOrder S8; S8.init(M, NQKV, G, bx); pg8::EpiBf16 E8{proj + C_Q, DIN, nullptr, F8_INV};
            pg8::gemm_phase<pg8::EpiBf16, pg8::StaticOrder, true, true>(lds, g8, S8, E8, wave); } } SEAM(1);
    if (IN(2)) { for (int unit = vcu; unit < BATCH * (SEQ / 128); unit += G) p2_unit(P, lds, unit, wave, (vcu & 1) != 0);     __syncthreads(); } SEAM(2);
    if (IN(3)) { pg8::Gemm g{FP8O ? (const bf16*)(ws + WS_MIX8) : mixed, Wout, M, D, FP8O ? D / 2 : D}; pg8::CvtOrder S; S.init(M, D, G, bx); pg8::EpiH1 E{xb, (const float*)(ws + WS_RMSX), h1, ss1p, FP8 ? ws + WS_H18 : nullptr, FP8O ? F8_INV : 1.f};
        S.w = pg8::CvtWork{P.w_gate, P.w_up, P.w_down, P.norm_ffn, ws, vcu, G}; S.slot = (DEFER_CVT && CVT_SPLIT == 2) ? (((vcu & 31) >> 2) % 3) : -1; S.lo = pg8::CvtWork::NGU; S.hi = pg8::CvtWork::NIT;
        pg8::gemm_phase<pg8::EpiH1, pg8::CvtOrder, true, FP8O != 0>(lds, g, S, E, wave);
        if (DEFER_CVT && CVT_SPLIT == 2 && S.nunits() - 1 <= S.slot) S.w.run(wave, S.lo, S.hi); } SEAM(3);
    if (IN(4)) { pg8::Gemm g{h1, Wr, M, 256, D}; pg8::StaticOrder S; S.init(M, 256, G, bx); pg8::EpiRouter E{ss1p, P.b_group, P.b_router, rs1, eid, ew, ent, (unsigned*)(ctl + CW_CNT)};
        pg8::gemm_phase<pg8::EpiRouter, pg8::StaticOrder, false>(lds, g, S, E, wave);
        __syncthreads();
        pg8::Gemm g2{pb, Wple, M, D, PLE}; pg8::PwOrder S2{G, bx, M / 256}; pg8::EpiF8 E2{(unsigned char*)pw, D, F8_PSCALE};
        pg8::gemm_phase<pg8::EpiF8, pg8::PwOrder, true>(lds, g2, S2, E2, wave); } SEAM(4);
    if (IN(5) || IN(6) || IN(7)) moe_tables(lds, ctl, wave);
    const LAS int* T0 = (const LAS int*)(lds + pg8::LST_OFF + 256);
    bool xs5 = XSEAM5 && IN(5) && IN(6) && G == 256;
    if (xs5) { for (int j = 0; j < 8; ++j) xs5 = xs5 && (xb_ld((unsigned*)ctl + CW_BAR + XB_XCNT(j)) == 32u); }
    if (IN(5)) { pg8::Gemm g{FP8 ? (const bf16*)(ws + WS_H18) : h1, Wgu, M, NE * 1024, FP8 ? D / 2 : D}; pg8::MoeOrder<true, 4> S{lds, ent, 0, T0[NLIST], G, vcu, wave, (const Ent*)(ctl + CW_ZERO)}; if (xs5) { S.xm = 1; S.c = xc; S.tsig = (unsigned*)ctl + CW_TD; } pg8::EpiGU E{hid, lds, FP8 ? F8_INV : 1.f, FP8 ? (unsigned char*)hid : nullptr};
        if (DEFER_CVT && CVT_SPLIT == 1) { S.w = pg8::CvtWork{P.w_gate, P.w_up, P.w_down, P.norm_ffn, ws, vcu, G}; S.slot = (vcu >> 2) % 3; }
        pg8::gemm_phase<pg8::EpiGU, pg8::MoeOrder<true, 4>, true, FP8 != 0>(lds, g, S, E, wave);
        if (DEFER_CVT && CVT_SPLIT == 1 && S.nunits() - 1 <= S.slot) S.w.run(wave, pg8::CvtWork::NGU, pg8::CvtWork::NIT); } if (!xs5) SEAM(5);
    if (IN(6)) { stagger(vcu, STAG6); pg8::Gemm g{hid, Wd, 0, NE * D, FP8 ? DEXP / 2 : DEXP}; pg8::MoeOrder<false, 8> S{lds, ent, 0, T0[NE], G, vcu, wave, (const Ent*)(ctl + CW_ZERO)}; if (xs5) { S.xm = 1; S.c = xc; S.twait = (unsigned*)ctl + CW_TD; } pg8::EpiDown<0> E{ws + WS_H28, lds, F8_DINV};
        pg8::gemm_phase<pg8::EpiDown<0>, pg8::MoeOrder<false, 8>, true, FP8 != 0>(lds, g, S, E, wave); } SEAM(6);
    if (IN(7)) { stagger(vcu, STAG6); pg8::Gemm g{hid, Wd, 0, NE * D, FP8 ? DEXP / 2 : DEXP}; pg8::MoeOrder<false, 8> S{lds, ent, T0[NE], T0[NLIST], G, vcu, wave, (const Ent*)(ctl + CW_ZERO)}; pg8::EpiDown<1> E{h1, h2, ss2p, lds, ws + WS_H28, F8_DINV};
        pg8::gemm_phase<pg8::EpiDown<1>, pg8::MoeOrder<false, 8>, true, FP8 != 0>(lds, g, S, E, wave); } SEAM79();
    if (IN(9)) { stagger(vcu, STAG9); pg8::Gemm g{FP8 ? (const bf16*)(ws + WS_H28) : h2, Wplg, M, D, FP8 ? D / 2 : D}; pg8::FinalOrder S; S.init(M, D, G, bx); S.ldsx = lds; S.ssp = ss2p; S.wave = wave; pg8::EpiFinal E{h2, (const unsigned char*)pw, P.out, lds, FP8 ? F8_INV : 1.f};
        pg8::gemm_phase<pg8::EpiFinal, pg8::FinalOrder, true, FP8 != 0>(lds, g, S, E, wave); }
#undef IN
#undef SEAM
}
extern "C" void kernel_launch(void* const* d_in, const int* in_sizes, int n_in, void* d_out, int out_size, void* d_ws, size_t ws_size, hipStream_t stream) {
    static int grid = 0;
    if (grid == 0) {
        if (n_in != 22 || in_sizes[0] != M * D || out_size != M * D || ws_size < WS_END) { fprintf(stderr, "kernel_launch: unexpected problem (n_in %d, in0 %d, out %d, ws %zu); nothing launched\n", n_in, n_in > 0 ? in_sizes[0] : -1, out_size, ws_size); grid = -1; return; }
        int dev = 0, cus = 0, per_cu = 0;
        if (hipGetDevice(&dev) != hipSuccess || hipDeviceGetAttribute(&cus, hipDeviceAttributeMultiprocessorCount, dev) != hipSuccess) { grid = -1; return; }
        if (hipFuncSetAttribute((const void*)mk_fwd, hipFuncAttributeMaxDynamicSharedMemorySize, pg8::LDS_BYTES) != hipSuccess) { fprintf(stderr, "kernel_launch: hipFuncSetAttribute failed\n"); grid = -1; return; }
        if (hipOccupancyMaxActiveBlocksPerMultiprocessor(&per_cu, (const void*)mk_fwd, NWAVES * 64, pg8::LDS_BYTES) != hipSuccess || per_cu < 1) { fprintf(stderr, "kernel_launch: occupancy query says %d workgroups per CU\n", per_cu); (void)hipGetLastError(); grid = -1; return; }
        grid = cus;
    }
    if (grid < 0) return;
    if (hipMemsetAsync((char*)d_ws + WS_CTL, 0, CTL_ZERO_BYTES, stream) != hipSuccess) return;
    Args a{};
    { const float** pp = (const float**)&a.P; for (int i = 0; i < 22; ++i) pp[i] = (const float*)d_in[i]; }
    a.P.out = (float*)d_out; a.P.ws = (unsigned char*)d_ws;
    a.ph_lo = 0; a.ph_hi = NPHASE;
    hipLaunchKernelGGL(mk_fwd, dim3(grid), dim3(NWAVES * 64), pg8::LDS_BYTES, stream, a);
}
```

```cpp
#include <hip/hip_runtime.h>
#include <cstdio>
#include <cstdint>

typedef unsigned short bf16;
typedef unsigned v4u __attribute__((ext_vector_type(4)));
typedef unsigned v2u __attribute__((ext_vector_type(2)));
typedef float f32x4 __attribute__((ext_vector_type(4)));
typedef float f32x16 __attribute__((ext_vector_type(16)));
typedef short bf16x8 __attribute__((ext_vector_type(8)));
#define GAS __attribute__((address_space(1)))
#define LAS __attribute__((address_space(3)))
typedef GAS unsigned gu32;

constexpr int BATCH = 4, SEQ = 8192, D = 2048, M = BATCH * SEQ;
constexpr int DCONV = 1024, NH = 16, NKV = 4, HD = 64, DATTN = 1024, DKV = 256, DIN = 4608;
constexpr int C_B = 0, C_C = 1024, C_HC = 2048, C_Q = 3072, C_K = 4096, C_V = 4352;
#ifndef UPROD
#define UPROD 1
#endif
constexpr int PP = UPROD ? DIN - 1024 : DIN;
constexpr int O_B = 0, O_U = 1024, O_Q = UPROD ? 2048 : C_Q, O_K = UPROD ? 3072 : C_K, O_V = UPROD ? 3328 : C_V;
constexpr int NGRP = 4, EPG = 8, NE = 32, DEXP = 512, PLE = 256, NRT = 36;
constexpr int NLIST = 64, LCAP = 32768;
constexpr float EPS = 1e-6f;
constexpr float LOG2E = 1.4426950408889634f;

constexpr size_t MiB = 1u << 20;
constexpr size_t WS_CTL = 0, CTL_ZERO_BYTES = 1 * MiB;
constexpr size_t WS_WIN = 2 * MiB;
constexpr size_t WS_WOUT = 20 * MiB;
constexpr size_t WS_WPLG = 28 * MiB;
constexpr size_t WS_WPLE = 36 * MiB;
constexpr size_t WS_WR = 37 * MiB;
constexpr size_t WS_RSX = 38 * MiB;
constexpr size_t WS_RS1 = 38 * MiB + 256 * 1024;
constexpr size_t WS_RS2 = 38 * MiB + 512 * 1024;
constexpr size_t WS_RMSX = 38 * MiB + 768 * 1024;
constexpr size_t WS_EID = 39 * MiB;
constexpr size_t WS_EW = 39 * MiB + 512 * 1024;
constexpr size_t WS_LOG = 42 * MiB;
constexpr size_t WS_SS1P = 50 * MiB;
constexpr size_t WS_SS2P = 54 * MiB;
#ifndef FP8
#define FP8 1
#endif
#ifndef FP8O
#define FP8O 0
#endif
constexpr size_t WS_MIX8 = 816 * MiB;
#ifndef FP8QKV
#define FP8QKV 0
#endif
constexpr size_t WS_XB8 = 128 * MiB;
constexpr size_t WS_WIN8 = 20 * MiB - 3 * MiB;
constexpr int NQKV = DATTN + 2 * DKV;
constexpr float F8_ASCALE = 16.f, F8_WSCALE = 32.f, F8_INV = 1.0f / (16.f * 32.f);
constexpr float F8_HSCALE = 16.f, F8_DSCALE = 16.f, F8_DINV = 1.0f / (16.f * 16.f);
constexpr float F8_PSCALE = 16.f, F8_PINV = 1.0f / 16.f;
constexpr float F8_YSCALE = 64.f, F8_YINV = 1.0f / 64.f;
constexpr size_t WS_WGU = 64 * MiB;
constexpr size_t WS_H18 = 128 * MiB;
constexpr size_t WS_H28 = 608 * MiB;
constexpr size_t WS_WD = 192 * MiB;
constexpr size_t WS_XB = 256 * MiB;
constexpr size_t WS_MIX = 816 * MiB;
constexpr size_t WS_PB = 384 * MiB;
constexpr size_t WS_PROJ = 400 * MiB;
constexpr size_t WS_HID = 400 * MiB;
constexpr size_t WS_PW = 480 * MiB;
constexpr size_t WS_H1 = 688 * MiB;
constexpr size_t WS_H2 = 816 * MiB;
constexpr size_t WS_YA = 688 * MiB;
constexpr size_t WS_ENT = 944 * MiB;
constexpr size_t WS_END = 976 * MiB;
constexpr int CW_TMO = 0, CW_BAR = 4096, CW_CNT = 8192, CW_ZERO = 16384, CW_RANK = 24576  , CW_TD = 32768  ;

__device__ __forceinline__ float bf2f(bf16 v) { return __uint_as_float(((unsigned)v) << 16); }
__device__ __forceinline__ unsigned f2bfu(float f) { unsigned u = __float_as_uint(f); return (u + 0x7fffu + ((u >> 16) & 1u)) >> 16; }
__device__ __forceinline__ bf16 f2bf(float f) { return (bf16)f2bfu(f); }
typedef float f32x2_t __attribute__((ext_vector_type(2))); typedef __bf16 bf16x2_t __attribute__((ext_vector_type(2)));
__device__ __forceinline__ unsigned pk2(float lo, float hi) { const f32x2_t v = {lo, hi}; const bf16x2_t b = __builtin_convertvector(v, bf16x2_t); return __builtin_bit_cast(unsigned, b); }
__device__ __forceinline__ float xsum32(float v) { const auto r = __builtin_amdgcn_permlane32_swap(__float_as_uint(v), __float_as_uint(v), false, false); return __uint_as_float(r[0]) + __uint_as_float(r[1]); }
__device__ __forceinline__ float xmax32(float v) { const auto r = __builtin_amdgcn_permlane32_swap(__float_as_uint(v), __float_as_uint(v), false, false); return fmaxf(__uint_as_float(r[0]), __uint_as_float(r[1])); }
__device__ __forceinline__ float rsqf(float x) { return __builtin_amdgcn_rsqf(x); }
__device__ __forceinline__ float wsum(float v) {
#pragma unroll
    for (int o = 32; o > 0; o >>= 1) v += __shfl_xor(v, o);
    return v;
}
__device__ __forceinline__ void unpack8(v4u w, float* f) {
    f[0] = __uint_as_float(w.x << 16); f[1] = __uint_as_float(w.x & 0xffff0000u);
    f[2] = __uint_as_float(w.y << 16); f[3] = __uint_as_float(w.y & 0xffff0000u);
    f[4] = __uint_as_float(w.z << 16); f[5] = __uint_as_float(w.z & 0xffff0000u);
    f[6] = __uint_as_float(w.w << 16); f[7] = __uint_as_float(w.w & 0xffff0000u);
}
__device__ __forceinline__ v2u pack8_f8(const float* f, float sc) {
    float c[8];
#pragma unroll
    for (int j = 0; j < 8; ++j) c[j] = __builtin_amdgcn_fmed3f(f[j] * sc, -448.f, 448.f);
    int lo = 0, hi = 0;
    lo = __builtin_amdgcn_cvt_pk_fp8_f32(c[0], c[1], lo, false); lo = __builtin_amdgcn_cvt_pk_fp8_f32(c[2], c[3], lo, true);
    hi = __builtin_amdgcn_cvt_pk_fp8_f32(c[4], c[5], hi, false); hi = __builtin_amdgcn_cvt_pk_fp8_f32(c[6], c[7], hi, true);
    v2u o; o.x = (unsigned)lo; o.y = (unsigned)hi; return o;
}
__device__ __forceinline__ v4u pack8(const float* f) { v4u o; o.x = pk2(f[0], f[1]); o.y = pk2(f[2], f[3]); o.z = pk2(f[4], f[5]); o.w = pk2(f[6], f[7]); return o; }

__device__ __forceinline__ int lane_id_asm() { int l; asm volatile("v_mbcnt_lo_u32_b32 %0, -1, 0\n\tv_mbcnt_hi_u32_b32 %0, -1, %0" : "=v"(l)); return l & 63; }
__device__ __forceinline__ int lane_id() { return lane_id_asm(); }
#define TIDX(wave_) (((wave_) & 7) * 64 + lane_id_asm())

#ifndef DEFER_CVT
#define DEFER_CVT 1
#endif
#ifndef CVT_SLOTS
#define CVT_SLOTS 8
#endif
#ifndef CVT_SPLIT
#define CVT_SPLIT 0
#endif
#ifndef XSEAM5
#define XSEAM5 0
#endif
struct Ptrs {
    const float *x, *p, *norm_mix, *w_in, *conv_w, *q_norm, *k_norm, *sinks, *onc, *ona, *w_out, *norm_ffn, *w_group, *b_group, *w_router, *b_router,
        *w_gate, *w_up, *w_down, *norm_ple, *w_ple_gate, *w_ple;
    float* out; unsigned char* ws;
};
struct Ent { int tok; float w; float rs; int pad; };
#ifndef BALK
#define BALK 0
#endif
#ifndef DMAFIRST
#define DMAFIRST 0
#endif
namespace pg8 {
typedef int v4i __attribute__((ext_vector_type(4)));
typedef int v8i __attribute__((ext_vector_type(8)));
constexpr int BM = 256, BK = 64, HALF = 128, HTB = HALF * BK * 2  , STAGE_BYTES = 8 * HTB, NXCD = 8;
#ifndef WGM_
#define WGM_ 4
#endif
constexpr int WGM = WGM_;
constexpr int RING_BYTES = 131072;
constexpr int LDSX_OFF = RING_BYTES;
constexpr int MISC_OFF = LDSX_OFF + 320;
constexpr int TAB_OFF = LDSX_OFF + 1024;
constexpr int LST_OFF = TAB_OFF + 8192;
constexpr int LDS_BYTES = 147456;

__host__ __device__ __forceinline__ int lds_byte(int r, int c) { const int st = (r >> 4) * 2 + (c >> 5), rr = r & 15, cc = c & 31, ob = rr * 64 + cc * 2; return st * 1024 + (ob ^ (((ob >> 9) & 1) << 5)); }
__host__ __device__ __forceinline__ void stage_rc(int b, int& R, int& C) { const int st = b / 1024, sb = b % 1024, swz = sb ^ (((sb >> 9) & 1) << 5); R = (st >> 1) * 16 + swz / 64; C = (st & 1) * 32 + (swz % 64) / 2; }
__host__ __device__ __forceinline__ int perm32(int rho) { const int n = rho >> 4, i = rho & 15; return 8 * (i >> 2) + 4 * n + (i & 3); }

struct Unit { int pm, pn, bt, par, lst, rk0, nl; };
struct Gemm { const bf16* A; const bf16* Bt; int M, N, K; };

struct StaticOrder {
    static constexpr bool GATHER = false;
    int nM, nN, nwg, G, c;
    __host__ __device__ void init(int M_, int N_, int G_, int c_) { nM = M_ / BM; nN = N_ / BM; nwg = nM * nN; G = G_; c = c_; }
    __host__ __device__ bool next(int i, Unit& u) const {
        const long L = (long)i * G + c; if (L >= nwg) return false;
        int wgid = (int)L; { const int q = nwg / NXCD, r = nwg % NXCD, xcd = wgid % NXCD, off = wgid / NXCD; wgid = (xcd < r ? xcd * (q + 1) : r * (q + 1) + (xcd - r) * q) + off; }
        const int nig = WGM * nN, gid = wgid / nig, fm = gid * WGM, gsz = (nM - fm) < WGM ? (nM - fm) : WGM;
        u.pm = fm + ((wgid % nig) % gsz); u.pn = (wgid % nig) / gsz; u.bt = u.pn; u.par = i & 1; u.lst = 0; u.rk0 = 0; u.nl = 0; return true;
    }
    __device__ __forceinline__ void a_prefetch(const Unit&) const {}
    __device__ __forceinline__ void a_first() const {}
    __device__ __forceinline__ void a_ready(const Unit&) const {}
    __device__ __forceinline__ void done(const Unit&) const {}
    __device__ __forceinline__ void between(int, int) const {}
    __device__ __forceinline__ void signal(int) const {}
};

struct SameTileOrder : StaticOrder { __host__ __device__ bool next(int i, Unit& u) const { if (!StaticOrder::next(i, u)) return false; u.pm = c & 7; u.pn = 0; u.bt = 0; return true; } };
struct PwOrder {
    static constexpr bool GATHER = false;
    int G, c, nr;
    __device__ __forceinline__ bool next(int i, Unit& u) const {
        int L;
        if (G == 256 && nr == 128) { if (c < nr || i >= 8) return false; L = (c - nr) * 8 + i; }
        else { L = i * G + c; if (L >= (M / BM) * (D / BM)) return false; }
        u.pm = L / (D / BM); u.pn = L % (D / BM); u.bt = u.pn; u.par = i & 1; u.lst = 0; u.rk0 = 0; u.nl = 0; return true;
    }
    __device__ __forceinline__ void a_prefetch(const Unit&) const {}
    __device__ __forceinline__ void a_first() const {}
    __device__ __forceinline__ void a_ready(const Unit&) const {}
    __device__ __forceinline__ void done(const Unit&) const {}
    __device__ __forceinline__ void between(int, int) const {}
    __device__ __forceinline__ void signal(int) const {}
};

template <bool GU> __device__ __forceinline__ void cvt_item(const float* W, const float* g0, unsigned char* WT8, int k0, int n0, int up, int lane) {
    constexpr int K = GU ? D : DEXP, N = GU ? DEXP : D;
    const int q = lane & 3, c4 = lane >> 2;
    f32x4 v[32];
    const __attribute__((address_space(1))) f32x4* src = (const __attribute__((address_space(1))) f32x4*)(W + (size_t)(k0 + 16 * q) * N + n0) + c4;
#pragma unroll
    for (int i = 0; i < 32; ++i) v[i] = __builtin_nontemporal_load(src + (size_t)((i & 15) + 64 * (i >> 4)) * (N / 4));
    float gg[32];
#pragma unroll
    for (int t = 0; t < 8; ++t) { f32x4 g4 = (f32x4){1.f, 1.f, 1.f, 1.f}; if (GU) g4 = *(const f32x4*)(g0 + k0 + 16 * q + 64 * (t >> 2) + 4 * (t & 3));
#pragma unroll
        for (int u = 0; u < 4; ++u) gg[4 * t + u] = g4[u] * (GU ? F8_WSCALE : F8_DSCALE); }
    const int n = n0 + 4 * c4;
    const int row = GU ? (n >> 7) * 256 + ((n & 127) >> 3) * 16 + up * 8 + (n & 7) : n;
    unsigned char* dst = WT8 + (size_t)row * K + k0 + 16 * q;
#pragma unroll
    for (int j = 0; j < 4; ++j) { v2u qv[4];
#pragma unroll
        for (int b = 0; b < 4; ++b) { float f[8];
#pragma unroll
            for (int t = 0; t < 8; ++t) f[t] = v[b * 8 + t][j] * gg[b * 8 + t];
            qv[b] = pack8_f8(f, 1.0f); }
        __builtin_nontemporal_store((v4u){qv[0].x, qv[0].y, qv[1].x, qv[1].y}, (v4u*)(dst + (size_t)j * K));
        __builtin_nontemporal_store((v4u){qv[2].x, qv[2].y, qv[3].x, qv[3].y}, (v4u*)(dst + (size_t)j * K + 64)); }
}
struct CvtWork {
    const float *w_gate, *w_up, *w_down, *norm_ffn; unsigned char* ws; int vcu, G;
    static constexpr int NGU = NE * 2 * (DEXP / 64) * (D / 128), ND = NE * (D / 64) * (DEXP / 128), NIT = NGU + ND;
    __device__ __forceinline__ void run(int wid, int lo, int hi) const {
        const int lane = lane_id_asm();
        const float* wg_ = w_gate; const float* wu_ = w_up; asm volatile("" : "+s"(wg_), "+s"(wu_));
        const int n = hi - lo, per = (n + G - 1) / G, perw = (per + 7) / 8, lim = lo + ((vcu + 1) * per < n ? (vcu + 1) * per : n);
        const int base = lo + vcu * per + wid * perw, top = base + perw < lim ? base + perw : lim;
#pragma unroll 1
        for (int it0 = base; it0 < top; ++it0) { const int it = __builtin_amdgcn_readfirstlane(it0);
            if (it < NGU) { const int kb = it & 15, nb = (it >> 4) & 7, up = (it >> 7) & 1, e = it >> 8;
                cvt_item<true>((up ? wu_ : wg_) + (size_t)e * D * DEXP, norm_ffn, ws + WS_WGU + (size_t)e * 1024 * D, kb * 128, nb * 64, up, lane); }
            else { const int j = it - NGU, kb = j & 3, nb = (j >> 2) & 31, e = j >> 7;
                cvt_item<false>(w_down + (size_t)e * DEXP * D, nullptr, ws + WS_WD + (size_t)e * D * DEXP, kb * 128, nb * 64, 0, lane); } }
    }
};
struct CvtOrder : StaticOrder {
    CvtWork w; int slot, lo, hi;
    __device__ __forceinline__ void between(int ui, int wid) const { if (ui == slot) w.run(wid, lo, hi); }
    __device__ __forceinline__ int nunits() const { return c < nwg ? (nwg - 1 - c) / G + 1 : 0; }
};

__device__ __forceinline__ unsigned cvt_pk_bf16(float lo, float hi) { unsigned r; asm volatile("v_cvt_pk_bf16_f32 %0, %1, %2" : "=v"(r) : "v"(lo), "v"(hi)); return r; }

template <class Epi, class Sched, bool ALIGN_EPI, bool F8 = false, int MMAMASK = 15>
__device__ __forceinline__ void gemm_phase(LAS unsigned char* lds, const Gemm g, const Sched& S, const Epi& E, const int wid) {
    const int lane = lane_id(), tid = wid * 64 + lane, wr = wid >> 2, wc = wid & 3, fr = lane & 15, fq = lane >> 4;
    const int K = g.K, nt = K / BK;
    unsigned voffA[2], voffB[2]; int R0 = 0, C0 = 0;
#pragma unroll
    for (int i = 0; i < 2; ++i) { int R, C; stage_rc(tid * 16 + i * 8192, R, C); const int Rb = Epi::PERM ? (64 * (R >> 5) + 16 * ((R & 15) >> 2) + 4 * ((R >> 4) & 1) + (R & 3)) : R;
        voffA[i] = (unsigned)(R * K + C) * 2u; voffB[i] = (unsigned)(Rb * K + C) * 2u; if (i == 0) { R0 = R; C0 = C; } }
    const size_t kstep = (size_t)(BK * 2);
    const size_t hstep = (size_t)HALF * K * 2;
    const size_t tstep = 2 * hstep;
    const size_t hstepB = Epi::PERM ? (size_t)8 * K * 2 : hstep;
    const unsigned ldsw = (unsigned)wid * 1024u;
    const int aoff = lds_byte(wr * 64 + fr, fq * 8), boff = lds_byte(wc * 32 + fr, fq * 8);
    unsigned gc[2][2] = {{0u, 0u}, {0u, 0u}}, gn[2][2] = {{0u, 0u}, {0u, 0u}}, gs[2][2] = {{0u, 0u}, {0u, 0u}};
#define PG8_TOK(par, r) (*(const LAS int*)(lds + TAB_OFF + (par) * 4096 + (r) * 16))
#define PG8_GLOAD(dst, par) do { _Pragma("unroll") for (int _h = 0; _h < 2; ++_h) _Pragma("unroll") for (int _i = 0; _i < 2; ++_i) \
        dst[_h][_i] = (unsigned)PG8_TOK(par, _h * 128 + _i * 64 + R0) * (unsigned)(K * 2) + (unsigned)(C0 * 2); } while (0)
#define PG8_SA(b, h) (((b) * 2 + (h)) * HTB)
#define PG8_SB(b, h) ((4 + (b) * 2 + (h)) * HTB)
#define PG8_STAGE(bufoff, gbase, voff) do { _Pragma("unroll") for (int _i = 0; _i < 2; ++_i) \
        __builtin_amdgcn_global_load_lds((const unsigned*)((const char*)(gbase) + (voff)[_i]), (LAS unsigned*)(lds + (bufoff) + ldsw + _i * 8192), 16, 0, 0); } while (0)
#define PG8_STAGE_A(bufoff, ub, go, h, kb) do { if constexpr (Sched::GATHER) { PG8_STAGE(bufoff, (const char*)g.A + (kb), go[h]); } else { PG8_STAGE(bufoff, (ub) + (kb) + (h) * hstep, voffA); } } while (0)
#define PG8_CAT(p_) __builtin_shufflevector(*(const LAS v4i*)(p_), *(const LAS v4i*)((p_) + 1024), 0, 1, 2, 3, 4, 5, 6, 7)
#define PG8_LDA(dst, b, h) do { if constexpr (F8) { _Pragma("unroll") for (int m = 0; m < 4; ++m) dst##8[m] = PG8_CAT(lds + PG8_SA(b, h) + aoff + m * 2048); } \
        else { _Pragma("unroll") for (int m = 0; m < 4; ++m) _Pragma("unroll") for (int k = 0; k < 2; ++k) dst[m][k] = *(const LAS bf16x8*)(lds + PG8_SA(b, h) + aoff + m * 2048 + k * 1024); } } while (0)
#define PG8_LDB(dst, b, h) do { if constexpr (F8) { _Pragma("unroll") for (int n = 0; n < 2; ++n) dst##8[n] = PG8_CAT(lds + PG8_SB(b, h) + boff + n * 2048); } \
        else { _Pragma("unroll") for (int n = 0; n < 2; ++n) _Pragma("unroll") for (int k = 0; k < 2; ++k) dst[n][k] = *(const LAS bf16x8*)(lds + PG8_SB(b, h) + boff + n * 2048 + k * 1024); } } while (0)
#define PG8_MMA(ai, bj, At, Bt) do { if constexpr (((MMAMASK >> ((ai) * 2 + (bj))) & 1) == 0) break; __builtin_amdgcn_s_setprio(1); _Pragma("unroll") for (int m = 0; m < 4; ++m) _Pragma("unroll") for (int n = 0; n < 2; ++n) { \
        if constexpr (F8) { asm volatile("v_mfma_scale_f32_16x16x128_f8f6f4 %0, %1, %2, %0, %3, %3 op_sel_hi:[0,0,0]" : "+v"(acc[ai][bj][m][n]) : "v"(Bt##8[n]), "v"(At##8[m]), "v"(f8scale)); } \
        else { _Pragma("unroll") for (int k = 0; k < 2; ++k) acc[ai][bj][m][n] = __builtin_amdgcn_mfma_f32_16x16x32_bf16(Bt[n][k], At[m][k], acc[ai][bj][m][n], 0, 0, 0); } } \
        __builtin_amdgcn_s_setprio(0); } while (0)
#define PG8_WAIT_V(n) asm volatile("s_waitcnt vmcnt(" #n ")" ::: "memory")
#define PG8_WAIT_L(n) asm volatile("s_waitcnt lgkmcnt(" #n ")" ::: "memory")
#define PG8_BAR __builtin_amdgcn_s_barrier()
#define PG8_SCHED __builtin_amdgcn_sched_barrier(0)
    Unit cur, nxt; int ui = 0, prev_pm = 0;
    if (!S.next(0, cur)) return;
    f32x4 acc[2][2][4][2];
#pragma unroll
    for (int a = 0; a < 2; ++a)
#pragma unroll
        for (int b = 0; b < 2; ++b)
#pragma unroll
            for (int m = 0; m < 4; ++m)
#pragma unroll
                for (int n = 0; n < 2; ++n) acc[a][b][m][n] = (f32x4){0.f, 0.f, 0.f, 0.f};
    bf16x8 At[4][2], B0[2][2], B1[2][2];
    const int f8scale = 0x7f7f7f7f;
    v8i At8[4], B08[2], B18[2];
    const char* cA = (const char*)g.A + (size_t)cur.pm * tstep; const char* cB = (const char*)g.Bt + (size_t)cur.bt * tstep;
    S.a_prefetch(cur); S.a_first(); S.a_ready(cur);
    if constexpr (Sched::GATHER) { PG8_GLOAD(gc, cur.par); }
    PG8_STAGE(PG8_SB(0, 0), cB, voffB); PG8_STAGE(PG8_SB(0, 1), cB + hstepB, voffB); PG8_STAGE_A(PG8_SA(0, 0), cA, gc, 0, (size_t)0); PG8_STAGE_A(PG8_SA(0, 1), cA, gc, 1, (size_t)0);
    if (wr == 1) PG8_BAR;
    PG8_WAIT_V(2); PG8_BAR;
    PG8_STAGE(PG8_SB(1, 0), cB + kstep, voffB); PG8_STAGE_A(PG8_SA(1, 0), cA, gc, 0, kstep); PG8_STAGE(PG8_SB(1, 1), cB + hstepB + kstep, voffB);
    PG8_WAIT_V(6); PG8_BAR;
    for (;;) {
        const bool has_next = S.next(ui + 1, nxt);
        const char* nA = has_next ? (const char*)g.A + (size_t)nxt.pm * tstep : cA; const char* nB = has_next ? (const char*)g.Bt + (size_t)nxt.bt * tstep : cB;
#pragma unroll 1
        for (int t = 0; t < nt; t += 2) {
            const bool last = (t == nt - 2);
            const size_t k1 = (size_t)(t + 1) * kstep;
            const char* sA = last ? nA : cA; const size_t k2 = last ? (size_t)0 : (size_t)(t + 2) * kstep, k3 = k2 + kstep;
            const char* b2 = last ? nB : cB + (size_t)(t + 2) * kstep; const char* b3 = b2 + kstep;
            if (last && has_next) { S.a_ready(nxt); if constexpr (Sched::GATHER) { PG8_GLOAD(gn, nxt.par); } }
            if constexpr (Sched::GATHER) {
#pragma unroll
                for (int h = 0; h < 2; ++h)
#pragma unroll
                    for (int i = 0; i < 2; ++i) gs[h][i] = (last && has_next) ? gn[h][i] : gc[h][i];
            }
#if BALK
            PG8_LDB(B0, 0, 0); PG8_LDB(B1, 0, 1); PG8_SCHED; PG8_LDA(At, 0, 0); PG8_STAGE_A(PG8_SA(1, 1), cA, gc, 1, k1);
            PG8_WAIT_V(8); PG8_WAIT_L(0); PG8_BAR; PG8_MMA(0, 0, At, B0); PG8_MMA(0, 1, At, B1); PG8_BAR; PG8_SCHED;
            if (has_next && t == nt - 4) S.a_prefetch(nxt);
            PG8_LDA(At, 0, 1); PG8_STAGE(PG8_SB(0, 0), b2, voffB); PG8_STAGE(PG8_SB(0, 1), b2 + hstepB, voffB);
            PG8_WAIT_V(6); PG8_WAIT_L(0); PG8_BAR; PG8_MMA(1, 0, At, B0); PG8_STAGE_A(PG8_SA(0, 0), sA, gs, 0, k2); PG8_MMA(1, 1, At, B1); PG8_BAR; PG8_SCHED;
            PG8_LDB(B0, 1, 0); PG8_LDB(B1, 1, 1); PG8_SCHED; PG8_LDA(At, 1, 0); PG8_STAGE_A(PG8_SA(0, 1), sA, gs, 1, k2);
            PG8_WAIT_V(8); PG8_WAIT_L(0); PG8_BAR; PG8_MMA(0, 0, At, B0); PG8_MMA(0, 1, At, B1); PG8_BAR; PG8_SCHED;
            PG8_LDA(At, 1, 1); PG8_STAGE(PG8_SB(1, 0), b3, voffB); PG8_STAGE(PG8_SB(1, 1), b3 + hstepB, voffB);
            PG8_WAIT_V(6); PG8_WAIT_L(0); PG8_BAR; PG8_MMA(1, 0, At, B0); PG8_STAGE_A(PG8_SA(1, 0), sA, gs, 0, k3); PG8_MMA(1, 1, At, B1); PG8_BAR; PG8_SCHED;
#else
#if DMAFIRST
            PG8_LDB(B0, 0, 0); PG8_LDB(B1, 0, 1); PG8_SCHED; PG8_LDA(At, 0, 0); PG8_WAIT_L(0); PG8_SCHED; PG8_STAGE_A(PG8_SA(1, 1), cA, gc, 1, k1);
            PG8_WAIT_V(8); PG8_BAR; PG8_MMA(0, 0, At, B0); PG8_MMA(0, 1, At, B1); PG8_BAR; PG8_SCHED;
            if (has_next && t == nt - 4) S.a_prefetch(nxt);
            PG8_LDA(At, 0, 1); PG8_WAIT_L(0); PG8_SCHED; PG8_STAGE(PG8_SB(0, 0), b2, voffB); PG8_STAGE(PG8_SB(0, 1), b2 + hstepB, voffB); PG8_STAGE_A(PG8_SA(0, 0), sA, gs, 0, k2);
            PG8_WAIT_V(8); PG8_BAR; PG8_MMA(1, 0, At, B0); PG8_MMA(1, 1, At, B1); PG8_BAR; PG8_SCHED;
            PG8_LDB(B0, 1, 0); PG8_LDB(B1, 1, 1); PG8_SCHED; PG8_LDA(At, 1, 0); PG8_WAIT_L(0); PG8_SCHED; PG8_STAGE_A(PG8_SA(0, 1), sA, gs, 1, k2);
            PG8_WAIT_V(8); PG8_BAR; PG8_MMA(0, 0, At, B0); PG8_MMA(0, 1, At, B1); PG8_BAR; PG8_SCHED;
            PG8_LDA(At, 1, 1); PG8_WAIT_L(0); PG8_SCHED; PG8_STAGE(PG8_SB(1, 0), b3, voffB); PG8_STAGE(PG8_SB(1, 1), b3 + hstepB, voffB); PG8_STAGE_A(PG8_SA(1, 0), sA, gs, 0, k3);
            PG8_WAIT_V(8); PG8_BAR; PG8_MMA(1, 0, At, B0); PG8_MMA(1, 1, At, B1); PG8_BAR; PG8_SCHED;
#else
            PG8_LDB(B0, 0, 0); PG8_LDB(B1, 0, 1); PG8_SCHED; PG8_LDA(At, 0, 0); PG8_STAGE_A(PG8_SA(1, 1), cA, gc, 1, k1);
            PG8_WAIT_V(8); PG8_WAIT_L(0); PG8_BAR; PG8_MMA(0, 0, At, B0); PG8_MMA(0, 1, At, B1); PG8_BAR; PG8_SCHED;
            if (has_next && t == nt - 4) S.a_prefetch(nxt);
            PG8_LDA(At, 0, 1); PG8_STAGE(PG8_SB(0, 0), b2, voffB); PG8_STAGE(PG8_SB(0, 1), b2 + hstepB, voffB); PG8_STAGE_A(PG8_SA(0, 0), sA, gs, 0, k2);
            PG8_WAIT_V(8); PG8_WAIT_L(0); PG8_BAR; PG8_MMA(1, 0, At, B0); PG8_MMA(1, 1, At, B1); PG8_BAR; PG8_SCHED;
            if (t == 0 && ui > 0) S.signal(prev_pm);
            PG8_LDB(B0, 1, 0); PG8_LDB(B1, 1, 1); PG8_SCHED; PG8_LDA(At, 1, 0); PG8_STAGE_A(PG8_SA(0, 1), sA, gs, 1, k2);
            PG8_WAIT_V(8); PG8_WAIT_L(0); PG8_BAR; PG8_MMA(0, 0, At, B0); PG8_MMA(0, 1, At, B1); PG8_BAR; PG8_SCHED;
            PG8_LDA(At, 1, 1); PG8_STAGE(PG8_SB(1, 0), b3, voffB); PG8_STAGE(PG8_SB(1, 1), b3 + hstepB, voffB); PG8_STAGE_A(PG8_SA(1, 0), sA, gs, 0, k3);
            PG8_WAIT_V(8); PG8_WAIT_L(0); PG8_BAR; PG8_MMA(1, 0, At, B0); PG8_MMA(1, 1, At, B1); PG8_BAR; PG8_SCHED;
#endif
#endif
        }
        if constexpr (F8) asm volatile("s_nop 15\n\ts_nop 15" ::: "memory");
        if constexpr (ALIGN_EPI) { if (wr == 0) PG8_BAR; }
        if constexpr (!Epi::AFTER_DRAIN) { E(acc, cur, wr, wc, fr, fq); S.done(cur); }
        if (!has_next) break;
        S.between(ui, wid);
#pragma unroll
        for (int a = 0; a < 2; ++a)
#pragma unroll
            for (int b = 0; b < 2; ++b)
#pragma unroll
                for (int m = 0; m < 4; ++m)
#pragma unroll
                    for (int n = 0; n < 2; ++n) acc[a][b][m][n] = (f32x4){0.f, 0.f, 0.f, 0.f};
        prev_pm = cur.pm; cur = nxt; cA = nA; cB = nB; ++ui;
        if constexpr (Sched::GATHER) {
#pragma unroll
            for (int h = 0; h < 2; ++h)
#pragma unroll
                for (int i = 0; i < 2; ++i) gc[h][i] = gn[h][i];
        }
        if constexpr (ALIGN_EPI) { if (wr == 1) PG8_BAR; }
    }
    PG8_WAIT_V(0);
    if constexpr (!ALIGN_EPI) { if (wr == 0) PG8_BAR; }
    PG8_BAR;
    if constexpr (!Epi::AFTER_DRAIN) S.signal(cur.pm);
    if constexpr (Epi::AFTER_DRAIN) { E.fused(acc, cur, wr, wc, fr, fq, lds, wid, lane); S.done(cur); }
#undef PG8_TOK
#undef PG8_GLOAD
#undef PG8_SA
#undef PG8_SB
#undef PG8_STAGE
#undef PG8_STAGE_A
#undef PG8_CAT
#undef PG8_LDA
#undef PG8_LDB
#undef PG8_MMA
#undef PG8_WAIT_V
#undef PG8_WAIT_L
#undef PG8_BAR
#undef PG8_SCHED
}

typedef f32x4 Acc[2][2][4][2];
#define TAB_ENT(ldsx, par, r) ((const LAS Ent*)((ldsx) + TAB_OFF + (par) * 4096 + (r) * 16))

#ifndef NTS_PROJ
#define NTS_PROJ 0
#endif
struct EpiBf16 {
    static constexpr bool PERM = true, AFTER_DRAIN = false, NTS = NTS_PROJ != 0;
    bf16* O; int ldc; const float* rs; float sc; bool uprod;
    __device__ __forceinline__ void operator()(const Acc& acc, const Unit& u, int wr, int wc, int fr, int fq) const {
        const int row0 = u.pm * BM + wr * 64 + fr;
        if (uprod && u.pn >= 4 && u.pn < 12) {
            const int col = O_U + 128 * (u.pn - 4) + wc * 32 + fq * 8;
#pragma unroll
            for (int ai = 0; ai < 2; ++ai)
#pragma unroll
                for (int m = 0; m < 4; ++m) { const int row = row0 + ai * HALF + m * 16; const float s = rs ? rs[row] * sc : sc;
                    const f32x4 p0 = (acc[ai][0][m][0] * s) * (acc[ai][1][m][0] * s), p1 = (acc[ai][0][m][1] * s) * (acc[ai][1][m][1] * s); v4u w;
                    w.x = cvt_pk_bf16(p0[0], p0[1]); w.y = cvt_pk_bf16(p0[2], p0[3]); w.z = cvt_pk_bf16(p1[0], p1[1]); w.w = cvt_pk_bf16(p1[2], p1[3]);
                    *(v4u*)(O + (size_t)row * ldc + col) = w; }
            return; }
        const int col0 = (uprod && u.pn >= 12 ? u.pn * BM - 1024 : u.pn * BM) + wc * 64 + 16 * fq;
#pragma unroll
        for (int ai = 0; ai < 2; ++ai)
#pragma unroll
            for (int m = 0; m < 4; ++m) { const int row = row0 + ai * HALF + m * 16; const float s = rs ? rs[row] * sc : sc; bf16* rowp = O + (size_t)row * ldc + col0;
#pragma unroll
                for (int bj = 0; bj < 2; ++bj) { const f32x4 v0 = acc[ai][bj][m][0] * s, v1 = acc[ai][bj][m][1] * s; v4u w;
                    w.x = cvt_pk_bf16(v0[0], v0[1]); w.y = cvt_pk_bf16(v0[2], v0[3]); w.z = cvt_pk_bf16(v1[0], v1[1]); w.w = cvt_pk_bf16(v1[2], v1[3]);
                    if (NTS) __builtin_nontemporal_store(w, (v4u*)(rowp + bj * 8)); else *(v4u*)(rowp + bj * 8) = w; } }
    }
};
struct EpiF8 {
    static constexpr bool PERM = true, AFTER_DRAIN = false;
    unsigned char* O; int ldc; float sc;
    __device__ __forceinline__ void operator()(const Acc& acc, const Unit& u, int wr, int wc, int fr, int fq) const {
        const int row0 = u.pm * BM + wr * 64 + fr, col0 = u.pn * BM + wc * 64 + 16 * fq;
#pragma unroll
        for (int ai = 0; ai < 2; ++ai)
#pragma unroll
            for (int m = 0; m < 4; ++m) { const int row = row0 + ai * HALF + m * 16; v2u f8[2];
#pragma unroll
                for (int bj = 0; bj < 2; ++bj) { float o[8];
#pragma unroll
                    for (int n = 0; n < 2; ++n)
#pragma unroll
                        for (int i = 0; i < 4; ++i) o[n * 4 + i] = acc[ai][bj][m][n][i];
                    f8[bj] = pack8_f8(o, sc); }
                *(v4u*)(O + (size_t)row * ldc + col0) = (v4u){f8[0].x, f8[0].y, f8[1].x, f8[1].y}; }
    }
};
struct EpiH1 {
    static constexpr bool PERM = true, AFTER_DRAIN = false;
    const bf16* xb; const float* rms; bf16* h1; float* ssp; unsigned char* h18; float sc;
    __device__ __forceinline__ void operator()(const Acc& acc, const Unit& u, int wr, int wc, int fr, int fq) const {
        const int row0 = u.pm * BM + wr * 64 + fr, col0 = u.pn * BM + wc * 64 + 16 * fq;
        v4u xv[8][2]; float rm[8];
#define H1_LOAD(g_) do { const size_t off_ = (size_t)(row0 + ((g_) >> 2) * HALF + ((g_) & 3) * 16) * D + col0; xv[g_][0] = *(const v4u*)(xb + off_); xv[g_][1] = *(const v4u*)(xb + off_ + 8); } while (0)
#pragma unroll
        for (int gi = 0; gi < 8; ++gi) { rm[gi] = rms[row0 + (gi >> 2) * HALF + (gi & 3) * 16]; H1_LOAD(gi); }
        asm volatile("" ::: "memory");
#pragma unroll
        for (int gi = 0; gi < 8; ++gi) { const int ai = gi >> 2, m = gi & 3;
            const int row = row0 + ai * HALF + m * 16; const size_t off = (size_t)row * D + col0; float ss = 0.f; const float r = rm[gi]; v2u f8[2];
#pragma unroll
            for (int bj = 0; bj < 2; ++bj) { float xf[8]; unpack8(xv[gi][bj], xf); float o[8];
#pragma unroll
                for (int n = 0; n < 2; ++n)
#pragma unroll
                    for (int i = 0; i < 4; ++i) { o[n * 4 + i] = xf[n * 4 + i] * r + acc[ai][bj][m][n][i] * sc; ss += o[n * 4 + i] * o[n * 4 + i]; }
                v4u w; w.x = cvt_pk_bf16(o[0], o[1]); w.y = cvt_pk_bf16(o[2], o[3]); w.z = cvt_pk_bf16(o[4], o[5]); w.w = cvt_pk_bf16(o[6], o[7]);
                *(v4u*)(h1 + off + bj * 8) = w; if (h18) f8[bj] = pack8_f8(o, F8_ASCALE); }
            if (h18) *(v4u*)(h18 + off) = (v4u){f8[0].x, f8[0].y, f8[1].x, f8[1].y};
            ss += __shfl_xor(ss, 16); ss = xsum32(ss);
            if (fq == 0) ssp[(size_t)row * 32 + u.pn * 4 + wc] = ss; }
#undef H1_LOAD
    }
};
struct EpiRouter {
    static constexpr bool PERM = false, AFTER_DRAIN = true;
    const float* ssp; const float* bg; const float* br; float* rs1; int* eid; float* ew; Ent* ent; unsigned* cnt;
    __device__ __forceinline__ void fused(const Acc& acc, const Unit& u, int wr, int wc, int fr, int fq, LAS unsigned char* lds, int wid, int lane) const {
        LAS float* LG = (LAS float*)lds;
        LAS unsigned* HIST = (LAS unsigned*)(lds + 65536);
        LAS unsigned* BASE = (LAS unsigned*)(lds + 65536 + 256);
        const int tid = wid * 64 + lane;
        if (tid < 64) HIST[tid] = 0u;
        if (wc < 2) {
#pragma unroll
            for (int ai = 0; ai < 2; ++ai)
#pragma unroll
                for (int m = 0; m < 4; ++m) { const int r = ai * HALF + wr * 64 + m * 16 + fr;
#pragma unroll
                    for (int n = 0; n < 2; ++n) { const int c = wc * 32 + 16 * n + 4 * fq; if (c < 40) *(LAS f32x4*)(LG + r * 40 + c) = acc[ai][0][m][n]; } }
        }
        __syncthreads();
        int l0 = 0, l1 = 0; unsigned k0 = 0, k1 = 0; float w0 = 0.f, w1 = 0.f, rs = 0.f; const int row = u.pm * BM + tid;
        if (tid < 256) {
            float ss = 0.f;
#pragma unroll
            for (int j = 0; j < 8; ++j) { const f32x4 p = *(const f32x4*)(ssp + (size_t)row * 32 + 4 * j); ss += (p[0] + p[1]) + (p[2] + p[3]); }
            rs = 1.0f / sqrtf(ss * (1.0f / D) + EPS);
            const LAS float* L = LG + tid * 40;
            float gl[NGRP]; int g = 0;
#pragma unroll
            for (int j = 0; j < NGRP; ++j) gl[j] = L[j] * rs + bg[j];
            float gm = gl[0];
#pragma unroll
            for (int j = 1; j < NGRP; ++j) if (gl[j] > gm) { gm = gl[j]; g = j; }
            float gsum = 0.f;
#pragma unroll
            for (int j = 0; j < NGRP; ++j) gsum += __expf(gl[j] - gm);
            const float gw = 1.0f / gsum;
            const LAS float* E = L + NGRP + g * EPG; const float* be = br + g * EPG;
            int i1 = 0; float v1 = E[0] * rs + be[0];
            for (int j = 1; j < EPG; ++j) { const float v = E[j] * rs + be[j]; if (v > v1) { v1 = v; i1 = j; } }
            int i2 = 0; float v2 = -3.0e38f;
            for (int j = 0; j < EPG; ++j) { const float v = E[j] * rs + be[j]; if (j != i1 && v > v2) { v2 = v; i2 = j; } }
            const float e2 = __expf(v2 - v1); w0 = gw / (1.0f + e2); w1 = gw * e2 / (1.0f + e2);
            l0 = g * EPG + i1; l1 = NE + g * EPG + i2;
            eid[row * 2] = l0; eid[row * 2 + 1] = l1 - NE; ew[row * 2] = w0; ew[row * 2 + 1] = w1; rs1[row] = rs;
            k0 = __hip_atomic_fetch_add(HIST + l0, 1u, __ATOMIC_RELAXED, __HIP_MEMORY_SCOPE_WORKGROUP); k1 = __hip_atomic_fetch_add(HIST + l1, 1u, __ATOMIC_RELAXED, __HIP_MEMORY_SCOPE_WORKGROUP);
        }
        __syncthreads();
        if (tid < 64) { const unsigned n = HIST[tid]; BASE[tid] = n ? __hip_atomic_fetch_add(cnt + 64 * tid, n, __ATOMIC_RELAXED, __HIP_MEMORY_SCOPE_AGENT) : 0u; }
        __syncthreads();
        if (tid < 256) {
            *(v4u*)(ent + (size_t)l0 * LCAP + BASE[l0] + k0) = (v4u){(unsigned)row, __float_as_uint(w0), __float_as_uint(rs), 0u};
            *(v4u*)(ent + (size_t)l1 * LCAP + BASE[l1] + k1) = (v4u){(unsigned)row, __float_as_uint(w1), __float_as_uint(rs), 0u};
        }
    }
};
struct EpiGU {
    static constexpr bool PERM = true, AFTER_DRAIN = false;
    bf16* hid; LAS unsigned char* ldsx; float sc; unsigned char* hid8;
    __device__ __forceinline__ void operator()(const Acc& acc, const Unit& u, int wr, int wc, int fr, int fq) const {
        const int col0 = u.pn * HALF + wc * 32 + 8 * fq;
#pragma unroll
        for (int ai = 0; ai < 2; ++ai)
#pragma unroll
            for (int m = 0; m < 4; ++m) { const int r = ai * HALF + wr * 64 + m * 16 + fr; const LAS Ent* e = TAB_ENT(ldsx, u.par, r); const float w = e->w, rs = e->rs * sc;
                float o[8];
#pragma unroll
                for (int n = 0; n < 2; ++n)
#pragma unroll
                    for (int i = 0; i < 4; ++i) { const float gg = acc[ai][0][m][n][i] * rs, uu = acc[ai][1][m][n][i] * rs; o[n * 4 + i] = w * (gg * __builtin_amdgcn_rcpf(1.0f + __expf(-gg))) * uu; }
                if (hid8) { *(v2u*)(hid8 + (size_t)(u.pm * BM + r) * DEXP + col0) = pack8_f8(o, F8_HSCALE); }
                else { v4u q; q.x = cvt_pk_bf16(o[0], o[1]); q.y = cvt_pk_bf16(o[2], o[3]); q.z = cvt_pk_bf16(o[4], o[5]); q.w = cvt_pk_bf16(o[6], o[7]);
                    *(v4u*)(hid + (size_t)(u.pm * BM + r) * DEXP + col0) = q; } }
    }
};
template <int KK> struct EpiDown;
template <> struct EpiDown<0> {
    static constexpr bool PERM = true, AFTER_DRAIN = false;
    unsigned char* y8; LAS unsigned char* ldsx; float sc;
    __device__ __forceinline__ void operator()(const Acc& acc, const Unit& u, int wr, int wc, int fr, int fq) const {
        const int col0 = u.pn * BM + wc * 64 + 16 * fq; const float s64 = sc * F8_YSCALE;
#pragma unroll
        for (int gi = 0; gi < 8; ++gi) { const int ai = gi >> 2, m = gi & 3;
            const int r = ai * HALF + wr * 64 + m * 16 + fr; const bool valid = (u.rk0 + r) < u.nl; const int tok = TAB_ENT(ldsx, u.par, r)->tok; v2u f8[2];
#pragma unroll
            for (int bj = 0; bj < 2; ++bj) { float o[8];
#pragma unroll
                for (int n = 0; n < 2; ++n)
#pragma unroll
                    for (int i = 0; i < 4; ++i) o[n * 4 + i] = acc[ai][bj][m][n][i];
                f8[bj] = pack8_f8(o, s64); }
            if (valid) *(v4u*)(y8 + (size_t)tok * D + col0) = (v4u){f8[0].x, f8[0].y, f8[1].x, f8[1].y}; }
    }
};
template <> struct EpiDown<1> {
    static constexpr bool PERM = true, AFTER_DRAIN = false;
    const bf16* base; bf16* h2; float* ssp; LAS unsigned char* ldsx; unsigned char* h28; float sc;
    __device__ __forceinline__ void operator()(const Acc& acc, const Unit& u, int wr, int wc, int fr, int fq) const {
        const int col0 = u.pn * BM + wc * 64 + 16 * fq;
#pragma unroll
        for (int hb = 0; hb < 2; ++hb) {
            v4u bv[4][2], yv[4]; int tk[4];
#pragma unroll
            for (int q = 0; q < 4; ++q) { const int gi = hb * 4 + q; tk[q] = TAB_ENT(ldsx, u.par, (gi >> 2) * HALF + wr * 64 + (gi & 3) * 16 + fr)->tok; const size_t off_ = (size_t)tk[q] * D + col0;
                bv[q][0] = *(const v4u*)(base + off_); bv[q][1] = *(const v4u*)(base + off_ + 8); yv[q] = *(const v4u*)(h28 + off_); }
            asm volatile("" ::: "memory");
#pragma unroll
            for (int q = 0; q < 4; ++q) { const int gi = hb * 4 + q, ai = gi >> 2, m = gi & 3;
                const int r = ai * HALF + wr * 64 + m * 16 + fr; const bool valid = (u.rk0 + r) < u.nl; const int tok = tk[q]; const size_t off = (size_t)tok * D + col0; float ss = 0.f; v2u f8[2];
                const unsigned yw[4] = {yv[q].x, yv[q].y, yv[q].z, yv[q].w};
#pragma unroll
                for (int bj = 0; bj < 2; ++bj) { float b[8]; unpack8(bv[q][bj], b); float o[8];
#pragma unroll
                    for (int n = 0; n < 2; ++n) { const unsigned w = yw[bj * 2 + n];
                        const float y0 = __builtin_amdgcn_cvt_f32_fp8((int)w, 0), y1 = __builtin_amdgcn_cvt_f32_fp8((int)w, 1), y2 = __builtin_amdgcn_cvt_f32_fp8((int)w, 2), y3 = __builtin_amdgcn_cvt_f32_fp8((int)w, 3);
                        const float yy[4] = {y0, y1, y2, y3};
#pragma unroll
                        for (int i = 0; i < 4; ++i) { o[n * 4 + i] = b[n * 4 + i] + yy[i] * F8_YINV + acc[ai][bj][m][n][i] * sc; ss += o[n * 4 + i] * o[n * 4 + i]; } }
                    v4u qv; qv.x = cvt_pk_bf16(o[0], o[1]); qv.y = cvt_pk_bf16(o[2], o[3]); qv.z = cvt_pk_bf16(o[4], o[5]); qv.w = cvt_pk_bf16(o[6], o[7]);
                    if (valid) *(v4u*)(h2 + off + bj * 8) = qv;
                    f8[bj] = pack8_f8(o, F8_ASCALE); }
                if (valid) *(v4u*)(h28 + off) = (v4u){f8[0].x, f8[0].y, f8[1].x, f8[1].y};
                ss += __shfl_xor(ss, 16); ss = xsum32(ss); if (fq == 0 && valid) ssp[(size_t)tok * 32 + u.pn * 4 + wc] = ss; }
            asm volatile("" ::: "memory"); }
    }
};
template <int MODE> struct EpiDownProbe {
    static constexpr bool PERM = true, AFTER_DRAIN = false;
    const bf16* base; bf16* h2; LAS unsigned char* ldsx; float sc;
    __device__ __forceinline__ void operator()(const Acc& acc, const Unit& u, int wr, int wc, int fr, int fq) const {
        const int col0 = u.pn * BM + wc * 64 + 16 * fq;
        v4u bv[8][2]; int tk[8];
#pragma unroll
        for (int gi = 0; gi < 8; ++gi) { tk[gi] = TAB_ENT(ldsx, u.par, (gi >> 2) * HALF + wr * 64 + (gi & 3) * 16 + fr)->tok; const size_t off_ = (size_t)tk[gi] * D + col0;
            if (MODE == 0) { bv[gi][0] = *(const v4u*)(base + off_); bv[gi][1] = *(const v4u*)(base + off_ + 8); } else { bv[gi][0] = (v4u){0u, 0u, 0u, 0u}; bv[gi][1] = (v4u){0u, 0u, 0u, 0u}; } }
        asm volatile("" ::: "memory");
#pragma unroll
        for (int gi = 0; gi < 8; ++gi) { const int ai = gi >> 2, m = gi & 3;
            const int r = ai * HALF + wr * 64 + m * 16 + fr; const bool valid = (u.rk0 + r) < u.nl; const size_t off = (size_t)tk[gi] * D + col0;
#pragma unroll
            for (int bj = 0; bj < 2; ++bj) { float b[8]; unpack8(bv[gi][bj], b); float o[8];
#pragma unroll
                for (int n = 0; n < 2; ++n)
#pragma unroll
                    for (int i = 0; i < 4; ++i) o[n * 4 + i] = b[n * 4 + i] + acc[ai][bj][m][n][i] * sc;
                v4u q; q.x = cvt_pk_bf16(o[0], o[1]); q.y = cvt_pk_bf16(o[2], o[3]); q.z = cvt_pk_bf16(o[4], o[5]); q.w = cvt_pk_bf16(o[6], o[7]);
                if (MODE == 2) { if (gi > 0) asm volatile("" :: "v"(q)); }
                if (valid && (MODE < 2 || gi == 0)) *(v4u*)(h2 + off + bj * 8) = q; } }
    }
};
struct EpiFinal {
    static constexpr bool PERM = true, AFTER_DRAIN = false;
    const bf16* h2; const unsigned char* pw8; float* out; LAS unsigned char* ldsx; float sc; bool pre;
    __device__ __forceinline__ void operator()(const Acc& acc, const Unit& u, int wr, int wc, int fr, int fq) const {
        const int col0 = u.pn * BM + wc * 64 + 16 * fq;
        v4u hv[2][2], pv[2];
#define FN_LOAD(g_, buf) do { const size_t off_ = (size_t)(u.pm * BM + ((g_) >> 2) * HALF + wr * 64 + ((g_) & 3) * 16 + fr) * D + col0; \
            hv[buf][0] = *(const v4u*)(h2 + off_); hv[buf][1] = *(const v4u*)(h2 + off_ + 8); pv[buf] = *(const v4u*)(pw8 + off_); } while (0)
#pragma unroll
        for (int half_ = 0; half_ < 4; ++half_) {
#pragma unroll
            for (int q = 0; q < 2; ++q) FN_LOAD(half_ * 2 + q, q);
            asm volatile("" ::: "memory");
#pragma unroll
            for (int q = 0; q < 2; ++q) { const int gi = half_ * 2 + q, ai = gi >> 2, m = gi & 3;
                const int r = ai * HALF + wr * 64 + m * 16 + fr; const float rs = (pre ? ((const LAS float*)(ldsx + TAB_OFF))[u.lst * 256 + r] : TAB_ENT(ldsx, u.par, r)->rs) * sc; const size_t off = (size_t)(u.pm * BM + r) * D + col0;
                const unsigned pwd[4] = {pv[q].x, pv[q].y, pv[q].z, pv[q].w};
#pragma unroll
                for (int bj = 0; bj < 2; ++bj) { float hf[8]; unpack8(hv[q][bj], hf);
#pragma unroll
                    for (int n = 0; n < 2; ++n) { const f32x4 z = acc[ai][bj][m][n] * rs; f32x4 o; const int w = (int)pwd[bj * 2 + n];
                        const float pf[4] = {__builtin_amdgcn_cvt_f32_fp8(w, 0), __builtin_amdgcn_cvt_f32_fp8(w, 1), __builtin_amdgcn_cvt_f32_fp8(w, 2), __builtin_amdgcn_cvt_f32_fp8(w, 3)};
#pragma unroll
                        for (int i = 0; i < 4; ++i) o[i] = hf[n * 4 + i] + (pf[i] * F8_PINV) * __builtin_amdgcn_rcpf(1.0f + __expf(-z[i]));
                        *(f32x4*)(out + off + bj * 8 + n * 4) = o; } } }
            asm volatile("" ::: "memory"); }
#undef FN_LOAD
    }
};

template <int MODE> struct EpiFinalProbe {
    static constexpr bool PERM = true, AFTER_DRAIN = false;
    const bf16* h2; const unsigned char* pw8; float* out; LAS unsigned char* ldsx; float sc;
    __device__ __forceinline__ void operator()(const Acc& acc, const Unit& u, int wr, int wc, int fr, int fq) const {
        const int col0 = u.pn * BM + wc * 64 + 16 * fq;
        v4u hv[2][2], pv[2];
#pragma unroll
        for (int half_ = 0; half_ < 4; ++half_) {
#pragma unroll
            for (int q = 0; q < 2; ++q) { const int g_ = half_ * 2 + q; const size_t off_ = (size_t)(u.pm * BM + (g_ >> 2) * HALF + wr * 64 + (g_ & 3) * 16 + fr) * D + col0;
                if (MODE == 0 || MODE == 3) { hv[q][0] = *(const v4u*)(h2 + off_); hv[q][1] = *(const v4u*)(h2 + off_ + 8); pv[q] = *(const v4u*)(pw8 + off_); }
                else { hv[q][0] = (v4u){0u, 0u, 0u, 0u}; hv[q][1] = hv[q][0]; pv[q] = hv[q][0]; } }
            asm volatile("" ::: "memory");
#pragma unroll
            for (int q = 0; q < 2; ++q) { const int gi = half_ * 2 + q, ai = gi >> 2, m = gi & 3;
                const int r = ai * HALF + wr * 64 + m * 16 + fr; const float rs = TAB_ENT(ldsx, u.par, r)->rs * sc; const size_t off = (size_t)(u.pm * BM + r) * 1024 + (col0 & 1023);
                const unsigned pwd[4] = {pv[q].x, pv[q].y, pv[q].z, pv[q].w};
#pragma unroll
                for (int bj = 0; bj < 2; ++bj) { float hf[8]; unpack8(hv[q][bj], hf);
#pragma unroll
                    for (int n = 0; n < 2; ++n) { const f32x4 z = acc[ai][bj][m][n] * rs; f32x4 o; const int w = (int)pwd[bj * 2 + n];
                        const float pf[4] = {__builtin_amdgcn_cvt_f32_fp8(w, 0), __builtin_amdgcn_cvt_f32_fp8(w, 1), __builtin_amdgcn_cvt_f32_fp8(w, 2), __builtin_amdgcn_cvt_f32_fp8(w, 3)};
#pragma unroll
                        for (int i = 0; i < 4; ++i) o[i] = (MODE == 3) ? hf[n * 4 + i] + (pf[i] * F8_PINV) * z[i] : hf[n * 4 + i] + (pf[i] * F8_PINV) * __builtin_amdgcn_rcpf(1.0f + __expf(-z[i]));
                        if (MODE == 2 && gi > 0) { asm volatile("" :: "v"(o)); } else *(f32x4*)(out + off + bj * 8 + n * 4) = o; } } }
            asm volatile("" ::: "memory"); }
    }
};
template <int MODE> struct EpiBf16Probe {
    static constexpr bool PERM = true, AFTER_DRAIN = false;
    bf16* O; int ldc;
    __device__ __forceinline__ void operator()(const Acc& acc, const Unit& u, int wr, int wc, int fr, int fq) const {
        const int row0 = u.pm * BM + wr * 64 + fr, col0 = u.pn * BM + wc * 64 + 16 * fq;
#pragma unroll
        for (int ai = 0; ai < 2; ++ai)
#pragma unroll
            for (int m = 0; m < 4; ++m) { const int row = row0 + ai * HALF + m * 16; bf16* rowp = O + (size_t)row * ldc + col0;
#pragma unroll
                for (int bj = 0; bj < 2; ++bj) { const f32x4 v0 = acc[ai][bj][m][0], v1 = acc[ai][bj][m][1]; v4u w;
                    w.x = cvt_pk_bf16(v0[0], v0[1]); w.y = cvt_pk_bf16(v0[2], v0[3]); w.z = cvt_pk_bf16(v1[0], v1[1]); w.w = cvt_pk_bf16(v1[2], v1[3]);
                    if (MODE == 1 && (ai || m)) { asm volatile("" :: "v"(w)); } else *(v4u*)(rowp + bj * 8) = w; } }
    }
};
template <bool GATHER_, int NPN> struct MoeOrder {
    static constexpr bool GATHER = GATHER_;
    LAS unsigned char* ldsx; const Ent* ent; int tlo, thi, G, c, wave; const Ent* zero;
    CvtWork w{}; int slot = -1;
    int xm = 0; unsigned* tsig = nullptr; unsigned* twait = nullptr;
    __device__ __forceinline__ int nunits() const { const int nun = (thi - tlo) * NPN; return c < nun ? (nun - 1 - c) / G + 1 : 0; }
    __device__ __forceinline__ bool next(int i, Unit& u) const {
        int tile, pn_;
        if (xm) { const int x = c >> 5, j = c & 31;
            if (NPN == 4) { tile = tlo + 64 * i + 8 * (j >> 2) + x; pn_ = j & 3; } else { const int l = 32 * i + (31 - j); tile = tlo + 8 * (l >> 3) + x; pn_ = l & 7; }
            if (tile >= thi) return false; }
        else { const long L = (long)i * G + c; const int nun = (thi - tlo) * NPN; if (L >= nun) return false; tile = tlo + (int)(L / NPN); pn_ = (int)(L % NPN); }
        const LAS int* T0 = (const LAS int*)(ldsx + LST_OFF + 256);
        int l = 0;
        for (int j = 1; j < NLIST; ++j) l += (T0[j] <= tile) ? 1 : 0;
        l = __builtin_amdgcn_readfirstlane(l);
        u.pm = tile; u.pn = pn_; u.bt = (l & (NE - 1)) * NPN + u.pn; u.par = i & 1; u.lst = l; u.rk0 = (tile - __builtin_amdgcn_readfirstlane(T0[l])) * BM; u.nl = __builtin_amdgcn_readfirstlane(((const LAS int*)(ldsx + LST_OFF))[l]);
        return true;
    }
    __device__ __forceinline__ void a_prefetch(const Unit& u) const {
        if (wave < 4) { const int tid = TIDX(wave); const int rk = u.rk0 + tid; const Ent* src = rk < u.nl ? ent + (size_t)u.lst * LCAP + rk : zero;
            __builtin_amdgcn_global_load_lds((const unsigned*)src, (LAS unsigned*)(ldsx + TAB_OFF + u.par * 4096 + wave * 1024), 16, 0, 0); }
    }
    __device__ __forceinline__ void a_first() const { asm volatile("s_waitcnt vmcnt(0)" ::: "memory"); __builtin_amdgcn_s_barrier(); asm volatile("" ::: "memory"); }
    __device__ __forceinline__ void a_ready(const Unit& u) const {
        if (twait) { unsigned sp = 0; while (__hip_atomic_load(twait + u.pm, __ATOMIC_RELAXED, __HIP_MEMORY_SCOPE_AGENT) < 4u) { __builtin_amdgcn_s_sleep(1); if (++sp > (1u << 22)) break; } asm volatile("" ::: "memory"); } }
    __device__ __forceinline__ void done(const Unit&) const {}
    __device__ __forceinline__ void between(int ui, int wid) const { if (GATHER_ && ui == slot) w.run(wid, CvtWork::NGU, CvtWork::NIT); }
    __device__ __forceinline__ void signal(int tile) const { if (tsig && TIDX(wave) == 0) (void)__hip_atomic_fetch_add(tsig + tile, 1u, __ATOMIC_RELAXED, __HIP_MEMORY_SCOPE_AGENT); }
};
struct FinalOrder : StaticOrder {
    LAS unsigned char* ldsx; const float* ssp; int wave; bool pre;
    __device__ __forceinline__ bool next(int i, Unit& u) const { const bool ok = StaticOrder::next(i, u); u.lst = i; return ok; }
    __device__ __forceinline__ void a_prefetch(const Unit&) const {}
    __device__ __forceinline__ void a_first() const {}
    __device__ __forceinline__ void fill_all() const {
        const int tid = TIDX(wave), r = tid & 255;
#pragma unroll 1
        for (int i = tid >> 8; i < 8; i += 2) { Unit u; if (!next(i, u)) break; const int row = u.pm * BM + r; float ss = 0.f;
#pragma unroll
            for (int j = 0; j < 8; ++j) { const f32x4 p = *(const f32x4*)(ssp + (size_t)row * 32 + 4 * j); ss += (p[0] + p[1]) + (p[2] + p[3]); }
            ((LAS float*)(ldsx + TAB_OFF))[i * 256 + r] = 1.0f / sqrtf(ss * (1.0f / D) + EPS); }
        __syncthreads();
    }
    __device__ __forceinline__ void a_ready(const Unit& u) const {
        if (pre) return;
        const int tid = TIDX(wave);
        if (tid < 256) { const int row = u.pm * BM + tid; float ss = 0.f;
#pragma unroll
            for (int j = 0; j < 8; ++j) { const f32x4 p = *(const f32x4*)(ssp + (size_t)row * 32 + 4 * j); ss += (p[0] + p[1]) + (p[2] + p[3]); }
            *(LAS v4u*)(ldsx + TAB_OFF + u.par * 4096 + tid * 16) = (v4u){(unsigned)row, 0u, __float_as_uint(1.0f / sqrtf(ss * (1.0f / D) + EPS)), 0u}; }
    }
};
}
#define RLX_AGENT __ATOMIC_RELAXED, __HIP_MEMORY_SCOPE_AGENT
#define XB_TMO      128
#define XB_XCNT(j)  (256  + 64 * (j))
#define XB_XSUB(j)  (1280 + 64 * (j))
#define XB_XGEN(j)  (2304 + 64 * (j))
#define XB_TOP      3328
#define XB_TOPGEN   3392
#define XCD_BAR_WORDS 3456
#define XB_SPIN_CAP (1u << 18)

__device__ __forceinline__ unsigned xb_ld(unsigned* p)              { return __hip_atomic_load(p, __ATOMIC_RELAXED, __HIP_MEMORY_SCOPE_AGENT); }
__device__ __forceinline__ unsigned xb_add(unsigned* p, unsigned v) { return __hip_atomic_fetch_add(p, v, __ATOMIC_RELAXED, __HIP_MEMORY_SCOPE_AGENT); }
__device__ __forceinline__ unsigned xb_xcc_id() { return (unsigned)__builtin_amdgcn_s_getreg((3 << 11) | 20) & 0xFu; }
#define XB_SPIN(cond, bar) do { unsigned _sp = 0; while (cond) { __builtin_amdgcn_s_sleep(1); \
    if ((++_sp & 255u) == 0u) { if (xb_ld(&(bar)[XB_TMO])) break; if (_sp > XB_SPIN_CAP) { atomicAdd(&(bar)[XB_TMO], 1u); break; } } } } while (0)

struct XcdBarrier {
    unsigned* bar; unsigned x;
    volatile LAS unsigned* st;
};
__device__ __forceinline__ XcdBarrier xcd_barrier_post(unsigned* bar, volatile LAS unsigned* st, const int wave_) {
    XcdBarrier b; b.bar = bar; b.x = xb_xcc_id(); b.st = st;
    if (TIDX(wave_) == 0) (void)xb_add(&bar[XB_XCNT(b.x)], 1u);
    return b;
}
__device__ __forceinline__ void xcd_barrier_complete(unsigned* bar, unsigned x, unsigned& nloc, unsigned& nx) {
    const unsigned G = gridDim.x * gridDim.y * gridDim.z;
    unsigned sum, cnt, mine, sp = 0u;
    for (;;) {
        sum = 0u; cnt = 0u; mine = 0u;
#pragma unroll
        for (unsigned j = 0; j < 16; ++j) { const unsigned c = xb_ld(&bar[XB_XCNT(j)]); sum += c; cnt += (c > 0u) ? 1u : 0u; mine = (j == x) ? c : mine; }
        if (sum == G) break;
        __builtin_amdgcn_s_sleep(1);
        if ((++sp & 255u) == 0u) { if (xb_ld(&bar[XB_TMO])) break; if (sp > XB_SPIN_CAP) { atomicAdd(&bar[XB_TMO], 1u); break; } }
    }
    nloc = mine > 0u ? mine : 1u; nx = cnt > 0u ? cnt : 1u;
}
__device__ __forceinline__ void xcd_barrier(const XcdBarrier& b, const int wave_) {
    asm volatile("s_waitcnt vmcnt(0)" ::: "memory");
    __syncthreads();
    if (TIDX(wave_) == 0) {
        unsigned* bar = b.bar;
        __builtin_amdgcn_s_waitcnt(0);
        unsigned nloc = b.st[0], nx = b.st[1];
        if (nloc == 0u) { xcd_barrier_complete(bar, b.x, nloc, nx); b.st[0] = nloc; b.st[1] = nx; }
        const unsigned old = xb_add(&bar[XB_XSUB(b.x)], 1u);
        const unsigned gen = old / nloc;
        if (old + 1u == (gen + 1u) * nloc) {
            __builtin_amdgcn_fence(__ATOMIC_RELEASE, "agent");
            asm volatile("s_waitcnt vmcnt(0)" ::: "memory");
            const unsigned og = xb_add(&bar[XB_TOP], 1u);
            const unsigned tg = og / nx;
            if (og + 1u == (tg + 1u) * nx) xb_add(&bar[XB_TOPGEN], 1u);
            else XB_SPIN(xb_ld(&bar[XB_TOPGEN]) == tg, bar);
            __builtin_amdgcn_fence(__ATOMIC_ACQUIRE, "agent");
            xb_add(&bar[XB_XGEN(b.x)], 1u);
            asm volatile("s_waitcnt vmcnt(0)" ::: "memory");
        } else {
            XB_SPIN(xb_ld(&bar[XB_XGEN(b.x)]) == gen, bar);
            __builtin_amdgcn_fence(__ATOMIC_ACQUIRE, "agent");
            asm volatile("s_waitcnt vmcnt(0)" ::: "memory");
        }
    }
    __syncthreads();
}

constexpr int NWAVES = 8;
__device__ __forceinline__ void p0_transpose_item(const float* W, int K, int N, const float* g0, const float* g1, int gsplit, bf16* WT, int rowbase, int k0, int n0, LAS float* scr, int lane, int rs8 = 8) {
    float v[32];
    const float* src = W + (size_t)(k0 + (lane >> 5)) * N + n0 + (lane & 31);
#pragma unroll
    for (int i = 0; i < 32; ++i) v[i] = __builtin_nontemporal_load(src + (size_t)(2 * i) * N);
    const int c = lane & 7;
    float gg[8];
#pragma unroll
    for (int j = 0; j < 8; ++j) { const int k = k0 + 8 * c + j; gg[j] = g0 ? (k < gsplit ? g0[k] : g1[k - gsplit]) : 1.f; }
#pragma unroll
    for (int i = 0; i < 32; ++i) scr[(2 * i + (lane >> 5)) * 33 + (lane & 31)] = v[i];
    asm volatile("s_waitcnt lgkmcnt(0)" ::: "memory");
#pragma unroll
    for (int j = 0; j < 4; ++j) { const int n = (lane >> 3) + 8 * j; const LAS float* s = scr + (8 * c) * 33 + n;
        v4u o; o.x = pk2(s[0 * 33] * gg[0], s[1 * 33] * gg[1]); o.y = pk2(s[2 * 33] * gg[2], s[3 * 33] * gg[3]); o.z = pk2(s[4 * 33] * gg[4], s[5 * 33] * gg[5]); o.w = pk2(s[6 * 33] * gg[6], s[7 * 33] * gg[7]);
        *(v4u*)(WT + (size_t)(rowbase + j * rs8 + (lane >> 3)) * K + k0 + 8 * c) = o; }
    asm volatile("s_waitcnt lgkmcnt(0)" ::: "memory");
}
__device__ __forceinline__ void p0_transpose_item8(const float* W, int K, int N, const float* g0, unsigned char* WT8, int rowbase, int k0, int n0, LAS float* scr, int lane, float sc, int rs8 = 8) {
    float v[32];
    const float* src = W + (size_t)(k0 + (lane >> 5)) * N + n0 + (lane & 31);
#pragma unroll
    for (int i = 0; i < 32; ++i) v[i] = __builtin_nontemporal_load(src + (size_t)(2 * i) * N);
    const int c = lane & 7;
    float gg[8];
#pragma unroll
    for (int j = 0; j < 8; ++j) gg[j] = (g0 ? g0[k0 + 8 * c + j] : 1.f) * sc;
#pragma unroll
    for (int i = 0; i < 32; ++i) scr[(2 * i + (lane >> 5)) * 33 + (lane & 31)] = v[i];
    asm volatile("s_waitcnt lgkmcnt(0)" ::: "memory");
#pragma unroll
    for (int j = 0; j < 4; ++j) { const int n = (lane >> 3) + 8 * j; const LAS float* s = scr + (8 * c) * 33 + n; float f[8];
#pragma unroll
        for (int q = 0; q < 8; ++q) f[q] = s[q * 33] * gg[q];
        *(v2u*)(WT8 + (size_t)(rowbase + j * rs8 + (lane >> 3)) * K + k0 + 8 * c) = pack8_f8(f, 1.0f); }
    asm volatile("s_waitcnt lgkmcnt(0)" ::: "memory");
}
__device__ __forceinline__ void p0_prologue(const Ptrs& P, LAS unsigned char* lds, int vcu, int G, const int wave) {
    const int lane = lane_id(), tid = wave * 64 + lane;
    unsigned char* ws = P.ws;
    LAS float* scr = (LAS float*)(lds + wave * 16384);
    const int gw = vcu * NWAVES + wave, NGW = G * NWAVES;
    constexpr int I_IN = (D / 64) * (DIN / 32), I_OUT = (D / 64) * (D / 32), I_PLG = I_OUT, I_PLE = (PLE / 64) * (D / 32), I_RT = (D / 64) * (NE / 32);
    constexpr int I_G1 = (D / 64) * (DEXP / 32), I_D1 = (DEXP / 64) * (D / 32);
    constexpr int NITEMS = I_IN + I_OUT + I_PLG + I_PLE + I_RT + (DEFER_CVT ? 0 : NE * (2 * I_G1 + I_D1));
    for (int it = gw; it < NITEMS; it += NGW) {
        int r = it;
        if (r < I_IN) { const int nb = DIN / 32; const int n0 = (r % nb) * 32, k0 = (r / nb) * 64;
            if (FP8QKV && n0 >= C_Q) p0_transpose_item8(P.w_in, D, DIN, P.norm_mix, ws + WS_WIN8, n0 - C_Q, k0, n0, scr, lane, F8_WSCALE);
            else if (UPROD && n0 >= C_C && n0 < C_Q) { const int isH = n0 >= C_HC ? 1 : 0, ch = n0 - (isH ? C_HC : C_C);
                p0_transpose_item(P.w_in, D, DIN, P.norm_mix, nullptr, D, (bf16*)(ws + WS_WIN), C_C + 256 * (ch >> 7) + 64 * ((ch & 127) >> 5) + 8 * isH, k0, n0, scr, lane, 16); }
            else p0_transpose_item(P.w_in, D, DIN, P.norm_mix, nullptr, D, (bf16*)(ws + WS_WIN), n0, k0, n0, scr, lane);
            continue; } r -= I_IN;
        if (r < I_OUT) { const int nb = D / 32; const int k0 = (r / nb) * 64;
            if (FP8O) p0_transpose_item8(P.w_out, D, D, k0 < DCONV ? P.onc : P.ona - DCONV, ws + WS_WOUT, (r % nb) * 32, k0, (r % nb) * 32, scr, lane, F8_WSCALE);
            else p0_transpose_item(P.w_out, D, D, P.onc, P.ona, DCONV, (bf16*)(ws + WS_WOUT), (r % nb) * 32, k0, (r % nb) * 32, scr, lane);
            continue; } r -= I_OUT;
        if (r < I_PLG) { const int nb = D / 32;
            if (FP8) p0_transpose_item8(P.w_ple_gate, D, D, P.norm_ple, ws + WS_WPLG, (r % nb) * 32, (r / nb) * 64, (r % nb) * 32, scr, lane, F8_WSCALE);
            else p0_transpose_item(P.w_ple_gate, D, D, P.norm_ple, nullptr, D, (bf16*)(ws + WS_WPLG), (r % nb) * 32, (r / nb) * 64, (r % nb) * 32, scr, lane);
            continue; } r -= I_PLG;
        if (r < I_PLE) { const int nb = D / 32; p0_transpose_item(P.w_ple, PLE, D, nullptr, nullptr, 0, (bf16*)(ws + WS_WPLE), (r % nb) * 32, (r / nb) * 64, (r % nb) * 32, scr, lane); continue; } r -= I_PLE;
        if (r < I_RT) { p0_transpose_item(P.w_router, D, NE, P.norm_ffn, nullptr, D, (bf16*)(ws + WS_WR), NGRP, r * 64, 0, scr, lane); continue; } r -= I_RT;
        const int e = r / (2 * I_G1 + I_D1); r -= e * (2 * I_G1 + I_D1);
        if (r < 2 * I_G1) { const int up = r >= I_G1; r -= up * I_G1; const int nb = DEXP / 32, n0 = (r % nb) * 32, k0 = (r / nb) * 64;
            if (FP8) p0_transpose_item8((up ? P.w_up : P.w_gate) + (size_t)e * D * DEXP, D, DEXP, P.norm_ffn, ws + WS_WGU + (size_t)e * 1024 * D, (n0 >> 7) * 256 + 2 * (n0 & 127) + up * 8, k0, n0, scr, lane, F8_WSCALE, 16);
            else p0_transpose_item((up ? P.w_up : P.w_gate) + (size_t)e * D * DEXP, D, DEXP, P.norm_ffn, nullptr, D, (bf16*)(ws + WS_WGU) + (size_t)e * 1024 * D, (n0 >> 7) * 256 + up * 128 + (n0 & 127), k0, n0, scr, lane);
            continue; }
        r -= 2 * I_G1; { const int nb = D / 32;
            if (FP8) p0_transpose_item8(P.w_down + (size_t)e * DEXP * D, DEXP, D, nullptr, ws + WS_WD + (size_t)e * D * DEXP, (r % nb) * 32, (r / nb) * 64, (r % nb) * 32, scr, lane, F8_DSCALE);
            else p0_transpose_item(P.w_down + (size_t)e * DEXP * D, DEXP, D, nullptr, nullptr, 0, (bf16*)(ws + WS_WD) + (size_t)e * D * DEXP, (r % nb) * 32, (r / nb) * 64, (r % nb) * 32, scr, lane); }
    }
    { bf16* Wr = (bf16*)(ws + WS_WR); const int gt = vcu * (NWAVES * 64) + tid, NT = G * NWAVES * 64;
      for (int i = gt; i < NGRP * D; i += NT) { const int n = i / D, k = i % D; Wr[(size_t)n * D + k] = f2bf(P.norm_ffn[k] * P.w_group[(size_t)k * NGRP + n]); }
      for (int i = gt; i < (256 - NRT) * D / 8; i += NT) *(v4u*)(Wr + (size_t)NRT * D + (size_t)i * 8) = (v4u){0u, 0u, 0u, 0u}; }
    for (int m = gw; m < M; m += NGW) {
        const f32x4* xr = (const f32x4*)(P.x + (size_t)m * D) + lane; f32x4 v[8]; float s = 0.f;
#pragma unroll
        for (int j = 0; j < 8; ++j) { v[j] = __builtin_nontemporal_load(xr + 64 * j); s += (v[j][0] * v[j][0] + v[j][1] * v[j][1]) + (v[j][2] * v[j][2] + v[j][3] * v[j][3]); }
        s = wsum(s);
        v2u* o8 = (v2u*)((bf16*)(ws + WS_XB) + (size_t)m * D) + lane;
        const float rstd = 1.0f / sqrtf(s * (1.0f / D) + EPS);
#pragma unroll
        for (int j = 0; j < 8; ++j) { v2u o; o.x = pk2(v[j][0] * rstd, v[j][1] * rstd); o.y = pk2(v[j][2] * rstd, v[j][3] * rstd); o8[64 * j] = o; }
        if (FP8QKV) { unsigned* o4 = (unsigned*)(ws + WS_XB8 + (size_t)m * D) + lane; const float r16 = rstd * F8_ASCALE;
#pragma unroll
            for (int j = 0; j < 8; ++j) { int w = 0; w = __builtin_amdgcn_cvt_pk_fp8_f32(v[j][0] * r16, v[j][1] * r16, w, false); w = __builtin_amdgcn_cvt_pk_fp8_f32(v[j][2] * r16, v[j][3] * r16, w, true); o4[64 * j] = (unsigned)w; } }
        if (lane == 0) { ((float*)(ws + WS_RSX))[m] = 1.0f; ((float*)(ws + WS_RMSX))[m] = sqrtf(s * (1.0f / D) + EPS); }
    }
    { const int gt = vcu * (NWAVES * 64) + tid, NT = G * NWAVES * 64; const f32x4* src = (const f32x4*)P.p; v4u* dst = (v4u*)(ws + WS_PB);
      for (int i = gt; i < M * PLE / 8; i += NT) { const f32x4 a = __builtin_nontemporal_load(src + 2 * i), b = __builtin_nontemporal_load(src + 2 * i + 1); v4u o; o.x = pk2(a[0], a[1]); o.y = pk2(a[2], a[3]); o.z = pk2(b[0], b[1]); o.w = pk2(b[2], b[3]); dst[i] = o; } }
}

#ifndef CONVR
#define CONVR 4
#endif
constexpr int P2_KS = 0, P2_KROW = 144, P2_VT = 36864, P2_VROW = 528, P2_OST = 70656, P2_OROW = 144, P2_SS = 107520, P2_RSTD = 108032, P2_QG = 108544;
__device__ __forceinline__ int crow(int r, int hi) { return (r & 3) + 8 * (r >> 2) + 4 * hi; }
__device__ __forceinline__ void p2_unit(const Ptrs& P, LAS unsigned char* lds, int unit, const int wid, const bool conv_first) {
    int lane_ = lane_id_asm(); asm volatile("" : "+v"(lane_));
    const int lane = lane_ & 63, tid = wid * 64 + lane, l32 = lane & 31, hi = lane >> 5;
    const bf16* proj = (const bf16*)(P.ws + WS_PROJ); bf16* mixed = (bf16*)(P.ws + WS_MIX); unsigned char* mixed8 = P.ws + WS_MIX8;
    bf16* osc = FP8O ? (bf16*)(P.ws + WS_MIX + 64 * MiB) : mixed + DCONV; constexpr int OLD = FP8O ? DATTN : D;
    const int b = unit / (SEQ / 128), qb = unit % (SEQ / 128), q0 = qb * 128; const size_t rowbase = (size_t)b * SEQ;
    LAS float* rowss = (LAS float*)(lds + P2_SS); LAS float* qg = (LAS float*)(lds + P2_QG);
    __syncthreads();
    if (tid < 128) rowss[tid] = 0.f;
    if (tid < 64) qg[tid] = P.q_norm[tid] * (0.125f * LOG2E);
    if (conv_first) {
    {
        int lc_ = lane_id_asm(); asm volatile("" : "+v"(lc_)); const int lane = lc_ & 63;
        const float* cw = P.conv_w; float w0[16], w1[16], w2[16];
#pragma unroll
        for (int j = 0; j < 16; ++j) { const int ch = (j >> 3) * 512 + lane * 8 + (j & 7); w0[j] = cw[ch]; w1[j] = cw[DCONV + ch]; w2[j] = cw[2 * DCONV + ch]; }
        float u1[16], u2[16];
        const int t0 = q0 + 16 * wid;
#pragma unroll
        for (int j = 0; j < 16; ++j) { u1[j] = 0.f; u2[j] = 0.f; }
        if (t0 >= 2) {
#pragma unroll
            for (int hf = 0; hf < 2; ++hf) { const int ch = hf * 512 + lane * 8; float c[8], hc[8];
                const bf16* pr = proj + (rowbase + t0 - 1) * PP; unpack8(*(const v4u*)(pr + O_U + ch), c); if (!UPROD) unpack8(*(const v4u*)(pr + C_HC + ch), hc);
#pragma unroll
                for (int j = 0; j < 8; ++j) u1[hf * 8 + j] = UPROD ? c[j] : c[j] * hc[j];
                pr -= PP; unpack8(*(const v4u*)(pr + O_U + ch), c); if (!UPROD) unpack8(*(const v4u*)(pr + C_HC + ch), hc);
#pragma unroll
                for (int j = 0; j < 8; ++j) u2[hf * 8 + j] = UPROD ? c[j] : c[j] * hc[j]; }
        }
#pragma unroll 1
        for (int r0 = 0; r0 < 16; r0 += CONVR) {
            v4u rb[CONVR][2], rc[CONVR][2], rh[CONVR][2];
#pragma unroll
            for (int rr = 0; rr < CONVR; ++rr) { const bf16* pr = proj + (rowbase + t0 + r0 + rr) * PP + lane * 8;
#pragma unroll
                for (int hf = 0; hf < 2; ++hf) { rb[rr][hf] = __builtin_nontemporal_load((const v4u*)(pr + O_B + hf * 512)); rc[rr][hf] = __builtin_nontemporal_load((const v4u*)(pr + O_U + hf * 512)); if (!UPROD) rh[rr][hf] = __builtin_nontemporal_load((const v4u*)(pr + C_HC + hf * 512)); } }
#pragma unroll
            for (int rr = 0; rr < CONVR; ++rr) { float y[16]; float ss = 0.f;
#pragma unroll
                for (int hf = 0; hf < 2; ++hf) { float bb[8], c[8], hc[8]; unpack8(rb[rr][hf], bb); unpack8(rc[rr][hf], c); if (!UPROD) unpack8(rh[rr][hf], hc);
#pragma unroll
                    for (int j = 0; j < 8; ++j) { const int jj = hf * 8 + j; const float u0 = UPROD ? c[j] : c[j] * hc[j];
                        y[jj] = bb[j] * (w0[jj] * u2[jj] + w1[jj] * u1[jj] + w2[jj] * u0); ss += y[jj] * y[jj]; u2[jj] = u1[jj]; u1[jj] = u0; } }
                ss = wsum(ss); const float rs = rsqf(ss * (1.0f / DCONV) + EPS);
#pragma unroll
                for (int hf = 0; hf < 2; ++hf) { float f[8];
#pragma unroll
                    for (int j = 0; j < 8; ++j) f[j] = y[hf * 8 + j] * rs;
                    if (FP8O) *(v2u*)(mixed8 + (rowbase + t0 + r0 + rr) * D + hf * 512 + lane * 8) = pack8_f8(f, F8_ASCALE);
                    else *(v4u*)(mixed + (rowbase + t0 + r0 + rr) * D + hf * 512 + lane * 8) = pack8(f); } }
        }
    }
    }
    const int h4 = wid & 3, half = wid >> 2;
    const int part = tid & 7;
    float kg[8];
#pragma unroll
    for (int j = 0; j < 8; ++j) kg[j] = P.k_norm[part * 8 + j];
    v4u kraw[4], vraw[4], qraw[4];
    const int kvoff = (tid >> 3) * PP + part * 8, qoff = l32 * PP + 8 * hi;
#define P2_LOAD_KV(g_) do { _Pragma("unroll") for (int i = 0; i < 4; ++i) { kraw[i] = (v4u){0u, 0u, 0u, 0u}; vraw[i] = (v4u){0u, 0u, 0u, 0u}; \
        if (q0 > 0 || i >= 2) { const bf16* ub = proj + (rowbase + q0 - 128 + 64 * i) * PP + (g_) * HD; kraw[i] = *(const v4u*)(ub + O_K + kvoff); vraw[i] = *(const v4u*)(ub + O_V + kvoff); } } } while (0)
#define P2_LOAD_Q(g_, sub_) do { const bf16* ub = proj + (rowbase + q0 + 64 * half + 32 * (sub_)) * PP + O_Q + ((g_) * 4 + h4) * HD; \
        _Pragma("unroll") for (int d0 = 0; d0 < 4; ++d0) qraw[d0] = __builtin_nontemporal_load((const v4u*)(ub + 16 * d0 + qoff)); } while (0)
    P2_LOAD_KV(0); P2_LOAD_Q(0, 0);
#pragma unroll 1
    for (int g = 0; g < NKV; ++g) {
        int lg_ = lane_id_asm(); asm volatile("" : "+v"(lg_));
        const int lane = lg_ & 63, tid = wid * 64 + lane, l32 = lane & 31, hi = lane >> 5, part = tid & 7;
        const int kvoff = (tid >> 3) * PP + part * 8, qoff = l32 * PP + 8 * hi, ooffo = (lane >> 3) * OLD + (lane & 7) * 8;
        __syncthreads();
#pragma unroll
        for (int i = 0; i < 4; ++i) {
            const int key = (tid >> 3) + 64 * i;
            float kf[8]; unpack8(kraw[i], kf); float ss = 0.f;
#pragma unroll
            for (int j = 0; j < 8; ++j) ss += kf[j] * kf[j];
            ss += __shfl_xor(ss, 1); ss += __shfl_xor(ss, 2); ss += __shfl_xor(ss, 4);
            const float rk = rsqf(ss * (1.0f / HD) + EPS);
#pragma unroll
            for (int j = 0; j < 8; ++j) kf[j] = kf[j] * rk * kg[j];
            *(LAS v4u*)(lds + P2_KS + key * P2_KROW + part * 16) = pack8(kf);
            const int x = key & 15; const int pos = (key & ~15) + (x & 3) + ((x >> 3) & 1) * 4 + ((x >> 2) & 1) * 8;
            LAS bf16* vt = (LAS bf16*)(lds + P2_VT) + pos;
            const unsigned vw[4] = {vraw[i].x, vraw[i].y, vraw[i].z, vraw[i].w};
#pragma unroll
            for (int j = 0; j < 4; ++j) { vt[(part * 8 + 2 * j) * (P2_VROW / 2)] = (bf16)(vw[j] & 0xffffu); vt[(part * 8 + 2 * j + 1) * (P2_VROW / 2)] = (bf16)(vw[j] >> 16); }
        }
        if (g + 1 < NKV) { P2_LOAD_KV(g + 1); }
        __syncthreads();
        const int h = g * 4 + h4;
        const float slope2 = exp2f(-0.5f * (float)(h + 1)) * LOG2E, sink2 = P.sinks[h] * LOG2E;
#pragma unroll
        for (int sub = 0; sub < 2; ++sub) {
            const int qs = 64 * half + 32 * sub;
            const int kt0 = 2 * half + sub;
            bf16x8 qf[4];
            { float qv[4][8]; float ss = 0.f;
#pragma unroll
              for (int d0 = 0; d0 < 4; ++d0) { unpack8(qraw[d0], qv[d0]);
#pragma unroll
                  for (int j = 0; j < 8; ++j) ss += qv[d0][j] * qv[d0][j]; }
              ss = xsum32(ss);
              const float rq = rsqf(ss * (1.0f / HD) + EPS);
#pragma unroll
              for (int d0 = 0; d0 < 4; ++d0) {
#pragma unroll
                  for (int j = 0; j < 8; ++j) qv[d0][j] = qv[d0][j] * rq * qg[16 * d0 + 8 * hi + j];
                  const v4u w = pack8(qv[d0]); qf[d0] = __builtin_bit_cast(bf16x8, w); } }
            if (sub == 0) { P2_LOAD_Q(g, 1); } else if (g + 1 < NKV) { P2_LOAD_Q(g + 1, 0); }
            f32x16 sc[5];
#pragma unroll
            for (int jt = 0; jt < 5; ++jt) { sc[jt] = (f32x16){0.f, 0.f, 0.f, 0.f, 0.f, 0.f, 0.f, 0.f, 0.f, 0.f, 0.f, 0.f, 0.f, 0.f, 0.f, 0.f};
#pragma unroll
                for (int d0 = 0; d0 < 4; ++d0) { const bf16x8 kfr = *(const LAS bf16x8*)(lds + P2_KS + ((kt0 + jt) * 32 + l32) * P2_KROW + (16 * d0 + 8 * hi) * 2);
                    sc[jt] = __builtin_amdgcn_mfma_f32_32x32x16_bf16(kfr, qf[d0], sc[jt], 0, 0, 0); } }
            int bl = l32 - 4 * hi; asm volatile("" : "+v"(bl));
            const float ab = -slope2 * (float)bl;
            const f32x2_t ns2 = (f32x2_t){-slope2, -slope2};
#pragma unroll
            for (int jt = 0; jt < 5; ++jt)
#pragma unroll
                for (int r = 0; r < 16; r += 2) { const int c0 = 128 - 32 * jt - (r & 3) - 8 * (r >> 2), c1 = 128 - 32 * jt - ((r + 1) & 3) - 8 * ((r + 1) >> 2);
                    f32x2_t v = (f32x2_t){(float)c0, (float)c1} * ns2 + (f32x2_t){sc[jt][r], sc[jt][r + 1]};
                    if (jt == 0) { v.x = (bl + c0 < 128) ? v.x : -1.0e30f; v.y = (bl + c1 < 128) ? v.y : -1.0e30f; }
                    if (jt == 4) { v.x = (bl + c0 >= 0) ? v.x : -1.0e30f; v.y = (bl + c1 >= 0) ? v.y : -1.0e30f; }
                    sc[jt][r] = v.x; sc[jt][r + 1] = v.y; }
            if (q0 == 0) {
                const int lim = 128 - qs;
#pragma unroll
                for (int jt = 0; jt < 4; ++jt)
#pragma unroll
                    for (int r = 0; r < 16; ++r) { const int kr = crow(r, hi); sc[jt][r] = (32 * jt + kr >= lim) ? sc[jt][r] : -1.0e30f; }
            }
            float mxt = -3.0e38f;
#pragma unroll
            for (int jt = 0; jt < 5; ++jt)
#pragma unroll
                for (int r = 0; r < 16; r += 2) mxt = fmaxf(mxt, fmaxf(sc[jt][r], sc[jt][r + 1]));
            float mx = fmaxf(sink2, mxt + ab); mx = xmax32(mx);
            f32x2_t l2 = (f32x2_t){0.f, 0.f}; const f32x2_t mx2 = (f32x2_t){mx - ab, mx - ab};
#pragma unroll
            for (int jt = 0; jt < 5; ++jt)
#pragma unroll
                for (int r = 0; r < 16; r += 2) { const f32x2_t d = (f32x2_t){sc[jt][r], sc[jt][r + 1]} - mx2; f32x2_t p; p.x = __builtin_amdgcn_exp2f(d.x); p.y = __builtin_amdgcn_exp2f(d.y); sc[jt][r] = p.x; sc[jt][r + 1] = p.y; l2 += p; }
            float l = l2.x + l2.y;
            l = xsum32(l); l += __builtin_amdgcn_exp2f(sink2 - mx);
            const float rl = __builtin_amdgcn_rcpf(l);
            f32x16 o[2];
#pragma unroll
            for (int dh = 0; dh < 2; ++dh) { o[dh] = (f32x16){0.f, 0.f, 0.f, 0.f, 0.f, 0.f, 0.f, 0.f, 0.f, 0.f, 0.f, 0.f, 0.f, 0.f, 0.f, 0.f}; }
#pragma unroll
            for (int jt = 0; jt < 5; ++jt)
#pragma unroll
                for (int j = 0; j < 2; ++j) { v4u pw; pw.x = pk2(sc[jt][8 * j + 0], sc[jt][8 * j + 1]); pw.y = pk2(sc[jt][8 * j + 2], sc[jt][8 * j + 3]); pw.z = pk2(sc[jt][8 * j + 4], sc[jt][8 * j + 5]); pw.w = pk2(sc[jt][8 * j + 6], sc[jt][8 * j + 7]);
                    const bf16x8 pf = __builtin_bit_cast(bf16x8, pw);
#pragma unroll
                    for (int dh = 0; dh < 2; ++dh) { const bf16x8 vf = *(const LAS bf16x8*)(lds + P2_VT + (32 * dh + l32) * P2_VROW + ((kt0 + jt) * 32 + 16 * j + 8 * hi) * 2);
                        o[dh] = __builtin_amdgcn_mfma_f32_32x32x16_bf16(vf, pf, o[dh], 0, 0, 0); } }
            float ss = 0.f;
            LAS unsigned char* ost = lds + P2_OST + wid * (32 * P2_OROW);
#pragma unroll
            for (int dh = 0; dh < 2; ++dh)
#pragma unroll
                for (int r4 = 0; r4 < 4; ++r4) { float a0 = o[dh][4 * r4] * rl, a1 = o[dh][4 * r4 + 1] * rl, a2 = o[dh][4 * r4 + 2] * rl, a3 = o[dh][4 * r4 + 3] * rl;
                    ss += (a0 * a0 + a1 * a1) + (a2 * a2 + a3 * a3);
                    v2u w; w.x = pk2(a0, a1); w.y = pk2(a2, a3);
                    *(LAS v2u*)(ost + l32 * P2_OROW + (32 * dh + 8 * r4 + 4 * hi) * 2) = w; }
            ss = xsum32(ss);
            if (hi == 0) __hip_atomic_fetch_add(rowss + qs + l32, ss, __ATOMIC_RELAXED, __HIP_MEMORY_SCOPE_WORKGROUP);
            asm volatile("s_waitcnt lgkmcnt(0)" ::: "memory");
#pragma unroll
            for (int i = 0; i < 4; ++i) { const int rr = i * 8 + (lane >> 3), ch = lane & 7; const v4u v = *(const LAS v4u*)(ost + rr * P2_OROW + ch * 16);
                bf16* ub = osc + (rowbase + q0 + qs + 8 * i) * OLD + h * HD; *(v4u*)(ub + ooffo) = v; }
            asm volatile("s_waitcnt lgkmcnt(0)" ::: "memory");
            __builtin_amdgcn_sched_barrier(0);
        }
    }
#undef P2_LOAD_KV
#undef P2_LOAD_Q
    asm volatile("s_waitcnt vmcnt(0)" ::: "memory");
    __syncthreads();
    LAS float* rstd = (LAS float*)(lds + P2_RSTD);
    if (tid < 128) rstd[tid] = rsqf(rowss[tid] * (1.0f / DATTN) + EPS);
    __syncthreads();
    { int lf_ = lane_id_asm(); asm volatile("" : "+v"(lf_)); const int tid = wid * 64 + (lf_ & 63);
#pragma unroll 8
    for (int i = 0; i < 32; ++i) { const int rr = (tid >> 7) + 4 * i, ch = tid & 127; bf16* p = osc + (rowbase + q0 + rr) * OLD + ch * 8;
        float f[8]; unpack8(*(const v4u*)p, f); const float s = rstd[rr];
#pragma unroll
        for (int j = 0; j < 8; ++j) f[j] *= s;
        if (FP8O) *(v2u*)(mixed8 + (rowbase + q0 + rr) * D + DCONV + ch * 8) = pack8_f8(f, F8_ASCALE); else *(v4u*)p = pack8(f); } }
    if (!conv_first) {
    {
        int lc_ = lane_id_asm(); asm volatile("" : "+v"(lc_)); const int lane = lc_ & 63;
        const float* cw = P.conv_w; float w0[16], w1[16], w2[16];
#pragma unroll
        for (int j = 0; j < 16; ++j) { const int ch = (j >> 3) * 512 + lane * 8 + (j & 7); w0[j] = cw[ch]; w1[j] = cw[DCONV + ch]; w2[j] = cw[2 * DCONV + ch]; }
        float u1[16], u2[16];
        const int t0 = q0 + 16 * wid;
#pragma unroll
        for (int j = 0; j < 16; ++j) { u1[j] = 0.f; u2[j] = 0.f; }
        if (t0 >= 2) {
#pragma unroll
            for (int hf = 0; hf < 2; ++hf) { const int ch = hf * 512 + lane * 8; float c[8], hc[8];
                const bf16* pr = proj + (rowbase + t0 - 1) * PP; unpack8(*(const v4u*)(pr + O_U + ch), c); if (!UPROD) unpack8(*(const v4u*)(pr + C_HC + ch), hc);
#pragma unroll
                for (int j = 0; j < 8; ++j) u1[hf * 8 + j] = UPROD ? c[j] : c[j] * hc[j];
                pr -= PP; unpack8(*(const v4u*)(pr + O_U + ch), c); if (!UPROD) unpack8(*(const v4u*)(pr + C_HC + ch), hc);
#pragma unroll
                for (int j = 0; j < 8; ++j) u2[hf * 8 + j] = UPROD ? c[j] : c[j] * hc[j]; }
        }
#pragma unroll 1
        for (int r0 = 0; r0 < 16; r0 += CONVR) {
            v4u rb[CONVR][2], rc[CONVR][2], rh[CONVR][2];
#pragma unroll
            for (int rr = 0; rr < CONVR; ++rr) { const bf16* pr = proj + (rowbase + t0 + r0 + rr) * PP + lane * 8;
#pragma unroll
                for (int hf = 0; hf < 2; ++hf) { rb[rr][hf] = __builtin_nontemporal_load((const v4u*)(pr + O_B + hf * 512)); rc[rr][hf] = __builtin_nontemporal_load((const v4u*)(pr + O_U + hf * 512)); if (!UPROD) rh[rr][hf] = __builtin_nontemporal_load((const v4u*)(pr + C_HC + hf * 512)); } }
#pragma unroll
            for (int rr = 0; rr < CONVR; ++rr) { float y[16]; float ss = 0.f;
#pragma unroll
                for (int hf = 0; hf < 2; ++hf) { float bb[8], c[8], hc[8]; unpack8(rb[rr][hf], bb); unpack8(rc[rr][hf], c); if (!UPROD) unpack8(rh[rr][hf], hc);
#pragma unroll
                    for (int j = 0; j < 8; ++j) { const int jj = hf * 8 + j; const float u0 = UPROD ? c[j] : c[j] * hc[j];
                        y[jj] = bb[j] * (w0[jj] * u2[jj] + w1[jj] * u1[jj] + w2[jj] * u0); ss += y[jj] * y[jj]; u2[jj] = u1[jj]; u1[jj] = u0; } }
                ss = wsum(ss); const float rs = rsqf(ss * (1.0f / DCONV) + EPS);
#pragma unroll
                for (int hf = 0; hf < 2; ++hf) { float f[8];
#pragma unroll
                    for (int j = 0; j < 8; ++j) f[j] = y[hf * 8 + j] * rs;
                    if (FP8O) *(v2u*)(mixed8 + (rowbase + t0 + r0 + rr) * D + hf * 512 + lane * 8) = pack8_f8(f, F8_ASCALE);
                    else *(v4u*)(mixed + (rowbase + t0 + r0 + rr) * D + hf * 512 + lane * 8) = pack8(f); } }
        }
    }
    }
}
constexpr int NPHASE = 10;
struct Args { Ptrs P; int ph_lo, ph_hi; };
__device__ __forceinline__ void moe_tables(LAS unsigned char* ldsx, gu32* ctl, const int wave_) {
    const int tid = TIDX(wave_);
    __syncthreads();
    if (tid < 64) {
        const int n = (int)__hip_atomic_load(ctl + CW_CNT + 64 * tid, RLX_AGENT);
        int x = (n + 255) >> 8;
#pragma unroll
        for (int o = 1; o < 64; o <<= 1) { const int v = __shfl_up(x, o); if (tid >= o) x += v; }
        ((LAS int*)(ldsx + pg8::LST_OFF))[tid] = n;
        ((LAS int*)(ldsx + pg8::LST_OFF + 256))[tid + 1] = x;
        if (tid == 0) ((LAS int*)(ldsx + pg8::LST_OFF + 256))[0] = 0;
    }
    __syncthreads();
}
#ifndef STAG6
#define STAG6 0
#endif
#ifndef STAG9
#define STAG9 0
#endif
__device__ __forceinline__ void stagger(int vcu, int us) {
    if ((vcu & 1) && us > 0) { const unsigned long long t0 = __builtin_amdgcn_s_memrealtime(); while (__builtin_amdgcn_s_memrealtime() - t0 < (unsigned long long)us * 100ull) __builtin_amdgcn_s_sleep(16); }
}
__global__ void __launch_bounds__(NWAVES * 64, 2) mk_fwd(Args args) {
    extern __shared__ __attribute__((aligned(16))) unsigned char lds_raw[];
    LAS unsigned char* lds = (LAS unsigned char*)lds_raw;
    const Ptrs& P = args.P;
    const int wave = __builtin_amdgcn_readfirstlane((int)(threadIdx.x >> 6));
    const int tid = TIDX(wave);
    const int G = gridDim.x, bx = blockIdx.x, vcu = (G % 8 == 0) ? (bx % 8) * (G / 8) + bx / 8 : bx;
    unsigned char* ws = P.ws; gu32* ctl = (gu32*)(ws + WS_CTL);
    for (int u = tid; u < (pg8::LDS_BYTES - pg8::LDSX_OFF) / 4; u += NWAVES * 64) ((LAS unsigned*)(lds + pg8::LDSX_OFF))[u] = 0u;
    __syncthreads();
    if (tid == 0) *((volatile LAS unsigned*)(lds + pg8::MISC_OFF) + 10) = __hip_atomic_fetch_add((unsigned*)ctl + CW_RANK + 64 * xb_xcc_id(), 1u, __ATOMIC_RELAXED, __HIP_MEMORY_SCOPE_AGENT);
    __syncthreads();
    const int xc = __builtin_amdgcn_readfirstlane((int)(xb_xcc_id() * 32u + *((volatile LAS unsigned*)(lds + pg8::MISC_OFF) + 10)));
    const int lo = args.ph_lo, hi = args.ph_hi;
    XcdBarrier bar; bar.bar = (unsigned*)(ctl + CW_BAR); bar.x = 0; bar.st = nullptr;
    if (hi - lo > 1) bar = xcd_barrier_post((unsigned*)(ctl + CW_BAR), (volatile LAS unsigned*)(lds + pg8::MISC_OFF) + 8, wave);
#ifdef ONLY_PHASE
#define IN(k) ((k) == ONLY_PHASE && lo <= (k) && (k) < hi)
#else
#define IN(k) (lo <= (k) && (k) < hi)
#endif
#define SEAM(k) do { if (IN(k) && IN((k) + 1) && (k) != 7 && (k) != 8) xcd_barrier(bar, wave); } while (0)
#define SEAM79() do { if (IN(7) && IN(9)) xcd_barrier(bar, wave); } while (0)
    bf16* Win = (bf16*)(ws + WS_WIN); bf16* Wout = (bf16*)(ws + WS_WOUT); bf16* Wplg = (bf16*)(ws + WS_WPLG); bf16* Wple = (bf16*)(ws + WS_WPLE);
    bf16* Wr = (bf16*)(ws + WS_WR); bf16* Wgu = (bf16*)(ws + WS_WGU); bf16* Wd = (bf16*)(ws + WS_WD);
    bf16* xb = (bf16*)(ws + WS_XB); bf16* mixed = (bf16*)(ws + WS_MIX); bf16* pb = (bf16*)(ws + WS_PB); bf16* proj = (bf16*)(ws + WS_PROJ);
    bf16* hid = (bf16*)(ws + WS_HID); bf16* pw = (bf16*)(ws + WS_PW); bf16* h1 = (bf16*)(ws + WS_H1); bf16* h2 = (bf16*)(ws + WS_H2);
    float* rsx = (float*)(ws + WS_RSX); float* rs1 = (float*)(ws + WS_RS1); float* ss1p = (float*)(ws + WS_SS1P); float* ss2p = (float*)(ws + WS_SS2P);
    int* eid = (int*)(ws + WS_EID); float* ew = (float*)(ws + WS_EW); Ent* ent = (Ent*)(ws + WS_ENT);

    if (IN(0)) { p0_prologue(P, lds, vcu, G, wave); } SEAM(0);
    if (IN(1)) { pg8::Gemm g{xb, Win, M, FP8QKV ? C_Q : DIN, D}; pg8::CvtOrder S; S.init(M, FP8QKV ? C_Q : DIN, G, bx); pg8::EpiBf16 E{proj, PP, nullptr, 1.f, UPROD != 0};
        S.w = pg8::CvtWork{P.w_gate, P.w_up, P.w_down, P.norm_ffn, ws, vcu, G}; S.slot = DEFER_CVT ? (((vcu & 31) >> 2) % CVT_SLOTS) : -1; S.lo = 0; S.hi = CVT_SPLIT ? pg8::CvtWork::NGU : pg8::CvtWork::NIT;
        pg8::gemm_phase<pg8::EpiBf16, pg8::CvtOrder, true>(lds, g, S, E, wave);
        if (DEFER_CVT && S.nunits() - 1 <= S.slot) S.w.run(wave, S.lo, S.hi);
        if (FP8QKV) { pg8::Gemm g8{(const bf16*)(ws + WS_XB8), (const bf16*)(ws + WS_WIN8), M, NQKV, D / 2}; pg8::StaticOrder S8; S8.init(M, NQKV, G, bx); pg8::EpiBf16 E8{proj + C_Q, DIN, nullptr, F8_INV, false};
            pg8::gemm_phase<pg8::EpiBf16, pg8::StaticOrder, true, true>(lds, g8, S8, E8, wave); } } SEAM(1);
    if (IN(2)) { for (int unit = vcu; unit < BATCH * (SEQ / 128); unit += G) p2_unit(P, lds, unit, wave, (vcu & 1) != 0);     __syncthreads(); } SEAM(2);
    if (IN(3)) { pg8::Gemm g{FP8O ? (const bf16*)(ws + WS_MIX8) : mixed, Wout, M, D, FP8O ? D / 2 : D}; pg8::CvtOrder S; S.init(M, D, G, bx); pg8::EpiH1 E{xb, (const float*)(ws + WS_RMSX), h1, ss1p, FP8 ? ws + WS_H18 : nullptr, FP8O ? F8_INV : 1.f};
        S.w = pg8::CvtWork{P.w_gate, P.w_up, P.w_down, P.norm_ffn, ws, vcu, G}; S.slot = (DEFER_CVT && CVT_SPLIT == 2) ? (((vcu & 31) >> 2) % 3) : -1; S.lo = pg8::CvtWork::NGU; S.hi = pg8::CvtWork::NIT;
        pg8::gemm_phase<pg8::EpiH1, pg8::CvtOrder, true, FP8O != 0>(lds, g, S, E, wave);
        if (DEFER_CVT && CVT_SPLIT == 2 && S.nunits() - 1 <= S.slot) S.w.run(wave, S.lo, S.hi); } SEAM(3);
    if (IN(4)) { pg8::Gemm g{h1, Wr, M, 256, D}; pg8::StaticOrder S; S.init(M, 256, G, bx); pg8::EpiRouter E{ss1p, P.b_group, P.b_router, rs1, eid, ew, ent, (unsigned*)(ctl + CW_CNT)};
        pg8::gemm_phase<pg8::EpiRouter, pg8::StaticOrder, false>(lds, g, S, E, wave);
        __syncthreads();
        pg8::Gemm g2{pb, Wple, M, D, PLE}; pg8::PwOrder S2{G, bx, M / 256}; pg8::EpiF8 E2{(unsigned char*)pw, D, F8_PSCALE};
        pg8::gemm_phase<pg8::EpiF8, pg8::PwOrder, true>(lds, g2, S2, E2, wave); } SEAM(4);
    if (IN(5) || IN(6) || IN(7)) moe_tables(lds, ctl, wave);
    const LAS int* T0 = (const LAS int*)(lds + pg8::LST_OFF + 256);
    bool xs5 = XSEAM5 && IN(5) && IN(6) && G == 256;
    if (xs5) { for (int j = 0; j < 8; ++j) xs5 = xs5 && (xb_ld((unsigned*)ctl + CW_BAR + XB_XCNT(j)) == 32u); }
    if (IN(5)) { pg8::Gemm g{FP8 ? (const bf16*)(ws + WS_H18) : h1, Wgu, M, NE * 1024, FP8 ? D / 2 : D}; pg8::MoeOrder<true, 4> S{lds, ent, 0, T0[NLIST], G, vcu, wave, (const Ent*)(ctl + CW_ZERO)}; if (xs5) { S.xm = 1; S.c = xc; S.tsig = (unsigned*)ctl + CW_TD; } pg8::EpiGU E{hid, lds, FP8 ? F8_INV : 1.f, FP8 ? (unsigned char*)hid : nullptr};
        if (DEFER_CVT && CVT_SPLIT == 1) { S.w = pg8::CvtWork{P.w_gate, P.w_up, P.w_down, P.norm_ffn, ws, vcu, G}; S.slot = (vcu >> 2) % 3; }
        pg8::gemm_phase<pg8::EpiGU, pg8::MoeOrder<true, 4>, true, FP8 != 0>(lds, g, S, E, wave);
        if (DEFER_CVT && CVT_SPLIT == 1 && S.nunits() - 1 <= S.slot) S.w.run(wave, pg8::CvtWork::NGU, pg8::CvtWork::NIT); } if (!xs5) SEAM(5);
    if (IN(6)) { stagger(vcu, STAG6); pg8::Gemm g{hid, Wd, 0, NE * D, FP8 ? DEXP / 2 : DEXP}; pg8::MoeOrder<false, 8> S{lds, ent, 0, T0[NE], G, vcu, wave, (const Ent*)(ctl + CW_ZERO)}; if (xs5) { S.xm = 1; S.c = xc; S.twait = (unsigned*)ctl + CW_TD; } pg8::EpiDown<0> E{ws + WS_H28, lds, F8_DINV};
        pg8::gemm_phase<pg8::EpiDown<0>, pg8::MoeOrder<false, 8>, true, FP8 != 0>(lds, g, S, E, wave); } SEAM(6);
    if (IN(7)) { stagger(vcu, STAG6); pg8::Gemm g{hid, Wd, 0, NE * D, FP8 ? DEXP / 2 : DEXP}; pg8::MoeOrder<false, 8> S{lds, ent, T0[NE], T0[NLIST], G, vcu, wave, (const Ent*)(ctl + CW_ZERO)}; pg8::EpiDown<1> E{h1, h2, ss2p, lds, ws + WS_H28, F8_DINV};
        pg8::gemm_phase<pg8::EpiDown<1>, pg8::MoeOrder<false, 8>, true, FP8 != 0>(lds, g, S, E, wave); } SEAM79();
    if (IN(9)) { stagger(vcu, STAG9); pg8::Gemm g{FP8 ? (const bf16*)(ws + WS_H28) : h2, Wplg, M, D, FP8 ? D / 2 : D}; pg8::FinalOrder S; S.init(M, D, G, bx); S.ldsx = lds; S.ssp = ss2p; S.wave = wave; S.pre = (long)8 * G >= S.nwg; pg8::EpiFinal E{h2, (const unsigned char*)pw, P.out, lds, FP8 ? F8_INV : 1.f, S.pre}; if (S.pre) S.fill_all();
        pg8::gemm_phase<pg8::EpiFinal, pg8::FinalOrder, true, FP8 != 0>(lds, g, S, E, wave); }
#undef IN
#undef SEAM
}
extern "C" void kernel_launch(void* const* d_in, const int* in_sizes, int n_in, void* d_out, int out_size, void* d_ws, size_t ws_size, hipStream_t stream) {
    static int grid = 0;
    if (grid == 0) {
        if (n_in != 22 || in_sizes[0] != M * D || out_size != M * D || ws_size < WS_END) { fprintf(stderr, "kernel_launch: unexpected problem (n_in %d, in0 %d, out %d, ws %zu); nothing launched\n", n_in, n_in > 0 ? in_sizes[0] : -1, out_size, ws_size); grid = -1; return; }
        int dev = 0, cus = 0, per_cu = 0;
        if (hipGetDevice(&dev) != hipSuccess || hipDeviceGetAttribute(&cus, hipDeviceAttributeMultiprocessorCount, dev) != hipSuccess) { grid = -1; return; }
        if (hipFuncSetAttribute((const void*)mk_fwd, hipFuncAttributeMaxDynamicSharedMemorySize, pg8::LDS_BYTES) != hipSuccess) { fprintf(stderr, "kernel_launch: hipFuncSetAttribute failed\n"); grid = -1; return; }
        if (hipOccupancyMaxActiveBlocksPerMultiprocessor(&per_cu, (const void*)mk_fwd, NWAVES * 64, pg8::LDS_BYTES) != hipSuccess || per_cu < 1) { fprintf(stderr, "kernel_launch: occupancy query says %d workgroups per CU\n", per_cu); (void)hipGetLastError(); grid = -1; return; }
        grid = cus;
    }
    if (grid < 0) return;
    if (hipMemsetAsync((char*)d_ws + WS_CTL, 0, CTL_ZERO_BYTES, stream) != hipSuccess) return;
    Args a{};
    { const float** pp = (const float**)&a.P; for (int i = 0; i < 22; ++i) pp[i] = (const float*)d_in[i]; }
    a.P.out = (float*)d_out; a.P.ws = (unsigned char*)d_ws;
    a.ph_lo = 0; a.ph_hi = NPHASE;
    hipLaunchKernelGGL(mk_fwd, dim3(grid), dim3(NWAVES * 64), pg8::LDS_BYTES, stream, a);
}
```

```cpp
#include <hip/hip_runtime.h>
#include <cstdio>
#include <cstdint>

typedef unsigned short bf16;
typedef unsigned v4u __attribute__((ext_vector_type(4)));
typedef unsigned v2u __attribute__((ext_vector_type(2)));
typedef float f32x4 __attribute__((ext_vector_type(4)));
typedef float f32x16 __attribute__((ext_vector_type(16)));
typedef short bf16x8 __attribute__((ext_vector_type(8)));
#define GAS __attribute__((address_space(1)))
#define LAS __attribute__((address_space(3)))
typedef GAS unsigned gu32;

constexpr int BATCH = 4, SEQ = 8192, D = 2048, M = BATCH * SEQ;
constexpr int DCONV = 1024, NH = 16, NKV = 4, HD = 64, DATTN = 1024, DKV = 256, DIN = 4608;
constexpr int C_B = 0, C_C = 1024, C_HC = 2048, C_Q = 3072, C_K = 4096, C_V = 4352;
#ifndef UPROD
#define UPROD 1
#endif
constexpr int PP = UPROD ? DIN - 1024 : DIN;
constexpr int O_B = 0, O_U = 1024, O_Q = UPROD ? 2048 : C_Q, O_K = UPROD ? 3072 : C_K, O_V = UPROD ? 3328 : C_V;
constexpr int NGRP = 4, EPG = 8, NE = 32, DEXP = 512, PLE = 256, NRT = 36;
constexpr int NLIST = 64, LCAP = 32768;
constexpr float EPS = 1e-6f;
constexpr float LOG2E = 1.4426950408889634f;

constexpr size_t MiB = 1u << 20;
constexpr size_t WS_CTL = 0, CTL_ZERO_BYTES = 1 * MiB;
constexpr size_t WS_WIN = 2 * MiB;
constexpr size_t WS_WOUT = 20 * MiB;
constexpr size_t WS_WPLG = 28 * MiB;
constexpr size_t WS_WPLE = 36 * MiB;
constexpr size_t WS_WR = 37 * MiB;
constexpr size_t WS_RSX = 38 * MiB;
constexpr size_t WS_RS1 = 38 * MiB + 256 * 1024;
constexpr size_t WS_RS2 = 38 * MiB + 512 * 1024;
constexpr size_t WS_RMSX = 38 * MiB + 768 * 1024;
constexpr size_t WS_EID = 39 * MiB;
constexpr size_t WS_EW = 39 * MiB + 512 * 1024;
constexpr size_t WS_LOG = 42 * MiB;
constexpr size_t WS_SS1P = 50 * MiB;
constexpr size_t WS_SS2P = 54 * MiB;
#ifndef FP8
#define FP8 1
#endif
#ifndef FP8O
#define FP8O 0
#endif
constexpr size_t WS_MIX8 = 816 * MiB;
#ifndef FP8QKV
#define FP8QKV 0
#endif
constexpr size_t WS_XB8 = 128 * MiB;
constexpr size_t WS_WIN8 = 20 * MiB - 3 * MiB;
constexpr int NQKV = DATTN + 2 * DKV;
constexpr float F8_ASCALE = 16.f, F8_WSCALE = 32.f, F8_INV = 1.0f / (16.f * 32.f);
constexpr float F8_HSCALE = 16.f, F8_DSCALE = 16.f, F8_DINV = 1.0f / (16.f * 16.f);
constexpr float F8_PSCALE = 16.f, F8_PINV = 1.0f / 16.f;
constexpr float F8_YSCALE = 64.f, F8_YINV = 1.0f / 64.f;
constexpr size_t WS_WGU = 64 * MiB;
constexpr size_t WS_H18 = 128 * MiB;
constexpr size_t WS_H28 = 608 * MiB;
constexpr size_t WS_WD = 192 * MiB;
constexpr size_t WS_XB = 256 * MiB;
constexpr size_t WS_MIX = 816 * MiB;
constexpr size_t WS_PB = 384 * MiB;
constexpr size_t WS_PROJ = 400 * MiB;
constexpr size_t WS_HID = 400 * MiB;
constexpr size_t WS_PW = 480 * MiB;
constexpr size_t WS_H1 = 688 * MiB;
constexpr size_t WS_H2 = 816 * MiB;
constexpr size_t WS_YA = 688 * MiB;
constexpr size_t WS_ENT = 944 * MiB;
constexpr size_t WS_END = 976 * MiB;
constexpr int CW_TMO = 0, CW_BAR = 4096, CW_CNT = 8192, CW_ZERO = 16384, CW_RANK = 24576  , CW_TD = 32768  ;

__device__ __forceinline__ float bf2f(bf16 v) { return __uint_as_float(((unsigned)v) << 16); }
__device__ __forceinline__ unsigned f2bfu(float f) { unsigned u = __float_as_uint(f); return (u + 0x7fffu + ((u >> 16) & 1u)) >> 16; }
__device__ __forceinline__ bf16 f2bf(float f) { return (bf16)f2bfu(f); }
typedef float f32x2_t __attribute__((ext_vector_type(2))); typedef __bf16 bf16x2_t __attribute__((ext_vector_type(2)));
__device__ __forceinline__ unsigned pk2(float lo, float hi) { const f32x2_t v = {lo, hi}; const bf16x2_t b = __builtin_convertvector(v, bf16x2_t); return __builtin_bit_cast(unsigned, b); }
__device__ __forceinline__ float xsum32(float v) { const auto r = __builtin_amdgcn_permlane32_swap(__float_as_uint(v), __float_as_uint(v), false, false); return __uint_as_float(r[0]) + __uint_as_float(r[1]); }
__device__ __forceinline__ float xmax32(float v) { const auto r = __builtin_amdgcn_permlane32_swap(__float_as_uint(v), __float_as_uint(v), false, false); return fmaxf(__uint_as_float(r[0]), __uint_as_float(r[1])); }
__device__ __forceinline__ float rsqf(float x) { return __builtin_amdgcn_rsqf(x); }
__device__ __forceinline__ float wsum(float v) {
#pragma unroll
    for (int o = 32; o > 0; o >>= 1) v += __shfl_xor(v, o);
    return v;
}
__device__ __forceinline__ void unpack8(v4u w, float* f) {
    f[0] = __uint_as_float(w.x << 16); f[1] = __uint_as_float(w.x & 0xffff0000u);
    f[2] = __uint_as_float(w.y << 16); f[3] = __uint_as_float(w.y & 0xffff0000u);
    f[4] = __uint_as_float(w.z << 16); f[5] = __uint_as_float(w.z & 0xffff0000u);
    f[6] = __uint_as_float(w.w << 16); f[7] = __uint_as_float(w.w & 0xffff0000u);
}
__device__ __forceinline__ v2u pack8_f8(const float* f, float sc) {
    float c[8];
#pragma unroll
    for (int j = 0; j < 8; ++j) c[j] = __builtin_amdgcn_fmed3f(f[j] * sc, -448.f, 448.f);
    int lo = 0, hi = 0;
    lo = __builtin_amdgcn_cvt_pk_fp8_f32(c[0], c[1], lo, false); lo = __builtin_amdgcn_cvt_pk_fp8_f32(c[2], c[3], lo, true);
    hi = __builtin_amdgcn_cvt_pk_fp8_f32(c[4], c[5], hi, false); hi = __builtin_amdgcn_cvt_pk_fp8_f32(c[6], c[7], hi, true);
    v2u o; o.x = (unsigned)lo; o.y = (unsigned)hi; return o;
}
__device__ __forceinline__ v4u pack8(const float* f) { v4u o; o.x = pk2(f[0], f[1]); o.y = pk2(f[2], f[3]); o.z = pk2(f[4], f[5]); o.w = pk2(f[6], f[7]); return o; }

__device__ __forceinline__ int lane_id_asm() { int l; asm volatile("v_mbcnt_lo_u32_b32 %0, -1, 0\n\tv_mbcnt_hi_u32_b32 %0, -1, %0" : "=v"(l)); return l & 63; }
__device__ __forceinline__ int lane_id() { return lane_id_asm(); }
#define TIDX(wave_) (((wave_) & 7) * 64 + lane_id_asm())

#ifndef DEFER_CVT
#define DEFER_CVT 1
#endif
#ifndef CVT_SLOTS
#define CVT_SLOTS 8
#endif
#ifndef CVT_SPLIT
#define CVT_SPLIT 0
#endif
#ifndef XSEAM5
#define XSEAM5 0
#endif
#ifndef MIDSCALE
#define MIDSCALE 1
#endif
struct Ptrs {
    const float *x, *p, *norm_mix, *w_in, *conv_w, *q_norm, *k_norm, *sinks, *onc, *ona, *w_out, *norm_ffn, *w_group, *b_group, *w_router, *b_router,
        *w_gate, *w_up, *w_down, *norm_ple, *w_ple_gate, *w_ple;
    float* out; unsigned char* ws;
};
struct Ent { int tok; float w; float rs; int pad; };
#ifndef BALK
#define BALK 0
#endif
#ifndef DMAFIRST
#define DMAFIRST 0
#endif
namespace pg8 {
typedef int v4i __attribute__((ext_vector_type(4)));
typedef int v8i __attribute__((ext_vector_type(8)));
constexpr int BM = 256, BK = 64, HALF = 128, HTB = HALF * BK * 2  , STAGE_BYTES = 8 * HTB, NXCD = 8;
#ifndef WGM_
#define WGM_ 4
#endif
constexpr int WGM = WGM_;
constexpr int RING_BYTES = 131072;
constexpr int LDSX_OFF = RING_BYTES;
constexpr int MISC_OFF = LDSX_OFF + 320;
constexpr int TAB_OFF = LDSX_OFF + 1024;
constexpr int LST_OFF = TAB_OFF + 8192;
constexpr int LDS_BYTES = 147456;

__host__ __device__ __forceinline__ int lds_byte(int r, int c) { const int st = (r >> 4) * 2 + (c >> 5), rr = r & 15, cc = c & 31, ob = rr * 64 + cc * 2; return st * 1024 + (ob ^ (((ob >> 9) & 1) << 5)); }
__host__ __device__ __forceinline__ void stage_rc(int b, int& R, int& C) { const int st = b / 1024, sb = b % 1024, swz = sb ^ (((sb >> 9) & 1) << 5); R = (st >> 1) * 16 + swz / 64; C = (st & 1) * 32 + (swz % 64) / 2; }
__host__ __device__ __forceinline__ int perm32(int rho) { const int n = rho >> 4, i = rho & 15; return 8 * (i >> 2) + 4 * n + (i & 3); }

struct Unit { int pm, pn, bt, par, lst, rk0, nl; };
struct Gemm { const bf16* A; const bf16* Bt; int M, N, K; };

struct StaticOrder {
    static constexpr bool GATHER = false, MID = false;
    int nM, nN, nwg, G, c;
    __host__ __device__ void init(int M_, int N_, int G_, int c_) { nM = M_ / BM; nN = N_ / BM; nwg = nM * nN; G = G_; c = c_; }
    __host__ __device__ bool next(int i, Unit& u) const {
        const long L = (long)i * G + c; if (L >= nwg) return false;
        int wgid = (int)L; { const int q = nwg / NXCD, r = nwg % NXCD, xcd = wgid % NXCD, off = wgid / NXCD; wgid = (xcd < r ? xcd * (q + 1) : r * (q + 1) + (xcd - r) * q) + off; }
        const int nig = WGM * nN, gid = wgid / nig, fm = gid * WGM, gsz = (nM - fm) < WGM ? (nM - fm) : WGM;
        u.pm = fm + ((wgid % nig) % gsz); u.pn = (wgid % nig) / gsz; u.bt = u.pn; u.par = i & 1; u.lst = 0; u.rk0 = 0; u.nl = 0; return true;
    }
    __device__ __forceinline__ void a_prefetch(const Unit&) const {}
    __device__ __forceinline__ void a_first() const {}
    __device__ __forceinline__ void a_ready(const Unit&) const {}
    __device__ __forceinline__ void done(const Unit&) const {}
    __device__ __forceinline__ void between(int, int) const {}
    __device__ __forceinline__ void signal(int) const {}
};

struct SameTileOrder : StaticOrder { __host__ __device__ bool next(int i, Unit& u) const { if (!StaticOrder::next(i, u)) return false; u.pm = c & 7; u.pn = 0; u.bt = 0; return true; } };
struct PwOrder {
    static constexpr bool GATHER = false, MID = false;
    int G, c, nr;
    __device__ __forceinline__ bool next(int i, Unit& u) const {
        int L;
        if (G == 256 && nr == 128) { if (c < nr || i >= 8) return false; L = (c - nr) * 8 + i; }
        else { L = i * G + c; if (L >= (M / BM) * (D / BM)) return false; }
        u.pm = L / (D / BM); u.pn = L % (D / BM); u.bt = u.pn; u.par = i & 1; u.lst = 0; u.rk0 = 0; u.nl = 0; return true;
    }
    __device__ __forceinline__ void a_prefetch(const Unit&) const {}
    __device__ __forceinline__ void a_first() const {}
    __device__ __forceinline__ void a_ready(const Unit&) const {}
    __device__ __forceinline__ void done(const Unit&) const {}
    __device__ __forceinline__ void between(int, int) const {}
    __device__ __forceinline__ void signal(int) const {}
};

template <bool GU> __device__ __forceinline__ void cvt_item(const float* W, const float* g0, unsigned char* WT8, int k0, int n0, int up, int lane) {
    constexpr int K = GU ? D : DEXP, N = GU ? DEXP : D;
    const int q = lane & 3, c4 = lane >> 2;
    f32x4 v[32];
    const __attribute__((address_space(1))) f32x4* src = (const __attribute__((address_space(1))) f32x4*)(W + (size_t)(k0 + 16 * q) * N + n0) + c4;
#pragma unroll
    for (int i = 0; i < 32; ++i) v[i] = __builtin_nontemporal_load(src + (size_t)((i & 15) + 64 * (i >> 4)) * (N / 4));
    float gg[32];
#pragma unroll
    for (int t = 0; t < 8; ++t) { f32x4 g4 = (f32x4){1.f, 1.f, 1.f, 1.f}; if (GU) g4 = *(const f32x4*)(g0 + k0 + 16 * q + 64 * (t >> 2) + 4 * (t & 3));
#pragma unroll
        for (int u = 0; u < 4; ++u) gg[4 * t + u] = g4[u] * (GU ? F8_WSCALE : F8_DSCALE); }
    const int n = n0 + 4 * c4;
    const int row = GU ? (n >> 7) * 256 + ((n & 127) >> 3) * 16 + up * 8 + (n & 7) : n;
    unsigned char* dst = WT8 + (size_t)row * K + k0 + 16 * q;
#pragma unroll
    for (int j = 0; j < 4; ++j) { v2u qv[4];
#pragma unroll
        for (int b = 0; b < 4; ++b) { float f[8];
#pragma unroll
            for (int t = 0; t < 8; ++t) f[t] = v[b * 8 + t][j] * gg[b * 8 + t];
            qv[b] = pack8_f8(f, 1.0f); }
        __builtin_nontemporal_store((v4u){qv[0].x, qv[0].y, qv[1].x, qv[1].y}, (v4u*)(dst + (size_t)j * K));
        __builtin_nontemporal_store((v4u){qv[2].x, qv[2].y, qv[3].x, qv[3].y}, (v4u*)(dst + (size_t)j * K + 64)); }
}
struct CvtWork {
    const float *w_gate, *w_up, *w_down, *norm_ffn; unsigned char* ws; int vcu, G;
    static constexpr int NGU = NE * 2 * (DEXP / 64) * (D / 128), ND = NE * (D / 64) * (DEXP / 128), NIT = NGU + ND;
    __device__ __forceinline__ void run(int wid, int lo, int hi) const {
        const int lane = lane_id_asm();
        const float* wg_ = w_gate; const float* wu_ = w_up; asm volatile("" : "+s"(wg_), "+s"(wu_));
        const int n = hi - lo, per = (n + G - 1) / G, perw = (per + 7) / 8, lim = lo + ((vcu + 1) * per < n ? (vcu + 1) * per : n);
        const int base = lo + vcu * per + wid * perw, top = base + perw < lim ? base + perw : lim;
#pragma unroll 1
        for (int it0 = base; it0 < top; ++it0) { const int it = __builtin_amdgcn_readfirstlane(it0);
            if (it < NGU) { const int kb = it & 15, nb = (it >> 4) & 7, up = (it >> 7) & 1, e = it >> 8;
                cvt_item<true>((up ? wu_ : wg_) + (size_t)e * D * DEXP, norm_ffn, ws + WS_WGU + (size_t)e * 1024 * D, kb * 128, nb * 64, up, lane); }
            else { const int j = it - NGU, kb = j & 3, nb = (j >> 2) & 31, e = j >> 7;
                cvt_item<false>(w_down + (size_t)e * DEXP * D, nullptr, ws + WS_WD + (size_t)e * D * DEXP, kb * 128, nb * 64, 0, lane); } }
    }
};
struct CvtOrder : StaticOrder {
    CvtWork w; int slot, lo, hi;
    __device__ __forceinline__ void between(int ui, int wid) const { if (ui == slot) w.run(wid, lo, hi); }
    __device__ __forceinline__ int nunits() const { return c < nwg ? (nwg - 1 - c) / G + 1 : 0; }
};
struct OutOrder : CvtOrder {
    static constexpr bool MID = true;
    LAS unsigned char* ldsx; const float* rsa; int wave; bool on;
    __device__ __forceinline__ bool next(int i, Unit& u) const { const bool ok = StaticOrder::next(i, u); u.lst = i; return ok; }
    __device__ __forceinline__ void fill_all() const {
        if (!on) return;
        const int tid = TIDX(wave), r = tid & 255;
#pragma unroll 1
        for (int i = tid >> 8; i < 4; i += 2) { Unit u; if (!next(i, u)) break; const float v = rsa[u.pm * BM + r];
            ((LAS float*)(ldsx + TAB_OFF))[i * 256 + r] = v; ((LAS float*)(ldsx + TAB_OFF + 4096))[i * 256 + r] = 1.0f / v; }
        __syncthreads();
    }
    __device__ __forceinline__ void mid(f32x4 (&acc)[2][2][4][2], const Unit& u, int wr, int fr, int fin = 0) const {
        if (!on) return;
#pragma unroll
        for (int ai = 0; ai < 2; ++ai)
#pragma unroll
            for (int m = 0; m < 4; ++m) { const float inv = ((const LAS float*)(ldsx + TAB_OFF + (fin ? 0 : 4096)))[u.lst * 256 + ai * HALF + wr * 64 + m * 16 + fr];
#pragma unroll
                for (int bj = 0; bj < 2; ++bj)
#pragma unroll
                    for (int n = 0; n < 2; ++n) acc[ai][bj][m][n] *= inv; }
    }
};

__device__ __forceinline__ unsigned cvt_pk_bf16(float lo, float hi) { unsigned r; asm volatile("v_cvt_pk_bf16_f32 %0, %1, %2" : "=v"(r) : "v"(lo), "v"(hi)); return r; }

template <class Epi, class Sched, bool ALIGN_EPI, bool F8 = false, int MMAMASK = 15>
__device__ __forceinline__ void gemm_phase(LAS unsigned char* lds, const Gemm g, const Sched& S, const Epi& E, const int wid) {
    const int lane = lane_id(), tid = wid * 64 + lane, wr = wid >> 2, wc = wid & 3, fr = lane & 15, fq = lane >> 4;
    const int K = g.K, nt = K / BK;
    unsigned voffA[2], voffB[2]; int R0 = 0, C0 = 0;
#pragma unroll
    for (int i = 0; i < 2; ++i) { int R, C; stage_rc(tid * 16 + i * 8192, R, C); const int Rb = Epi::PERM ? (64 * (R >> 5) + 16 * ((R & 15) >> 2) + 4 * ((R >> 4) & 1) + (R & 3)) : R;
        voffA[i] = (unsigned)(R * K + C) * 2u; voffB[i] = (unsigned)(Rb * K + C) * 2u; if (i == 0) { R0 = R; C0 = C; } }
    const size_t kstep = (size_t)(BK * 2);
    const size_t hstep = (size_t)HALF * K * 2;
    const size_t tstep = 2 * hstep;
    const size_t hstepB = Epi::PERM ? (size_t)8 * K * 2 : hstep;
    const unsigned ldsw = (unsigned)wid * 1024u;
    const int aoff = lds_byte(wr * 64 + fr, fq * 8), boff = lds_byte(wc * 32 + fr, fq * 8);
    unsigned gc[2][2] = {{0u, 0u}, {0u, 0u}}, gn[2][2] = {{0u, 0u}, {0u, 0u}}, gs[2][2] = {{0u, 0u}, {0u, 0u}};
#define PG8_TOK(par, r) (*(const LAS int*)(lds + TAB_OFF + (par) * 4096 + (r) * 16))
#define PG8_GLOAD(dst, par) do { _Pragma("unroll") for (int _h = 0; _h < 2; ++_h) _Pragma("unroll") for (int _i = 0; _i < 2; ++_i) \
        dst[_h][_i] = (unsigned)PG8_TOK(par, _h * 128 + _i * 64 + R0) * (unsigned)(K * 2) + (unsigned)(C0 * 2); } while (0)
#define PG8_SA(b, h) (((b) * 2 + (h)) * HTB)
#define PG8_SB(b, h) ((4 + (b) * 2 + (h)) * HTB)
#define PG8_STAGE(bufoff, gbase, voff) do { _Pragma("unroll") for (int _i = 0; _i < 2; ++_i) \
        __builtin_amdgcn_global_load_lds((const unsigned*)((const char*)(gbase) + (voff)[_i]), (LAS unsigned*)(lds + (bufoff) + ldsw + _i * 8192), 16, 0, 0); } while (0)
#define PG8_STAGE_A(bufoff, ub, go, h, kb) do { if constexpr (Sched::GATHER) { PG8_STAGE(bufoff, (const char*)g.A + (kb), go[h]); } else { PG8_STAGE(bufoff, (ub) + (kb) + (h) * hstep, voffA); } } while (0)
#define PG8_CAT(p_) __builtin_shufflevector(*(const LAS v4i*)(p_), *(const LAS v4i*)((p_) + 1024), 0, 1, 2, 3, 4, 5, 6, 7)
#define PG8_LDA(dst, b, h) do { if constexpr (F8) { _Pragma("unroll") for (int m = 0; m < 4; ++m) dst##8[m] = PG8_CAT(lds + PG8_SA(b, h) + aoff + m * 2048); } \
        else { _Pragma("unroll") for (int m = 0; m < 4; ++m) _Pragma("unroll") for (int k = 0; k < 2; ++k) dst[m][k] = *(const LAS bf16x8*)(lds + PG8_SA(b, h) + aoff + m * 2048 + k * 1024); } } while (0)
#define PG8_LDB(dst, b, h) do { if constexpr (F8) { _Pragma("unroll") for (int n = 0; n < 2; ++n) dst##8[n] = PG8_CAT(lds + PG8_SB(b, h) + boff + n * 2048); } \
        else { _Pragma("unroll") for (int n = 0; n < 2; ++n) _Pragma("unroll") for (int k = 0; k < 2; ++k) dst[n][k] = *(const LAS bf16x8*)(lds + PG8_SB(b, h) + boff + n * 2048 + k * 1024); } } while (0)
#define PG8_MMA(ai, bj, At, Bt) do { if constexpr (((MMAMASK >> ((ai) * 2 + (bj))) & 1) == 0) break; __builtin_amdgcn_s_setprio(1); _Pragma("unroll") for (int m = 0; m < 4; ++m) _Pragma("unroll") for (int n = 0; n < 2; ++n) { \
        if constexpr (F8) { asm volatile("v_mfma_scale_f32_16x16x128_f8f6f4 %0, %1, %2, %0, %3, %3 op_sel_hi:[0,0,0]" : "+v"(acc[ai][bj][m][n]) : "v"(Bt##8[n]), "v"(At##8[m]), "v"(f8scale)); } \
        else { _Pragma("unroll") for (int k = 0; k < 2; ++k) acc[ai][bj][m][n] = __builtin_amdgcn_mfma_f32_16x16x32_bf16(Bt[n][k], At[m][k], acc[ai][bj][m][n], 0, 0, 0); } } \
        __builtin_amdgcn_s_setprio(0); } while (0)
#define PG8_WAIT_V(n) asm volatile("s_waitcnt vmcnt(" #n ")" ::: "memory")
#define PG8_WAIT_L(n) asm volatile("s_waitcnt lgkmcnt(" #n ")" ::: "memory")
#define PG8_BAR __builtin_amdgcn_s_barrier()
#define PG8_SCHED __builtin_amdgcn_sched_barrier(0)
    Unit cur, nxt; int ui = 0, prev_pm = 0;
    if (!S.next(0, cur)) return;
    f32x4 acc[2][2][4][2];
#pragma unroll
    for (int a = 0; a < 2; ++a)
#pragma unroll
        for (int b = 0; b < 2; ++b)
#pragma unroll
            for (int m = 0; m < 4; ++m)
#pragma unroll
                for (int n = 0; n < 2; ++n) acc[a][b][m][n] = (f32x4){0.f, 0.f, 0.f, 0.f};
    bf16x8 At[4][2], B0[2][2], B1[2][2];
    const int f8scale = 0x7f7f7f7f;
    v8i At8[4], B08[2], B18[2];
    const char* cA = (const char*)g.A + (size_t)cur.pm * tstep; const char* cB = (const char*)g.Bt + (size_t)cur.bt * tstep;
    S.a_prefetch(cur); S.a_first(); S.a_ready(cur);
    if constexpr (Sched::GATHER) { PG8_GLOAD(gc, cur.par); }
    PG8_STAGE(PG8_SB(0, 0), cB, voffB); PG8_STAGE(PG8_SB(0, 1), cB + hstepB, voffB); PG8_STAGE_A(PG8_SA(0, 0), cA, gc, 0, (size_t)0); PG8_STAGE_A(PG8_SA(0, 1), cA, gc, 1, (size_t)0);
    if (wr == 1) PG8_BAR;
    PG8_WAIT_V(2); PG8_BAR;
    PG8_STAGE(PG8_SB(1, 0), cB + kstep, voffB); PG8_STAGE_A(PG8_SA(1, 0), cA, gc, 0, kstep); PG8_STAGE(PG8_SB(1, 1), cB + hstepB + kstep, voffB);
    PG8_WAIT_V(6); PG8_BAR;
    for (;;) {
        const bool has_next = S.next(ui + 1, nxt);
        const char* nA = has_next ? (const char*)g.A + (size_t)nxt.pm * tstep : cA; const char* nB = has_next ? (const char*)g.Bt + (size_t)nxt.bt * tstep : cB;
#pragma unroll 1
        for (int t = 0; t < nt; t += 2) {
            const bool last = (t == nt - 2);
            if constexpr (Sched::MID) { if (t == nt / 2) S.mid(acc, cur, wr, fr); }
            const size_t k1 = (size_t)(t + 1) * kstep;
            const char* sA = last ? nA : cA; const size_t k2 = last ? (size_t)0 : (size_t)(t + 2) * kstep, k3 = k2 + kstep;
            const char* b2 = last ? nB : cB + (size_t)(t + 2) * kstep; const char* b3 = b2 + kstep;
            if (last && has_next) { S.a_ready(nxt); if constexpr (Sched::GATHER) { PG8_GLOAD(gn, nxt.par); } }
            if constexpr (Sched::GATHER) {
#pragma unroll
                for (int h = 0; h < 2; ++h)
#pragma unroll
                    for (int i = 0; i < 2; ++i) gs[h][i] = (last && has_next) ? gn[h][i] : gc[h][i];
            }
#if BALK
            PG8_LDB(B0, 0, 0); PG8_LDB(B1, 0, 1); PG8_SCHED; PG8_LDA(At, 0, 0); PG8_STAGE_A(PG8_SA(1, 1), cA, gc, 1, k1);
            PG8_WAIT_V(8); PG8_WAIT_L(0); PG8_BAR; PG8_MMA(0, 0, At, B0); PG8_MMA(0, 1, At, B1); PG8_BAR; PG8_SCHED;
            if (has_next && t == nt - 4) S.a_prefetch(nxt);
            PG8_LDA(At, 0, 1); PG8_STAGE(PG8_SB(0, 0), b2, voffB); PG8_STAGE(PG8_SB(0, 1), b2 + hstepB, voffB);
            PG8_WAIT_V(6); PG8_WAIT_L(0); PG8_BAR; PG8_MMA(1, 0, At, B0); PG8_STAGE_A(PG8_SA(0, 0), sA, gs, 0, k2); PG8_MMA(1, 1, At, B1); PG8_BAR; PG8_SCHED;
            PG8_LDB(B0, 1, 0); PG8_LDB(B1, 1, 1); PG8_SCHED; PG8_LDA(At, 1, 0); PG8_STAGE_A(PG8_SA(0, 1), sA, gs, 1, k2);
            PG8_WAIT_V(8); PG8_WAIT_L(0); PG8_BAR; PG8_MMA(0, 0, At, B0); PG8_MMA(0, 1, At, B1); PG8_BAR; PG8_SCHED;
            PG8_LDA(At, 1, 1); PG8_STAGE(PG8_SB(1, 0), b3, voffB); PG8_STAGE(PG8_SB(1, 1), b3 + hstepB, voffB);
            PG8_WAIT_V(6); PG8_WAIT_L(0); PG8_BAR; PG8_MMA(1, 0, At, B0); PG8_STAGE_A(PG8_SA(1, 0), sA, gs, 0, k3); PG8_MMA(1, 1, At, B1); PG8_BAR; PG8_SCHED;
#else
#if DMAFIRST
            PG8_LDB(B0, 0, 0); PG8_LDB(B1, 0, 1); PG8_SCHED; PG8_LDA(At, 0, 0); PG8_WAIT_L(0); PG8_SCHED; PG8_STAGE_A(PG8_SA(1, 1), cA, gc, 1, k1);
            PG8_WAIT_V(8); PG8_BAR; PG8_MMA(0, 0, At, B0); PG8_MMA(0, 1, At, B1); PG8_BAR; PG8_SCHED;
            if (has_next && t == nt - 4) S.a_prefetch(nxt);
            PG8_LDA(At, 0, 1); PG8_WAIT_L(0); PG8_SCHED; PG8_STAGE(PG8_SB(0, 0), b2, voffB); PG8_STAGE(PG8_SB(0, 1), b2 + hstepB, voffB); PG8_STAGE_A(PG8_SA(0, 0), sA, gs, 0, k2);
            PG8_WAIT_V(8); PG8_BAR; PG8_MMA(1, 0, At, B0); PG8_MMA(1, 1, At, B1); PG8_BAR; PG8_SCHED;
            PG8_LDB(B0, 1, 0); PG8_LDB(B1, 1, 1); PG8_SCHED; PG8_LDA(At, 1, 0); PG8_WAIT_L(0); PG8_SCHED; PG8_STAGE_A(PG8_SA(0, 1), sA, gs, 1, k2);
            PG8_WAIT_V(8); PG8_BAR; PG8_MMA(0, 0, At, B0); PG8_MMA(0, 1, At, B1); PG8_BAR; PG8_SCHED;
            PG8_LDA(At, 1, 1); PG8_WAIT_L(0); PG8_SCHED; PG8_STAGE(PG8_SB(1, 0), b3, voffB); PG8_STAGE(PG8_SB(1, 1), b3 + hstepB, voffB); PG8_STAGE_A(PG8_SA(1, 0), sA, gs, 0, k3);
            PG8_WAIT_V(8); PG8_BAR; PG8_MMA(1, 0, At, B0); PG8_MMA(1, 1, At, B1); PG8_BAR; PG8_SCHED;
#else
            PG8_LDB(B0, 0, 0); PG8_LDB(B1, 0, 1); PG8_SCHED; PG8_LDA(At, 0, 0); PG8_STAGE_A(PG8_SA(1, 1), cA, gc, 1, k1);
            PG8_WAIT_V(8); PG8_WAIT_L(0); PG8_BAR; PG8_MMA(0, 0, At, B0); PG8_MMA(0, 1, At, B1); PG8_BAR; PG8_SCHED;
            if (has_next && t == nt - 4) S.a_prefetch(nxt);
            PG8_LDA(At, 0, 1); PG8_STAGE(PG8_SB(0, 0), b2, voffB); PG8_STAGE(PG8_SB(0, 1), b2 + hstepB, voffB); PG8_STAGE_A(PG8_SA(0, 0), sA, gs, 0, k2);
            PG8_WAIT_V(8); PG8_WAIT_L(0); PG8_BAR; PG8_MMA(1, 0, At, B0); PG8_MMA(1, 1, At, B1); PG8_BAR; PG8_SCHED;
            if (t == 0 && ui > 0) S.signal(prev_pm);
            PG8_LDB(B0, 1, 0); PG8_LDB(B1, 1, 1); PG8_SCHED; PG8_LDA(At, 1, 0); PG8_STAGE_A(PG8_SA(0, 1), sA, gs, 1, k2);
            PG8_WAIT_V(8); PG8_WAIT_L(0); PG8_BAR; PG8_MMA(0, 0, At, B0); PG8_MMA(0, 1, At, B1); PG8_BAR; PG8_SCHED;
            PG8_LDA(At, 1, 1); PG8_STAGE(PG8_SB(1, 0), b3, voffB); PG8_STAGE(PG8_SB(1, 1), b3 + hstepB, voffB); PG8_STAGE_A(PG8_SA(1, 0), sA, gs, 0, k3);
            PG8_WAIT_V(8); PG8_WAIT_L(0); PG8_BAR; PG8_MMA(1, 0, At, B0); PG8_MMA(1, 1, At, B1); PG8_BAR; PG8_SCHED;
#endif
#endif
        }
        if constexpr (F8) asm volatile("s_nop 15\n\ts_nop 15" ::: "memory");
        if constexpr (Sched::MID) S.mid(acc, cur, wr, fr, 1);
        if constexpr (ALIGN_EPI) { if (wr == 0) PG8_BAR; }
        if constexpr (!Epi::AFTER_DRAIN) { E(acc, cur, wr, wc, fr, fq); S.done(cur); }
        if (!has_next) break;
        S.between(ui, wid);
#pragma unroll
        for (int a = 0; a < 2; ++a)
#pragma unroll
            for (int b = 0; b < 2; ++b)
#pragma unroll
                for (int m = 0; m < 4; ++m)
#pragma unroll
                    for (int n = 0; n < 2; ++n) acc[a][b][m][n] = (f32x4){0.f, 0.f, 0.f, 0.f};
        prev_pm = cur.pm; cur = nxt; cA = nA; cB = nB; ++ui;
        if constexpr (Sched::GATHER) {
#pragma unroll
            for (int h = 0; h < 2; ++h)
#pragma unroll
                for (int i = 0; i < 2; ++i) gc[h][i] = gn[h][i];
        }
        if constexpr (ALIGN_EPI) { if (wr == 1) PG8_BAR; }
    }
    PG8_WAIT_V(0);
    if constexpr (!ALIGN_EPI) { if (wr == 0) PG8_BAR; }
    PG8_BAR;
    if constexpr (!Epi::AFTER_DRAIN) S.signal(cur.pm);
    if constexpr (Epi::AFTER_DRAIN) { E.fused(acc, cur, wr, wc, fr, fq, lds, wid, lane); S.done(cur); }
#undef PG8_TOK
#undef PG8_GLOAD
#undef PG8_SA
#undef PG8_SB
#undef PG8_STAGE
#undef PG8_STAGE_A
#undef PG8_CAT
#undef PG8_LDA
#undef PG8_LDB
#undef PG8_MMA
#undef PG8_WAIT_V
#undef PG8_WAIT_L
#undef PG8_BAR
#undef PG8_SCHED
}

typedef f32x4 Acc[2][2][4][2];
#define TAB_ENT(ldsx, par, r) ((const LAS Ent*)((ldsx) + TAB_OFF + (par) * 4096 + (r) * 16))

#ifndef NTS_PROJ
#define NTS_PROJ 0
#endif
struct EpiBf16 {
    static constexpr bool PERM = true, AFTER_DRAIN = false, NTS = NTS_PROJ != 0;
    bf16* O; int ldc; const float* rs; float sc; bool uprod;
    __device__ __forceinline__ void operator()(const Acc& acc, const Unit& u, int wr, int wc, int fr, int fq) const {
        const int row0 = u.pm * BM + wr * 64 + fr;
        if (uprod && u.pn >= 4 && u.pn < 12) {
            const int col = O_U + 128 * (u.pn - 4) + wc * 32 + fq * 8;
#pragma unroll
            for (int ai = 0; ai < 2; ++ai)
#pragma unroll
                for (int m = 0; m < 4; ++m) { const int row = row0 + ai * HALF + m * 16; const float s = rs ? rs[row] * sc : sc;
                    const f32x4 p0 = (acc[ai][0][m][0] * s) * (acc[ai][1][m][0] * s), p1 = (acc[ai][0][m][1] * s) * (acc[ai][1][m][1] * s); v4u w;
                    w.x = cvt_pk_bf16(p0[0], p0[1]); w.y = cvt_pk_bf16(p0[2], p0[3]); w.z = cvt_pk_bf16(p1[0], p1[1]); w.w = cvt_pk_bf16(p1[2], p1[3]);
                    *(v4u*)(O + (size_t)row * ldc + col) = w; }
            return; }
        const int col0 = (uprod && u.pn >= 12 ? u.pn * BM - 1024 : u.pn * BM) + wc * 64 + 16 * fq;
#pragma unroll
        for (int ai = 0; ai < 2; ++ai)
#pragma unroll
            for (int m = 0; m < 4; ++m) { const int row = row0 + ai * HALF + m * 16; const float s = rs ? rs[row] * sc : sc; bf16* rowp = O + (size_t)row * ldc + col0;
#pragma unroll
                for (int bj = 0; bj < 2; ++bj) { const f32x4 v0 = acc[ai][bj][m][0] * s, v1 = acc[ai][bj][m][1] * s; v4u w;
                    w.x = cvt_pk_bf16(v0[0], v0[1]); w.y = cvt_pk_bf16(v0[2], v0[3]); w.z = cvt_pk_bf16(v1[0], v1[1]); w.w = cvt_pk_bf16(v1[2], v1[3]);
                    if (NTS) __builtin_nontemporal_store(w, (v4u*)(rowp + bj * 8)); else *(v4u*)(rowp + bj * 8) = w; } }
    }
};
struct EpiF8 {
    static constexpr bool PERM = true, AFTER_DRAIN = false;
    unsigned char* O; int ldc; float sc;
    __device__ __forceinline__ void operator()(const Acc& acc, const Unit& u, int wr, int wc, int fr, int fq) const {
        const int row0 = u.pm * BM + wr * 64 + fr, col0 = u.pn * BM + wc * 64 + 16 * fq;
#pragma unroll
        for (int ai = 0; ai < 2; ++ai)
#pragma unroll
            for (int m = 0; m < 4; ++m) { const int row = row0 + ai * HALF + m * 16; v2u f8[2];
#pragma unroll
                for (int bj = 0; bj < 2; ++bj) { float o[8];
#pragma unroll
                    for (int n = 0; n < 2; ++n)
#pragma unroll
                        for (int i = 0; i < 4; ++i) o[n * 4 + i] = acc[ai][bj][m][n][i];
                    f8[bj] = pack8_f8(o, sc); }
                *(v4u*)(O + (size_t)row * ldc + col0) = (v4u){f8[0].x, f8[0].y, f8[1].x, f8[1].y}; }
    }
};
struct EpiH1 {
    static constexpr bool PERM = true, AFTER_DRAIN = false;
    const bf16* xb; const float* rms; bf16* h1; float* ssp; unsigned char* h18; float sc;
    __device__ __forceinline__ void operator()(const Acc& acc, const Unit& u, int wr, int wc, int fr, int fq) const {
        const int row0 = u.pm * BM + wr * 64 + fr, col0 = u.pn * BM + wc * 64 + 16 * fq;
        v4u xv[8][2]; float rm[8];
#define H1_LOAD(g_) do { const size_t off_ = (size_t)(row0 + ((g_) >> 2) * HALF + ((g_) & 3) * 16) * D + col0; xv[g_][0] = *(const v4u*)(xb + off_); xv[g_][1] = *(const v4u*)(xb + off_ + 8); } while (0)
#pragma unroll
        for (int gi = 0; gi < 8; ++gi) { rm[gi] = rms[row0 + (gi >> 2) * HALF + (gi & 3) * 16]; H1_LOAD(gi); }
        asm volatile("" ::: "memory");
#pragma unroll
        for (int gi = 0; gi < 8; ++gi) { const int ai = gi >> 2, m = gi & 3;
            const int row = row0 + ai * HALF + m * 16; const size_t off = (size_t)row * D + col0; float ss = 0.f; const float r = rm[gi]; v2u f8[2];
#pragma unroll
            for (int bj = 0; bj < 2; ++bj) { float xf[8]; unpack8(xv[gi][bj], xf); float o[8];
#pragma unroll
                for (int n = 0; n < 2; ++n)
#pragma unroll
                    for (int i = 0; i < 4; ++i) { o[n * 4 + i] = xf[n * 4 + i] * r + acc[ai][bj][m][n][i] * sc; ss += o[n * 4 + i] * o[n * 4 + i]; }
                v4u w; w.x = cvt_pk_bf16(o[0], o[1]); w.y = cvt_pk_bf16(o[2], o[3]); w.z = cvt_pk_bf16(o[4], o[5]); w.w = cvt_pk_bf16(o[6], o[7]);
                *(v4u*)(h1 + off + bj * 8) = w; if (h18) f8[bj] = pack8_f8(o, F8_ASCALE); }
            if (h18) *(v4u*)(h18 + off) = (v4u){f8[0].x, f8[0].y, f8[1].x, f8[1].y};
            ss += __shfl_xor(ss, 16); ss = xsum32(ss);
            if (fq == 0) ssp[(size_t)row * 32 + u.pn * 4 + wc] = ss; }
#undef H1_LOAD
    }
};
struct EpiRouter {
    static constexpr bool PERM = false, AFTER_DRAIN = true;
    const float* ssp; const float* bg; const float* br; float* rs1; int* eid; float* ew; Ent* ent; unsigned* cnt;
    __device__ __forceinline__ void fused(const Acc& acc, const Unit& u, int wr, int wc, int fr, int fq, LAS unsigned char* lds, int wid, int lane) const {
        LAS float* LG = (LAS float*)lds;
        LAS unsigned* HIST = (LAS unsigned*)(lds + 65536);
        LAS unsigned* BASE = (LAS unsigned*)(lds + 65536 + 256);
        const int tid = wid * 64 + lane;
        if (tid < 64) HIST[tid] = 0u;
        if (wc < 2) {
#pragma unroll
            for (int ai = 0; ai < 2; ++ai)
#pragma unroll
                for (int m = 0; m < 4; ++m) { const int r = ai * HALF + wr * 64 + m * 16 + fr;
#pragma unroll
                    for (int n = 0; n < 2; ++n) { const int c = wc * 32 + 16 * n + 4 * fq; if (c < 40) *(LAS f32x4*)(LG + r * 40 + c) = acc[ai][0][m][n]; } }
        }
        __syncthreads();
        int l0 = 0, l1 = 0; unsigned k0 = 0, k1 = 0; float w0 = 0.f, w1 = 0.f, rs = 0.f; const int row = u.pm * BM + tid;
        if (tid < 256) {
            float ss = 0.f;
#pragma unroll
            for (int j = 0; j < 8; ++j) { const f32x4 p = *(const f32x4*)(ssp + (size_t)row * 32 + 4 * j); ss += (p[0] + p[1]) + (p[2] + p[3]); }
            rs = 1.0f / sqrtf(ss * (1.0f / D) + EPS);
            const LAS float* L = LG + tid * 40;
            float gl[NGRP]; int g = 0;
#pragma unroll
            for (int j = 0; j < NGRP; ++j) gl[j] = L[j] * rs + bg[j];
            float gm = gl[0];
#pragma unroll
            for (int j = 1; j < NGRP; ++j) if (gl[j] > gm) { gm = gl[j]; g = j; }
            float gsum = 0.f;
#pragma unroll
            for (int j = 0; j < NGRP; ++j) gsum += __expf(gl[j] - gm);
            const float gw = 1.0f / gsum;
            const LAS float* E = L + NGRP + g * EPG; const float* be = br + g * EPG;
            int i1 = 0; float v1 = E[0] * rs + be[0];
            for (int j = 1; j < EPG; ++j) { const float v = E[j] * rs + be[j]; if (v > v1) { v1 = v; i1 = j; } }
            int i2 = 0; float v2 = -3.0e38f;
            for (int j = 0; j < EPG; ++j) { const float v = E[j] * rs + be[j]; if (j != i1 && v > v2) { v2 = v; i2 = j; } }
            const float e2 = __expf(v2 - v1); w0 = gw / (1.0f + e2); w1 = gw * e2 / (1.0f + e2);
            l0 = g * EPG + i1; l1 = NE + g * EPG + i2;
            eid[row * 2] = l0; eid[row * 2 + 1] = l1 - NE; ew[row * 2] = w0; ew[row * 2 + 1] = w1; rs1[row] = rs;
            k0 = __hip_atomic_fetch_add(HIST + l0, 1u, __ATOMIC_RELAXED, __HIP_MEMORY_SCOPE_WORKGROUP); k1 = __hip_atomic_fetch_add(HIST + l1, 1u, __ATOMIC_RELAXED, __HIP_MEMORY_SCOPE_WORKGROUP);
        }
        __syncthreads();
        if (tid < 64) { const unsigned n = HIST[tid]; BASE[tid] = n ? __hip_atomic_fetch_add(cnt + 64 * tid, n, __ATOMIC_RELAXED, __HIP_MEMORY_SCOPE_AGENT) : 0u; }
        __syncthreads();
        if (tid < 256) {
            *(v4u*)(ent + (size_t)l0 * LCAP + BASE[l0] + k0) = (v4u){(unsigned)row, __float_as_uint(w0), __float_as_uint(rs), 0u};
            *(v4u*)(ent + (size_t)l1 * LCAP + BASE[l1] + k1) = (v4u){(unsigned)row, __float_as_uint(w1), __float_as_uint(rs), 0u};
        }
    }
};
struct EpiGU {
    static constexpr bool PERM = true, AFTER_DRAIN = false;
    bf16* hid; LAS unsigned char* ldsx; float sc; unsigned char* hid8;
    __device__ __forceinline__ void operator()(const Acc& acc, const Unit& u, int wr, int wc, int fr, int fq) const {
        const int col0 = u.pn * HALF + wc * 32 + 8 * fq;
#pragma unroll
        for (int ai = 0; ai < 2; ++ai)
#pragma unroll
            for (int m = 0; m < 4; ++m) { const int r = ai * HALF + wr * 64 + m * 16 + fr; const LAS Ent* e = TAB_ENT(ldsx, u.par, r); const float w = e->w, rs = e->rs * sc;
                float o[8];
#pragma unroll
                for (int n = 0; n < 2; ++n)
#pragma unroll
                    for (int i = 0; i < 4; ++i) { const float gg = acc[ai][0][m][n][i] * rs, uu = acc[ai][1][m][n][i] * rs; o[n * 4 + i] = w * (gg * __builtin_amdgcn_rcpf(1.0f + __expf(-gg))) * uu; }
                if (hid8) { *(v2u*)(hid8 + (size_t)(u.pm * BM + r) * DEXP + col0) = pack8_f8(o, F8_HSCALE); }
                else { v4u q; q.x = cvt_pk_bf16(o[0], o[1]); q.y = cvt_pk_bf16(o[2], o[3]); q.z = cvt_pk_bf16(o[4], o[5]); q.w = cvt_pk_bf16(o[6], o[7]);
                    *(v4u*)(hid + (size_t)(u.pm * BM + r) * DEXP + col0) = q; } }
    }
};
template <int KK> struct EpiDown;
template <> struct EpiDown<0> {
    static constexpr bool PERM = true, AFTER_DRAIN = false;
    unsigned char* y8; LAS unsigned char* ldsx; float sc;
    __device__ __forceinline__ void operator()(const Acc& acc, const Unit& u, int wr, int wc, int fr, int fq) const {
        const int col0 = u.pn * BM + wc * 64 + 16 * fq; const float s64 = sc * F8_YSCALE;
#pragma unroll
        for (int gi = 0; gi < 8; ++gi) { const int ai = gi >> 2, m = gi & 3;
            const int r = ai * HALF + wr * 64 + m * 16 + fr; const bool valid = (u.rk0 + r) < u.nl; const int tok = TAB_ENT(ldsx, u.par, r)->tok; v2u f8[2];
#pragma unroll
            for (int bj = 0; bj < 2; ++bj) { float o[8];
#pragma unroll
                for (int n = 0; n < 2; ++n)
#pragma unroll
                    for (int i = 0; i < 4; ++i) o[n * 4 + i] = acc[ai][bj][m][n][i];
                f8[bj] = pack8_f8(o, s64); }
            if (valid) *(v4u*)(y8 + (size_t)tok * D + col0) = (v4u){f8[0].x, f8[0].y, f8[1].x, f8[1].y}; }
    }
};
template <> struct EpiDown<1> {
    static constexpr bool PERM = true, AFTER_DRAIN = false;
    const bf16* base; bf16* h2; float* ssp; LAS unsigned char* ldsx; unsigned char* h28; float sc;
    __device__ __forceinline__ void operator()(const Acc& acc, const Unit& u, int wr, int wc, int fr, int fq) const {
        const int col0 = u.pn * BM + wc * 64 + 16 * fq;
#pragma unroll
        for (int hb = 0; hb < 2; ++hb) {
            v4u bv[4][2], yv[4]; int tk[4];
#pragma unroll
            for (int q = 0; q < 4; ++q) { const int gi = hb * 4 + q; tk[q] = TAB_ENT(ldsx, u.par, (gi >> 2) * HALF + wr * 64 + (gi & 3) * 16 + fr)->tok; const size_t off_ = (size_t)tk[q] * D + col0;
                bv[q][0] = *(const v4u*)(base + off_); bv[q][1] = *(const v4u*)(base + off_ + 8); yv[q] = *(const v4u*)(h28 + off_); }
            asm volatile("" ::: "memory");
#pragma unroll
            for (int q = 0; q < 4; ++q) { const int gi = hb * 4 + q, ai = gi >> 2, m = gi & 3;
                const int r = ai * HALF + wr * 64 + m * 16 + fr; const bool valid = (u.rk0 + r) < u.nl; const int tok = tk[q]; const size_t off = (size_t)tok * D + col0; float ss = 0.f; v2u f8[2];
                const unsigned yw[4] = {yv[q].x, yv[q].y, yv[q].z, yv[q].w};
#pragma unroll
                for (int bj = 0; bj < 2; ++bj) { float b[8]; unpack8(bv[q][bj], b); float o[8];
#pragma unroll
                    for (int n = 0; n < 2; ++n) { const unsigned w = yw[bj * 2 + n];
                        const float y0 = __builtin_amdgcn_cvt_f32_fp8((int)w, 0), y1 = __builtin_amdgcn_cvt_f32_fp8((int)w, 1), y2 = __builtin_amdgcn_cvt_f32_fp8((int)w, 2), y3 = __builtin_amdgcn_cvt_f32_fp8((int)w, 3);
                        const float yy[4] = {y0, y1, y2, y3};
#pragma unroll
                        for (int i = 0; i < 4; ++i) { o[n * 4 + i] = b[n * 4 + i] + yy[i] * F8_YINV + acc[ai][bj][m][n][i] * sc; ss += o[n * 4 + i] * o[n * 4 + i]; } }
                    v4u qv; qv.x = cvt_pk_bf16(o[0], o[1]); qv.y = cvt_pk_bf16(o[2], o[3]); qv.z = cvt_pk_bf16(o[4], o[5]); qv.w = cvt_pk_bf16(o[6], o[7]);
                    if (valid) *(v4u*)(h2 + off + bj * 8) = qv;
                    f8[bj] = pack8_f8(o, F8_ASCALE); }
                if (valid) *(v4u*)(h28 + off) = (v4u){f8[0].x, f8[0].y, f8[1].x, f8[1].y};
                ss += __shfl_xor(ss, 16); ss = xsum32(ss); if (fq == 0 && valid) ssp[(size_t)tok * 32 + u.pn * 4 + wc] = ss; }
            asm volatile("" ::: "memory"); }
    }
};
template <int MODE> struct EpiDownProbe {
    static constexpr bool PERM = true, AFTER_DRAIN = false;
    const bf16* base; bf16* h2; LAS unsigned char* ldsx; float sc;
    __device__ __forceinline__ void operator()(const Acc& acc, const Unit& u, int wr, int wc, int fr, int fq) const {
        const int col0 = u.pn * BM + wc * 64 + 16 * fq;
        v4u bv[8][2]; int tk[8];
#pragma unroll
        for (int gi = 0; gi < 8; ++gi) { tk[gi] = TAB_ENT(ldsx, u.par, (gi >> 2) * HALF + wr * 64 + (gi & 3) * 16 + fr)->tok; const size_t off_ = (size_t)tk[gi] * D + col0;
            if (MODE == 0) { bv[gi][0] = *(const v4u*)(base + off_); bv[gi][1] = *(const v4u*)(base + off_ + 8); } else { bv[gi][0] = (v4u){0u, 0u, 0u, 0u}; bv[gi][1] = (v4u){0u, 0u, 0u, 0u}; } }
        asm volatile("" ::: "memory");
#pragma unroll
        for (int gi = 0; gi < 8; ++gi) { const int ai = gi >> 2, m = gi & 3;
            const int r = ai * HALF + wr * 64 + m * 16 + fr; const bool valid = (u.rk0 + r) < u.nl; const size_t off = (size_t)tk[gi] * D + col0;
#pragma unroll
            for (int bj = 0; bj < 2; ++bj) { float b[8]; unpack8(bv[gi][bj], b); float o[8];
#pragma unroll
                for (int n = 0; n < 2; ++n)
#pragma unroll
                    for (int i = 0; i < 4; ++i) o[n * 4 + i] = b[n * 4 + i] + acc[ai][bj][m][n][i] * sc;
                v4u q; q.x = cvt_pk_bf16(o[0], o[1]); q.y = cvt_pk_bf16(o[2], o[3]); q.z = cvt_pk_bf16(o[4], o[5]); q.w = cvt_pk_bf16(o[6], o[7]);
                if (MODE == 2) { if (gi > 0) asm volatile("" :: "v"(q)); }
                if (valid && (MODE < 2 || gi == 0)) *(v4u*)(h2 + off + bj * 8) = q; } }
    }
};
struct EpiFinal {
    static constexpr bool PERM = true, AFTER_DRAIN = false;
    const bf16* h2; const unsigned char* pw8; float* out; LAS unsigned char* ldsx; float sc; bool pre;
    __device__ __forceinline__ void operator()(const Acc& acc, const Unit& u, int wr, int wc, int fr, int fq) const {
        const int col0 = u.pn * BM + wc * 64 + 16 * fq;
        v4u hv[2][2], pv[2];
#define FN_LOAD(g_, buf) do { const size_t off_ = (size_t)(u.pm * BM + ((g_) >> 2) * HALF + wr * 64 + ((g_) & 3) * 16 + fr) * D + col0; \
            hv[buf][0] = *(const v4u*)(h2 + off_); hv[buf][1] = *(const v4u*)(h2 + off_ + 8); pv[buf] = *(const v4u*)(pw8 + off_); } while (0)
#pragma unroll
        for (int half_ = 0; half_ < 4; ++half_) {
#pragma unroll
            for (int q = 0; q < 2; ++q) FN_LOAD(half_ * 2 + q, q);
            asm volatile("" ::: "memory");
#pragma unroll
            for (int q = 0; q < 2; ++q) { const int gi = half_ * 2 + q, ai = gi >> 2, m = gi & 3;
                const int r = ai * HALF + wr * 64 + m * 16 + fr; const float rs = (pre ? ((const LAS float*)(ldsx + TAB_OFF))[u.lst * 256 + r] : TAB_ENT(ldsx, u.par, r)->rs) * sc; const size_t off = (size_t)(u.pm * BM + r) * D + col0;
                const unsigned pwd[4] = {pv[q].x, pv[q].y, pv[q].z, pv[q].w};
#pragma unroll
                for (int bj = 0; bj < 2; ++bj) { float hf[8]; unpack8(hv[q][bj], hf);
#pragma unroll
                    for (int n = 0; n < 2; ++n) { const f32x4 z = acc[ai][bj][m][n] * rs; f32x4 o; const int w = (int)pwd[bj * 2 + n];
                        const float pf[4] = {__builtin_amdgcn_cvt_f32_fp8(w, 0), __builtin_amdgcn_cvt_f32_fp8(w, 1), __builtin_amdgcn_cvt_f32_fp8(w, 2), __builtin_amdgcn_cvt_f32_fp8(w, 3)};
#pragma unroll
                        for (int i = 0; i < 4; ++i) o[i] = hf[n * 4 + i] + (pf[i] * F8_PINV) * __builtin_amdgcn_rcpf(1.0f + __expf(-z[i]));
                        *(f32x4*)(out + off + bj * 8 + n * 4) = o; } } }
            asm volatile("" ::: "memory"); }
#undef FN_LOAD
    }
};

template <int MODE> struct EpiFinalProbe {
    static constexpr bool PERM = true, AFTER_DRAIN = false;
    const bf16* h2; const unsigned char* pw8; float* out; LAS unsigned char* ldsx; float sc;
    __device__ __forceinline__ void operator()(const Acc& acc, const Unit& u, int wr, int wc, int fr, int fq) const {
        const int col0 = u.pn * BM + wc * 64 + 16 * fq;
        v4u hv[2][2], pv[2];
#pragma unroll
        for (int half_ = 0; half_ < 4; ++half_) {
#pragma unroll
            for (int q = 0; q < 2; ++q) { const int g_ = half_ * 2 + q; const size_t off_ = (size_t)(u.pm * BM + (g_ >> 2) * HALF + wr * 64 + (g_ & 3) * 16 + fr) * D + col0;
                if (MODE == 0 || MODE == 3) { hv[q][0] = *(const v4u*)(h2 + off_); hv[q][1] = *(const v4u*)(h2 + off_ + 8); pv[q] = *(const v4u*)(pw8 + off_); }
                else { hv[q][0] = (v4u){0u, 0u, 0u, 0u}; hv[q][1] = hv[q][0]; pv[q] = hv[q][0]; } }
            asm volatile("" ::: "memory");
#pragma unroll
            for (int q = 0; q < 2; ++q) { const int gi = half_ * 2 + q, ai = gi >> 2, m = gi & 3;
                const int r = ai * HALF + wr * 64 + m * 16 + fr; const float rs = TAB_ENT(ldsx, u.par, r)->rs * sc; const size_t off = (size_t)(u.pm * BM + r) * 1024 + (col0 & 1023);
                const unsigned pwd[4] = {pv[q].x, pv[q].y, pv[q].z, pv[q].w};
#pragma unroll
                for (int bj = 0; bj < 2; ++bj) { float hf[8]; unpack8(hv[q][bj], hf);
#pragma unroll
                    for (int n = 0; n < 2; ++n) { const f32x4 z = acc[ai][bj][m][n] * rs; f32x4 o; const int w = (int)pwd[bj * 2 + n];
                        const float pf[4] = {__builtin_amdgcn_cvt_f32_fp8(w, 0), __builtin_amdgcn_cvt_f32_fp8(w, 1), __builtin_amdgcn_cvt_f32_fp8(w, 2), __builtin_amdgcn_cvt_f32_fp8(w, 3)};
#pragma unroll
                        for (int i = 0; i < 4; ++i) o[i] = (MODE == 3) ? hf[n * 4 + i] + (pf[i] * F8_PINV) * z[i] : hf[n * 4 + i] + (pf[i] * F8_PINV) * __builtin_amdgcn_rcpf(1.0f + __expf(-z[i]));
                        if (MODE == 2 && gi > 0) { asm volatile("" :: "v"(o)); } else *(f32x4*)(out + off + bj * 8 + n * 4) = o; } } }
            asm volatile("" ::: "memory"); }
    }
};
template <int MODE> struct EpiBf16Probe {
    static constexpr bool PERM = true, AFTER_DRAIN = false;
    bf16* O; int ldc;
    __device__ __forceinline__ void operator()(const Acc& acc, const Unit& u, int wr, int wc, int fr, int fq) const {
        const int row0 = u.pm * BM + wr * 64 + fr, col0 = u.pn * BM + wc * 64 + 16 * fq;
#pragma unroll
        for (int ai = 0; ai < 2; ++ai)
#pragma unroll
            for (int m = 0; m < 4; ++m) { const int row = row0 + ai * HALF + m * 16; bf16* rowp = O + (size_t)row * ldc + col0;
#pragma unroll
                for (int bj = 0; bj < 2; ++bj) { const f32x4 v0 = acc[ai][bj][m][0], v1 = acc[ai][bj][m][1]; v4u w;
                    w.x = cvt_pk_bf16(v0[0], v0[1]); w.y = cvt_pk_bf16(v0[2], v0[3]); w.z = cvt_pk_bf16(v1[0], v1[1]); w.w = cvt_pk_bf16(v1[2], v1[3]);
                    if (MODE == 1 && (ai || m)) { asm volatile("" :: "v"(w)); } else *(v4u*)(rowp + bj * 8) = w; } }
    }
};
template <bool GATHER_, int NPN> struct MoeOrder {
    static constexpr bool GATHER = GATHER_, MID = false;
    LAS unsigned char* ldsx; const Ent* ent; int tlo, thi, G, c, wave; const Ent* zero;
    CvtWork w{}; int slot = -1;
    int xm = 0; unsigned* tsig = nullptr; unsigned* twait = nullptr;
    __device__ __forceinline__ int nunits() const { const int nun = (thi - tlo) * NPN; return c < nun ? (nun - 1 - c) / G + 1 : 0; }
    __device__ __forceinline__ bool next(int i, Unit& u) const {
        int tile, pn_;
        if (xm) { const int x = c >> 5, j = c & 31;
            if (NPN == 4) { tile = tlo + 64 * i + 8 * (j >> 2) + x; pn_ = j & 3; } else { const int l = 32 * i + (31 - j); tile = tlo + 8 * (l >> 3) + x; pn_ = l & 7; }
            if (tile >= thi) return false; }
        else { const long L = (long)i * G + c; const int nun = (thi - tlo) * NPN; if (L >= nun) return false; tile = tlo + (int)(L / NPN); pn_ = (int)(L % NPN); }
        const LAS int* T0 = (const LAS int*)(ldsx + LST_OFF + 256);
        int l = 0;
        for (int j = 1; j < NLIST; ++j) l += (T0[j] <= tile) ? 1 : 0;
        l = __builtin_amdgcn_readfirstlane(l);
        u.pm = tile; u.pn = pn_; u.bt = (l & (NE - 1)) * NPN + u.pn; u.par = i & 1; u.lst = l; u.rk0 = (tile - __builtin_amdgcn_readfirstlane(T0[l])) * BM; u.nl = __builtin_amdgcn_readfirstlane(((const LAS int*)(ldsx + LST_OFF))[l]);
        return true;
    }
    __device__ __forceinline__ void a_prefetch(const Unit& u) const {
        if (wave < 4) { const int tid = TIDX(wave); const int rk = u.rk0 + tid; const Ent* src = rk < u.nl ? ent + (size_t)u.lst * LCAP + rk : zero;
            __builtin_amdgcn_global_load_lds((const unsigned*)src, (LAS unsigned*)(ldsx + TAB_OFF + u.par * 4096 + wave * 1024), 16, 0, 0); }
    }
    __device__ __forceinline__ void a_first() const { asm volatile("s_waitcnt vmcnt(0)" ::: "memory"); __builtin_amdgcn_s_barrier(); asm volatile("" ::: "memory"); }
    __device__ __forceinline__ void a_ready(const Unit& u) const {
        if (twait) { unsigned sp = 0; while (__hip_atomic_load(twait + u.pm, __ATOMIC_RELAXED, __HIP_MEMORY_SCOPE_AGENT) < 4u) { __builtin_amdgcn_s_sleep(1); if (++sp > (1u << 22)) break; } asm volatile("" ::: "memory"); } }
    __device__ __forceinline__ void done(const Unit&) const {}
    __device__ __forceinline__ void between(int ui, int wid) const { if (GATHER_ && ui == slot) w.run(wid, CvtWork::NGU, CvtWork::NIT); }
    __device__ __forceinline__ void signal(int tile) const { if (tsig && TIDX(wave) == 0) (void)__hip_atomic_fetch_add(tsig + tile, 1u, __ATOMIC_RELAXED, __HIP_MEMORY_SCOPE_AGENT); }
};
struct FinalOrder : StaticOrder {
    LAS unsigned char* ldsx; const float* ssp; int wave; bool pre;
    __device__ __forceinline__ bool next(int i, Unit& u) const { const bool ok = StaticOrder::next(i, u); u.lst = i; return ok; }
    __device__ __forceinline__ void a_prefetch(const Unit&) const {}
    __device__ __forceinline__ void a_first() const {}
    __device__ __forceinline__ void fill_all() const {
        const int tid = TIDX(wave), r = tid & 255;
#pragma unroll 1
        for (int i = tid >> 8; i < 8; i += 2) { Unit u; if (!next(i, u)) break; const int row = u.pm * BM + r; float ss = 0.f;
#pragma unroll
            for (int j = 0; j < 8; ++j) { const f32x4 p = *(const f32x4*)(ssp + (size_t)row * 32 + 4 * j); ss += (p[0] + p[1]) + (p[2] + p[3]); }
            ((LAS float*)(ldsx + TAB_OFF))[i * 256 + r] = 1.0f / sqrtf(ss * (1.0f / D) + EPS); }
        __syncthreads();
    }
    __device__ __forceinline__ void a_ready(const Unit& u) const {
        if (pre) return;
        const int tid = TIDX(wave);
        if (tid < 256) { const int row = u.pm * BM + tid; float ss = 0.f;
#pragma unroll
            for (int j = 0; j < 8; ++j) { const f32x4 p = *(const f32x4*)(ssp + (size_t)row * 32 + 4 * j); ss += (p[0] + p[1]) + (p[2] + p[3]); }
            *(LAS v4u*)(ldsx + TAB_OFF + u.par * 4096 + tid * 16) = (v4u){(unsigned)row, 0u, __float_as_uint(1.0f / sqrtf(ss * (1.0f / D) + EPS)), 0u}; }
    }
};
}
#define RLX_AGENT __ATOMIC_RELAXED, __HIP_MEMORY_SCOPE_AGENT
#define XB_TMO      128
#define XB_XCNT(j)  (256  + 64 * (j))
#define XB_XSUB(j)  (1280 + 64 * (j))
#define XB_XGEN(j)  (2304 + 64 * (j))
#define XB_TOP      3328
#define XB_TOPGEN   3392
#define XCD_BAR_WORDS 3456
#define XB_SPIN_CAP (1u << 18)

__device__ __forceinline__ unsigned xb_ld(unsigned* p)              { return __hip_atomic_load(p, __ATOMIC_RELAXED, __HIP_MEMORY_SCOPE_AGENT); }
__device__ __forceinline__ unsigned xb_add(unsigned* p, unsigned v) { return __hip_atomic_fetch_add(p, v, __ATOMIC_RELAXED, __HIP_MEMORY_SCOPE_AGENT); }
__device__ __forceinline__ unsigned xb_xcc_id() { return (unsigned)__builtin_amdgcn_s_getreg((3 << 11) | 20) & 0xFu; }
#define XB_SPIN(cond, bar) do { unsigned _sp = 0; while (cond) { __builtin_amdgcn_s_sleep(1); \
    if ((++_sp & 255u) == 0u) { if (xb_ld(&(bar)[XB_TMO])) break; if (_sp > XB_SPIN_CAP) { atomicAdd(&(bar)[XB_TMO], 1u); break; } } } } while (0)

struct XcdBarrier {
    unsigned* bar; unsigned x;
    volatile LAS unsigned* st;
};
__device__ __forceinline__ XcdBarrier xcd_barrier_post(unsigned* bar, volatile LAS unsigned* st, const int wave_) {
    XcdBarrier b; b.bar = bar; b.x = xb_xcc_id(); b.st = st;
    if (TIDX(wave_) == 0) (void)xb_add(&bar[XB_XCNT(b.x)], 1u);
    return b;
}
__device__ __forceinline__ void xcd_barrier_complete(unsigned* bar, unsigned x, unsigned& nloc, unsigned& nx) {
    const unsigned G = gridDim.x * gridDim.y * gridDim.z;
    unsigned sum, cnt, mine, sp = 0u;
    for (;;) {
        sum = 0u; cnt = 0u; mine = 0u;
#pragma unroll
        for (unsigned j = 0; j < 16; ++j) { const unsigned c = xb_ld(&bar[XB_XCNT(j)]); sum += c; cnt += (c > 0u) ? 1u : 0u; mine = (j == x) ? c : mine; }
        if (sum == G) break;
        __builtin_amdgcn_s_sleep(1);
        if ((++sp & 255u) == 0u) { if (xb_ld(&bar[XB_TMO])) break; if (sp > XB_SPIN_CAP) { atomicAdd(&bar[XB_TMO], 1u); break; } }
    }
    nloc = mine > 0u ? mine : 1u; nx = cnt > 0u ? cnt : 1u;
}
__device__ __forceinline__ void xcd_barrier(const XcdBarrier& b, const int wave_) {
    asm volatile("s_waitcnt vmcnt(0)" ::: "memory");
    __syncthreads();
    if (TIDX(wave_) == 0) {
        unsigned* bar = b.bar;
        __builtin_amdgcn_s_waitcnt(0);
        unsigned nloc = b.st[0], nx = b.st[1];
        if (nloc == 0u) { xcd_barrier_complete(bar, b.x, nloc, nx); b.st[0] = nloc; b.st[1] = nx; }
        const unsigned old = xb_add(&bar[XB_XSUB(b.x)], 1u);
        const unsigned gen = old / nloc;
        if (old + 1u == (gen + 1u) * nloc) {
            __builtin_amdgcn_fence(__ATOMIC_RELEASE, "agent");
            asm volatile("s_waitcnt vmcnt(0)" ::: "memory");
            const unsigned og = xb_add(&bar[XB_TOP], 1u);
            const unsigned tg = og / nx;
            if (og + 1u == (tg + 1u) * nx) xb_add(&bar[XB_TOPGEN], 1u);
            else XB_SPIN(xb_ld(&bar[XB_TOPGEN]) == tg, bar);
            __builtin_amdgcn_fence(__ATOMIC_ACQUIRE, "agent");
            xb_add(&bar[XB_XGEN(b.x)], 1u);
            asm volatile("s_waitcnt vmcnt(0)" ::: "memory");
        } else {
            XB_SPIN(xb_ld(&bar[XB_XGEN(b.x)]) == gen, bar);
            __builtin_amdgcn_fence(__ATOMIC_ACQUIRE, "agent");
            asm volatile("s_waitcnt vmcnt(0)" ::: "memory");
        }
    }
    __syncthreads();
}

constexpr int NWAVES = 8;
__device__ __forceinline__ void p0_transpose_item(const float* W, int K, int N, const float* g0, const float* g1, int gsplit, bf16* WT, int rowbase, int k0, int n0, LAS float* scr, int lane, int rs8 = 8) {
    float v[32];
    const float* src = W + (size_t)(k0 + (lane >> 5)) * N + n0 + (lane & 31);
#pragma unroll
    for (int i = 0; i < 32; ++i) v[i] = __builtin_nontemporal_load(src + (size_t)(2 * i) * N);
    const int c = lane & 7;
    float gg[8];
#pragma unroll
    for (int j = 0; j < 8; ++j) { const int k = k0 + 8 * c + j; gg[j] = g0 ? (k < gsplit ? g0[k] : g1[k - gsplit]) : 1.f; }
#pragma unroll
    for (int i = 0; i < 32; ++i) scr[(2 * i + (lane >> 5)) * 33 + (lane & 31)] = v[i];
    asm volatile("s_waitcnt lgkmcnt(0)" ::: "memory");
#pragma unroll
    for (int j = 0; j < 4; ++j) { const int n = (lane >> 3) + 8 * j; const LAS float* s = scr + (8 * c) * 33 + n;
        v4u o; o.x = pk2(s[0 * 33] * gg[0], s[1 * 33] * gg[1]); o.y = pk2(s[2 * 33] * gg[2], s[3 * 33] * gg[3]); o.z = pk2(s[4 * 33] * gg[4], s[5 * 33] * gg[5]); o.w = pk2(s[6 * 33] * gg[6], s[7 * 33] * gg[7]);
        *(v4u*)(WT + (size_t)(rowbase + j * rs8 + (lane >> 3)) * K + k0 + 8 * c) = o; }
    asm volatile("s_waitcnt lgkmcnt(0)" ::: "memory");
}
__device__ __forceinline__ void p0_transpose_item8(const float* W, int K, int N, const float* g0, unsigned char* WT8, int rowbase, int k0, int n0, LAS float* scr, int lane, float sc, int rs8 = 8) {
    float v[32];
    const float* src = W + (size_t)(k0 + (lane >> 5)) * N + n0 + (lane & 31);
#pragma unroll
    for (int i = 0; i < 32; ++i) v[i] = __builtin_nontemporal_load(src + (size_t)(2 * i) * N);
    const int c = lane & 7;
    float gg[8];
#pragma unroll
    for (int j = 0; j < 8; ++j) gg[j] = (g0 ? g0[k0 + 8 * c + j] : 1.f) * sc;
#pragma unroll
    for (int i = 0; i < 32; ++i) scr[(2 * i + (lane >> 5)) * 33 + (lane & 31)] = v[i];
    asm volatile("s_waitcnt lgkmcnt(0)" ::: "memory");
#pragma unroll
    for (int j = 0; j < 4; ++j) { const int n = (lane >> 3) + 8 * j; const LAS float* s = scr + (8 * c) * 33 + n; float f[8];
#pragma unroll
        for (int q = 0; q < 8; ++q) f[q] = s[q * 33] * gg[q];
        *(v2u*)(WT8 + (size_t)(rowbase + j * rs8 + (lane >> 3)) * K + k0 + 8 * c) = pack8_f8(f, 1.0f); }
    asm volatile("s_waitcnt lgkmcnt(0)" ::: "memory");
}
__device__ __forceinline__ void p0_prologue(const Ptrs& P, LAS unsigned char* lds, int vcu, int G, const int wave) {
    const int lane = lane_id(), tid = wave * 64 + lane;
    unsigned char* ws = P.ws;
    LAS float* scr = (LAS float*)(lds + wave * 16384);
    const int gw = vcu * NWAVES + wave, NGW = G * NWAVES;
    constexpr int I_IN = (D / 64) * (DIN / 32), I_OUT = (D / 64) * (D / 32), I_PLG = I_OUT, I_PLE = (PLE / 64) * (D / 32), I_RT = (D / 64) * (NE / 32);
    constexpr int I_G1 = (D / 64) * (DEXP / 32), I_D1 = (DEXP / 64) * (D / 32);
    constexpr int NITEMS = I_IN + I_OUT + I_PLG + I_PLE + I_RT + (DEFER_CVT ? 0 : NE * (2 * I_G1 + I_D1));
    for (int it = gw; it < NITEMS; it += NGW) {
        int r = it;
        if (r < I_IN) { const int nb = DIN / 32; const int n0 = (r % nb) * 32, k0 = (r / nb) * 64;
            if (FP8QKV && n0 >= C_Q) p0_transpose_item8(P.w_in, D, DIN, P.norm_mix, ws + WS_WIN8, n0 - C_Q, k0, n0, scr, lane, F8_WSCALE);
            else if (UPROD && n0 >= C_C && n0 < C_Q) { const int isH = n0 >= C_HC ? 1 : 0, ch = n0 - (isH ? C_HC : C_C);
                p0_transpose_item(P.w_in, D, DIN, P.norm_mix, nullptr, D, (bf16*)(ws + WS_WIN), C_C + 256 * (ch >> 7) + 64 * ((ch & 127) >> 5) + 8 * isH, k0, n0, scr, lane, 16); }
            else p0_transpose_item(P.w_in, D, DIN, P.norm_mix, nullptr, D, (bf16*)(ws + WS_WIN), n0, k0, n0, scr, lane);
            continue; } r -= I_IN;
        if (r < I_OUT) { const int nb = D / 32; const int k0 = (r / nb) * 64;
            if (FP8O) p0_transpose_item8(P.w_out, D, D, k0 < DCONV ? P.onc : P.ona - DCONV, ws + WS_WOUT, (r % nb) * 32, k0, (r % nb) * 32, scr, lane, F8_WSCALE);
            else p0_transpose_item(P.w_out, D, D, P.onc, P.ona, DCONV, (bf16*)(ws + WS_WOUT), (r % nb) * 32, k0, (r % nb) * 32, scr, lane);
            continue; } r -= I_OUT;
        if (r < I_PLG) { const int nb = D / 32;
            if (FP8) p0_transpose_item8(P.w_ple_gate, D, D, P.norm_ple, ws + WS_WPLG, (r % nb) * 32, (r / nb) * 64, (r % nb) * 32, scr, lane, F8_WSCALE);
            else p0_transpose_item(P.w_ple_gate, D, D, P.norm_ple, nullptr, D, (bf16*)(ws + WS_WPLG), (r % nb) * 32, (r / nb) * 64, (r % nb) * 32, scr, lane);
            continue; } r -= I_PLG;
        if (r < I_PLE) { const int nb = D / 32; p0_transpose_item(P.w_ple, PLE, D, nullptr, nullptr, 0, (bf16*)(ws + WS_WPLE), (r % nb) * 32, (r / nb) * 64, (r % nb) * 32, scr, lane); continue; } r -= I_PLE;
        if (r < I_RT) { p0_transpose_item(P.w_router, D, NE, P.norm_ffn, nullptr, D, (bf16*)(ws + WS_WR), NGRP, r * 64, 0, scr, lane); continue; } r -= I_RT;
        const int e = r / (2 * I_G1 + I_D1); r -= e * (2 * I_G1 + I_D1);
        if (r < 2 * I_G1) { const int up = r >= I_G1; r -= up * I_G1; const int nb = DEXP / 32, n0 = (r % nb) * 32, k0 = (r / nb) * 64;
            if (FP8) p0_transpose_item8((up ? P.w_up : P.w_gate) + (size_t)e * D * DEXP, D, DEXP, P.norm_ffn, ws + WS_WGU + (size_t)e * 1024 * D, (n0 >> 7) * 256 + 2 * (n0 & 127) + up * 8, k0, n0, scr, lane, F8_WSCALE, 16);
            else p0_transpose_item((up ? P.w_up : P.w_gate) + (size_t)e * D * DEXP, D, DEXP, P.norm_ffn, nullptr, D, (bf16*)(ws + WS_WGU) + (size_t)e * 1024 * D, (n0 >> 7) * 256 + up * 128 + (n0 & 127), k0, n0, scr, lane);
            continue; }
        r -= 2 * I_G1; { const int nb = D / 32;
            if (FP8) p0_transpose_item8(P.w_down + (size_t)e * DEXP * D, DEXP, D, nullptr, ws + WS_WD + (size_t)e * D * DEXP, (r % nb) * 32, (r / nb) * 64, (r % nb) * 32, scr, lane, F8_DSCALE);
            else p0_transpose_item(P.w_down + (size_t)e * DEXP * D, DEXP, D, nullptr, nullptr, 0, (bf16*)(ws + WS_WD) + (size_t)e * D * DEXP, (r % nb) * 32, (r / nb) * 64, (r % nb) * 32, scr, lane); }
    }
    { bf16* Wr = (bf16*)(ws + WS_WR); const int gt = vcu * (NWAVES * 64) + tid, NT = G * NWAVES * 64;
      for (int i = gt; i < NGRP * D; i += NT) { const int n = i / D, k = i % D; Wr[(size_t)n * D + k] = f2bf(P.norm_ffn[k] * P.w_group[(size_t)k * NGRP + n]); }
      for (int i = gt; i < (256 - NRT) * D / 8; i += NT) *(v4u*)(Wr + (size_t)NRT * D + (size_t)i * 8) = (v4u){0u, 0u, 0u, 0u}; }
    for (int m = gw; m < M; m += NGW) {
        const f32x4* xr = (const f32x4*)(P.x + (size_t)m * D) + lane; f32x4 v[8]; float s = 0.f;
#pragma unroll
        for (int j = 0; j < 8; ++j) { v[j] = __builtin_nontemporal_load(xr + 64 * j); s += (v[j][0] * v[j][0] + v[j][1] * v[j][1]) + (v[j][2] * v[j][2] + v[j][3] * v[j][3]); }
        s = wsum(s);
        v2u* o8 = (v2u*)((bf16*)(ws + WS_XB) + (size_t)m * D) + lane;
        const float rstd = 1.0f / sqrtf(s * (1.0f / D) + EPS);
#pragma unroll
        for (int j = 0; j < 8; ++j) { v2u o; o.x = pk2(v[j][0] * rstd, v[j][1] * rstd); o.y = pk2(v[j][2] * rstd, v[j][3] * rstd); o8[64 * j] = o; }
        if (FP8QKV) { unsigned* o4 = (unsigned*)(ws + WS_XB8 + (size_t)m * D) + lane; const float r16 = rstd * F8_ASCALE;
#pragma unroll
            for (int j = 0; j < 8; ++j) { int w = 0; w = __builtin_amdgcn_cvt_pk_fp8_f32(v[j][0] * r16, v[j][1] * r16, w, false); w = __builtin_amdgcn_cvt_pk_fp8_f32(v[j][2] * r16, v[j][3] * r16, w, true); o4[64 * j] = (unsigned)w; } }
        if (lane == 0) { ((float*)(ws + WS_RSX))[m] = 1.0f; ((float*)(ws + WS_RMSX))[m] = sqrtf(s * (1.0f / D) + EPS); }
    }
    { const int gt = vcu * (NWAVES * 64) + tid, NT = G * NWAVES * 64; const f32x4* src = (const f32x4*)P.p; v4u* dst = (v4u*)(ws + WS_PB);
      for (int i = gt; i < M * PLE / 8; i += NT) { const f32x4 a = __builtin_nontemporal_load(src + 2 * i), b = __builtin_nontemporal_load(src + 2 * i + 1); v4u o; o.x = pk2(a[0], a[1]); o.y = pk2(a[2], a[3]); o.z = pk2(b[0], b[1]); o.w = pk2(b[2], b[3]); dst[i] = o; } }
}

#ifndef CONVR
#define CONVR 4
#endif
constexpr int P2_KS = 0, P2_KROW = 144, P2_VT = 36864, P2_VROW = 528, P2_OST = 70656, P2_OROW = 144, P2_SS = 107520, P2_RSTD = 108032, P2_QG = 108544;
__device__ __forceinline__ int crow(int r, int hi) { return (r & 3) + 8 * (r >> 2) + 4 * hi; }
__device__ __forceinline__ void p2_unit(const Ptrs& P, LAS unsigned char* lds, int unit, const int wid, const bool conv_first, const bool fixup) {
    int lane_ = lane_id_asm(); asm volatile("" : "+v"(lane_));
    const int lane = lane_ & 63, tid = wid * 64 + lane, l32 = lane & 31, hi = lane >> 5;
    const bf16* proj = (const bf16*)(P.ws + WS_PROJ); bf16* mixed = (bf16*)(P.ws + WS_MIX); unsigned char* mixed8 = P.ws + WS_MIX8;
    bf16* osc = FP8O ? (bf16*)(P.ws + WS_MIX + 64 * MiB) : mixed + DCONV; constexpr int OLD = FP8O ? DATTN : D;
    const int b = unit / (SEQ / 128), qb = unit % (SEQ / 128), q0 = qb * 128; const size_t rowbase = (size_t)b * SEQ;
    LAS float* rowss = (LAS float*)(lds + P2_SS); LAS float* qg = (LAS float*)(lds + P2_QG);
    __syncthreads();
    if (tid < 128) rowss[tid] = 0.f;
    if (tid < 64) qg[tid] = P.q_norm[tid] * (0.125f * LOG2E);
    if (conv_first) {
    {
        int lc_ = lane_id_asm(); asm volatile("" : "+v"(lc_)); const int lane = lc_ & 63;
        const float* cw = P.conv_w; float w0[16], w1[16], w2[16];
#pragma unroll
        for (int j = 0; j < 16; ++j) { const int ch = (j >> 3) * 512 + lane * 8 + (j & 7); w0[j] = cw[ch]; w1[j] = cw[DCONV + ch]; w2[j] = cw[2 * DCONV + ch]; }
        float u1[16], u2[16];
        const int t0 = q0 + 16 * wid;
#pragma unroll
        for (int j = 0; j < 16; ++j) { u1[j] = 0.f; u2[j] = 0.f; }
        if (t0 >= 2) {
#pragma unroll
            for (int hf = 0; hf < 2; ++hf) { const int ch = hf * 512 + lane * 8; float c[8], hc[8];
                const bf16* pr = proj + (rowbase + t0 - 1) * PP; unpack8(*(const v4u*)(pr + O_U + ch), c); if (!UPROD) unpack8(*(const v4u*)(pr + C_HC + ch), hc);
#pragma unroll
                for (int j = 0; j < 8; ++j) u1[hf * 8 + j] = UPROD ? c[j] : c[j] * hc[j];
                pr -= PP; unpack8(*(const v4u*)(pr + O_U + ch), c); if (!UPROD) unpack8(*(const v4u*)(pr + C_HC + ch), hc);
#pragma unroll
                for (int j = 0; j < 8; ++j) u2[hf * 8 + j] = UPROD ? c[j] : c[j] * hc[j]; }
        }
#pragma unroll 1
        for (int r0 = 0; r0 < 16; r0 += CONVR) {
            v4u rb[CONVR][2], rc[CONVR][2], rh[CONVR][2];
#pragma unroll
            for (int rr = 0; rr < CONVR; ++rr) { const bf16* pr = proj + (rowbase + t0 + r0 + rr) * PP + lane * 8;
#pragma unroll
                for (int hf = 0; hf < 2; ++hf) { rb[rr][hf] = __builtin_nontemporal_load((const v4u*)(pr + O_B + hf * 512)); rc[rr][hf] = __builtin_nontemporal_load((const v4u*)(pr + O_U + hf * 512)); if (!UPROD) rh[rr][hf] = __builtin_nontemporal_load((const v4u*)(pr + C_HC + hf * 512)); } }
#pragma unroll
            for (int rr = 0; rr < CONVR; ++rr) { float y[16]; float ss = 0.f;
#pragma unroll
                for (int hf = 0; hf < 2; ++hf) { float bb[8], c[8], hc[8]; unpack8(rb[rr][hf], bb); unpack8(rc[rr][hf], c); if (!UPROD) unpack8(rh[rr][hf], hc);
#pragma unroll
                    for (int j = 0; j < 8; ++j) { const int jj = hf * 8 + j; const float u0 = UPROD ? c[j] : c[j] * hc[j];
                        y[jj] = bb[j] * (w0[jj] * u2[jj] + w1[jj] * u1[jj] + w2[jj] * u0); ss += y[jj] * y[jj]; u2[jj] = u1[jj]; u1[jj] = u0; } }
                ss = wsum(ss); const float rs = rsqf(ss * (1.0f / DCONV) + EPS);
#pragma unroll
                for (int hf = 0; hf < 2; ++hf) { float f[8];
#pragma unroll
                    for (int j = 0; j < 8; ++j) f[j] = y[hf * 8 + j] * rs;
                    if (FP8O) *(v2u*)(mixed8 + (rowbase + t0 + r0 + rr) * D + hf * 512 + lane * 8) = pack8_f8(f, F8_ASCALE);
                    else *(v4u*)(mixed + (rowbase + t0 + r0 + rr) * D + hf * 512 + lane * 8) = pack8(f); } }
        }
    }
    }
    const int h4 = wid & 3, half = wid >> 2;
    const int part = tid & 7;
    float kg[8];
#pragma unroll
    for (int j = 0; j < 8; ++j) kg[j] = P.k_norm[part * 8 + j];
    v4u kraw[4], vraw[4], qraw[4];
    const int kvoff = (tid >> 3) * PP + part * 8, qoff = l32 * PP + 8 * hi;
#define P2_LOAD_KV(g_) do { _Pragma("unroll") for (int i = 0; i < 4; ++i) { kraw[i] = (v4u){0u, 0u, 0u, 0u}; vraw[i] = (v4u){0u, 0u, 0u, 0u}; \
        if (q0 > 0 || i >= 2) { const bf16* ub = proj + (rowbase + q0 - 128 + 64 * i) * PP + (g_) * HD; kraw[i] = *(const v4u*)(ub + O_K + kvoff); vraw[i] = *(const v4u*)(ub + O_V + kvoff); } } } while (0)
#define P2_LOAD_Q(g_, sub_) do { const bf16* ub = proj + (rowbase + q0 + 64 * half + 32 * (sub_)) * PP + O_Q + ((g_) * 4 + h4) * HD; \
        _Pragma("unroll") for (int d0 = 0; d0 < 4; ++d0) qraw[d0] = __builtin_nontemporal_load((const v4u*)(ub + 16 * d0 + qoff)); } while (0)
    P2_LOAD_KV(0); P2_LOAD_Q(0, 0);
#pragma unroll 1
    for (int g = 0; g < NKV; ++g) {
        int lg_ = lane_id_asm(); asm volatile("" : "+v"(lg_));
        const int lane = lg_ & 63, tid = wid * 64 + lane, l32 = lane & 31, hi = lane >> 5, part = tid & 7;
        const int kvoff = (tid >> 3) * PP + part * 8, qoff = l32 * PP + 8 * hi, ooffo = (lane >> 3) * OLD + (lane & 7) * 8;
        __syncthreads();
#pragma unroll
        for (int i = 0; i < 4; ++i) {
            const int key = (tid >> 3) + 64 * i;
            float kf[8]; unpack8(kraw[i], kf); float ss = 0.f;
#pragma unroll
            for (int j = 0; j < 8; ++j) ss += kf[j] * kf[j];
            ss += __shfl_xor(ss, 1); ss += __shfl_xor(ss, 2); ss += __shfl_xor(ss, 4);
            const float rk = rsqf(ss * (1.0f / HD) + EPS);
#pragma unroll
            for (int j = 0; j < 8; ++j) kf[j] = kf[j] * rk * kg[j];
            *(LAS v4u*)(lds + P2_KS + key * P2_KROW + part * 16) = pack8(kf);
            const int x = key & 15; const int pos = (key & ~15) + (x & 3) + ((x >> 3) & 1) * 4 + ((x >> 2) & 1) * 8;
            LAS bf16* vt = (LAS bf16*)(lds + P2_VT) + pos;
            const unsigned vw[4] = {vraw[i].x, vraw[i].y, vraw[i].z, vraw[i].w};
#pragma unroll
            for (int j = 0; j < 4; ++j) { vt[(part * 8 + 2 * j) * (P2_VROW / 2)] = (bf16)(vw[j] & 0xffffu); vt[(part * 8 + 2 * j + 1) * (P2_VROW / 2)] = (bf16)(vw[j] >> 16); }
        }
        if (g + 1 < NKV) { P2_LOAD_KV(g + 1); }
        __syncthreads();
        const int h = g * 4 + h4;
        const float slope2 = exp2f(-0.5f * (float)(h + 1)) * LOG2E, sink2 = P.sinks[h] * LOG2E;
#pragma unroll
        for (int sub = 0; sub < 2; ++sub) {
            const int qs = 64 * half + 32 * sub;
            const int kt0 = 2 * half + sub;
            bf16x8 qf[4];
            { float qv[4][8]; float ss = 0.f;
#pragma unroll
              for (int d0 = 0; d0 < 4; ++d0) { unpack8(qraw[d0], qv[d0]);
#pragma unroll
                  for (int j = 0; j < 8; ++j) ss += qv[d0][j] * qv[d0][j]; }
              ss = xsum32(ss);
              const float rq = rsqf(ss * (1.0f / HD) + EPS);
#pragma unroll
              for (int d0 = 0; d0 < 4; ++d0) {
#pragma unroll
                  for (int j = 0; j < 8; ++j) qv[d0][j] = qv[d0][j] * rq * qg[16 * d0 + 8 * hi + j];
                  const v4u w = pack8(qv[d0]); qf[d0] = __builtin_bit_cast(bf16x8, w); } }
            if (sub == 0) { P2_LOAD_Q(g, 1); } else if (g + 1 < NKV) { P2_LOAD_Q(g + 1, 0); }
            f32x16 sc[5];
#pragma unroll
            for (int jt = 0; jt < 5; ++jt) { sc[jt] = (f32x16){0.f, 0.f, 0.f, 0.f, 0.f, 0.f, 0.f, 0.f, 0.f, 0.f, 0.f, 0.f, 0.f, 0.f, 0.f, 0.f};
#pragma unroll
                for (int d0 = 0; d0 < 4; ++d0) { const bf16x8 kfr = *(const LAS bf16x8*)(lds + P2_KS + ((kt0 + jt) * 32 + l32) * P2_KROW + (16 * d0 + 8 * hi) * 2);
                    sc[jt] = __builtin_amdgcn_mfma_f32_32x32x16_bf16(kfr, qf[d0], sc[jt], 0, 0, 0); } }
            int bl = l32 - 4 * hi; asm volatile("" : "+v"(bl));
            const float ab = -slope2 * (float)bl;
            const f32x2_t ns2 = (f32x2_t){-slope2, -slope2};
#pragma unroll
            for (int jt = 0; jt < 5; ++jt)
#pragma unroll
                for (int r = 0; r < 16; r += 2) { const int c0 = 128 - 32 * jt - (r & 3) - 8 * (r >> 2), c1 = 128 - 32 * jt - ((r + 1) & 3) - 8 * ((r + 1) >> 2);
                    f32x2_t v = (f32x2_t){(float)c0, (float)c1} * ns2 + (f32x2_t){sc[jt][r], sc[jt][r + 1]};
                    if (jt == 0) { v.x = (bl + c0 < 128) ? v.x : -1.0e30f; v.y = (bl + c1 < 128) ? v.y : -1.0e30f; }
                    if (jt == 4) { v.x = (bl + c0 >= 0) ? v.x : -1.0e30f; v.y = (bl + c1 >= 0) ? v.y : -1.0e30f; }
                    sc[jt][r] = v.x; sc[jt][r + 1] = v.y; }
            if (q0 == 0) {
                const int lim = 128 - qs;
#pragma unroll
                for (int jt = 0; jt < 4; ++jt)
#pragma unroll
                    for (int r = 0; r < 16; ++r) { const int kr = crow(r, hi); sc[jt][r] = (32 * jt + kr >= lim) ? sc[jt][r] : -1.0e30f; }
            }
            float mxt = -3.0e38f;
#pragma unroll
            for (int jt = 0; jt < 5; ++jt)
#pragma unroll
                for (int r = 0; r < 16; r += 2) mxt = fmaxf(mxt, fmaxf(sc[jt][r], sc[jt][r + 1]));
            float mx = fmaxf(sink2, mxt + ab); mx = xmax32(mx);
            f32x2_t l2 = (f32x2_t){0.f, 0.f}; const f32x2_t mx2 = (f32x2_t){mx - ab, mx - ab};
#pragma unroll
            for (int jt = 0; jt < 5; ++jt)
#pragma unroll
                for (int r = 0; r < 16; r += 2) { const f32x2_t d = (f32x2_t){sc[jt][r], sc[jt][r + 1]} - mx2; f32x2_t p; p.x = __builtin_amdgcn_exp2f(d.x); p.y = __builtin_amdgcn_exp2f(d.y); sc[jt][r] = p.x; sc[jt][r + 1] = p.y; l2 += p; }
            float l = l2.x + l2.y;
            l = xsum32(l); l += __builtin_amdgcn_exp2f(sink2 - mx);
            const float rl = __builtin_amdgcn_rcpf(l);
            f32x16 o[2];
#pragma unroll
            for (int dh = 0; dh < 2; ++dh) { o[dh] = (f32x16){0.f, 0.f, 0.f, 0.f, 0.f, 0.f, 0.f, 0.f, 0.f, 0.f, 0.f, 0.f, 0.f, 0.f, 0.f, 0.f}; }
#pragma unroll
            for (int jt = 0; jt < 5; ++jt)
#pragma unroll
                for (int j = 0; j < 2; ++j) { v4u pw; pw.x = pk2(sc[jt][8 * j + 0], sc[jt][8 * j + 1]); pw.y = pk2(sc[jt][8 * j + 2], sc[jt][8 * j + 3]); pw.z = pk2(sc[jt][8 * j + 4], sc[jt][8 * j + 5]); pw.w = pk2(sc[jt][8 * j + 6], sc[jt][8 * j + 7]);
                    const bf16x8 pf = __builtin_bit_cast(bf16x8, pw);
#pragma unroll
                    for (int dh = 0; dh < 2; ++dh) { const bf16x8 vf = *(const LAS bf16x8*)(lds + P2_VT + (32 * dh + l32) * P2_VROW + ((kt0 + jt) * 32 + 16 * j + 8 * hi) * 2);
                        o[dh] = __builtin_amdgcn_mfma_f32_32x32x16_bf16(vf, pf, o[dh], 0, 0, 0); } }
            float ss = 0.f;
            LAS unsigned char* ost = lds + P2_OST + wid * (32 * P2_OROW);
#pragma unroll
            for (int dh = 0; dh < 2; ++dh)
#pragma unroll
                for (int r4 = 0; r4 < 4; ++r4) { float a0 = o[dh][4 * r4] * rl, a1 = o[dh][4 * r4 + 1] * rl, a2 = o[dh][4 * r4 + 2] * rl, a3 = o[dh][4 * r4 + 3] * rl;
                    ss += (a0 * a0 + a1 * a1) + (a2 * a2 + a3 * a3);
                    v2u w; w.x = pk2(a0, a1); w.y = pk2(a2, a3);
                    *(LAS v2u*)(ost + l32 * P2_OROW + (32 * dh + 8 * r4 + 4 * hi) * 2) = w; }
            ss = xsum32(ss);
            if (hi == 0) __hip_atomic_fetch_add(rowss + qs + l32, ss, __ATOMIC_RELAXED, __HIP_MEMORY_SCOPE_WORKGROUP);
            asm volatile("s_waitcnt lgkmcnt(0)" ::: "memory");
#pragma unroll
            for (int i = 0; i < 4; ++i) { const int rr = i * 8 + (lane >> 3), ch = lane & 7; const v4u v = *(const LAS v4u*)(ost + rr * P2_OROW + ch * 16);
                bf16* ub = osc + (rowbase + q0 + qs + 8 * i) * OLD + h * HD; *(v4u*)(ub + ooffo) = v; }
            asm volatile("s_waitcnt lgkmcnt(0)" ::: "memory");
            __builtin_amdgcn_sched_barrier(0);
        }
    }
#undef P2_LOAD_KV
#undef P2_LOAD_Q
    if (!fixup) { __syncthreads(); if (tid < 128) ((float*)(P.ws + WS_RS2))[rowbase + q0 + tid] = rsqf(rowss[tid] * (1.0f / DATTN) + EPS); }
    else {
    asm volatile("s_waitcnt vmcnt(0)" ::: "memory");
    __syncthreads();
    LAS float* rstd = (LAS float*)(lds + P2_RSTD);
    if (tid < 128) rstd[tid] = rsqf(rowss[tid] * (1.0f / DATTN) + EPS);
    __syncthreads();
    { int lf_ = lane_id_asm(); asm volatile("" : "+v"(lf_)); const int tid = wid * 64 + (lf_ & 63);
#pragma unroll 8
    for (int i = 0; i < 32; ++i) { const int rr = (tid >> 7) + 4 * i, ch = tid & 127; bf16* p = osc + (rowbase + q0 + rr) * OLD + ch * 8;
        float f[8]; unpack8(*(const v4u*)p, f); const float s = rstd[rr];
#pragma unroll
        for (int j = 0; j < 8; ++j) f[j] *= s;
        if (FP8O) *(v2u*)(mixed8 + (rowbase + q0 + rr) * D + DCONV + ch * 8) = pack8_f8(f, F8_ASCALE); else *(v4u*)p = pack8(f); } }
    }
    if (!conv_first) {
    {
        int lc_ = lane_id_asm(); asm volatile("" : "+v"(lc_)); const int lane = lc_ & 63;
        const float* cw = P.conv_w; float w0[16], w1[16], w2[16];
#pragma unroll
        for (int j = 0; j < 16; ++j) { const int ch = (j >> 3) * 512 + lane * 8 + (j & 7); w0[j] = cw[ch]; w1[j] = cw[DCONV + ch]; w2[j] = cw[2 * DCONV + ch]; }
        float u1[16], u2[16];
        const int t0 = q0 + 16 * wid;
#pragma unroll
        for (int j = 0; j < 16; ++j) { u1[j] = 0.f; u2[j] = 0.f; }
        if (t0 >= 2) {
#pragma unroll
            for (int hf = 0; hf < 2; ++hf) { const int ch = hf * 512 + lane * 8; float c[8], hc[8];
                const bf16* pr = proj + (rowbase + t0 - 1) * PP; unpack8(*(const v4u*)(pr + O_U + ch), c); if (!UPROD) unpack8(*(const v4u*)(pr + C_HC + ch), hc);
#pragma unroll
                for (int j = 0; j < 8; ++j) u1[hf * 8 + j] = UPROD ? c[j] : c[j] * hc[j];
                pr -= PP; unpack8(*(const v4u*)(pr + O_U + ch), c); if (!UPROD) unpack8(*(const v4u*)(pr + C_HC + ch), hc);
#pragma unroll
                for (int j = 0; j < 8; ++j) u2[hf * 8 + j] = UPROD ? c[j] : c[j] * hc[j]; }
        }
#pragma unroll 1
        for (int r0 = 0; r0 < 16; r0 += CONVR) {
            v4u rb[CONVR][2], rc[CONVR][2], rh[CONVR][2];
#pragma unroll
            for (int rr = 0; rr < CONVR; ++rr) { const bf16* pr = proj + (rowbase + t0 + r0 + rr) * PP + lane * 8;
#pragma unroll
                for (int hf = 0; hf < 2; ++hf) { rb[rr][hf] = __builtin_nontemporal_load((const v4u*)(pr + O_B + hf * 512)); rc[rr][hf] = __builtin_nontemporal_load((const v4u*)(pr + O_U + hf * 512)); if (!UPROD) rh[rr][hf] = __builtin_nontemporal_load((const v4u*)(pr + C_HC + hf * 512)); } }
#pragma unroll
            for (int rr = 0; rr < CONVR; ++rr) { float y[16]; float ss = 0.f;
#pragma unroll
                for (int hf = 0; hf < 2; ++hf) { float bb[8], c[8], hc[8]; unpack8(rb[rr][hf], bb); unpack8(rc[rr][hf], c); if (!UPROD) unpack8(rh[rr][hf], hc);
#pragma unroll
                    for (int j = 0; j < 8; ++j) { const int jj = hf * 8 + j; const float u0 = UPROD ? c[j] : c[j] * hc[j];
                        y[jj] = bb[j] * (w0[jj] * u2[jj] + w1[jj] * u1[jj] + w2[jj] * u0); ss += y[jj] * y[jj]; u2[jj] = u1[jj]; u1[jj] = u0; } }
                ss = wsum(ss); const float rs = rsqf(ss * (1.0f / DCONV) + EPS);
#pragma unroll
                for (int hf = 0; hf < 2; ++hf) { float f[8];
#pragma unroll
                    for (int j = 0; j < 8; ++j) f[j] = y[hf * 8 + j] * rs;
                    if (FP8O) *(v2u*)(mixed8 + (rowbase + t0 + r0 + rr) * D + hf * 512 + lane * 8) = pack8_f8(f, F8_ASCALE);
                    else *(v4u*)(mixed + (rowbase + t0 + r0 + rr) * D + hf * 512 + lane * 8) = pack8(f); } }
        }
    }
    }
}
constexpr int NPHASE = 10;
struct Args { Ptrs P; int ph_lo, ph_hi; };
__device__ __forceinline__ void moe_tables(LAS unsigned char* ldsx, gu32* ctl, const int wave_) {
    const int tid = TIDX(wave_);
    __syncthreads();
    if (tid < 64) {
        const int n = (int)__hip_atomic_load(ctl + CW_CNT + 64 * tid, RLX_AGENT);
        int x = (n + 255) >> 8;
#pragma unroll
        for (int o = 1; o < 64; o <<= 1) { const int v = __shfl_up(x, o); if (tid >= o) x += v; }
        ((LAS int*)(ldsx + pg8::LST_OFF))[tid] = n;
        ((LAS int*)(ldsx + pg8::LST_OFF + 256))[tid + 1] = x;
        if (tid == 0) ((LAS int*)(ldsx + pg8::LST_OFF + 256))[0] = 0;
    }
    __syncthreads();
}
#ifndef STAG6
#define STAG6 0
#endif
#ifndef STAG9
#define STAG9 0
#endif
__device__ __forceinline__ void stagger(int vcu, int us) {
    if ((vcu & 1) && us > 0) { const unsigned long long t0 = __builtin_amdgcn_s_memrealtime(); while (__builtin_amdgcn_s_memrealtime() - t0 < (unsigned long long)us * 100ull) __builtin_amdgcn_s_sleep(16); }
}
__global__ void __launch_bounds__(NWAVES * 64, 2) mk_fwd(Args args) {
    extern __shared__ __attribute__((aligned(16))) unsigned char lds_raw[];
    LAS unsigned char* lds = (LAS unsigned char*)lds_raw;
    const Ptrs& P = args.P;
    const int wave = __builtin_amdgcn_readfirstlane((int)(threadIdx.x >> 6));
    const int tid = TIDX(wave);
    const int G = gridDim.x, bx = blockIdx.x, vcu = (G % 8 == 0) ? (bx % 8) * (G / 8) + bx / 8 : bx;
    unsigned char* ws = P.ws; gu32* ctl = (gu32*)(ws + WS_CTL);
    for (int u = tid; u < (pg8::LDS_BYTES - pg8::LDSX_OFF) / 4; u += NWAVES * 64) ((LAS unsigned*)(lds + pg8::LDSX_OFF))[u] = 0u;
    __syncthreads();
    if (tid == 0) *((volatile LAS unsigned*)(lds + pg8::MISC_OFF) + 10) = __hip_atomic_fetch_add((unsigned*)ctl + CW_RANK + 64 * xb_xcc_id(), 1u, __ATOMIC_RELAXED, __HIP_MEMORY_SCOPE_AGENT);
    __syncthreads();
    const int xc = __builtin_amdgcn_readfirstlane((int)(xb_xcc_id() * 32u + *((volatile LAS unsigned*)(lds + pg8::MISC_OFF) + 10)));
    const int lo = args.ph_lo, hi = args.ph_hi;
    XcdBarrier bar; bar.bar = (unsigned*)(ctl + CW_BAR); bar.x = 0; bar.st = nullptr;
    if (hi - lo > 1) bar = xcd_barrier_post((unsigned*)(ctl + CW_BAR), (volatile LAS unsigned*)(lds + pg8::MISC_OFF) + 8, wave);
#ifdef ONLY_PHASE
#define IN(k) ((k) == ONLY_PHASE && lo <= (k) && (k) < hi)
#else
#define IN(k) (lo <= (k) && (k) < hi)
#endif
#define SEAM(k) do { if (IN(k) && IN((k) + 1) && (k) != 7 && (k) != 8) xcd_barrier(bar, wave); } while (0)
#define SEAM79() do { if (IN(7) && IN(9)) xcd_barrier(bar, wave); } while (0)
    bf16* Win = (bf16*)(ws + WS_WIN); bf16* Wout = (bf16*)(ws + WS_WOUT); bf16* Wplg = (bf16*)(ws + WS_WPLG); bf16* Wple = (bf16*)(ws + WS_WPLE);
    bf16* Wr = (bf16*)(ws + WS_WR); bf16* Wgu = (bf16*)(ws + WS_WGU); bf16* Wd = (bf16*)(ws + WS_WD);
    bf16* xb = (bf16*)(ws + WS_XB); bf16* mixed = (bf16*)(ws + WS_MIX); bf16* pb = (bf16*)(ws + WS_PB); bf16* proj = (bf16*)(ws + WS_PROJ);
    bf16* hid = (bf16*)(ws + WS_HID); bf16* pw = (bf16*)(ws + WS_PW); bf16* h1 = (bf16*)(ws + WS_H1); bf16* h2 = (bf16*)(ws + WS_H2);
    float* rsx = (float*)(ws + WS_RSX); float* rs1 = (float*)(ws + WS_RS1); float* ss1p = (float*)(ws + WS_SS1P); float* ss2p = (float*)(ws + WS_SS2P);
    int* eid = (int*)(ws + WS_EID); float* ew = (float*)(ws + WS_EW); Ent* ent = (Ent*)(ws + WS_ENT);

    if (IN(0)) { p0_prologue(P, lds, vcu, G, wave); } SEAM(0);
    if (IN(1)) { pg8::Gemm g{xb, Win, M, FP8QKV ? C_Q : DIN, D}; pg8::CvtOrder S; S.init(M, FP8QKV ? C_Q : DIN, G, bx); pg8::EpiBf16 E{proj, PP, nullptr, 1.f, UPROD != 0};
        S.w = pg8::CvtWork{P.w_gate, P.w_up, P.w_down, P.norm_ffn, ws, vcu, G}; S.slot = DEFER_CVT ? (((vcu & 31) >> 2) % CVT_SLOTS) : -1; S.lo = 0; S.hi = CVT_SPLIT ? pg8::CvtWork::NGU : pg8::CvtWork::NIT;
        pg8::gemm_phase<pg8::EpiBf16, pg8::CvtOrder, true>(lds, g, S, E, wave);
        if (DEFER_CVT && S.nunits() - 1 <= S.slot) S.w.run(wave, S.lo, S.hi);
        if (FP8QKV) { pg8::Gemm g8{(const bf16*)(ws + WS_XB8), (const bf16*)(ws + WS_WIN8), M, NQKV, D / 2}; pg8::StaticOrder S8; S8.init(M, NQKV, G, bx); pg8::EpiBf16 E8{proj + C_Q, DIN, nullptr, F8_INV, false};
            pg8::gemm_phase<pg8::EpiBf16, pg8::StaticOrder, true, true>(lds, g8, S8, E8, wave); } } SEAM(1);
    const bool mids = MIDSCALE && !FP8O && (long)4 * G >= (M / 256) * (D / 256);
    if (IN(2)) { for (int unit = vcu; unit < BATCH * (SEQ / 128); unit += G) p2_unit(P, lds, unit, wave, (vcu & 1) != 0, !mids);     __syncthreads(); } SEAM(2);
    if (IN(3)) { pg8::Gemm g{FP8O ? (const bf16*)(ws + WS_MIX8) : mixed, Wout, M, D, FP8O ? D / 2 : D}; pg8::OutOrder S; S.init(M, D, G, bx); S.ldsx = lds; S.rsa = (const float*)(ws + WS_RS2); S.wave = wave; S.on = mids; pg8::EpiH1 E{xb, (const float*)(ws + WS_RMSX), h1, ss1p, FP8 ? ws + WS_H18 : nullptr, FP8O ? F8_INV : 1.f};
        S.w = pg8::CvtWork{P.w_gate, P.w_up, P.w_down, P.norm_ffn, ws, vcu, G}; S.slot = (DEFER_CVT && CVT_SPLIT == 2) ? (((vcu & 31) >> 2) % 3) : -1; S.lo = pg8::CvtWork::NGU; S.hi = pg8::CvtWork::NIT;
        S.fill_all();
        pg8::gemm_phase<pg8::EpiH1, pg8::OutOrder, true, FP8O != 0>(lds, g, S, E, wave);
        if (DEFER_CVT && CVT_SPLIT == 2 && S.nunits() - 1 <= S.slot) S.w.run(wave, S.lo, S.hi); } SEAM(3);
    if (IN(4)) { pg8::Gemm g{h1, Wr, M, 256, D}; pg8::StaticOrder S; S.init(M, 256, G, bx); pg8::EpiRouter E{ss1p, P.b_group, P.b_router, rs1, eid, ew, ent, (unsigned*)(ctl + CW_CNT)};
        pg8::gemm_phase<pg8::EpiRouter, pg8::StaticOrder, false>(lds, g, S, E, wave);
        __syncthreads();
        pg8::Gemm g2{pb, Wple, M, D, PLE}; pg8::PwOrder S2{G, bx, M / 256}; pg8::EpiF8 E2{(unsigned char*)pw, D, F8_PSCALE};
        pg8::gemm_phase<pg8::EpiF8, pg8::PwOrder, true>(lds, g2, S2, E2, wave); } SEAM(4);
    if (IN(5) || IN(6) || IN(7)) moe_tables(lds, ctl, wave);
    const LAS int* T0 = (const LAS int*)(lds + pg8::LST_OFF + 256);
    bool xs5 = XSEAM5 && IN(5) && IN(6) && G == 256;
    if (xs5) { for (int j = 0; j < 8; ++j) xs5 = xs5 && (xb_ld((unsigned*)ctl + CW_BAR + XB_XCNT(j)) == 32u); }
    if (IN(5)) { pg8::Gemm g{FP8 ? (const bf16*)(ws + WS_H18) : h1, Wgu, M, NE * 1024, FP8 ? D / 2 : D}; pg8::MoeOrder<true, 4> S{lds, ent, 0, T0[NLIST], G, vcu, wave, (const Ent*)(ctl + CW_ZERO)}; if (xs5) { S.xm = 1; S.c = xc; S.tsig = (unsigned*)ctl + CW_TD; } pg8::EpiGU E{hid, lds, FP8 ? F8_INV : 1.f, FP8 ? (unsigned char*)hid : nullptr};
        if (DEFER_CVT && CVT_SPLIT == 1) { S.w = pg8::CvtWork{P.w_gate, P.w_up, P.w_down, P.norm_ffn, ws, vcu, G}; S.slot = (vcu >> 2) % 3; }
        pg8::gemm_phase<pg8::EpiGU, pg8::MoeOrder<true, 4>, true, FP8 != 0>(lds, g, S, E, wave);
        if (DEFER_CVT && CVT_SPLIT == 1 && S.nunits() - 1 <= S.slot) S.w.run(wave, pg8::CvtWork::NGU, pg8::CvtWork::NIT); } if (!xs5) SEAM(5);
    if (IN(6)) { stagger(vcu, STAG6); pg8::Gemm g{hid, Wd, 0, NE * D, FP8 ? DEXP / 2 : DEXP}; pg8::MoeOrder<false, 8> S{lds, ent, 0, T0[NE], G, vcu, wave, (const Ent*)(ctl + CW_ZERO)}; if (xs5) { S.xm = 1; S.c = xc; S.twait = (unsigned*)ctl + CW_TD; } pg8::EpiDown<0> E{ws + WS_H28, lds, F8_DINV};
        pg8::gemm_phase<pg8::EpiDown<0>, pg8::MoeOrder<false, 8>, true, FP8 != 0>(lds, g, S, E, wave); } SEAM(6);
    if (IN(7)) { stagger(vcu, STAG6); pg8::Gemm g{hid, Wd, 0, NE * D, FP8 ? DEXP / 2 : DEXP}; pg8::MoeOrder<false, 8> S{lds, ent, T0[NE], T0[NLIST], G, vcu, wave, (const Ent*)(ctl + CW_ZERO)}; pg8::EpiDown<1> E{h1, h2, ss2p, lds, ws + WS_H28, F8_DINV};
        pg8::gemm_phase<pg8::EpiDown<1>, pg8::MoeOrder<false, 8>, true, FP8 != 0>(lds, g, S, E, wave); } SEAM79();
    if (IN(9)) { stagger(vcu, STAG9); pg8::Gemm g{FP8 ? (const bf16*)(ws + WS_H28) : h2, Wplg, M, D, FP8 ? D / 2 : D}; pg8::FinalOrder S; S.init(M, D, G, bx); S.ldsx = lds; S.ssp = ss2p; S.wave = wave; S.pre = (long)8 * G >= S.nwg; pg8::EpiFinal E{h2, (const unsigned char*)pw, P.out, lds, FP8 ? F8_INV : 1.f, S.pre}; if (S.pre) S.fill_all();
        pg8::gemm_phase<pg8::EpiFinal, pg8::FinalOrder, true, FP8 != 0>(lds, g, S, E, wave); }
#undef IN
#undef SEAM
}
extern "C" void kernel_launch(void* const* d_in, const int* in_sizes, int n_in, void* d_out, int out_size, void* d_ws, size_t ws_size, hipStream_t stream) {
    static int grid = 0;
    if (grid == 0) {
        if (n_in != 22 || in_sizes[0] != M * D || out_size != M * D || ws_size < WS_END) { fprintf(stderr, "kernel_launch: unexpected problem (n_in %d, in0 %d, out %d, ws %zu); nothing launched\n", n_in, n_in > 0 ? in_sizes[0] : -1, out_size, ws_size); grid = -1; return; }
        int dev = 0, cus = 0, per_cu = 0;
        if (hipGetDevice(&dev) != hipSuccess || hipDeviceGetAttribute(&cus, hipDeviceAttributeMultiprocessorCount, dev) != hipSuccess) { grid = -1; return; }
        if (hipFuncSetAttribute((const void*)mk_fwd, hipFuncAttributeMaxDynamicSharedMemorySize, pg8::LDS_BYTES) != hipSuccess) { fprintf(stderr, "kernel_launch: hipFuncSetAttribute failed\n"); grid = -1; return; }
        if (hipOccupancyMaxActiveBlocksPerMultiprocessor(&per_cu, (const void*)mk_fwd, NWAVES * 64, pg8::LDS_BYTES) != hipSuccess || per_cu < 1) { fprintf(stderr, "kernel_launch: occupancy query says %d workgroups per CU\n", per_cu); (void)hipGetLastError(); grid = -1; return; }
        grid = cus;
    }
    if (grid < 0) return;
    if (hipMemsetAsync((char*)d_ws + WS_CTL, 0, CTL_ZERO_BYTES, stream) != hipSuccess) return;
    Args a{};
    { const float** pp = (const float**)&a.P; for (int i = 0; i < 22; ++i) pp[i] = (const float*)d_in[i]; }
    a.P.out = (float*)d_out; a.P.ws = (unsigned char*)d_ws;
    a.ph_lo = 0; a.ph_hi = NPHASE;
    hipLaunchKernelGGL(mk_fwd, dim3(grid), dim3(NWAVES * 64), pg8::LDS_BYTES, stream, a);
}
```

```cpp
#include <hip/hip_runtime.h>
#include <cstdio>
#include <cstdint>

typedef unsigned short bf16;
typedef unsigned v4u __attribute__((ext_vector_type(4)));
typedef unsigned v2u __attribute__((ext_vector_type(2)));
typedef float f32x4 __attribute__((ext_vector_type(4)));
typedef float f32x16 __attribute__((ext_vector_type(16)));
typedef short bf16x8 __attribute__((ext_vector_type(8)));
#define GAS __attribute__((address_space(1)))
#define LAS __attribute__((address_space(3)))
typedef GAS unsigned gu32;

constexpr int BATCH = 4, SEQ = 8192, D = 2048, M = BATCH * SEQ;
constexpr int DCONV = 1024, NH = 16, NKV = 4, HD = 64, DATTN = 1024, DKV = 256, DIN = 4608;
constexpr int C_B = 0, C_C = 1024, C_HC = 2048, C_Q = 3072, C_K = 4096, C_V = 4352;
#ifndef UPROD
#define UPROD 1
#endif
constexpr int PP = UPROD ? DIN - 1024 : DIN;
constexpr int O_B = 0, O_U = 1024, O_Q = UPROD ? 2048 : C_Q, O_K = UPROD ? 3072 : C_K, O_V = UPROD ? 3328 : C_V;
constexpr int NGRP = 4, EPG = 8, NE = 32, DEXP = 512, PLE = 256, NRT = 36;
constexpr int NLIST = 64, LCAP = 32768;
constexpr float EPS = 1e-6f;
constexpr float LOG2E = 1.4426950408889634f;

constexpr size_t MiB = 1u << 20;
constexpr size_t WS_CTL = 0, CTL_ZERO_BYTES = 1 * MiB;
constexpr size_t WS_WIN = 2 * MiB;
constexpr size_t WS_WOUT = 20 * MiB;
constexpr size_t WS_WPLG = 28 * MiB;
constexpr size_t WS_WPLE = 36 * MiB;
constexpr size_t WS_WR = 37 * MiB;
constexpr size_t WS_RSX = 38 * MiB;
constexpr size_t WS_RS1 = 38 * MiB + 256 * 1024;
constexpr size_t WS_RS2 = 38 * MiB + 512 * 1024;
constexpr size_t WS_RMSX = 38 * MiB + 768 * 1024;
constexpr size_t WS_EID = 39 * MiB;
constexpr size_t WS_EW = 39 * MiB + 512 * 1024;
constexpr size_t WS_LOG = 42 * MiB;
constexpr size_t WS_SS1P = 50 * MiB;
constexpr size_t WS_SS2P = 54 * MiB;
#ifndef FP8
#define FP8 1
#endif
#ifndef FP8O
#define FP8O 0
#endif
constexpr size_t WS_MIX8 = 816 * MiB;
#ifndef FP8QKV
#define FP8QKV 0
#endif
constexpr size_t WS_XB8 = 128 * MiB;
constexpr size_t WS_WIN8 = 20 * MiB - 3 * MiB;
constexpr int NQKV = DATTN + 2 * DKV;
constexpr float F8_ASCALE = 16.f, F8_WSCALE = 32.f, F8_INV = 1.0f / (16.f * 32.f);
constexpr float F8_HSCALE = 16.f, F8_DSCALE = 16.f, F8_DINV = 1.0f / (16.f * 16.f);
constexpr float F8_PSCALE = 16.f, F8_PINV = 1.0f / 16.f;
constexpr float F8_YSCALE = 64.f, F8_YINV = 1.0f / 64.f;
constexpr size_t WS_WGU = 64 * MiB;
constexpr size_t WS_H18 = 128 * MiB;
constexpr size_t WS_H28 = 608 * MiB;
constexpr size_t WS_WD = 192 * MiB;
constexpr size_t WS_XB = 256 * MiB;
constexpr size_t WS_MIX = 816 * MiB;
constexpr size_t WS_PB = 384 * MiB;
constexpr size_t WS_PROJ = 400 * MiB;
constexpr size_t WS_HID = 400 * MiB;
constexpr size_t WS_PW = 480 * MiB;
constexpr size_t WS_H1 = 688 * MiB;
constexpr size_t WS_H2 = 816 * MiB;
constexpr size_t WS_YA = 688 * MiB;
constexpr size_t WS_ENT = 944 * MiB;
constexpr size_t WS_END = 976 * MiB;
constexpr int CW_TMO = 0, CW_BAR = 4096, CW_CNT = 8192, CW_ZERO = 16384, CW_RANK = 24576  , CW_TD = 32768  ;

__device__ __forceinline__ float bf2f(bf16 v) { return __uint_as_float(((unsigned)v) << 16); }
__device__ __forceinline__ unsigned f2bfu(float f) { unsigned u = __float_as_uint(f); return (u + 0x7fffu + ((u >> 16) & 1u)) >> 16; }
__device__ __forceinline__ bf16 f2bf(float f) { return (bf16)f2bfu(f); }
typedef float f32x2_t __attribute__((ext_vector_type(2))); typedef __bf16 bf16x2_t __attribute__((ext_vector_type(2)));
__device__ __forceinline__ unsigned pk2(float lo, float hi) { const f32x2_t v = {lo, hi}; const bf16x2_t b = __builtin_convertvector(v, bf16x2_t); return __builtin_bit_cast(unsigned, b); }
__device__ __forceinline__ float xsum32(float v) { const auto r = __builtin_amdgcn_permlane32_swap(__float_as_uint(v), __float_as_uint(v), false, false); return __uint_as_float(r[0]) + __uint_as_float(r[1]); }
__device__ __forceinline__ float xmax32(float v) { const auto r = __builtin_amdgcn_permlane32_swap(__float_as_uint(v), __float_as_uint(v), false, false); return fmaxf(__uint_as_float(r[0]), __uint_as_float(r[1])); }
__device__ __forceinline__ float rsqf(float x) { return __builtin_amdgcn_rsqf(x); }
__device__ __forceinline__ float wsum(float v) {
#pragma unroll
    for (int o = 32; o > 0; o >>= 1) v += __shfl_xor(v, o);
    return v;
}
__device__ __forceinline__ void unpack8(v4u w, float* f) {
    f[0] = __uint_as_float(w.x << 16); f[1] = __uint_as_float(w.x & 0xffff0000u);
    f[2] = __uint_as_float(w.y << 16); f[3] = __uint_as_float(w.y & 0xffff0000u);
    f[4] = __uint_as_float(w.z << 16); f[5] = __uint_as_float(w.z & 0xffff0000u);
    f[6] = __uint_as_float(w.w << 16); f[7] = __uint_as_float(w.w & 0xffff0000u);
}
__device__ __forceinline__ v2u pack8_f8(const float* f, float sc) {
    float c[8];
#pragma unroll
    for (int j = 0; j < 8; ++j) c[j] = __builtin_amdgcn_fmed3f(f[j] * sc, -448.f, 448.f);
    int lo = 0, hi = 0;
    lo = __builtin_amdgcn_cvt_pk_fp8_f32(c[0], c[1], lo, false); lo = __builtin_amdgcn_cvt_pk_fp8_f32(c[2], c[3], lo, true);
    hi = __builtin_amdgcn_cvt_pk_fp8_f32(c[4], c[5], hi, false); hi = __builtin_amdgcn_cvt_pk_fp8_f32(c[6], c[7], hi, true);
    v2u o; o.x = (unsigned)lo; o.y = (unsigned)hi; return o;
}
__device__ __forceinline__ v4u pack8(const float* f) { v4u o; o.x = pk2(f[0], f[1]); o.y = pk2(f[2], f[3]); o.z = pk2(f[4], f[5]); o.w = pk2(f[6], f[7]); return o; }

__device__ __forceinline__ int lane_id_asm() { int l; asm volatile("v_mbcnt_lo_u32_b32 %0, -1, 0\n\tv_mbcnt_hi_u32_b32 %0, -1, %0" : "=v"(l)); return l & 63; }
__device__ __forceinline__ int lane_id() { return lane_id_asm(); }
#define TIDX(wave_) (((wave_) & 7) * 64 + lane_id_asm())

#ifndef DEFER_CVT
#define DEFER_CVT 1
#endif
#ifndef CVT_SLOTS
#define CVT_SLOTS 8
#endif
#ifndef CVT_SPLIT
#define CVT_SPLIT 0
#endif
#ifndef XSEAM5
#define XSEAM5 0
#endif
#ifndef MIDSCALE
#define MIDSCALE 1
#endif
struct Ptrs {
    const float *x, *p, *norm_mix, *w_in, *conv_w, *q_norm, *k_norm, *sinks, *onc, *ona, *w_out, *norm_ffn, *w_group, *b_group, *w_router, *b_router,
        *w_gate, *w_up, *w_down, *norm_ple, *w_ple_gate, *w_ple;
    float* out; unsigned char* ws;
};
struct Ent { int tok; float w; float rs; int pad; };
#ifndef BALK
#define BALK 0
#endif
#ifndef DMAFIRST
#define DMAFIRST 0
#endif
#ifndef HALFU
#define HALFU 1
#endif
namespace pg8 {
typedef int v4i __attribute__((ext_vector_type(4)));
typedef int v8i __attribute__((ext_vector_type(8)));
constexpr int HALF_ROWS = 128;
constexpr int BM = 256, BK = 64, HALF = 128, HTB = HALF * BK * 2  , STAGE_BYTES = 8 * HTB, NXCD = 8;
#ifndef WGM_
#define WGM_ 4
#endif
constexpr int WGM = WGM_;
constexpr int RING_BYTES = 131072;
constexpr int LDSX_OFF = RING_BYTES;
constexpr int MISC_OFF = LDSX_OFF + 320;
constexpr int TAB_OFF = LDSX_OFF + 1024;
constexpr int LST_OFF = TAB_OFF + 8192;
constexpr int LDS_BYTES = 147456;

__host__ __device__ __forceinline__ int lds_byte(int r, int c) { const int st = (r >> 4) * 2 + (c >> 5), rr = r & 15, cc = c & 31, ob = rr * 64 + cc * 2; return st * 1024 + (ob ^ (((ob >> 9) & 1) << 5)); }
__host__ __device__ __forceinline__ void stage_rc(int b, int& R, int& C) { const int st = b / 1024, sb = b % 1024, swz = sb ^ (((sb >> 9) & 1) << 5); R = (st >> 1) * 16 + swz / 64; C = (st & 1) * 32 + (swz % 64) / 2; }
__host__ __device__ __forceinline__ int perm32(int rho) { const int n = rho >> 4, i = rho & 15; return 8 * (i >> 2) + 4 * n + (i & 3); }

struct Unit { int pm, pn, bt, par, lst, rk0, nl; };
struct Gemm { const bf16* A; const bf16* Bt; int M, N, K; };

struct StaticOrder {
    static constexpr bool GATHER = false, MID = false, TAILSKIP = false;
    int nM, nN, nwg, G, c;
    __host__ __device__ void init(int M_, int N_, int G_, int c_) { nM = M_ / BM; nN = N_ / BM; nwg = nM * nN; G = G_; c = c_; }
    __host__ __device__ bool next(int i, Unit& u) const {
        const long L = (long)i * G + c; if (L >= nwg) return false;
        int wgid = (int)L; { const int q = nwg / NXCD, r = nwg % NXCD, xcd = wgid % NXCD, off = wgid / NXCD; wgid = (xcd < r ? xcd * (q + 1) : r * (q + 1) + (xcd - r) * q) + off; }
        const int nig = WGM * nN, gid = wgid / nig, fm = gid * WGM, gsz = (nM - fm) < WGM ? (nM - fm) : WGM;
        u.pm = fm + ((wgid % nig) % gsz); u.pn = (wgid % nig) / gsz; u.bt = u.pn; u.par = i & 1; u.lst = 0; u.rk0 = 0; u.nl = 0; return true;
    }
    __device__ __forceinline__ void a_prefetch(const Unit&) const {}
    __device__ __forceinline__ void a_first() const {}
    __device__ __forceinline__ void a_ready(const Unit&) const {}
    __device__ __forceinline__ void done(const Unit&) const {}
    __device__ __forceinline__ void between(int, int) const {}
    __device__ __forceinline__ void signal(int) const {}
};

struct SameTileOrder : StaticOrder { __host__ __device__ bool next(int i, Unit& u) const { if (!StaticOrder::next(i, u)) return false; u.pm = c & 7; u.pn = 0; u.bt = 0; return true; } };
struct PwOrder {
    static constexpr bool GATHER = false, MID = false, TAILSKIP = false;
    int G, c, nr;
    __device__ __forceinline__ bool next(int i, Unit& u) const {
        int L;
        if (G == 256 && nr == 128) { if (c < nr || i >= 8) return false; L = (c - nr) * 8 + i; }
        else { L = i * G + c; if (L >= (M / BM) * (D / BM)) return false; }
        u.pm = L / (D / BM); u.pn = L % (D / BM); u.bt = u.pn; u.par = i & 1; u.lst = 0; u.rk0 = 0; u.nl = 0; return true;
    }
    __device__ __forceinline__ void a_prefetch(const Unit&) const {}
    __device__ __forceinline__ void a_first() const {}
    __device__ __forceinline__ void a_ready(const Unit&) const {}
    __device__ __forceinline__ void done(const Unit&) const {}
    __device__ __forceinline__ void between(int, int) const {}
    __device__ __forceinline__ void signal(int) const {}
};

template <bool GU> __device__ __forceinline__ void cvt_item(const float* W, const float* g0, unsigned char* WT8, int k0, int n0, int up, int lane) {
    constexpr int K = GU ? D : DEXP, N = GU ? DEXP : D;
    const int q = lane & 3, c4 = lane >> 2;
    f32x4 v[32];
    const __attribute__((address_space(1))) f32x4* src = (const __attribute__((address_space(1))) f32x4*)(W + (size_t)(k0 + 16 * q) * N + n0) + c4;
#pragma unroll
    for (int i = 0; i < 32; ++i) v[i] = __builtin_nontemporal_load(src + (size_t)((i & 15) + 64 * (i >> 4)) * (N / 4));
    float gg[32];
#pragma unroll
    for (int t = 0; t < 8; ++t) { f32x4 g4 = (f32x4){1.f, 1.f, 1.f, 1.f}; if (GU) g4 = *(const f32x4*)(g0 + k0 + 16 * q + 64 * (t >> 2) + 4 * (t & 3));
#pragma unroll
        for (int u = 0; u < 4; ++u) gg[4 * t + u] = g4[u] * (GU ? F8_WSCALE : F8_DSCALE); }
    const int n = n0 + 4 * c4;
    const int row = GU ? (n >> 7) * 256 + ((n & 127) >> 3) * 16 + up * 8 + (n & 7) : n;
    unsigned char* dst = WT8 + (size_t)row * K + k0 + 16 * q;
#pragma unroll
    for (int j = 0; j < 4; ++j) { v2u qv[4];
#pragma unroll
        for (int b = 0; b < 4; ++b) { float f[8];
#pragma unroll
            for (int t = 0; t < 8; ++t) f[t] = v[b * 8 + t][j] * gg[b * 8 + t];
            qv[b] = pack8_f8(f, 1.0f); }
        __builtin_nontemporal_store((v4u){qv[0].x, qv[0].y, qv[1].x, qv[1].y}, (v4u*)(dst + (size_t)j * K));
        __builtin_nontemporal_store((v4u){qv[2].x, qv[2].y, qv[3].x, qv[3].y}, (v4u*)(dst + (size_t)j * K + 64)); }
}
struct CvtWork {
    const float *w_gate, *w_up, *w_down, *norm_ffn; unsigned char* ws; int vcu, G;
    static constexpr int NGU = NE * 2 * (DEXP / 64) * (D / 128), ND = NE * (D / 64) * (DEXP / 128), NIT = NGU + ND;
    __device__ __forceinline__ void run(int wid, int lo, int hi) const {
        const int lane = lane_id_asm();
        const float* wg_ = w_gate; const float* wu_ = w_up; asm volatile("" : "+s"(wg_), "+s"(wu_));
        const int n = hi - lo, per = (n + G - 1) / G, perw = (per + 7) / 8, lim = lo + ((vcu + 1) * per < n ? (vcu + 1) * per : n);
        const int base = lo + vcu * per + wid * perw, top = base + perw < lim ? base + perw : lim;
#pragma unroll 1
        for (int it0 = base; it0 < top; ++it0) { const int it = __builtin_amdgcn_readfirstlane(it0);
            if (it < NGU) { const int kb = it & 15, nb = (it >> 4) & 7, up = (it >> 7) & 1, e = it >> 8;
                cvt_item<true>((up ? wu_ : wg_) + (size_t)e * D * DEXP, norm_ffn, ws + WS_WGU + (size_t)e * 1024 * D, kb * 128, nb * 64, up, lane); }
            else { const int j = it - NGU, kb = j & 3, nb = (j >> 2) & 31, e = j >> 7;
                cvt_item<false>(w_down + (size_t)e * DEXP * D, nullptr, ws + WS_WD + (size_t)e * D * DEXP, kb * 128, nb * 64, 0, lane); } }
    }
};
struct CvtOrder : StaticOrder {
    CvtWork w; int slot, lo, hi;
    __device__ __forceinline__ void between(int ui, int wid) const { if (ui == slot) w.run(wid, lo, hi); }
    __device__ __forceinline__ int nunits() const { return c < nwg ? (nwg - 1 - c) / G + 1 : 0; }
};
struct OutOrder : CvtOrder {
    static constexpr bool MID = true;
    LAS unsigned char* ldsx; const float* rsa; int wave; bool on;
    __device__ __forceinline__ bool next(int i, Unit& u) const { const bool ok = StaticOrder::next(i, u); u.lst = i; return ok; }
    __device__ __forceinline__ void fill_all() const {
        if (!on) return;
        const int tid = TIDX(wave), r = tid & 255;
#pragma unroll 1
        for (int i = tid >> 8; i < 4; i += 2) { Unit u; if (!next(i, u)) break; const float v = rsa[u.pm * BM + r];
            ((LAS float*)(ldsx + TAB_OFF))[i * 256 + r] = v; ((LAS float*)(ldsx + TAB_OFF + 4096))[i * 256 + r] = 1.0f / v; }
        __syncthreads();
    }
    __device__ __forceinline__ void mid(f32x4 (&acc)[2][2][4][2], const Unit& u, int wr, int fr, int fin = 0) const {
        if (!on) return;
#pragma unroll
        for (int ai = 0; ai < 2; ++ai)
#pragma unroll
            for (int m = 0; m < 4; ++m) { const float inv = ((const LAS float*)(ldsx + TAB_OFF + (fin ? 0 : 4096)))[u.lst * 256 + ai * HALF + wr * 64 + m * 16 + fr];
#pragma unroll
                for (int bj = 0; bj < 2; ++bj)
#pragma unroll
                    for (int n = 0; n < 2; ++n) acc[ai][bj][m][n] *= inv; }
    }
};

__device__ __forceinline__ unsigned cvt_pk_bf16(float lo, float hi) { unsigned r; asm volatile("v_cvt_pk_bf16_f32 %0, %1, %2" : "=v"(r) : "v"(lo), "v"(hi)); return r; }

template <class Epi, class Sched, bool ALIGN_EPI, bool F8 = false, int MMAMASK = 15>
__device__ __forceinline__ void gemm_phase(LAS unsigned char* lds, const Gemm g, const Sched& S, const Epi& E, const int wid) {
    const int lane = lane_id(), tid = wid * 64 + lane, wr = wid >> 2, wc = wid & 3, fr = lane & 15, fq = lane >> 4;
    const int K = g.K, nt = K / BK;
    unsigned voffA[2], voffB[2]; int R0 = 0, C0 = 0;
#pragma unroll
    for (int i = 0; i < 2; ++i) { int R, C; stage_rc(tid * 16 + i * 8192, R, C); const int Rb = Epi::PERM ? (64 * (R >> 5) + 16 * ((R & 15) >> 2) + 4 * ((R >> 4) & 1) + (R & 3)) : R;
        voffA[i] = (unsigned)(R * K + C) * 2u; voffB[i] = (unsigned)(Rb * K + C) * 2u; if (i == 0) { R0 = R; C0 = C; } }
    const size_t kstep = (size_t)(BK * 2);
    const size_t hstep = (size_t)HALF * K * 2;
    const size_t tstep = 2 * hstep;
    const size_t hstepB = Epi::PERM ? (size_t)8 * K * 2 : hstep;
    const unsigned ldsw = (unsigned)wid * 1024u;
    const int aoff = lds_byte(wr * 64 + fr, fq * 8), boff = lds_byte(wc * 32 + fr, fq * 8);
    unsigned gc[2][2] = {{0u, 0u}, {0u, 0u}}, gn[2][2] = {{0u, 0u}, {0u, 0u}}, gs[2][2] = {{0u, 0u}, {0u, 0u}};
#define PG8_TOK(par, r) (*(const LAS int*)(lds + TAB_OFF + (par) * 4096 + (r) * 16))
#define PG8_GLOAD(dst, par) do { _Pragma("unroll") for (int _h = 0; _h < 2; ++_h) _Pragma("unroll") for (int _i = 0; _i < 2; ++_i) \
        dst[_h][_i] = (unsigned)PG8_TOK(par, _h * 128 + _i * 64 + R0) * (unsigned)(K * 2) + (unsigned)(C0 * 2); } while (0)
#define PG8_SA(b, h) (((b) * 2 + (h)) * HTB)
#define PG8_SB(b, h) ((4 + (b) * 2 + (h)) * HTB)
#define PG8_STAGE(bufoff, gbase, voff) do { _Pragma("unroll") for (int _i = 0; _i < 2; ++_i) \
        __builtin_amdgcn_global_load_lds((const unsigned*)((const char*)(gbase) + (voff)[_i]), (LAS unsigned*)(lds + (bufoff) + ldsw + _i * 8192), 16, 0, 0); } while (0)
#define PG8_STAGE_A(bufoff, ub, go, h, kb) do { if constexpr (Sched::GATHER) { PG8_STAGE(bufoff, (const char*)g.A + (kb), go[h]); } else { PG8_STAGE(bufoff, (ub) + (kb) + (h) * hstep, voffA); } } while (0)
#define PG8_CAT(p_) __builtin_shufflevector(*(const LAS v4i*)(p_), *(const LAS v4i*)((p_) + 1024), 0, 1, 2, 3, 4, 5, 6, 7)
#define PG8_LDA(dst, b, h) do { if constexpr (F8) { _Pragma("unroll") for (int m = 0; m < 4; ++m) dst##8[m] = PG8_CAT(lds + PG8_SA(b, h) + aoff + m * 2048); } \
        else { _Pragma("unroll") for (int m = 0; m < 4; ++m) _Pragma("unroll") for (int k = 0; k < 2; ++k) dst[m][k] = *(const LAS bf16x8*)(lds + PG8_SA(b, h) + aoff + m * 2048 + k * 1024); } } while (0)
#define PG8_LDB(dst, b, h) do { if constexpr (F8) { _Pragma("unroll") for (int n = 0; n < 2; ++n) dst##8[n] = PG8_CAT(lds + PG8_SB(b, h) + boff + n * 2048); } \
        else { _Pragma("unroll") for (int n = 0; n < 2; ++n) _Pragma("unroll") for (int k = 0; k < 2; ++k) dst[n][k] = *(const LAS bf16x8*)(lds + PG8_SB(b, h) + boff + n * 2048 + k * 1024); } } while (0)
#define PG8_MMA(ai, bj, At, Bt) do { if constexpr (((MMAMASK >> ((ai) * 2 + (bj))) & 1) == 0) break; __builtin_amdgcn_s_setprio(1); _Pragma("unroll") for (int m = 0; m < 4; ++m) _Pragma("unroll") for (int n = 0; n < 2; ++n) { \
        if constexpr (F8) { asm volatile("v_mfma_scale_f32_16x16x128_f8f6f4 %0, %1, %2, %0, %3, %3 op_sel_hi:[0,0,0]" : "+v"(acc[ai][bj][m][n]) : "v"(Bt##8[n]), "v"(At##8[m]), "v"(f8scale)); } \
        else { _Pragma("unroll") for (int k = 0; k < 2; ++k) acc[ai][bj][m][n] = __builtin_amdgcn_mfma_f32_16x16x32_bf16(Bt[n][k], At[m][k], acc[ai][bj][m][n], 0, 0, 0); } } \
        __builtin_amdgcn_s_setprio(0); } while (0)
#define PG8_WAIT_V(n) asm volatile("s_waitcnt vmcnt(" #n ")" ::: "memory")
#define PG8_WAIT_L(n) asm volatile("s_waitcnt lgkmcnt(" #n ")" ::: "memory")
#define PG8_BAR __builtin_amdgcn_s_barrier()
#define PG8_SCHED __builtin_amdgcn_sched_barrier(0)
    Unit cur, nxt; int ui = 0, prev_pm = 0;
    if (!S.next(0, cur)) return;
    f32x4 acc[2][2][4][2];
#pragma unroll
    for (int a = 0; a < 2; ++a)
#pragma unroll
        for (int b = 0; b < 2; ++b)
#pragma unroll
            for (int m = 0; m < 4; ++m)
#pragma unroll
                for (int n = 0; n < 2; ++n) acc[a][b][m][n] = (f32x4){0.f, 0.f, 0.f, 0.f};
    bf16x8 At[4][2], B0[2][2], B1[2][2];
    const int f8scale = 0x7f7f7f7f;
    v8i At8[4], B08[2], B18[2];
    const char* cA = (const char*)g.A + (size_t)cur.pm * tstep; const char* cB = (const char*)g.Bt + (size_t)cur.bt * tstep;
    S.a_prefetch(cur); S.a_first(); S.a_ready(cur);
    if constexpr (Sched::GATHER) { PG8_GLOAD(gc, cur.par); }
    PG8_STAGE(PG8_SB(0, 0), cB, voffB); PG8_STAGE(PG8_SB(0, 1), cB + hstepB, voffB); PG8_STAGE_A(PG8_SA(0, 0), cA, gc, 0, (size_t)0); PG8_STAGE_A(PG8_SA(0, 1), cA, gc, 1, (size_t)0);
    if (wr == 1) PG8_BAR;
    PG8_WAIT_V(2); PG8_BAR;
    PG8_STAGE(PG8_SB(1, 0), cB + kstep, voffB); PG8_STAGE_A(PG8_SA(1, 0), cA, gc, 0, kstep); PG8_STAGE(PG8_SB(1, 1), cB + hstepB + kstep, voffB);
    PG8_WAIT_V(6); PG8_BAR;
    for (;;) {
        const bool has_next = S.next(ui + 1, nxt);
        bool hu = false, qu = false; if constexpr (Sched::TAILSKIP) { hu = S.halfu(cur); qu = S.quartu(cur) && wr == 1; }
        const char* nA = has_next ? (const char*)g.A + (size_t)nxt.pm * tstep : cA; const char* nB = has_next ? (const char*)g.Bt + (size_t)nxt.bt * tstep : cB;
#pragma unroll 1
        for (int t = 0; t < nt; t += 2) {
            const bool last = (t == nt - 2);
            if constexpr (Sched::MID) { if (t == nt / 2) S.mid(acc, cur, wr, fr); }
            const size_t k1 = (size_t)(t + 1) * kstep;
            const char* sA = last ? nA : cA; const size_t k2 = last ? (size_t)0 : (size_t)(t + 2) * kstep, k3 = k2 + kstep;
            const char* b2 = last ? nB : cB + (size_t)(t + 2) * kstep; const char* b3 = b2 + kstep;
            if (last && has_next) { S.a_ready(nxt); if constexpr (Sched::GATHER) { PG8_GLOAD(gn, nxt.par); } }
            if constexpr (Sched::GATHER) {
#pragma unroll
                for (int h = 0; h < 2; ++h)
#pragma unroll
                    for (int i = 0; i < 2; ++i) gs[h][i] = (last && has_next) ? gn[h][i] : gc[h][i];
            }
#if BALK
            PG8_LDB(B0, 0, 0); PG8_LDB(B1, 0, 1); PG8_SCHED; PG8_LDA(At, 0, 0); PG8_STAGE_A(PG8_SA(1, 1), cA, gc, 1, k1);
            PG8_WAIT_V(8); PG8_WAIT_L(0); PG8_BAR; PG8_MMA(0, 0, At, B0); PG8_MMA(0, 1, At, B1); PG8_BAR; PG8_SCHED;
            if (has_next && t == nt - 4) S.a_prefetch(nxt);
            PG8_LDA(At, 0, 1); PG8_STAGE(PG8_SB(0, 0), b2, voffB); PG8_STAGE(PG8_SB(0, 1), b2 + hstepB, voffB);
            PG8_WAIT_V(6); PG8_WAIT_L(0); PG8_BAR; PG8_MMA(1, 0, At, B0); PG8_STAGE_A(PG8_SA(0, 0), sA, gs, 0, k2); PG8_MMA(1, 1, At, B1); PG8_BAR; PG8_SCHED;
            PG8_LDB(B0, 1, 0); PG8_LDB(B1, 1, 1); PG8_SCHED; PG8_LDA(At, 1, 0); PG8_STAGE_A(PG8_SA(0, 1), sA, gs, 1, k2);
            PG8_WAIT_V(8); PG8_WAIT_L(0); PG8_BAR; PG8_MMA(0, 0, At, B0); PG8_MMA(0, 1, At, B1); PG8_BAR; PG8_SCHED;
            PG8_LDA(At, 1, 1); PG8_STAGE(PG8_SB(1, 0), b3, voffB); PG8_STAGE(PG8_SB(1, 1), b3 + hstepB, voffB);
            PG8_WAIT_V(6); PG8_WAIT_L(0); PG8_BAR; PG8_MMA(1, 0, At, B0); PG8_STAGE_A(PG8_SA(1, 0), sA, gs, 0, k3); PG8_MMA(1, 1, At, B1); PG8_BAR; PG8_SCHED;
#else
#if DMAFIRST
            PG8_LDB(B0, 0, 0); PG8_LDB(B1, 0, 1); PG8_SCHED; PG8_LDA(At, 0, 0); PG8_WAIT_L(0); PG8_SCHED; PG8_STAGE_A(PG8_SA(1, 1), cA, gc, 1, k1);
            PG8_WAIT_V(8); PG8_BAR; PG8_MMA(0, 0, At, B0); PG8_MMA(0, 1, At, B1); PG8_BAR; PG8_SCHED;
            if (has_next && t == nt - 4) S.a_prefetch(nxt);
            PG8_LDA(At, 0, 1); PG8_WAIT_L(0); PG8_SCHED; PG8_STAGE(PG8_SB(0, 0), b2, voffB); PG8_STAGE(PG8_SB(0, 1), b2 + hstepB, voffB); PG8_STAGE_A(PG8_SA(0, 0), sA, gs, 0, k2);
            PG8_WAIT_V(8); PG8_BAR; PG8_MMA(1, 0, At, B0); PG8_MMA(1, 1, At, B1); PG8_BAR; PG8_SCHED;
            PG8_LDB(B0, 1, 0); PG8_LDB(B1, 1, 1); PG8_SCHED; PG8_LDA(At, 1, 0); PG8_WAIT_L(0); PG8_SCHED; PG8_STAGE_A(PG8_SA(0, 1), sA, gs, 1, k2);
            PG8_WAIT_V(8); PG8_BAR; PG8_MMA(0, 0, At, B0); PG8_MMA(0, 1, At, B1); PG8_BAR; PG8_SCHED;
            PG8_LDA(At, 1, 1); PG8_WAIT_L(0); PG8_SCHED; PG8_STAGE(PG8_SB(1, 0), b3, voffB); PG8_STAGE(PG8_SB(1, 1), b3 + hstepB, voffB); PG8_STAGE_A(PG8_SA(1, 0), sA, gs, 0, k3);
            PG8_WAIT_V(8); PG8_BAR; PG8_MMA(1, 0, At, B0); PG8_MMA(1, 1, At, B1); PG8_BAR; PG8_SCHED;
#else
            PG8_LDB(B0, 0, 0); PG8_LDB(B1, 0, 1); PG8_SCHED; PG8_LDA(At, 0, 0); PG8_STAGE_A(PG8_SA(1, 1), cA, gc, 1, k1);
            PG8_WAIT_V(8); PG8_WAIT_L(0); PG8_BAR; if (!qu) { PG8_MMA(0, 0, At, B0); PG8_MMA(0, 1, At, B1); } PG8_BAR; PG8_SCHED;
            if (has_next && t == nt - 4) S.a_prefetch(nxt);
            PG8_LDA(At, 0, 1); PG8_STAGE(PG8_SB(0, 0), b2, voffB); PG8_STAGE(PG8_SB(0, 1), b2 + hstepB, voffB); PG8_STAGE_A(PG8_SA(0, 0), sA, gs, 0, k2);
            PG8_WAIT_V(8); PG8_WAIT_L(0); PG8_BAR; if (!hu) { PG8_MMA(1, 0, At, B0); PG8_MMA(1, 1, At, B1); } PG8_BAR; PG8_SCHED;
            if (t == 0 && ui > 0) S.signal(prev_pm);
            PG8_LDB(B0, 1, 0); PG8_LDB(B1, 1, 1); PG8_SCHED; PG8_LDA(At, 1, 0); PG8_STAGE_A(PG8_SA(0, 1), sA, gs, 1, k2);
            PG8_WAIT_V(8); PG8_WAIT_L(0); PG8_BAR; if (!qu) { PG8_MMA(0, 0, At, B0); PG8_MMA(0, 1, At, B1); } PG8_BAR; PG8_SCHED;
            PG8_LDA(At, 1, 1); PG8_STAGE(PG8_SB(1, 0), b3, voffB); PG8_STAGE(PG8_SB(1, 1), b3 + hstepB, voffB); PG8_STAGE_A(PG8_SA(1, 0), sA, gs, 0, k3);
            PG8_WAIT_V(8); PG8_WAIT_L(0); PG8_BAR; if (!hu) { PG8_MMA(1, 0, At, B0); PG8_MMA(1, 1, At, B1); } PG8_BAR; PG8_SCHED;
#endif
#endif
        }
        if constexpr (F8) asm volatile("s_nop 15\n\ts_nop 15" ::: "memory");
        if constexpr (Sched::MID) S.mid(acc, cur, wr, fr, 1);
        if constexpr (ALIGN_EPI) { if (wr == 0) PG8_BAR; }
        if constexpr (!Epi::AFTER_DRAIN) { E(acc, cur, wr, wc, fr, fq); S.done(cur); }
        if (!has_next) break;
        S.between(ui, wid);
#pragma unroll
        for (int a = 0; a < 2; ++a)
#pragma unroll
            for (int b = 0; b < 2; ++b)
#pragma unroll
                for (int m = 0; m < 4; ++m)
#pragma unroll
                    for (int n = 0; n < 2; ++n) acc[a][b][m][n] = (f32x4){0.f, 0.f, 0.f, 0.f};
        prev_pm = cur.pm; cur = nxt; cA = nA; cB = nB; ++ui;
        if constexpr (Sched::GATHER) {
#pragma unroll
            for (int h = 0; h < 2; ++h)
#pragma unroll
                for (int i = 0; i < 2; ++i) gc[h][i] = gn[h][i];
        }
        if constexpr (ALIGN_EPI) { if (wr == 1) PG8_BAR; }
    }
    PG8_WAIT_V(0);
    if constexpr (!ALIGN_EPI) { if (wr == 0) PG8_BAR; }
    PG8_BAR;
    if constexpr (!Epi::AFTER_DRAIN) S.signal(cur.pm);
    if constexpr (Epi::AFTER_DRAIN) { E.fused(acc, cur, wr, wc, fr, fq, lds, wid, lane); S.done(cur); }
#undef PG8_TOK
#undef PG8_GLOAD
#undef PG8_SA
#undef PG8_SB
#undef PG8_STAGE
#undef PG8_STAGE_A
#undef PG8_CAT
#undef PG8_LDA
#undef PG8_LDB
#undef PG8_MMA
#undef PG8_WAIT_V
#undef PG8_WAIT_L
#undef PG8_BAR
#undef PG8_SCHED
}

typedef f32x4 Acc[2][2][4][2];
#define TAB_ENT(ldsx, par, r) ((const LAS Ent*)((ldsx) + TAB_OFF + (par) * 4096 + (r) * 16))

#ifndef NTS_PROJ
#define NTS_PROJ 0
#endif
struct EpiBf16 {
    static constexpr bool PERM = true, AFTER_DRAIN = false, NTS = NTS_PROJ != 0;
    bf16* O; int ldc; const float* rs; float sc; bool uprod;
    __device__ __forceinline__ void operator()(const Acc& acc, const Unit& u, int wr, int wc, int fr, int fq) const {
        const int row0 = u.pm * BM + wr * 64 + fr;
        if (uprod && u.pn >= 4 && u.pn < 12) {
            const int col = O_U + 128 * (u.pn - 4) + wc * 32 + fq * 8;
#pragma unroll
            for (int ai = 0; ai < 2; ++ai)
#pragma unroll
                for (int m = 0; m < 4; ++m) { const int row = row0 + ai * HALF + m * 16; const float s = rs ? rs[row] * sc : sc;
                    const f32x4 p0 = (acc[ai][0][m][0] * s) * (acc[ai][1][m][0] * s), p1 = (acc[ai][0][m][1] * s) * (acc[ai][1][m][1] * s); v4u w;
                    w.x = cvt_pk_bf16(p0[0], p0[1]); w.y = cvt_pk_bf16(p0[2], p0[3]); w.z = cvt_pk_bf16(p1[0], p1[1]); w.w = cvt_pk_bf16(p1[2], p1[3]);
                    *(v4u*)(O + (size_t)row * ldc + col) = w; }
            return; }
        const int col0 = (uprod && u.pn >= 12 ? u.pn * BM - 1024 : u.pn * BM) + wc * 64 + 16 * fq;
#pragma unroll
        for (int ai = 0; ai < 2; ++ai)
#pragma unroll
            for (int m = 0; m < 4; ++m) { const int row = row0 + ai * HALF + m * 16; const float s = rs ? rs[row] * sc : sc; bf16* rowp = O + (size_t)row * ldc + col0;
#pragma unroll
                for (int bj = 0; bj < 2; ++bj) { const f32x4 v0 = acc[ai][bj][m][0] * s, v1 = acc[ai][bj][m][1] * s; v4u w;
                    w.x = cvt_pk_bf16(v0[0], v0[1]); w.y = cvt_pk_bf16(v0[2], v0[3]); w.z = cvt_pk_bf16(v1[0], v1[1]); w.w = cvt_pk_bf16(v1[2], v1[3]);
                    if (NTS) __builtin_nontemporal_store(w, (v4u*)(rowp + bj * 8)); else *(v4u*)(rowp + bj * 8) = w; } }
    }
};
struct EpiF8 {
    static constexpr bool PERM = true, AFTER_DRAIN = false;
    unsigned char* O; int ldc; float sc;
    __device__ __forceinline__ void operator()(const Acc& acc, const Unit& u, int wr, int wc, int fr, int fq) const {
        const int row0 = u.pm * BM + wr * 64 + fr, col0 = u.pn * BM + wc * 64 + 16 * fq;
#pragma unroll
        for (int ai = 0; ai < 2; ++ai)
#pragma unroll
            for (int m = 0; m < 4; ++m) { const int row = row0 + ai * HALF + m * 16; v2u f8[2];
#pragma unroll
                for (int bj = 0; bj < 2; ++bj) { float o[8];
#pragma unroll
                    for (int n = 0; n < 2; ++n)
#pragma unroll
                        for (int i = 0; i < 4; ++i) o[n * 4 + i] = acc[ai][bj][m][n][i];
                    f8[bj] = pack8_f8(o, sc); }
                *(v4u*)(O + (size_t)row * ldc + col0) = (v4u){f8[0].x, f8[0].y, f8[1].x, f8[1].y}; }
    }
};
struct EpiH1 {
    static constexpr bool PERM = true, AFTER_DRAIN = false;
    const bf16* xb; const float* rms; bf16* h1; float* ssp; unsigned char* h18; float sc;
    __device__ __forceinline__ void operator()(const Acc& acc, const Unit& u, int wr, int wc, int fr, int fq) const {
        const int row0 = u.pm * BM + wr * 64 + fr, col0 = u.pn * BM + wc * 64 + 16 * fq;
        v4u xv[8][2]; float rm[8];
#define H1_LOAD(g_) do { const size_t off_ = (size_t)(row0 + ((g_) >> 2) * HALF + ((g_) & 3) * 16) * D + col0; xv[g_][0] = *(const v4u*)(xb + off_); xv[g_][1] = *(const v4u*)(xb + off_ + 8); } while (0)
#pragma unroll
        for (int gi = 0; gi < 8; ++gi) { rm[gi] = rms[row0 + (gi >> 2) * HALF + (gi & 3) * 16]; H1_LOAD(gi); }
        asm volatile("" ::: "memory");
#pragma unroll
        for (int gi = 0; gi < 8; ++gi) { const int ai = gi >> 2, m = gi & 3;
            const int row = row0 + ai * HALF + m * 16; const size_t off = (size_t)row * D + col0; float ss = 0.f; const float r = rm[gi]; v2u f8[2];
#pragma unroll
            for (int bj = 0; bj < 2; ++bj) { float xf[8]; unpack8(xv[gi][bj], xf); float o[8];
#pragma unroll
                for (int n = 0; n < 2; ++n)
#pragma unroll
                    for (int i = 0; i < 4; ++i) { o[n * 4 + i] = xf[n * 4 + i] * r + acc[ai][bj][m][n][i] * sc; ss += o[n * 4 + i] * o[n * 4 + i]; }
                v4u w; w.x = cvt_pk_bf16(o[0], o[1]); w.y = cvt_pk_bf16(o[2], o[3]); w.z = cvt_pk_bf16(o[4], o[5]); w.w = cvt_pk_bf16(o[6], o[7]);
                *(v4u*)(h1 + off + bj * 8) = w; if (h18) f8[bj] = pack8_f8(o, F8_ASCALE); }
            if (h18) *(v4u*)(h18 + off) = (v4u){f8[0].x, f8[0].y, f8[1].x, f8[1].y};
            ss += __shfl_xor(ss, 16); ss = xsum32(ss);
            if (fq == 0) ssp[(size_t)row * 32 + u.pn * 4 + wc] = ss; }
#undef H1_LOAD
    }
};
struct EpiRouter {
    static constexpr bool PERM = false, AFTER_DRAIN = true;
    const float* ssp; const float* bg; const float* br; float* rs1; int* eid; float* ew; Ent* ent; unsigned* cnt;
    __device__ __forceinline__ void fused(const Acc& acc, const Unit& u, int wr, int wc, int fr, int fq, LAS unsigned char* lds, int wid, int lane) const {
        LAS float* LG = (LAS float*)lds;
        LAS unsigned* HIST = (LAS unsigned*)(lds + 65536);
        LAS unsigned* BASE = (LAS unsigned*)(lds + 65536 + 256);
        const int tid = wid * 64 + lane;
        if (tid < 64) HIST[tid] = 0u;
        if (wc < 2) {
#pragma unroll
            for (int ai = 0; ai < 2; ++ai)
#pragma unroll
                for (int m = 0; m < 4; ++m) { const int r = ai * HALF + wr * 64 + m * 16 + fr;
#pragma unroll
                    for (int n = 0; n < 2; ++n) { const int c = wc * 32 + 16 * n + 4 * fq; if (c < 40) *(LAS f32x4*)(LG + r * 40 + c) = acc[ai][0][m][n]; } }
        }
        __syncthreads();
        int l0 = 0, l1 = 0; unsigned k0 = 0, k1 = 0; float w0 = 0.f, w1 = 0.f, rs = 0.f; const int row = u.pm * BM + tid;
        if (tid < 256) {
            float ss = 0.f;
#pragma unroll
            for (int j = 0; j < 8; ++j) { const f32x4 p = *(const f32x4*)(ssp + (size_t)row * 32 + 4 * j); ss += (p[0] + p[1]) + (p[2] + p[3]); }
            rs = 1.0f / sqrtf(ss * (1.0f / D) + EPS);
            const LAS float* L = LG + tid * 40;
            float gl[NGRP]; int g = 0;
#pragma unroll
            for (int j = 0; j < NGRP; ++j) gl[j] = L[j] * rs + bg[j];
            float gm = gl[0];
#pragma unroll
            for (int j = 1; j < NGRP; ++j) if (gl[j] > gm) { gm = gl[j]; g = j; }
            float gsum = 0.f;
#pragma unroll
            for (int j = 0; j < NGRP; ++j) gsum += __expf(gl[j] - gm);
            const float gw = 1.0f / gsum;
            const LAS float* E = L + NGRP + g * EPG; const float* be = br + g * EPG;
            int i1 = 0; float v1 = E[0] * rs + be[0];
            for (int j = 1; j < EPG; ++j) { const float v = E[j] * rs + be[j]; if (v > v1) { v1 = v; i1 = j; } }
            int i2 = 0; float v2 = -3.0e38f;
            for (int j = 0; j < EPG; ++j) { const float v = E[j] * rs + be[j]; if (j != i1 && v > v2) { v2 = v; i2 = j; } }
            const float e2 = __expf(v2 - v1); w0 = gw / (1.0f + e2); w1 = gw * e2 / (1.0f + e2);
            l0 = g * EPG + i1; l1 = NE + g * EPG + i2;
            eid[row * 2] = l0; eid[row * 2 + 1] = l1 - NE; ew[row * 2] = w0; ew[row * 2 + 1] = w1; rs1[row] = rs;
            k0 = __hip_atomic_fetch_add(HIST + l0, 1u, __ATOMIC_RELAXED, __HIP_MEMORY_SCOPE_WORKGROUP); k1 = __hip_atomic_fetch_add(HIST + l1, 1u, __ATOMIC_RELAXED, __HIP_MEMORY_SCOPE_WORKGROUP);
        }
        __syncthreads();
        if (tid < 64) { const unsigned n = HIST[tid]; BASE[tid] = n ? __hip_atomic_fetch_add(cnt + 64 * tid, n, __ATOMIC_RELAXED, __HIP_MEMORY_SCOPE_AGENT) : 0u; }
        __syncthreads();
        if (tid < 256) {
            *(v4u*)(ent + (size_t)l0 * LCAP + BASE[l0] + k0) = (v4u){(unsigned)row, __float_as_uint(w0), __float_as_uint(rs), 0u};
            *(v4u*)(ent + (size_t)l1 * LCAP + BASE[l1] + k1) = (v4u){(unsigned)row, __float_as_uint(w1), __float_as_uint(rs), 0u};
        }
    }
};
struct EpiGU {
    static constexpr bool PERM = true, AFTER_DRAIN = false;
    bf16* hid; LAS unsigned char* ldsx; float sc; unsigned char* hid8;
    __device__ __forceinline__ void operator()(const Acc& acc, const Unit& u, int wr, int wc, int fr, int fq) const {
        const int col0 = u.pn * HALF + wc * 32 + 8 * fq;
#pragma unroll
        for (int ai = 0; ai < 2; ++ai)
#pragma unroll
            for (int m = 0; m < 4; ++m) { const int r = ai * HALF + wr * 64 + m * 16 + fr; const LAS Ent* e = TAB_ENT(ldsx, u.par, r); const float w = e->w, rs = e->rs * sc;
                float o[8];
#pragma unroll
                for (int n = 0; n < 2; ++n)
#pragma unroll
                    for (int i = 0; i < 4; ++i) { const float gg = acc[ai][0][m][n][i] * rs, uu = acc[ai][1][m][n][i] * rs; o[n * 4 + i] = w * (gg * __builtin_amdgcn_rcpf(1.0f + __expf(-gg))) * uu; }
                if (hid8) { *(v2u*)(hid8 + (size_t)(u.pm * BM + r) * DEXP + col0) = pack8_f8(o, F8_HSCALE); }
                else { v4u q; q.x = cvt_pk_bf16(o[0], o[1]); q.y = cvt_pk_bf16(o[2], o[3]); q.z = cvt_pk_bf16(o[4], o[5]); q.w = cvt_pk_bf16(o[6], o[7]);
                    *(v4u*)(hid + (size_t)(u.pm * BM + r) * DEXP + col0) = q; } }
    }
};
template <int KK> struct EpiDown;
template <> struct EpiDown<0> {
    static constexpr bool PERM = true, AFTER_DRAIN = false;
    unsigned char* y8; LAS unsigned char* ldsx; float sc;
    __device__ __forceinline__ void operator()(const Acc& acc, const Unit& u, int wr, int wc, int fr, int fq) const {
        const int col0 = u.pn * BM + wc * 64 + 16 * fq; const float s64 = sc * F8_YSCALE;
#pragma unroll
        for (int gi = 0; gi < 8; ++gi) { const int ai = gi >> 2, m = gi & 3;
            const int r = ai * HALF + wr * 64 + m * 16 + fr; const bool valid = (u.rk0 + r) < u.nl; const int tok = TAB_ENT(ldsx, u.par, r)->tok; v2u f8[2];
#pragma unroll
            for (int bj = 0; bj < 2; ++bj) { float o[8];
#pragma unroll
                for (int n = 0; n < 2; ++n)
#pragma unroll
                    for (int i = 0; i < 4; ++i) o[n * 4 + i] = acc[ai][bj][m][n][i];
                f8[bj] = pack8_f8(o, s64); }
            if (valid) *(v4u*)(y8 + (size_t)tok * D + col0) = (v4u){f8[0].x, f8[0].y, f8[1].x, f8[1].y}; }
    }
};
template <> struct EpiDown<1> {
    static constexpr bool PERM = true, AFTER_DRAIN = false;
    const bf16* base; bf16* h2; float* ssp; LAS unsigned char* ldsx; unsigned char* h28; float sc;
    __device__ __forceinline__ void operator()(const Acc& acc, const Unit& u, int wr, int wc, int fr, int fq) const {
        const int col0 = u.pn * BM + wc * 64 + 16 * fq;
#pragma unroll
        for (int hb = 0; hb < 2; ++hb) {
            v4u bv[4][2], yv[4]; int tk[4];
#pragma unroll
            for (int q = 0; q < 4; ++q) { const int gi = hb * 4 + q; tk[q] = TAB_ENT(ldsx, u.par, (gi >> 2) * HALF + wr * 64 + (gi & 3) * 16 + fr)->tok; const size_t off_ = (size_t)tk[q] * D + col0;
                bv[q][0] = *(const v4u*)(base + off_); bv[q][1] = *(const v4u*)(base + off_ + 8); yv[q] = *(const v4u*)(h28 + off_); }
            asm volatile("" ::: "memory");
#pragma unroll
            for (int q = 0; q < 4; ++q) { const int gi = hb * 4 + q, ai = gi >> 2, m = gi & 3;
                const int r = ai * HALF + wr * 64 + m * 16 + fr; const bool valid = (u.rk0 + r) < u.nl; const int tok = tk[q]; const size_t off = (size_t)tok * D + col0; float ss = 0.f; v2u f8[2];
                const unsigned yw[4] = {yv[q].x, yv[q].y, yv[q].z, yv[q].w};
#pragma unroll
                for (int bj = 0; bj < 2; ++bj) { float b[8]; unpack8(bv[q][bj], b); float o[8];
#pragma unroll
                    for (int n = 0; n < 2; ++n) { const unsigned w = yw[bj * 2 + n];
                        const float y0 = __builtin_amdgcn_cvt_f32_fp8((int)w, 0), y1 = __builtin_amdgcn_cvt_f32_fp8((int)w, 1), y2 = __builtin_amdgcn_cvt_f32_fp8((int)w, 2), y3 = __builtin_amdgcn_cvt_f32_fp8((int)w, 3);
                        const float yy[4] = {y0, y1, y2, y3};
#pragma unroll
                        for (int i = 0; i < 4; ++i) { o[n * 4 + i] = b[n * 4 + i] + yy[i] * F8_YINV + acc[ai][bj][m][n][i] * sc; ss += o[n * 4 + i] * o[n * 4 + i]; } }
                    v4u qv; qv.x = cvt_pk_bf16(o[0], o[1]); qv.y = cvt_pk_bf16(o[2], o[3]); qv.z = cvt_pk_bf16(o[4], o[5]); qv.w = cvt_pk_bf16(o[6], o[7]);
                    if (valid) *(v4u*)(h2 + off + bj * 8) = qv;
                    f8[bj] = pack8_f8(o, F8_ASCALE); }
                if (valid) *(v4u*)(h28 + off) = (v4u){f8[0].x, f8[0].y, f8[1].x, f8[1].y};
                ss += __shfl_xor(ss, 16); ss = xsum32(ss); if (fq == 0 && valid) ssp[(size_t)tok * 32 + u.pn * 4 + wc] = ss; }
            asm volatile("" ::: "memory"); }
    }
};
template <int MODE> struct EpiDownProbe {
    static constexpr bool PERM = true, AFTER_DRAIN = false;
    const bf16* base; bf16* h2; LAS unsigned char* ldsx; float sc;
    __device__ __forceinline__ void operator()(const Acc& acc, const Unit& u, int wr, int wc, int fr, int fq) const {
        const int col0 = u.pn * BM + wc * 64 + 16 * fq;
        v4u bv[8][2]; int tk[8];
#pragma unroll
        for (int gi = 0; gi < 8; ++gi) { tk[gi] = TAB_ENT(ldsx, u.par, (gi >> 2) * HALF + wr * 64 + (gi & 3) * 16 + fr)->tok; const size_t off_ = (size_t)tk[gi] * D + col0;
            if (MODE == 0) { bv[gi][0] = *(const v4u*)(base + off_); bv[gi][1] = *(const v4u*)(base + off_ + 8); } else { bv[gi][0] = (v4u){0u, 0u, 0u, 0u}; bv[gi][1] = (v4u){0u, 0u, 0u, 0u}; } }
        asm volatile("" ::: "memory");
#pragma unroll
        for (int gi = 0; gi < 8; ++gi) { const int ai = gi >> 2, m = gi & 3;
            const int r = ai * HALF + wr * 64 + m * 16 + fr; const bool valid = (u.rk0 + r) < u.nl; const size_t off = (size_t)tk[gi] * D + col0;
#pragma unroll
            for (int bj = 0; bj < 2; ++bj) { float b[8]; unpack8(bv[gi][bj], b); float o[8];
#pragma unroll
                for (int n = 0; n < 2; ++n)
#pragma unroll
                    for (int i = 0; i < 4; ++i) o[n * 4 + i] = b[n * 4 + i] + acc[ai][bj][m][n][i] * sc;
                v4u q; q.x = cvt_pk_bf16(o[0], o[1]); q.y = cvt_pk_bf16(o[2], o[3]); q.z = cvt_pk_bf16(o[4], o[5]); q.w = cvt_pk_bf16(o[6], o[7]);
                if (MODE == 2) { if (gi > 0) asm volatile("" :: "v"(q)); }
                if (valid && (MODE < 2 || gi == 0)) *(v4u*)(h2 + off + bj * 8) = q; } }
    }
};
struct EpiFinal {
    static constexpr bool PERM = true, AFTER_DRAIN = false;
    const bf16* h2; const unsigned char* pw8; float* out; LAS unsigned char* ldsx; float sc; bool pre;
    __device__ __forceinline__ void operator()(const Acc& acc, const Unit& u, int wr, int wc, int fr, int fq) const {
        const int col0 = u.pn * BM + wc * 64 + 16 * fq;
        v4u hv[2][2], pv[2];
#define FN_LOAD(g_, buf) do { const size_t off_ = (size_t)(u.pm * BM + ((g_) >> 2) * HALF + wr * 64 + ((g_) & 3) * 16 + fr) * D + col0; \
            hv[buf][0] = *(const v4u*)(h2 + off_); hv[buf][1] = *(const v4u*)(h2 + off_ + 8); pv[buf] = *(const v4u*)(pw8 + off_); } while (0)
#pragma unroll
        for (int half_ = 0; half_ < 4; ++half_) {
#pragma unroll
            for (int q = 0; q < 2; ++q) FN_LOAD(half_ * 2 + q, q);
            asm volatile("" ::: "memory");
#pragma unroll
            for (int q = 0; q < 2; ++q) { const int gi = half_ * 2 + q, ai = gi >> 2, m = gi & 3;
                const int r = ai * HALF + wr * 64 + m * 16 + fr; const float rs = (pre ? ((const LAS float*)(ldsx + TAB_OFF))[u.lst * 256 + r] : TAB_ENT(ldsx, u.par, r)->rs) * sc; const size_t off = (size_t)(u.pm * BM + r) * D + col0;
                const unsigned pwd[4] = {pv[q].x, pv[q].y, pv[q].z, pv[q].w};
#pragma unroll
                for (int bj = 0; bj < 2; ++bj) { float hf[8]; unpack8(hv[q][bj], hf);
#pragma unroll
                    for (int n = 0; n < 2; ++n) { const f32x4 z = acc[ai][bj][m][n] * rs; f32x4 o; const int w = (int)pwd[bj * 2 + n];
                        const float pf[4] = {__builtin_amdgcn_cvt_f32_fp8(w, 0), __builtin_amdgcn_cvt_f32_fp8(w, 1), __builtin_amdgcn_cvt_f32_fp8(w, 2), __builtin_amdgcn_cvt_f32_fp8(w, 3)};
#pragma unroll
                        for (int i = 0; i < 4; ++i) o[i] = hf[n * 4 + i] + (pf[i] * F8_PINV) * __builtin_amdgcn_rcpf(1.0f + __expf(-z[i]));
                        *(f32x4*)(out + off + bj * 8 + n * 4) = o; } } }
            asm volatile("" ::: "memory"); }
#undef FN_LOAD
    }
};

template <int MODE> struct EpiFinalProbe {
    static constexpr bool PERM = true, AFTER_DRAIN = false;
    const bf16* h2; const unsigned char* pw8; float* out; LAS unsigned char* ldsx; float sc;
    __device__ __forceinline__ void operator()(const Acc& acc, const Unit& u, int wr, int wc, int fr, int fq) const {
        const int col0 = u.pn * BM + wc * 64 + 16 * fq;
        v4u hv[2][2], pv[2];
#pragma unroll
        for (int half_ = 0; half_ < 4; ++half_) {
#pragma unroll
            for (int q = 0; q < 2; ++q) { const int g_ = half_ * 2 + q; const size_t off_ = (size_t)(u.pm * BM + (g_ >> 2) * HALF + wr * 64 + (g_ & 3) * 16 + fr) * D + col0;
                if (MODE == 0 || MODE == 3) { hv[q][0] = *(const v4u*)(h2 + off_); hv[q][1] = *(const v4u*)(h2 + off_ + 8); pv[q] = *(const v4u*)(pw8 + off_); }
                else { hv[q][0] = (v4u){0u, 0u, 0u, 0u}; hv[q][1] = hv[q][0]; pv[q] = hv[q][0]; } }
            asm volatile("" ::: "memory");
#pragma unroll
            for (int q = 0; q < 2; ++q) { const int gi = half_ * 2 + q, ai = gi >> 2, m = gi & 3;
                const int r = ai * HALF + wr * 64 + m * 16 + fr; const float rs = TAB_ENT(ldsx, u.par, r)->rs * sc; const size_t off = (size_t)(u.pm * BM + r) * 1024 + (col0 & 1023);
                const unsigned pwd[4] = {pv[q].x, pv[q].y, pv[q].z, pv[q].w};
#pragma unroll
                for (int bj = 0; bj < 2; ++bj) { float hf[8]; unpack8(hv[q][bj], hf);
#pragma unroll
                    for (int n = 0; n < 2; ++n) { const f32x4 z = acc[ai][bj][m][n] * rs; f32x4 o; const int w = (int)pwd[bj * 2 + n];
                        const float pf[4] = {__builtin_amdgcn_cvt_f32_fp8(w, 0), __builtin_amdgcn_cvt_f32_fp8(w, 1), __builtin_amdgcn_cvt_f32_fp8(w, 2), __builtin_amdgcn_cvt_f32_fp8(w, 3)};
#pragma unroll
                        for (int i = 0; i < 4; ++i) o[i] = (MODE == 3) ? hf[n * 4 + i] + (pf[i] * F8_PINV) * z[i] : hf[n * 4 + i] + (pf[i] * F8_PINV) * __builtin_amdgcn_rcpf(1.0f + __expf(-z[i]));
                        if (MODE == 2 && gi > 0) { asm volatile("" :: "v"(o)); } else *(f32x4*)(out + off + bj * 8 + n * 4) = o; } } }
            asm volatile("" ::: "memory"); }
    }
};
template <int MODE> struct EpiBf16Probe {
    static constexpr bool PERM = true, AFTER_DRAIN = false;
    bf16* O; int ldc;
    __device__ __forceinline__ void operator()(const Acc& acc, const Unit& u, int wr, int wc, int fr, int fq) const {
        const int row0 = u.pm * BM + wr * 64 + fr, col0 = u.pn * BM + wc * 64 + 16 * fq;
#pragma unroll
        for (int ai = 0; ai < 2; ++ai)
#pragma unroll
            for (int m = 0; m < 4; ++m) { const int row = row0 + ai * HALF + m * 16; bf16* rowp = O + (size_t)row * ldc + col0;
#pragma unroll
                for (int bj = 0; bj < 2; ++bj) { const f32x4 v0 = acc[ai][bj][m][0], v1 = acc[ai][bj][m][1]; v4u w;
                    w.x = cvt_pk_bf16(v0[0], v0[1]); w.y = cvt_pk_bf16(v0[2], v0[3]); w.z = cvt_pk_bf16(v1[0], v1[1]); w.w = cvt_pk_bf16(v1[2], v1[3]);
                    if (MODE == 1 && (ai || m)) { asm volatile("" :: "v"(w)); } else *(v4u*)(rowp + bj * 8) = w; } }
    }
};
template <bool GATHER_, int NPN> struct MoeOrder {
    static constexpr bool GATHER = GATHER_, MID = false, TAILSKIP = HALFU != 0;
    __device__ __forceinline__ bool halfu(const Unit& u) const { return u.nl - u.rk0 <= HALF_ROWS; }
    __device__ __forceinline__ bool quartu(const Unit& u) const { return u.nl - u.rk0 <= 64; }
    LAS unsigned char* ldsx; const Ent* ent; int tlo, thi, G, c, wave; const Ent* zero;
    CvtWork w{}; int slot = -1;
    int xm = 0; unsigned* tsig = nullptr; unsigned* twait = nullptr;
    __device__ __forceinline__ int nunits() const { const int nun = (thi - tlo) * NPN; return c < nun ? (nun - 1 - c) / G + 1 : 0; }
    __device__ __forceinline__ bool next(int i, Unit& u) const {
        int tile, pn_;
        if (xm) { const int x = c >> 5, j = c & 31;
            if (NPN == 4) { tile = tlo + 64 * i + 8 * (j >> 2) + x; pn_ = j & 3; } else { const int l = 32 * i + (31 - j); tile = tlo + 8 * (l >> 3) + x; pn_ = l & 7; }
            if (tile >= thi) return false; }
        else { const long L = (long)i * G + c; const int nun = (thi - tlo) * NPN; if (L >= nun) return false; tile = tlo + (int)(L / NPN); pn_ = (int)(L % NPN); }
        const LAS int* T0 = (const LAS int*)(ldsx + LST_OFF + 256);
        int l = 0;
        for (int j = 1; j < NLIST; ++j) l += (T0[j] <= tile) ? 1 : 0;
        l = __builtin_amdgcn_readfirstlane(l);
        u.pm = tile; u.pn = pn_; u.bt = (l & (NE - 1)) * NPN + u.pn; u.par = i & 1; u.lst = l; u.rk0 = (tile - __builtin_amdgcn_readfirstlane(T0[l])) * BM; u.nl = __builtin_amdgcn_readfirstlane(((const LAS int*)(ldsx + LST_OFF))[l]);
        return true;
    }
    __device__ __forceinline__ void a_prefetch(const Unit& u) const {
        if (wave < 4) { const int tid = TIDX(wave); const int rk = u.rk0 + tid; const Ent* src = rk < u.nl ? ent + (size_t)u.lst * LCAP + rk : zero;
            __builtin_amdgcn_global_load_lds((const unsigned*)src, (LAS unsigned*)(ldsx + TAB_OFF + u.par * 4096 + wave * 1024), 16, 0, 0); }
    }
    __device__ __forceinline__ void a_first() const { asm volatile("s_waitcnt vmcnt(0)" ::: "memory"); __builtin_amdgcn_s_barrier(); asm volatile("" ::: "memory"); }
    __device__ __forceinline__ void a_ready(const Unit& u) const {
        if (twait) { unsigned sp = 0; while (__hip_atomic_load(twait + u.pm, __ATOMIC_RELAXED, __HIP_MEMORY_SCOPE_AGENT) < 4u) { __builtin_amdgcn_s_sleep(1); if (++sp > (1u << 22)) break; } asm volatile("" ::: "memory"); } }
    __device__ __forceinline__ void done(const Unit&) const {}
    __device__ __forceinline__ void between(int ui, int wid) const { if (GATHER_ && ui == slot) w.run(wid, CvtWork::NGU, CvtWork::NIT); }
    __device__ __forceinline__ void signal(int tile) const { if (tsig && TIDX(wave) == 0) (void)__hip_atomic_fetch_add(tsig + tile, 1u, __ATOMIC_RELAXED, __HIP_MEMORY_SCOPE_AGENT); }
};
struct FinalOrder : StaticOrder {
    LAS unsigned char* ldsx; const float* ssp; int wave; bool pre;
    __device__ __forceinline__ bool next(int i, Unit& u) const { const bool ok = StaticOrder::next(i, u); u.lst = i; return ok; }
    __device__ __forceinline__ void a_prefetch(const Unit&) const {}
    __device__ __forceinline__ void a_first() const {}
    __device__ __forceinline__ void fill_all() const {
        const int tid = TIDX(wave), r = tid & 255;
#pragma unroll 1
        for (int i = tid >> 8; i < 8; i += 2) { Unit u; if (!next(i, u)) break; const int row = u.pm * BM + r; float ss = 0.f;
#pragma unroll
            for (int j = 0; j < 8; ++j) { const f32x4 p = *(const f32x4*)(ssp + (size_t)row * 32 + 4 * j); ss += (p[0] + p[1]) + (p[2] + p[3]); }
            ((LAS float*)(ldsx + TAB_OFF))[i * 256 + r] = 1.0f / sqrtf(ss * (1.0f / D) + EPS); }
        __syncthreads();
    }
    __device__ __forceinline__ void a_ready(const Unit& u) const {
        if (pre) return;
        const int tid = TIDX(wave);
        if (tid < 256) { const int row = u.pm * BM + tid; float ss = 0.f;
#pragma unroll
            for (int j = 0; j < 8; ++j) { const f32x4 p = *(const f32x4*)(ssp + (size_t)row * 32 + 4 * j); ss += (p[0] + p[1]) + (p[2] + p[3]); }
            *(LAS v4u*)(ldsx + TAB_OFF + u.par * 4096 + tid * 16) = (v4u){(unsigned)row, 0u, __float_as_uint(1.0f / sqrtf(ss * (1.0f / D) + EPS)), 0u}; }
    }
};
}
#define RLX_AGENT __ATOMIC_RELAXED, __HIP_MEMORY_SCOPE_AGENT
#define XB_TMO      128
#define XB_XCNT(j)  (256  + 64 * (j))
#define XB_XSUB(j)  (1280 + 64 * (j))
#define XB_XGEN(j)  (2304 + 64 * (j))
#define XB_TOP      3328
#define XB_TOPGEN   3392
#define XCD_BAR_WORDS 3456
#define XB_SPIN_CAP (1u << 18)

__device__ __forceinline__ unsigned xb_ld(unsigned* p)              { return __hip_atomic_load(p, __ATOMIC_RELAXED, __HIP_MEMORY_SCOPE_AGENT); }
__device__ __forceinline__ unsigned xb_add(unsigned* p, unsigned v) { return __hip_atomic_fetch_add(p, v, __ATOMIC_RELAXED, __HIP_MEMORY_SCOPE_AGENT); }
__device__ __forceinline__ unsigned xb_xcc_id() { return (unsigned)__builtin_amdgcn_s_getreg((3 << 11) | 20) & 0xFu; }
#define XB_SPIN(cond, bar) do { unsigned _sp = 0; while (cond) { __builtin_amdgcn_s_sleep(1); \
    if ((++_sp & 255u) == 0u) { if (xb_ld(&(bar)[XB_TMO])) break; if (_sp > XB_SPIN_CAP) { atomicAdd(&(bar)[XB_TMO], 1u); break; } } } } while (0)

struct XcdBarrier {
    unsigned* bar; unsigned x;
    volatile LAS unsigned* st;
};
__device__ __forceinline__ XcdBarrier xcd_barrier_post(unsigned* bar, volatile LAS unsigned* st, const int wave_) {
    XcdBarrier b; b.bar = bar; b.x = xb_xcc_id(); b.st = st;
    if (TIDX(wave_) == 0) (void)xb_add(&bar[XB_XCNT(b.x)], 1u);
    return b;
}
__device__ __forceinline__ void xcd_barrier_complete(unsigned* bar, unsigned x, unsigned& nloc, unsigned& nx) {
    const unsigned G = gridDim.x * gridDim.y * gridDim.z;
    unsigned sum, cnt, mine, sp = 0u;
    for (;;) {
        sum = 0u; cnt = 0u; mine = 0u;
#pragma unroll
        for (unsigned j = 0; j < 16; ++j) { const unsigned c = xb_ld(&bar[XB_XCNT(j)]); sum += c; cnt += (c > 0u) ? 1u : 0u; mine = (j == x) ? c : mine; }
        if (sum == G) break;
        __builtin_amdgcn_s_sleep(1);
        if ((++sp & 255u) == 0u) { if (xb_ld(&bar[XB_TMO])) break; if (sp > XB_SPIN_CAP) { atomicAdd(&bar[XB_TMO], 1u); break; } }
    }
    nloc = mine > 0u ? mine : 1u; nx = cnt > 0u ? cnt : 1u;
}
__device__ __forceinline__ void xcd_barrier(const XcdBarrier& b, const int wave_) {
    asm volatile("s_waitcnt vmcnt(0)" ::: "memory");
    __syncthreads();
    if (TIDX(wave_) == 0) {
        unsigned* bar = b.bar;
        __builtin_amdgcn_s_waitcnt(0);
        unsigned nloc = b.st[0], nx = b.st[1];
        if (nloc == 0u) { xcd_barrier_complete(bar, b.x, nloc, nx); b.st[0] = nloc; b.st[1] = nx; }
        const unsigned old = xb_add(&bar[XB_XSUB(b.x)], 1u);
        const unsigned gen = old / nloc;
        if (old + 1u == (gen + 1u) * nloc) {
            __builtin_amdgcn_fence(__ATOMIC_RELEASE, "agent");
            asm volatile("s_waitcnt vmcnt(0)" ::: "memory");
            const unsigned og = xb_add(&bar[XB_TOP], 1u);
            const unsigned tg = og / nx;
            if (og + 1u == (tg + 1u) * nx) xb_add(&bar[XB_TOPGEN], 1u);
            else XB_SPIN(xb_ld(&bar[XB_TOPGEN]) == tg, bar);
            __builtin_amdgcn_fence(__ATOMIC_ACQUIRE, "agent");
            xb_add(&bar[XB_XGEN(b.x)], 1u);
            asm volatile("s_waitcnt vmcnt(0)" ::: "memory");
        } else {
            XB_SPIN(xb_ld(&bar[XB_XGEN(b.x)]) == gen, bar);
            __builtin_amdgcn_fence(__ATOMIC_ACQUIRE, "agent");
            asm volatile("s_waitcnt vmcnt(0)" ::: "memory");
        }
    }
    __syncthreads();
}

constexpr int NWAVES = 8;
__device__ __forceinline__ void p0_transpose_item(const float* W, int K, int N, const float* g0, const float* g1, int gsplit, bf16* WT, int rowbase, int k0, int n0, LAS float* scr, int lane, int rs8 = 8) {
    float v[32];
    const float* src = W + (size_t)(k0 + (lane >> 5)) * N + n0 + (lane & 31);
#pragma unroll
    for (int i = 0; i < 32; ++i) v[i] = __builtin_nontemporal_load(src + (size_t)(2 * i) * N);
    const int c = lane & 7;
    float gg[8];
#pragma unroll
    for (int j = 0; j < 8; ++j) { const int k = k0 + 8 * c + j; gg[j] = g0 ? (k < gsplit ? g0[k] : g1[k - gsplit]) : 1.f; }
#pragma unroll
    for (int i = 0; i < 32; ++i) scr[(2 * i + (lane >> 5)) * 33 + (lane & 31)] = v[i];
    asm volatile("s_waitcnt lgkmcnt(0)" ::: "memory");
#pragma unroll
    for (int j = 0; j < 4; ++j) { const int n = (lane >> 3) + 8 * j; const LAS float* s = scr + (8 * c) * 33 + n;
        v4u o; o.x = pk2(s[0 * 33] * gg[0], s[1 * 33] * gg[1]); o.y = pk2(s[2 * 33] * gg[2], s[3 * 33] * gg[3]); o.z = pk2(s[4 * 33] * gg[4], s[5 * 33] * gg[5]); o.w = pk2(s[6 * 33] * gg[6], s[7 * 33] * gg[7]);
        *(v4u*)(WT + (size_t)(rowbase + j * rs8 + (lane >> 3)) * K + k0 + 8 * c) = o; }
    asm volatile("s_waitcnt lgkmcnt(0)" ::: "memory");
}
__device__ __forceinline__ void p0_transpose_item8(const float* W, int K, int N, const float* g0, unsigned char* WT8, int rowbase, int k0, int n0, LAS float* scr, int lane, float sc, int rs8 = 8) {
    float v[32];
    const float* src = W + (size_t)(k0 + (lane >> 5)) * N + n0 + (lane & 31);
#pragma unroll
    for (int i = 0; i < 32; ++i) v[i] = __builtin_nontemporal_load(src + (size_t)(2 * i) * N);
    const int c = lane & 7;
    float gg[8];
#pragma unroll
    for (int j = 0; j < 8; ++j) gg[j] = (g0 ? g0[k0 + 8 * c + j] : 1.f) * sc;
#pragma unroll
    for (int i = 0; i < 32; ++i) scr[(2 * i + (lane >> 5)) * 33 + (lane & 31)] = v[i];
    asm volatile("s_waitcnt lgkmcnt(0)" ::: "memory");
#pragma unroll
    for (int j = 0; j < 4; ++j) { const int n = (lane >> 3) + 8 * j; const LAS float* s = scr + (8 * c) * 33 + n; float f[8];
#pragma unroll
        for (int q = 0; q < 8; ++q) f[q] = s[q * 33] * gg[q];
        *(v2u*)(WT8 + (size_t)(rowbase + j * rs8 + (lane >> 3)) * K + k0 + 8 * c) = pack8_f8(f, 1.0f); }
    asm volatile("s_waitcnt lgkmcnt(0)" ::: "memory");
}
__device__ __forceinline__ void p0_prologue(const Ptrs& P, LAS unsigned char* lds, int vcu, int G, const int wave) {
    const int lane = lane_id(), tid = wave * 64 + lane;
    unsigned char* ws = P.ws;
    LAS float* scr = (LAS float*)(lds + wave * 16384);
    const int gw = vcu * NWAVES + wave, NGW = G * NWAVES;
    constexpr int I_IN = (D / 64) * (DIN / 32), I_OUT = (D / 64) * (D / 32), I_PLG = I_OUT, I_PLE = (PLE / 64) * (D / 32), I_RT = (D / 64) * (NE / 32);
    constexpr int I_G1 = (D / 64) * (DEXP / 32), I_D1 = (DEXP / 64) * (D / 32);
    constexpr int NITEMS = I_IN + I_OUT + I_PLG + I_PLE + I_RT + (DEFER_CVT ? 0 : NE * (2 * I_G1 + I_D1));
    for (int it = gw; it < NITEMS; it += NGW) {
        int r = it;
        if (r < I_IN) { const int nb = DIN / 32; const int n0 = (r % nb) * 32, k0 = (r / nb) * 64;
            if (FP8QKV && n0 >= C_Q) p0_transpose_item8(P.w_in, D, DIN, P.norm_mix, ws + WS_WIN8, n0 - C_Q, k0, n0, scr, lane, F8_WSCALE);
            else if (UPROD && n0 >= C_C && n0 < C_Q) { const int isH = n0 >= C_HC ? 1 : 0, ch = n0 - (isH ? C_HC : C_C);
                p0_transpose_item(P.w_in, D, DIN, P.norm_mix, nullptr, D, (bf16*)(ws + WS_WIN), C_C + 256 * (ch >> 7) + 64 * ((ch & 127) >> 5) + 8 * isH, k0, n0, scr, lane, 16); }
            else p0_transpose_item(P.w_in, D, DIN, P.norm_mix, nullptr, D, (bf16*)(ws + WS_WIN), n0, k0, n0, scr, lane);
            continue; } r -= I_IN;
        if (r < I_OUT) { const int nb = D / 32; const int k0 = (r / nb) * 64;
            if (FP8O) p0_transpose_item8(P.w_out, D, D, k0 < DCONV ? P.onc : P.ona - DCONV, ws + WS_WOUT, (r % nb) * 32, k0, (r % nb) * 32, scr, lane, F8_WSCALE);
            else p0_transpose_item(P.w_out, D, D, P.onc, P.ona, DCONV, (bf16*)(ws + WS_WOUT), (r % nb) * 32, k0, (r % nb) * 32, scr, lane);
            continue; } r -= I_OUT;
        if (r < I_PLG) { const int nb = D / 32;
            if (FP8) p0_transpose_item8(P.w_ple_gate, D, D, P.norm_ple, ws + WS_WPLG, (r % nb) * 32, (r / nb) * 64, (r % nb) * 32, scr, lane, F8_WSCALE);
            else p0_transpose_item(P.w_ple_gate, D, D, P.norm_ple, nullptr, D, (bf16*)(ws + WS_WPLG), (r % nb) * 32, (r / nb) * 64, (r % nb) * 32, scr, lane);
            continue; } r -= I_PLG;
        if (r < I_PLE) { const int nb = D / 32; p0_transpose_item(P.w_ple, PLE, D, nullptr, nullptr, 0, (bf16*)(ws + WS_WPLE), (r % nb) * 32, (r / nb) * 64, (r % nb) * 32, scr, lane); continue; } r -= I_PLE;
        if (r < I_RT) { p0_transpose_item(P.w_router, D, NE, P.norm_ffn, nullptr, D, (bf16*)(ws + WS_WR), NGRP, r * 64, 0, scr, lane); continue; } r -= I_RT;
        const int e = r / (2 * I_G1 + I_D1); r -= e * (2 * I_G1 + I_D1);
        if (r < 2 * I_G1) { const int up = r >= I_G1; r -= up * I_G1; const int nb = DEXP / 32, n0 = (r % nb) * 32, k0 = (r / nb) * 64;
            if (FP8) p0_transpose_item8((up ? P.w_up : P.w_gate) + (size_t)e * D * DEXP, D, DEXP, P.norm_ffn, ws + WS_WGU + (size_t)e * 1024 * D, (n0 >> 7) * 256 + 2 * (n0 & 127) + up * 8, k0, n0, scr, lane, F8_WSCALE, 16);
            else p0_transpose_item((up ? P.w_up : P.w_gate) + (size_t)e * D * DEXP, D, DEXP, P.norm_ffn, nullptr, D, (bf16*)(ws + WS_WGU) + (size_t)e * 1024 * D, (n0 >> 7) * 256 + up * 128 + (n0 & 127), k0, n0, scr, lane);
            continue; }
        r -= 2 * I_G1; { const int nb = D / 32;
            if (FP8) p0_transpose_item8(P.w_down + (size_t)e * DEXP * D, DEXP, D, nullptr, ws + WS_WD + (size_t)e * D * DEXP, (r % nb) * 32, (r / nb) * 64, (r % nb) * 32, scr, lane, F8_DSCALE);
            else p0_transpose_item(P.w_down + (size_t)e * DEXP * D, DEXP, D, nullptr, nullptr, 0, (bf16*)(ws + WS_WD) + (size_t)e * D * DEXP, (r % nb) * 32, (r / nb) * 64, (r % nb) * 32, scr, lane); }
    }
    { bf16* Wr = (bf16*)(ws + WS_WR); const int gt = vcu * (NWAVES * 64) + tid, NT = G * NWAVES * 64;
      for (int i = gt; i < NGRP * D; i += NT) { const int n = i / D, k = i % D; Wr[(size_t)n * D + k] = f2bf(P.norm_ffn[k] * P.w_group[(size_t)k * NGRP + n]); }
      for (int i = gt; i < (256 - NRT) * D / 8; i += NT) *(v4u*)(Wr + (size_t)NRT * D + (size_t)i * 8) = (v4u){0u, 0u, 0u, 0u}; }
    for (int m = gw; m < M; m += NGW) {
        const f32x4* xr = (const f32x4*)(P.x + (size_t)m * D) + lane; f32x4 v[8]; float s = 0.f;
#pragma unroll
        for (int j = 0; j < 8; ++j) { v[j] = __builtin_nontemporal_load(xr + 64 * j); s += (v[j][0] * v[j][0] + v[j][1] * v[j][1]) + (v[j][2] * v[j][2] + v[j][3] * v[j][3]); }
        s = wsum(s);
        v2u* o8 = (v2u*)((bf16*)(ws + WS_XB) + (size_t)m * D) + lane;
        const float rstd = 1.0f / sqrtf(s * (1.0f / D) + EPS);
#pragma unroll
        for (int j = 0; j < 8; ++j) { v2u o; o.x = pk2(v[j][0] * rstd, v[j][1] * rstd); o.y = pk2(v[j][2] * rstd, v[j][3] * rstd); o8[64 * j] = o; }
        if (FP8QKV) { unsigned* o4 = (unsigned*)(ws + WS_XB8 + (size_t)m * D) + lane; const float r16 = rstd * F8_ASCALE;
#pragma unroll
            for (int j = 0; j < 8; ++j) { int w = 0; w = __builtin_amdgcn_cvt_pk_fp8_f32(v[j][0] * r16, v[j][1] * r16, w, false); w = __builtin_amdgcn_cvt_pk_fp8_f32(v[j][2] * r16, v[j][3] * r16, w, true); o4[64 * j] = (unsigned)w; } }
        if (lane == 0) { ((float*)(ws + WS_RSX))[m] = 1.0f; ((float*)(ws + WS_RMSX))[m] = sqrtf(s * (1.0f / D) + EPS); }
    }
    { const int gt = vcu * (NWAVES * 64) + tid, NT = G * NWAVES * 64; const f32x4* src = (const f32x4*)P.p; v4u* dst = (v4u*)(ws + WS_PB);
      for (int i = gt; i < M * PLE / 8; i += NT) { const f32x4 a = __builtin_nontemporal_load(src + 2 * i), b = __builtin_nontemporal_load(src + 2 * i + 1); v4u o; o.x = pk2(a[0], a[1]); o.y = pk2(a[2], a[3]); o.z = pk2(b[0], b[1]); o.w = pk2(b[2], b[3]); dst[i] = o; } }
}

#ifndef CONVR
#define CONVR 4
#endif
constexpr int P2_KS = 0, P2_KROW = 144, P2_VT = 36864, P2_VROW = 528, P2_OST = 70656, P2_OROW = 144, P2_SS = 107520, P2_RSTD = 108032, P2_QG = 108544;
__device__ __forceinline__ int crow(int r, int hi) { return (r & 3) + 8 * (r >> 2) + 4 * hi; }
__device__ __forceinline__ void p2_unit(const Ptrs& P, LAS unsigned char* lds, int unit, const int wid, const bool conv_first, const bool fixup) {
    int lane_ = lane_id_asm(); asm volatile("" : "+v"(lane_));
    const int lane = lane_ & 63, tid = wid * 64 + lane, l32 = lane & 31, hi = lane >> 5;
    const bf16* proj = (const bf16*)(P.ws + WS_PROJ); bf16* mixed = (bf16*)(P.ws + WS_MIX); unsigned char* mixed8 = P.ws + WS_MIX8;
    bf16* osc = FP8O ? (bf16*)(P.ws + WS_MIX + 64 * MiB) : mixed + DCONV; constexpr int OLD = FP8O ? DATTN : D;
    const int b = unit / (SEQ / 128), qb = unit % (SEQ / 128), q0 = qb * 128; const size_t rowbase = (size_t)b * SEQ;
    LAS float* rowss = (LAS float*)(lds + P2_SS); LAS float* qg = (LAS float*)(lds + P2_QG);
    __syncthreads();
    if (tid < 128) rowss[tid] = 0.f;
    if (tid < 64) qg[tid] = P.q_norm[tid] * (0.125f * LOG2E);
    if (conv_first) {
    {
        int lc_ = lane_id_asm(); asm volatile("" : "+v"(lc_)); const int lane = lc_ & 63;
        const float* cw = P.conv_w; float w0[16], w1[16], w2[16];
#pragma unroll
        for (int j = 0; j < 16; ++j) { const int ch = (j >> 3) * 512 + lane * 8 + (j & 7); w0[j] = cw[ch]; w1[j] = cw[DCONV + ch]; w2[j] = cw[2 * DCONV + ch]; }
        float u1[16], u2[16];
        const int t0 = q0 + 16 * wid;
#pragma unroll
        for (int j = 0; j < 16; ++j) { u1[j] = 0.f; u2[j] = 0.f; }
        if (t0 >= 2) {
#pragma unroll
            for (int hf = 0; hf < 2; ++hf) { const int ch = hf * 512 + lane * 8; float c[8], hc[8];
                const bf16* pr = proj + (rowbase + t0 - 1) * PP; unpack8(*(const v4u*)(pr + O_U + ch), c); if (!UPROD) unpack8(*(const v4u*)(pr + C_HC + ch), hc);
#pragma unroll
                for (int j = 0; j < 8; ++j) u1[hf * 8 + j] = UPROD ? c[j] : c[j] * hc[j];
                pr -= PP; unpack8(*(const v4u*)(pr + O_U + ch), c); if (!UPROD) unpack8(*(const v4u*)(pr + C_HC + ch), hc);
#pragma unroll
                for (int j = 0; j < 8; ++j) u2[hf * 8 + j] = UPROD ? c[j] : c[j] * hc[j]; }
        }
#pragma unroll 1
        for (int r0 = 0; r0 < 16; r0 += CONVR) {
            v4u rb[CONVR][2], rc[CONVR][2], rh[CONVR][2];
#pragma unroll
            for (int rr = 0; rr < CONVR; ++rr) { const bf16* pr = proj + (rowbase + t0 + r0 + rr) * PP + lane * 8;
#pragma unroll
                for (int hf = 0; hf < 2; ++hf) { rb[rr][hf] = __builtin_nontemporal_load((const v4u*)(pr + O_B + hf * 512)); rc[rr][hf] = __builtin_nontemporal_load((const v4u*)(pr + O_U + hf * 512)); if (!UPROD) rh[rr][hf] = __builtin_nontemporal_load((const v4u*)(pr + C_HC + hf * 512)); } }
#pragma unroll
            for (int rr = 0; rr < CONVR; ++rr) { float y[16]; float ss = 0.f;
#pragma unroll
                for (int hf = 0; hf < 2; ++hf) { float bb[8], c[8], hc[8]; unpack8(rb[rr][hf], bb); unpack8(rc[rr][hf], c); if (!UPROD) unpack8(rh[rr][hf], hc);
#pragma unroll
                    for (int j = 0; j < 8; ++j) { const int jj = hf * 8 + j; const float u0 = UPROD ? c[j] : c[j] * hc[j];
                        y[jj] = bb[j] * (w0[jj] * u2[jj] + w1[jj] * u1[jj] + w2[jj] * u0); ss += y[jj] * y[jj]; u2[jj] = u1[jj]; u1[jj] = u0; } }
                ss = wsum(ss); const float rs = rsqf(ss * (1.0f / DCONV) + EPS);
#pragma unroll
                for (int hf = 0; hf < 2; ++hf) { float f[8];
#pragma unroll
                    for (int j = 0; j < 8; ++j) f[j] = y[hf * 8 + j] * rs;
                    if (FP8O) *(v2u*)(mixed8 + (rowbase + t0 + r0 + rr) * D + hf * 512 + lane * 8) = pack8_f8(f, F8_ASCALE);
                    else *(v4u*)(mixed + (rowbase + t0 + r0 + rr) * D + hf * 512 + lane * 8) = pack8(f); } }
        }
    }
    }
    const int h4 = wid & 3, half = wid >> 2;
    const int part = tid & 7;
    float kg[8];
#pragma unroll
    for (int j = 0; j < 8; ++j) kg[j] = P.k_norm[part * 8 + j];
    v4u kraw[4], vraw[4], qraw[4];
    const int kvoff = (tid >> 3) * PP + part * 8, qoff = l32 * PP + 8 * hi;
#define P2_LOAD_KV(g_) do { _Pragma("unroll") for (int i = 0; i < 4; ++i) { kraw[i] = (v4u){0u, 0u, 0u, 0u}; vraw[i] = (v4u){0u, 0u, 0u, 0u}; \
        if (q0 > 0 || i >= 2) { const bf16* ub = proj + (rowbase + q0 - 128 + 64 * i) * PP + (g_) * HD; kraw[i] = *(const v4u*)(ub + O_K + kvoff); vraw[i] = *(const v4u*)(ub + O_V + kvoff); } } } while (0)
#define P2_LOAD_Q(g_, sub_) do { const bf16* ub = proj + (rowbase + q0 + 64 * half + 32 * (sub_)) * PP + O_Q + ((g_) * 4 + h4) * HD; \
        _Pragma("unroll") for (int d0 = 0; d0 < 4; ++d0) qraw[d0] = __builtin_nontemporal_load((const v4u*)(ub + 16 * d0 + qoff)); } while (0)
    P2_LOAD_KV(0); P2_LOAD_Q(0, 0);
#pragma unroll 1
    for (int g = 0; g < NKV; ++g) {
        int lg_ = lane_id_asm(); asm volatile("" : "+v"(lg_));
        const int lane = lg_ & 63, tid = wid * 64 + lane, l32 = lane & 31, hi = lane >> 5, part = tid & 7;
        const int kvoff = (tid >> 3) * PP + part * 8, qoff = l32 * PP + 8 * hi, ooffo = (lane >> 3) * OLD + (lane & 7) * 8;
        __syncthreads();
#pragma unroll
        for (int i = 0; i < 4; ++i) {
            const int key = (tid >> 3) + 64 * i;
            float kf[8]; unpack8(kraw[i], kf); float ss = 0.f;
#pragma unroll
            for (int j = 0; j < 8; ++j) ss += kf[j] * kf[j];
            ss += __shfl_xor(ss, 1); ss += __shfl_xor(ss, 2); ss += __shfl_xor(ss, 4);
            const float rk = rsqf(ss * (1.0f / HD) + EPS);
#pragma unroll
            for (int j = 0; j < 8; ++j) kf[j] = kf[j] * rk * kg[j];
            *(LAS v4u*)(lds + P2_KS + key * P2_KROW + part * 16) = pack8(kf);
            const int x = key & 15; const int pos = (key & ~15) + (x & 3) + ((x >> 3) & 1) * 4 + ((x >> 2) & 1) * 8;
            LAS bf16* vt = (LAS bf16*)(lds + P2_VT) + pos;
            const unsigned vw[4] = {vraw[i].x, vraw[i].y, vraw[i].z, vraw[i].w};
#pragma unroll
            for (int j = 0; j < 4; ++j) { vt[(part * 8 + 2 * j) * (P2_VROW / 2)] = (bf16)(vw[j] & 0xffffu); vt[(part * 8 + 2 * j + 1) * (P2_VROW / 2)] = (bf16)(vw[j] >> 16); }
        }
        if (g + 1 < NKV) { P2_LOAD_KV(g + 1); }
        __syncthreads();
        const int h = g * 4 + h4;
        const float slope2 = exp2f(-0.5f * (float)(h + 1)) * LOG2E, sink2 = P.sinks[h] * LOG2E;
#pragma unroll
        for (int sub = 0; sub < 2; ++sub) {
            const int qs = 64 * half + 32 * sub;
            const int kt0 = 2 * half + sub;
            bf16x8 qf[4];
            { float qv[4][8]; float ss = 0.f;
#pragma unroll
              for (int d0 = 0; d0 < 4; ++d0) { unpack8(qraw[d0], qv[d0]);
#pragma unroll
                  for (int j = 0; j < 8; ++j) ss += qv[d0][j] * qv[d0][j]; }
              ss = xsum32(ss);
              const float rq = rsqf(ss * (1.0f / HD) + EPS);
#pragma unroll
              for (int d0 = 0; d0 < 4; ++d0) {
#pragma unroll
                  for (int j = 0; j < 8; ++j) qv[d0][j] = qv[d0][j] * rq * qg[16 * d0 + 8 * hi + j];
                  const v4u w = pack8(qv[d0]); qf[d0] = __builtin_bit_cast(bf16x8, w); } }
            if (sub == 0) { P2_LOAD_Q(g, 1); } else if (g + 1 < NKV) { P2_LOAD_Q(g + 1, 0); }
            f32x16 sc[5];
#pragma unroll
            for (int jt = 0; jt < 5; ++jt) { sc[jt] = (f32x16){0.f, 0.f, 0.f, 0.f, 0.f, 0.f, 0.f, 0.f, 0.f, 0.f, 0.f, 0.f, 0.f, 0.f, 0.f, 0.f};
#pragma unroll
                for (int d0 = 0; d0 < 4; ++d0) { const bf16x8 kfr = *(const LAS bf16x8*)(lds + P2_KS + ((kt0 + jt) * 32 + l32) * P2_KROW + (16 * d0 + 8 * hi) * 2);
                    sc[jt] = __builtin_amdgcn_mfma_f32_32x32x16_bf16(kfr, qf[d0], sc[jt], 0, 0, 0); } }
            int bl = l32 - 4 * hi; asm volatile("" : "+v"(bl));
            const float ab = -slope2 * (float)bl;
            const f32x2_t ns2 = (f32x2_t){-slope2, -slope2};
#pragma unroll
            for (int jt = 0; jt < 5; ++jt)
#pragma unroll
                for (int r = 0; r < 16; r += 2) { const int c0 = 128 - 32 * jt - (r & 3) - 8 * (r >> 2), c1 = 128 - 32 * jt - ((r + 1) & 3) - 8 * ((r + 1) >> 2);
                    f32x2_t v = (f32x2_t){(float)c0, (float)c1} * ns2 + (f32x2_t){sc[jt][r], sc[jt][r + 1]};
                    if (jt == 0) { v.x = (bl + c0 < 128) ? v.x : -1.0e30f; v.y = (bl + c1 < 128) ? v.y : -1.0e30f; }
                    if (jt == 4) { v.x = (bl + c0 >= 0) ? v.x : -1.0e30f; v.y = (bl + c1 >= 0) ? v.y : -1.0e30f; }
                    sc[jt][r] = v.x; sc[jt][r + 1] = v.y; }
            if (q0 == 0) {
                const int lim = 128 - qs;
#pragma unroll
                for (int jt = 0; jt < 4; ++jt)
#pragma unroll
                    for (int r = 0; r < 16; ++r) { const int kr = crow(r, hi); sc[jt][r] = (32 * jt + kr >= lim) ? sc[jt][r] : -1.0e30f; }
            }
            float mxt = -3.0e38f;
#pragma unroll
            for (int jt = 0; jt < 5; ++jt)
#pragma unroll
                for (int r = 0; r < 16; r += 2) mxt = fmaxf(mxt, fmaxf(sc[jt][r], sc[jt][r + 1]));
            float mx = fmaxf(sink2, mxt + ab); mx = xmax32(mx);
            f32x2_t l2 = (f32x2_t){0.f, 0.f}; const f32x2_t mx2 = (f32x2_t){mx - ab, mx - ab};
#pragma unroll
            for (int jt = 0; jt < 5; ++jt)
#pragma unroll
                for (int r = 0; r < 16; r += 2) { const f32x2_t d = (f32x2_t){sc[jt][r], sc[jt][r + 1]} - mx2; f32x2_t p; p.x = __builtin_amdgcn_exp2f(d.x); p.y = __builtin_amdgcn_exp2f(d.y); sc[jt][r] = p.x; sc[jt][r + 1] = p.y; l2 += p; }
            float l = l2.x + l2.y;
            l = xsum32(l); l += __builtin_amdgcn_exp2f(sink2 - mx);
            const float rl = __builtin_amdgcn_rcpf(l);
            f32x16 o[2];
#pragma unroll
            for (int dh = 0; dh < 2; ++dh) { o[dh] = (f32x16){0.f, 0.f, 0.f, 0.f, 0.f, 0.f, 0.f, 0.f, 0.f, 0.f, 0.f, 0.f, 0.f, 0.f, 0.f, 0.f}; }
#pragma unroll
            for (int jt = 0; jt < 5; ++jt)
#pragma unroll
                for (int j = 0; j < 2; ++j) { v4u pw; pw.x = pk2(sc[jt][8 * j + 0], sc[jt][8 * j + 1]); pw.y = pk2(sc[jt][8 * j + 2], sc[jt][8 * j + 3]); pw.z = pk2(sc[jt][8 * j + 4], sc[jt][8 * j + 5]); pw.w = pk2(sc[jt][8 * j + 6], sc[jt][8 * j + 7]);
                    const bf16x8 pf = __builtin_bit_cast(bf16x8, pw);
#pragma unroll
                    for (int dh = 0; dh < 2; ++dh) { const bf16x8 vf = *(const LAS bf16x8*)(lds + P2_VT + (32 * dh + l32) * P2_VROW + ((kt0 + jt) * 32 + 16 * j + 8 * hi) * 2);
                        o[dh] = __builtin_amdgcn_mfma_f32_32x32x16_bf16(vf, pf, o[dh], 0, 0, 0); } }
            float ss = 0.f;
            LAS unsigned char* ost = lds + P2_OST + wid * (32 * P2_OROW);
#pragma unroll
            for (int dh = 0; dh < 2; ++dh)
#pragma unroll
                for (int r4 = 0; r4 < 4; ++r4) { float a0 = o[dh][4 * r4] * rl, a1 = o[dh][4 * r4 + 1] * rl, a2 = o[dh][4 * r4 + 2] * rl, a3 = o[dh][4 * r4 + 3] * rl;
                    ss += (a0 * a0 + a1 * a1) + (a2 * a2 + a3 * a3);
                    v2u w; w.x = pk2(a0, a1); w.y = pk2(a2, a3);
                    *(LAS v2u*)(ost + l32 * P2_OROW + (32 * dh + 8 * r4 + 4 * hi) * 2) = w; }
            ss = xsum32(ss);
            if (hi == 0) __hip_atomic_fetch_add(rowss + qs + l32, ss, __ATOMIC_RELAXED, __HIP_MEMORY_SCOPE_WORKGROUP);
            asm volatile("s_waitcnt lgkmcnt(0)" ::: "memory");
#pragma unroll
            for (int i = 0; i < 4; ++i) { const int rr = i * 8 + (lane >> 3), ch = lane & 7; const v4u v = *(const LAS v4u*)(ost + rr * P2_OROW + ch * 16);
                bf16* ub = osc + (rowbase + q0 + qs + 8 * i) * OLD + h * HD; *(v4u*)(ub + ooffo) = v; }
            asm volatile("s_waitcnt lgkmcnt(0)" ::: "memory");
            __builtin_amdgcn_sched_barrier(0);
        }
    }
#undef P2_LOAD_KV
#undef P2_LOAD_Q
    if (!fixup) { __syncthreads(); if (tid < 128) ((float*)(P.ws + WS_RS2))[rowbase + q0 + tid] = rsqf(rowss[tid] * (1.0f / DATTN) + EPS); }
    else {
    asm volatile("s_waitcnt vmcnt(0)" ::: "memory");
    __syncthreads();
    LAS float* rstd = (LAS float*)(lds + P2_RSTD);
    if (tid < 128) rstd[tid] = rsqf(rowss[tid] * (1.0f / DATTN) + EPS);
    __syncthreads();
    { int lf_ = lane_id_asm(); asm volatile("" : "+v"(lf_)); const int tid = wid * 64 + (lf_ & 63);
#pragma unroll 8
    for (int i = 0; i < 32; ++i) { const int rr = (tid >> 7) + 4 * i, ch = tid & 127; bf16* p = osc + (rowbase + q0 + rr) * OLD + ch * 8;
        float f[8]; unpack8(*(const v4u*)p, f); const float s = rstd[rr];
#pragma unroll
        for (int j = 0; j < 8; ++j) f[j] *= s;
        if (FP8O) *(v2u*)(mixed8 + (rowbase + q0 + rr) * D + DCONV + ch * 8) = pack8_f8(f, F8_ASCALE); else *(v4u*)p = pack8(f); } }
    }
    if (!conv_first) {
    {
        int lc_ = lane_id_asm(); asm volatile("" : "+v"(lc_)); const int lane = lc_ & 63;
        const float* cw = P.conv_w; float w0[16], w1[16], w2[16];
#pragma unroll
        for (int j = 0; j < 16; ++j) { const int ch = (j >> 3) * 512 + lane * 8 + (j & 7); w0[j] = cw[ch]; w1[j] = cw[DCONV + ch]; w2[j] = cw[2 * DCONV + ch]; }
        float u1[16], u2[16];
        const int t0 = q0 + 16 * wid;
#pragma unroll
        for (int j = 0; j < 16; ++j) { u1[j] = 0.f; u2[j] = 0.f; }
        if (t0 >= 2) {
#pragma unroll
            for (int hf = 0; hf < 2; ++hf) { const int ch = hf * 512 + lane * 8; float c[8], hc[8];
                const bf16* pr = proj + (rowbase + t0 - 1) * PP; unpack8(*(const v4u*)(pr + O_U + ch), c); if (!UPROD) unpack8(*(const v4u*)(pr + C_HC + ch), hc);
#pragma unroll
                for (int j = 0; j < 8; ++j) u1[hf * 8 + j] = UPROD ? c[j] : c[j] * hc[j];
                pr -= PP; unpack8(*(const v4u*)(pr + O_U + ch), c); if (!UPROD) unpack8(*(const v4u*)(pr + C_HC + ch), hc);
#pragma unroll
                for (int j = 0; j < 8; ++j) u2[hf * 8 + j] = UPROD ? c[j] : c[j] * hc[j]; }
        }
#pragma unroll 1
        for (int r0 = 0; r0 < 16; r0 += CONVR) {
            v4u rb[CONVR][2], rc[CONVR][2], rh[CONVR][2];
#pragma unroll
            for (int rr = 0; rr < CONVR; ++rr) { const bf16* pr = proj + (rowbase + t0 + r0 + rr) * PP + lane * 8;
#pragma unroll
                for (int hf = 0; hf < 2; ++hf) { rb[rr][hf] = __builtin_nontemporal_load((const v4u*)(pr + O_B + hf * 512)); rc[rr][hf] = __builtin_nontemporal_load((const v4u*)(pr + O_U + hf * 512)); if (!UPROD) rh[rr][hf] = __builtin_nontemporal_load((const v4u*)(pr + C_HC + hf * 512)); } }
#pragma unroll
            for (int rr = 0; rr < CONVR; ++rr) { float y[16]; float ss = 0.f;
#pragma unroll
                for (int hf = 0; hf < 2; ++hf) { float bb[8], c[8], hc[8]; unpack8(rb[rr][hf], bb); unpack8(rc[rr][hf], c); if (!UPROD) unpack8(rh[rr][hf], hc);
#pragma unroll
                    for (int j = 0; j < 8; ++j) { const int jj = hf * 8 + j; const float u0 = UPROD ? c[j] : c[j] * hc[j];
                        y[jj] = bb[j] * (w0[jj] * u2[jj] + w1[jj] * u1[jj] + w2[jj] * u0); ss += y[jj] * y[jj]; u2[jj] = u1[jj]; u1[jj] = u0; } }
                ss = wsum(ss); const float rs = rsqf(ss * (1.0f / DCONV) + EPS);
#pragma unroll
                for (int hf = 0; hf < 2; ++hf) { float f[8];
#pragma unroll
                    for (int j = 0; j < 8; ++j) f[j] = y[hf * 8 + j] * rs;
                    if (FP8O) *(v2u*)(mixed8 + (rowbase + t0 + r0 + rr) * D + hf * 512 + lane * 8) = pack8_f8(f, F8_ASCALE);
                    else *(v4u*)(mixed + (rowbase + t0 + r0 + rr) * D + hf * 512 + lane * 8) = pack8(f); } }
        }
    }
    }
}
constexpr int NPHASE = 10;
struct Args { Ptrs P; int ph_lo, ph_hi; };
__device__ __forceinline__ void moe_tables(LAS unsigned char* ldsx, gu32* ctl, const int wave_) {
    const int tid = TIDX(wave_);
    __syncthreads();
    if (tid < 64) {
        const int n = (int)__hip_atomic_load(ctl + CW_CNT + 64 * tid, RLX_AGENT);
        int x = (n + 255) >> 8;
#pragma unroll
        for (int o = 1; o < 64; o <<= 1) { const int v = __shfl_up(x, o); if (tid >= o) x += v; }
        ((LAS int*)(ldsx + pg8::LST_OFF))[tid] = n;
        ((LAS int*)(ldsx + pg8::LST_OFF + 256))[tid + 1] = x;
        if (tid == 0) ((LAS int*)(ldsx + pg8::LST_OFF + 256))[0] = 0;
    }
    __syncthreads();
}
#ifndef STAG6
#define STAG6 0
#endif
#ifndef STAG9
#define STAG9 0
#endif
__device__ __forceinline__ void stagger(int vcu, int us) {
    if ((vcu & 1) && us > 0) { const unsigned long long t0 = __builtin_amdgcn_s_memrealtime(); while (__builtin_amdgcn_s_memrealtime() - t0 < (unsigned long long)us * 100ull) __builtin_amdgcn_s_sleep(16); }
}
__global__ void __launch_bounds__(NWAVES * 64, 2) mk_fwd(Args args) {
    extern __shared__ __attribute__((aligned(16))) unsigned char lds_raw[];
    LAS unsigned char* lds = (LAS unsigned char*)lds_raw;
    const Ptrs& P = args.P;
    const int wave = __builtin_amdgcn_readfirstlane((int)(threadIdx.x >> 6));
    const int tid = TIDX(wave);
    const int G = gridDim.x, bx = blockIdx.x, vcu = (G % 8 == 0) ? (bx % 8) * (G / 8) + bx / 8 : bx;
    unsigned char* ws = P.ws; gu32* ctl = (gu32*)(ws + WS_CTL);
    for (int u = tid; u < (pg8::LDS_BYTES - pg8::LDSX_OFF) / 4; u += NWAVES * 64) ((LAS unsigned*)(lds + pg8::LDSX_OFF))[u] = 0u;
    __syncthreads();
    if (tid == 0) *((volatile LAS unsigned*)(lds + pg8::MISC_OFF) + 10) = __hip_atomic_fetch_add((unsigned*)ctl + CW_RANK + 64 * xb_xcc_id(), 1u, __ATOMIC_RELAXED, __HIP_MEMORY_SCOPE_AGENT);
    __syncthreads();
    const int xc = __builtin_amdgcn_readfirstlane((int)(xb_xcc_id() * 32u + *((volatile LAS unsigned*)(lds + pg8::MISC_OFF) + 10)));
    const int lo = args.ph_lo, hi = args.ph_hi;
    XcdBarrier bar; bar.bar = (unsigned*)(ctl + CW_BAR); bar.x = 0; bar.st = nullptr;
    if (hi - lo > 1) bar = xcd_barrier_post((unsigned*)(ctl + CW_BAR), (volatile LAS unsigned*)(lds + pg8::MISC_OFF) + 8, wave);
#ifdef ONLY_PHASE
#define IN(k) ((k) == ONLY_PHASE && lo <= (k) && (k) < hi)
#else
#define IN(k) (lo <= (k) && (k) < hi)
#endif
#define SEAM(k) do { if (IN(k) && IN((k) + 1) && (k) != 7 && (k) != 8) xcd_barrier(bar, wave); } while (0)
#define SEAM79() do { if (IN(7) && IN(9)) xcd_barrier(bar, wave); } while (0)
    bf16* Win = (bf16*)(ws + WS_WIN); bf16* Wout = (bf16*)(ws + WS_WOUT); bf16* Wplg = (bf16*)(ws + WS_WPLG); bf16* Wple = (bf16*)(ws + WS_WPLE);
    bf16* Wr = (bf16*)(ws + WS_WR); bf16* Wgu = (bf16*)(ws + WS_WGU); bf16* Wd = (bf16*)(ws + WS_WD);
    bf16* xb = (bf16*)(ws + WS_XB); bf16* mixed = (bf16*)(ws + WS_MIX); bf16* pb = (bf16*)(ws + WS_PB); bf16* proj = (bf16*)(ws + WS_PROJ);
    bf16* hid = (bf16*)(ws + WS_HID); bf16* pw = (bf16*)(ws + WS_PW); bf16* h1 = (bf16*)(ws + WS_H1); bf16* h2 = (bf16*)(ws + WS_H2);
    float* rsx = (float*)(ws + WS_RSX); float* rs1 = (float*)(ws + WS_RS1); float* ss1p = (float*)(ws + WS_SS1P); float* ss2p = (float*)(ws + WS_SS2P);
    int* eid = (int*)(ws + WS_EID); float* ew = (float*)(ws + WS_EW); Ent* ent = (Ent*)(ws + WS_ENT);

    if (IN(0)) { p0_prologue(P, lds, vcu, G, wave); } SEAM(0);
    if (IN(1)) { pg8::Gemm g{xb, Win, M, FP8QKV ? C_Q : DIN, D}; pg8::CvtOrder S; S.init(M, FP8QKV ? C_Q : DIN, G, bx); pg8::EpiBf16 E{proj, PP, nullptr, 1.f, UPROD != 0};
        S.w = pg8::CvtWork{P.w_gate, P.w_up, P.w_down, P.norm_ffn, ws, vcu, G}; S.slot = DEFER_CVT ? (((vcu & 31) >> 2) % CVT_SLOTS) : -1; S.lo = 0; S.hi = CVT_SPLIT ? pg8::CvtWork::NGU : pg8::CvtWork::NIT;
        pg8::gemm_phase<pg8::EpiBf16, pg8::CvtOrder, true>(lds, g, S, E, wave);
        if (DEFER_CVT && S.nunits() - 1 <= S.slot) S.w.run(wave, S.lo, S.hi);
        if (FP8QKV) { pg8::Gemm g8{(const bf16*)(ws + WS_XB8), (const bf16*)(ws + WS_WIN8), M, NQKV, D / 2}; pg8::StaticOrder S8; S8.init(M, NQKV, G, bx); pg8::EpiBf16 E8{proj + C_Q, DIN, nullptr, F8_INV, false};
            pg8::gemm_phase<pg8::EpiBf16, pg8::StaticOrder, true, true>(lds, g8, S8, E8, wave); } } SEAM(1);
    const bool mids = MIDSCALE && !FP8O && (long)4 * G >= (M / 256) * (D / 256);
    if (IN(2)) { for (int unit = vcu; unit < BATCH * (SEQ / 128); unit += G) p2_unit(P, lds, unit, wave, (vcu & 1) != 0, !mids);     __syncthreads(); } SEAM(2);
    if (IN(3)) { pg8::Gemm g{FP8O ? (const bf16*)(ws + WS_MIX8) : mixed, Wout, M, D, FP8O ? D / 2 : D}; pg8::OutOrder S; S.init(M, D, G, bx); S.ldsx = lds; S.rsa = (const float*)(ws + WS_RS2); S.wave = wave; S.on = mids; pg8::EpiH1 E{xb, (const float*)(ws + WS_RMSX), h1, ss1p, FP8 ? ws + WS_H18 : nullptr, FP8O ? F8_INV : 1.f};
        S.w = pg8::CvtWork{P.w_gate, P.w_up, P.w_down, P.norm_ffn, ws, vcu, G}; S.slot = (DEFER_CVT && CVT_SPLIT == 2) ? (((vcu & 31) >> 2) % 3) : -1; S.lo = pg8::CvtWork::NGU; S.hi = pg8::CvtWork::NIT;
        S.fill_all();
        pg8::gemm_phase<pg8::EpiH1, pg8::OutOrder, true, FP8O != 0>(lds, g, S, E, wave);
        if (DEFER_CVT && CVT_SPLIT == 2 && S.nunits() - 1 <= S.slot) S.w.run(wave, S.lo, S.hi); } SEAM(3);
    if (IN(4)) { pg8::Gemm g{h1, Wr, M, 256, D}; pg8::StaticOrder S; S.init(M, 256, G, bx); pg8::EpiRouter E{ss1p, P.b_group, P.b_router, rs1, eid, ew, ent, (unsigned*)(ctl + CW_CNT)};
        pg8::gemm_phase<pg8::EpiRouter, pg8::StaticOrder, false>(lds, g, S, E, wave);
        __syncthreads();
        pg8::Gemm g2{pb, Wple, M, D, PLE}; pg8::PwOrder S2{G, bx, M / 256}; pg8::EpiF8 E2{(unsigned char*)pw, D, F8_PSCALE};
        pg8::gemm_phase<pg8::EpiF8, pg8::PwOrder, true>(lds, g2, S2, E2, wave); } SEAM(4);
    if (IN(5) || IN(6) || IN(7)) moe_tables(lds, ctl, wave);
    const LAS int* T0 = (const LAS int*)(lds + pg8::LST_OFF + 256);
    bool xs5 = XSEAM5 && IN(5) && IN(6) && G == 256;
    if (xs5) { for (int j = 0; j < 8; ++j) xs5 = xs5 && (xb_ld((unsigned*)ctl + CW_BAR + XB_XCNT(j)) == 32u); }
    if (IN(5)) { pg8::Gemm g{FP8 ? (const bf16*)(ws + WS_H18) : h1, Wgu, M, NE * 1024, FP8 ? D / 2 : D}; pg8::MoeOrder<true, 4> S{lds, ent, 0, T0[NLIST], G, vcu, wave, (const Ent*)(ctl + CW_ZERO)}; if (xs5) { S.xm = 1; S.c = xc; S.tsig = (unsigned*)ctl + CW_TD; } pg8::EpiGU E{hid, lds, FP8 ? F8_INV : 1.f, FP8 ? (unsigned char*)hid : nullptr};
        if (DEFER_CVT && CVT_SPLIT == 1) { S.w = pg8::CvtWork{P.w_gate, P.w_up, P.w_down, P.norm_ffn, ws, vcu, G}; S.slot = (vcu >> 2) % 3; }
        pg8::gemm_phase<pg8::EpiGU, pg8::MoeOrder<true, 4>, true, FP8 != 0>(lds, g, S, E, wave);
        if (DEFER_CVT && CVT_SPLIT == 1 && S.nunits() - 1 <= S.slot) S.w.run(wave, pg8::CvtWork::NGU, pg8::CvtWork::NIT); } if (!xs5) SEAM(5);
    if (IN(6)) { stagger(vcu, STAG6); pg8::Gemm g{hid, Wd, 0, NE * D, FP8 ? DEXP / 2 : DEXP}; pg8::MoeOrder<false, 8> S{lds, ent, 0, T0[NE], G, vcu, wave, (const Ent*)(ctl + CW_ZERO)}; if (xs5) { S.xm = 1; S.c = xc; S.twait = (unsigned*)ctl + CW_TD; } pg8::EpiDown<0> E{ws + WS_H28, lds, F8_DINV};
        pg8::gemm_phase<pg8::EpiDown<0>, pg8::MoeOrder<false, 8>, true, FP8 != 0>(lds, g, S, E, wave); } SEAM(6);
    if (IN(7)) { stagger(vcu, STAG6); pg8::Gemm g{hid, Wd, 0, NE * D, FP8 ? DEXP / 2 : DEXP}; pg8::MoeOrder<false, 8> S{lds, ent, T0[NE], T0[NLIST], G, vcu, wave, (const Ent*)(ctl + CW_ZERO)}; pg8::EpiDown<1> E{h1, h2, ss2p, lds, ws + WS_H28, F8_DINV};
        pg8::gemm_phase<pg8::EpiDown<1>, pg8::MoeOrder<false, 8>, true, FP8 != 0>(lds, g, S, E, wave); } SEAM79();
    if (IN(9)) { stagger(vcu, STAG9); pg8::Gemm g{FP8 ? (const bf16*)(ws + WS_H28) : h2, Wplg, M, D, FP8 ? D / 2 : D}; pg8::FinalOrder S; S.init(M, D, G, bx); S.ldsx = lds; S.ssp = ss2p; S.wave = wave; S.pre = (long)8 * G >= S.nwg; pg8::EpiFinal E{h2, (const unsigned char*)pw, P.out, lds, FP8 ? F8_INV : 1.f, S.pre}; if (S.pre) S.fill_all();
        pg8::gemm_phase<pg8::EpiFinal, pg8::FinalOrder, true, FP8 != 0>(lds, g, S, E, wave); }
#undef IN
#undef SEAM
}
extern "C" void kernel_launch(void* const* d_in, const int* in_sizes, int n_in, void* d_out, int out_size, void* d_ws, size_t ws_size, hipStream_t stream) {
    static int grid = 0;
    if (grid == 0) {
        if (n_in != 22 || in_sizes[0] != M * D || out_size != M * D || ws_size < WS_END) { fprintf(stderr, "kernel_launch: unexpected problem (n_in %d, in0 %d, out %d, ws %zu); nothing launched\n", n_in, n_in > 0 ? in_sizes[0] : -1, out_size, ws_size); grid = -1; return; }
        int dev = 0, cus = 0, per_cu = 0;
        if (hipGetDevice(&dev) != hipSuccess || hipDeviceGetAttribute(&cus, hipDeviceAttributeMultiprocessorCount, dev) != hipSuccess) { grid = -1; return; }
        if (hipFuncSetAttribute((const void*)mk_fwd, hipFuncAttributeMaxDynamicSharedMemorySize, pg8::LDS_BYTES) != hipSuccess) { fprintf(stderr, "kernel_launch: hipFuncSetAttribute failed\n"); grid = -1; return; }
        if (hipOccupancyMaxActiveBlocksPerMultiprocessor(&per_cu, (const void*)mk_fwd, NWAVES * 64, pg8::LDS_BYTES) != hipSuccess || per_cu < 1) { fprintf(stderr, "kernel_launch: occupancy query says %d workgroups per CU\n", per_cu); (void)hipGetLastError(); grid = -1; return; }
        grid = cus;
    }
    if (grid < 0) return;
    if (hipMemsetAsync((char*)d_ws + WS_CTL, 0, CTL_ZERO_BYTES, stream) != hipSuccess) return;
    Args a{};
    { const float** pp = (const float**)&a.P; for (int i = 0; i < 22; ++i) pp[i] = (const float*)d_in[i]; }
    a.P.out = (float*)d_out; a.P.ws = (unsigned char*)d_ws;
    a.ph_lo = 0; a.ph_hi = NPHASE;
    hipLaunchKernelGGL(mk_fwd, dim3(grid), dim3(NWAVES * 64), pg8::LDS_BYTES, stream, a);
}
```
